# Optimizing an MI355X kernel written in HIP

```python
import math
import jax
import jax.numpy as jnp
from jax import lax
import numpy as np

D_MODEL = 2048
BATCH = 2
SEQ = 4096
DEPTH = 4
DEC_BATCH = 4
DEC_SEQ = 4096
PAST_LEN = 128

PLE_DIM = 256
GRID_W = 64
RMS_EPS = 1e-6

A_HEADS = 8
A_DK = 128
A_DV = 128
A_CONV_W = 5
DN_CHUNK = 64

B_HEADS = 8
B_DH = 128
NA_ROWS = 8
NA_COLS = 16

C_HEADS = 8
C_DH = 128
ROPE_THETA = 500000.0
ROPE_DIMS = C_DH // 4
Q_BLOCK = 128

D_FF = 8192
FFN_CONV_W = 3

N_AB = (DEPTH + 1) // 2
N_C = DEPTH // 2
A_QK_W = A_HEADS * A_DK
A_V_W = A_HEADS * A_DV
A_QKV_W = 2 * A_QK_W + A_V_W
B_W = B_HEADS * B_DH
AB_IN = A_QKV_W + A_V_W + 4 * A_HEADS + 3 * B_W
AB_MIX = A_V_W + B_W
C_QK_W = C_HEADS * 2 * C_DH
C_V_W = C_HEADS * 2 * C_DH
C_IN = 2 * C_QK_W + C_V_W

kernel_name = 'hybrid_deltanet_natten_diffattn_encoder'


def rmsnorm(x, w):
    xf = x.astype(jnp.float32)
    y = xf * lax.rsqrt(jnp.mean(xf * xf, axis=-1, keepdims=True) + RMS_EPS)
    return (y * w.astype(jnp.float32)).astype(x.dtype)


def l2norm(x):
    return x * lax.rsqrt(jnp.sum(x * x, axis=-1, keepdims=True) + 1e-6)


def dwconv_centred(x, w):
    k, s = w.shape[0], x.shape[1]
    xp = jnp.pad(x, ((0, 0), (k // 2, k // 2), (0, 0)))
    return sum(xp[:, i:i + s] * w[i].astype(x.dtype) for i in range(k))


def gated_delta_chunked(q, k, v, g, beta):
    bn, h, s, dk = k.shape
    dv = v.shape[-1]
    c = DN_CHUNK
    n = s // c
    q, k, v = (t.reshape(bn, h, n, c, t.shape[-1]) for t in (q, k, v))
    g = jnp.cumsum(g.reshape(bn, h, n, c), axis=-1)
    beta = beta.reshape(bn, h, n, c)
    incl = jnp.tril(jnp.ones((c, c), dtype=bool))
    strict = jnp.tril(jnp.ones((c, c), dtype=bool), -1)
    decay = jnp.exp(jnp.where(incl, g[..., :, None] - g[..., None, :], -jnp.inf))
    kb = k * beta[..., None]
    lower = jnp.where(strict, jnp.einsum('bhnid,bhnjd->bhnij', kb, k) * decay, 0.0)
    rhs = jnp.concatenate([v * beta[..., None], kb * jnp.exp(g)[..., None]], axis=-1)
    sol = lax.linalg.triangular_solve(lower + jnp.eye(c, dtype=lower.dtype), rhs,
                                      left_side=True, lower=True)
    u, w = sol[..., :dv], sol[..., dv:]
    intra = jnp.einsum('bhnid,bhnjd->bhnij', q, k) * decay

    def step(state, xs):
        q_c, k_c, u_c, w_c, g_c, a_c = xs
        v_new = u_c - jnp.einsum('bhck,bhkv->bhcv', w_c, state)
        o = (jnp.einsum('bhck,bhkv->bhcv', q_c * jnp.exp(g_c)[..., None], state)
             + jnp.einsum('bhcm,bhmv->bhcv', a_c, v_new))
        g_last = g_c[..., -1]
        state = (state * jnp.exp(g_last)[..., None, None]
                 + jnp.einsum('bhck,bhcv->bhkv', k_c * jnp.exp(g_last[..., None] - g_c)[..., None], v_new))
        return state, o

    xs = tuple(jnp.moveaxis(t, 2, 0) for t in (q, k, u, w, g, intra))
    _, o = lax.scan(step, jnp.zeros((bn, h, dk, dv), jnp.float32), xs)
    return jnp.moveaxis(o, 0, 2).reshape(bn, h, s, dv)


def deltanet_mixer(qkv, z, gates, conv_w, a_log, dt_bias, out_norm):
    bn, s, _ = qkv.shape
    f32 = jnp.float32
    qkv = jax.nn.silu(dwconv_centred(qkv, conv_w)).astype(f32)
    q = l2norm(qkv[..., :A_QK_W].reshape(bn, s, A_HEADS, A_DK)) * (A_DK ** -0.5)
    k = l2norm(qkv[..., A_QK_W:2 * A_QK_W].reshape(bn, s, A_HEADS, A_DK))
    v = qkv[..., 2 * A_QK_W:].reshape(bn, s, A_HEADS, A_DV)
    gates = gates.astype(f32).reshape(bn, s, 2, 2, A_HEADS)
    g = -jnp.exp(a_log.astype(f32)) * jax.nn.softplus(gates[:, :, 0] + dt_bias.astype(f32))
    beta = jax.nn.sigmoid(gates[:, :, 1])
    qh, kh, vh = (jnp.moveaxis(t, 1, 2) for t in (q, k, v))
    gh = jnp.moveaxis(g, 1, -1)
    bh = jnp.moveaxis(beta, 1, -1)
    o_fwd = gated_delta_chunked(qh, kh, vh, gh[:, 0], bh[:, 0])
    o_bwd = jnp.flip(gated_delta_chunked(jnp.flip(qh, 2), jnp.flip(kh, 2), jnp.flip(vh, 2),
                                         jnp.flip(gh[:, 1], -1), jnp.flip(bh[:, 1], -1)), 2)
    o = jnp.moveaxis(o_fwd + o_bwd, 1, 2)
    o = rmsnorm(o, out_norm) * jax.nn.silu(z.astype(f32).reshape(bn, s, A_HEADS, A_DV))
    return o.reshape(bn, s, A_V_W).astype(z.dtype)


def neighbourhood_attention(q, k, v, rpb):
    bn, s, h, d = q.shape
    rows = s // GRID_W
    wr = min(NA_ROWS, rows)
    r = np.arange(rows)
    row_start = np.clip(r - wr // 2, 0, rows - wr)
    row_idx = row_start[:, None] + np.arange(wr)[None, :]
    c = np.arange(GRID_W)
    col_start = np.clip(c - NA_COLS // 2, 0, GRID_W - NA_COLS)
    col_in = (c[None, :] >= col_start[:, None]) & (c[None, :] < col_start[:, None] + NA_COLS)
    dr = row_idx - r[:, None] + NA_ROWS - 1
    dc = np.clip(c[None, :] - c[:, None] + NA_COLS - 1, 0, 2 * NA_COLS - 2)
    bias = rpb[:, dr[:, None, :, None], dc[None, :, None, :]]
    bias = jnp.where(col_in[None, None, :, None, :], bias, -jnp.inf)
    qg = q.reshape(bn, rows, GRID_W, h, d)
    kg = k.reshape(bn, rows, GRID_W, h, d)[:, row_idx]
    vg = v.reshape(bn, rows, GRID_W, h, d)[:, row_idx]
    sc = jnp.einsum('brchd,brikhd->bhrcik', qg, kg, preferred_element_type=jnp.float32) * (d ** -0.5)
    p = jax.nn.softmax(sc + bias[None].astype(jnp.float32), axis=(-2, -1))
    o = jnp.einsum('bhrcik,brikhd->brchd', p.astype(v.dtype), vg)
    return o.reshape(bn, s, h * d)


def partial_rope(x, cos, sin):
    half = ROPE_DIMS // 2
    xf = x[..., :ROPE_DIMS].astype(jnp.float32)
    x1, x2 = xf[..., :half], xf[..., half:]
    cb = cos[None, :, None, None, :]
    sb = sin[None, :, None, None, :]
    rot = jnp.concatenate([x1 * cb - x2 * sb, x2 * cb + x1 * sb], axis=-1)
    return jnp.concatenate([rot.astype(x.dtype), x[..., ROPE_DIMS:]], axis=-1)


def rope_tables(s):
    inv = ROPE_THETA ** (-jnp.arange(0, ROPE_DIMS, 2, dtype=jnp.float32) / ROPE_DIMS)
    ang = jnp.arange(s, dtype=jnp.float32)[:, None] * inv[None, :]
    return jnp.cos(ang), jnp.sin(ang)


def mixer_ab(hn, w_in, conv_w, a_log, dt_bias, out_norm, rpb, w_out):
    bn, s, _ = hn.shape
    proj = hn @ w_in
    o1 = A_QKV_W
    o2 = o1 + A_V_W
    o3 = o2 + 4 * A_HEADS
    o_a = deltanet_mixer(proj[..., :o1], proj[..., o1:o2], proj[..., o2:o3],
                         conv_w, a_log, dt_bias, out_norm)
    qkv_b = proj[..., o3:].reshape(bn, s, 3, B_HEADS, B_DH)
    o_b = neighbourhood_attention(qkv_b[:, :, 0], qkv_b[:, :, 1], qkv_b[:, :, 2], rpb)
    return jnp.concatenate([o_a, o_b], axis=-1) @ w_out


def mixer_c(hn, w_in, lam_params, subln_w, w_out, cos, sin, layer):
    bn, s, _ = hn.shape
    proj = hn @ w_in
    q = proj[..., :C_QK_W].reshape(bn, s, C_HEADS, 2, C_DH)
    k = proj[..., C_QK_W:2 * C_QK_W].reshape(bn, s, C_HEADS, 2, C_DH)
    v = proj[..., 2 * C_QK_W:].reshape(bn, s, C_HEADS, 2 * C_DH)
    q = partial_rope(q, cos, sin)
    k = partial_rope(k, cos, sin)
    lambda_init = 0.8 - 0.6 * math.exp(-0.3 * layer)
    lp = lam_params.astype(jnp.float32)
    lam = jnp.exp(jnp.sum(lp[0] * lp[1])) - jnp.exp(jnp.sum(lp[2] * lp[3])) + lambda_init
    scale = C_DH ** -0.5
    nblk = s // Q_BLOCK
    qb = jnp.moveaxis(q.reshape(bn, nblk, Q_BLOCK, C_HEADS, 2, C_DH), 1, 0)

    def block(q_blk):
        sc = jnp.einsum('bqhjd,bkhjd->bhjqk', q_blk, k, preferred_element_type=jnp.float32) * scale
        pm = jax.nn.softmax(sc, axis=-1)
        a = pm[:, :, 0] - lam * pm[:, :, 1]
        return jnp.einsum('bhqk,bkhe->bqhe', a.astype(v.dtype), v)

    o = lax.map(block, qb)
    o = jnp.moveaxis(o, 0, 1).reshape(bn, s, C_HEADS, 2 * C_DH)
    o = rmsnorm(o, subln_w) * (1.0 - lambda_init)
    return o.reshape(bn, s, C_V_W) @ w_out


def conv_ffn(x, w_in, conv_w, conv_b, w_out):
    hid = dwconv_centred(x @ w_in, conv_w) + conv_b.astype(x.dtype)
    gate, up = hid[..., :D_FF], hid[..., D_FF:]
    return (jax.nn.gelu(gate, approximate=True) * up) @ w_out


def trunk(x, p, ab_w_in, ab_conv_w, ab_a_log, ab_dt_bias, ab_out_norm, ab_rpb, ab_w_out,
          c_w_in, c_lambda, c_subln, c_w_out, norms, ffn_w_in, ffn_conv_w, ffn_conv_b,
          ffn_w_out, ple_w_proj, ple_w_gate):
    cos, sin = rope_tables(x.shape[1])
    h = x
    for layer in range(DEPTH):
        j = layer // 2
        hn = rmsnorm(h, norms[layer, 0])
        if layer % 2 == 0:
            mix = mixer_ab(hn, ab_w_in[j], ab_conv_w[j], ab_a_log[j], ab_dt_bias[j],
                           ab_out_norm[j], ab_rpb[j], ab_w_out[j])
        else:
            mix = mixer_c(hn, c_w_in[j], c_lambda[j], c_subln[j], c_w_out[j], cos, sin, layer)
        h = h + rmsnorm(mix, norms[layer, 1])
        f = conv_ffn(rmsnorm(h, norms[layer, 2]), ffn_w_in[layer], ffn_conv_w[layer],
                     ffn_conv_b[layer], ffn_w_out[layer])
        h = h + rmsnorm(f, norms[layer, 3])
        h = h + jax.nn.sigmoid(h @ ple_w_gate[layer]) * (p[layer] @ ple_w_proj[layer])
    return h


def setup_inputs(seed: int = 0) -> dict:
    key = jax.random.key(seed)
    ks = jax.random.split(key, 24)
    f32 = jnp.float32

    def nrm(k, shape, scale):
        return jax.random.normal(k, shape, f32) * scale

    dt = jnp.exp(jax.random.uniform(ks[7], (N_AB, 2, A_HEADS), f32, math.log(1e-3), math.log(1e-1)))
    return {
        'x_prompt': nrm(ks[0], (BATCH, SEQ, D_MODEL), 1.0),
        'x_sample': nrm(ks[1], (DEC_BATCH, DEC_SEQ, D_MODEL), 1.0),
        'p_prompt': nrm(ks[2], (DEPTH, BATCH, SEQ, PLE_DIM), 1.0),
        'p_sample': nrm(ks[3], (DEPTH, DEC_BATCH, DEC_SEQ, PLE_DIM), 1.0),
        'ab_w_in': nrm(ks[4], (N_AB, D_MODEL, AB_IN), D_MODEL ** -0.5),
        'ab_conv_w': nrm(ks[5], (N_AB, A_CONV_W, A_QKV_W), A_CONV_W ** -0.5),
        'ab_a_log': jnp.log(jax.random.uniform(ks[6], (N_AB, 2, A_HEADS), f32, 1.0, 16.0)),
        'ab_dt_bias': dt + jnp.log(-jnp.expm1(-dt)),
        'ab_out_norm': 1.0 + nrm(ks[8], (N_AB, A_DV), 0.05),
        'ab_rpb': nrm(ks[9], (N_AB, B_HEADS, 2 * NA_ROWS - 1, 2 * NA_COLS - 1), 0.1),
        'ab_w_out': nrm(ks[10], (N_AB, AB_MIX, D_MODEL), AB_MIX ** -0.5),
        'c_w_in': nrm(ks[11], (N_C, D_MODEL, C_IN), D_MODEL ** -0.5),
        'c_lambda': nrm(ks[12], (N_C, 4, C_DH), 0.1),
        'c_subln': 1.0 + nrm(ks[13], (N_C, 2 * C_DH), 0.05),
        'c_w_out': nrm(ks[14], (N_C, C_V_W, D_MODEL), C_V_W ** -0.5),
        'norms': 1.0 + nrm(ks[15], (DEPTH, 4, D_MODEL), 0.05),
        'ffn_w_in': nrm(ks[16], (DEPTH, D_MODEL, 2 * D_FF), D_MODEL ** -0.5),
        'ffn_conv_w': nrm(ks[17], (DEPTH, FFN_CONV_W, 2 * D_FF), FFN_CONV_W ** -0.5),
        'ffn_conv_b': nrm(ks[18], (DEPTH, 2 * D_FF), 0.01),
        'ffn_w_out': nrm(ks[19], (DEPTH, D_FF, D_MODEL), D_FF ** -0.5),
        'ple_w_proj': nrm(ks[20], (DEPTH, PLE_DIM, D_MODEL), PLE_DIM ** -0.5),
        'ple_w_gate': nrm(ks[21], (DEPTH, D_MODEL, D_MODEL), D_MODEL ** -0.5),
    }


def reference(x_prompt, x_sample, p_prompt, p_sample, ab_w_in, ab_conv_w, ab_a_log, ab_dt_bias,
              ab_out_norm, ab_rpb, ab_w_out, c_w_in, c_lambda, c_subln, c_w_out, norms,
              ffn_w_in, ffn_conv_w, ffn_conv_b, ffn_w_out, ple_w_proj, ple_w_gate):
    y_prompt = trunk(x_prompt, p_prompt, ab_w_in, ab_conv_w, ab_a_log, ab_dt_bias, ab_out_norm,
                     ab_rpb, ab_w_out, c_w_in, c_lambda, c_subln, c_w_out, norms, ffn_w_in,
                     ffn_conv_w, ffn_conv_b, ffn_w_out, ple_w_proj, ple_w_gate)
    y_sample = trunk(x_sample, p_sample, ab_w_in, ab_conv_w, ab_a_log, ab_dt_bias, ab_out_norm,
                     ab_rpb, ab_w_out, c_w_in, c_lambda, c_subln, c_w_out, norms, ffn_w_in,
                     ffn_conv_w, ffn_conv_b, ffn_w_out, ple_w_proj, ple_w_gate)
    return (y_prompt, y_sample)
```

```cpp
#ifndef EMU
#include <hip/hip_runtime.h>
#include <cstdio>
#include <cstdint>
#include <cstring>
#define DEVFN __device__ __forceinline__
#else
#include <cstdio>
#include <cstdint>
#include <cstdlib>
#include <cstring>
#include <cmath>
#include <vector>
#define DEVFN static inline
#endif
#include <cmath>

#ifndef EMU
constexpr int D = 2048, NSEQ = 6, NPROMPT = 2, S = 4096, PLE = 256, DFF = 8192;
#else
constexpr int D = 256, NSEQ = 2, NPROMPT = 1, S = 1024, PLE = 64, DFF = 512;
#endif
constexpr int T = NSEQ * S, DEPTH = 4, NH = 8, DH = 128;
constexpr int AQKV = 3072, ABIN = 7200, ABINP = 7424, ABMIX = 2048, CIN = 6144, CV = 2048;
constexpr int COL_Z = 3072, COL_G = 4096, COL_QB = 4128, COL_KB = 4128 + 1024, COL_VB = 4128 + 2048;
constexpr int GW = 64, ROWS = S / GW, NAR = 8, NAC = 16, WR = (NAR < ROWS ? NAR : ROWS);
constexpr float RMS_EPS = 1e-6f;

typedef unsigned short bf16;
DEVFN float bf2f(bf16 b) { unsigned u = ((unsigned)b) << 16; float f; memcpy(&f, &u, 4); return f; }
DEVFN bf16 f2bf(float f) { unsigned u; memcpy(&u, &f, 4); u += 0x7fffu + ((u >> 16) & 1u); return (bf16)(u >> 16); }
DEVFN float siluf(float x) { return x / (1.f + expf(-x)); }
DEVFN float sigmoidf(float x) { return 1.f / (1.f + expf(-x)); }
DEVFN float softplusf(float x) { return x > 20.f ? x : log1pf(expf(x)); }
DEVFN int clampi(int v, int lo, int hi) { return v < lo ? lo : (v > hi ? hi : v); }

constexpr size_t MiB = 1u << 20;
constexpr size_t SZ_TD2 = (size_t)T * D * 2, SZ_TD4 = (size_t)T * D * 4;
constexpr size_t al(size_t x) { return (x + MiB - 1) / MiB * MiB; }
constexpr size_t WS_CTL = 0;
constexpr size_t WS_WABIN = 2 * MiB;
constexpr size_t WS_WABOUT = WS_WABIN + al((size_t)2 * ABINP * D * 2);
constexpr size_t WS_WCIN = WS_WABOUT + al((size_t)2 * D * ABMIX * 2);
constexpr size_t WS_WCOUT = WS_WCIN + al((size_t)2 * CIN * D * 2);
constexpr size_t WS_WFIN = WS_WCOUT + al((size_t)2 * D * CV * 2);
constexpr size_t WS_WFOUT = WS_WFIN + al((size_t)4 * 2 * DFF * D * 2);
constexpr size_t WS_WPP = WS_WFOUT + al((size_t)4 * D * DFF * 2);
constexpr size_t WS_WPG = WS_WPP + al((size_t)4 * D * PLE * 2);
constexpr size_t WS_HN = WS_WPG + al((size_t)4 * D * D * 2);
constexpr size_t WS_MIXIN = WS_HN + al(SZ_TD2);
constexpr size_t WS_PB = WS_MIXIN + al((size_t)T * 2048 * 2);
constexpr size_t WS_SMALL = WS_PB + al((size_t)T * PLE * 2);
constexpr size_t WS_RSTD = WS_SMALL, WS_G = WS_SMALL + al((size_t)T * 4), WS_BETA = WS_G + al((size_t)T * 16 * 4), WS_LAM = WS_BETA + al((size_t)T * 16 * 4);
constexpr size_t WS_R = WS_LAM + MiB;
constexpr size_t WS_GOUT = WS_R;
constexpr size_t WS_GOUT2 = WS_GOUT + al(SZ_TD4);
constexpr size_t WS_HID = WS_R;
constexpr size_t WS_ACT = WS_HID + al((size_t)T * 2 * DFF * 2);
constexpr size_t WS_PROJ = WS_GOUT + al(SZ_TD4);
constexpr size_t WS_X1 = WS_PROJ + al((size_t)T * ABINP * 2);
constexpr size_t SZ_HD4 = al((size_t)T * NH * DH * 4);
constexpr size_t WS_QN = WS_X1, WS_KN = WS_QN + SZ_HD4, WS_VV = WS_KN + SZ_HD4, WS_OF = WS_VV + SZ_HD4, WS_OB = WS_OF + SZ_HD4, WS_NASC = WS_OB + SZ_HD4;
constexpr size_t WS_END_AB = WS_NASC + SZ_HD4;
constexpr size_t WS_O0 = WS_X1, WS_O1 = WS_O0 + al((size_t)T * 2048 * 4);
constexpr size_t WS_END_C = WS_O1 + al((size_t)T * 2048 * 4);
constexpr size_t WS_END_F = WS_ACT + al((size_t)T * DFF * 2);
constexpr size_t WS_END = (WS_END_AB > WS_END_C ? (WS_END_AB > WS_END_F ? WS_END_AB : WS_END_F) : (WS_END_C > WS_END_F ? WS_END_C : WS_END_F));
#ifndef EMU
static_assert(WS_END <= (size_t)2048 * MiB, "workspace map exceeds 2 GiB");
#endif

struct P {
    const float *x_prompt, *x_sample, *p_prompt, *p_sample, *ab_w_in, *ab_conv_w, *ab_a_log, *ab_dt_bias, *ab_out_norm, *ab_rpb, *ab_w_out,
        *c_w_in, *c_lambda, *c_subln, *c_w_out, *norms, *ffn_w_in, *ffn_conv_w, *ffn_conv_b, *ffn_w_out, *ple_w_proj, *ple_w_gate;
    float* h;
    unsigned char* ws;
};
#define WSP(type, off) ((type*)(p.ws + (off)))
constexpr long N_INIT = (long)T * D / 4;
DEVFN void st_init(const P& p, int, long g) {
    const long i = g * 4, np = (long)NPROMPT * S * D;
    const float* src = i < np ? p.x_prompt + i : p.x_sample + (i - np);
    for (int k = 0; k < 4; ++k) p.h[i + k] = src[k];
}
constexpr long N_PB = (long)T * PLE;
DEVFN void st_pb(const P& p, int layer, long g) {
    const long np = (long)NPROMPT * S * PLE, ns = (long)(NSEQ - NPROMPT) * S * PLE;
    const float v = g < np ? p.p_prompt[(long)layer * np + g] : p.p_sample[(long)layer * ns + (g - np)];
    WSP(bf16, WS_PB)[g] = f2bf(v);
}
struct WT { const float* W; bf16* O; int K, N, Npad; };
DEVFN void st_wt(const WT& w, long g) {
    const int n = (int)(g / w.K), k = (int)(g % w.K);
    w.O[g] = n < w.N ? f2bf(w.W[(size_t)k * w.N + n]) : (bf16)0;
}
constexpr long N_ROWS = T;
DEVFN void st_rowss(const P& p, const float* x, long g) {
    const float* r = x + (size_t)g * D; float s = 0.f;
    for (int c = 0; c < D; ++c) s += r[c] * r[c];
    WSP(float, WS_RSTD)[g] = 1.0f / sqrtf(s / (float)D + RMS_EPS);
}
constexpr long N_TD = (long)T * D;
DEVFN void st_norm_bf16(const P& p, const float* w, long g) {
    const long t = g / D; const int c = (int)(g % D);
    WSP(bf16, WS_HN)[g] = f2bf(p.h[g] * WSP(float, WS_RSTD)[t] * w[c]);
}
DEVFN void st_resid(const P& p, const float* y, const float* w, int write_hb, long g) {
    const long t = g / D; const int c = (int)(g % D);
    const float v = p.h[g] + y[g] * WSP(float, WS_RSTD)[t] * w[c];
    p.h[g] = v; if (write_hb) WSP(bf16, WS_HN)[g] = f2bf(v);
}
constexpr long N_TH = (long)T * NH;
DEVFN void st_dn_prep(const P& p, int layer, long g) {
    const int j = layer / 2; const long t = g / NH; const int hh = (int)(g % NH); const int tt = (int)(t % S); const long t0 = t - tt;
    const bf16* proj = WSP(bf16, WS_PROJ); const float* cw = p.ab_conv_w + (size_t)j * 5 * AQKV;
    for (int part = 0; part < 3; ++part) {
        float* o = (part == 0 ? WSP(float, WS_QN) : (part == 1 ? WSP(float, WS_KN) : WSP(float, WS_VV))) + (size_t)g * DH; float ss = 0.f;
        for (int d = 0; d < DH; ++d) {
            const int col = part * 1024 + hh * DH + d; float acc = 0.f;
            for (int i = 0; i < 5; ++i) { const int ts = tt + i - 2; if (ts >= 0 && ts < S) acc += bf2f(proj[(size_t)(t0 + ts) * ABINP + col]) * cw[i * AQKV + col]; }
            const float y = siluf(acc); ss += y * y; o[d] = y;
        }
        if (part < 2) { const float r = (1.0f / sqrtf(ss + 1e-6f)) * (part == 0 ? 0.08838834764831845f : 1.f); for (int d = 0; d < DH; ++d) o[d] *= r; }
    }
    for (int dir = 0; dir < 2; ++dir) {
        const float graw = bf2f(proj[(size_t)t * ABINP + COL_G + dir * NH + hh]), braw = bf2f(proj[(size_t)t * ABINP + COL_G + 16 + dir * NH + hh]);
        const float a = expf(p.ab_a_log[(j * 2 + dir) * NH + hh]), dtb = p.ab_dt_bias[(j * 2 + dir) * NH + hh];
        WSP(float, WS_G)[(t * 2 + dir) * NH + hh] = -a * softplusf(graw + dtb);
        WSP(float, WS_BETA)[(t * 2 + dir) * NH + hh] = sigmoidf(braw);
    }
}
constexpr long N_SCAN = (long)NSEQ * NH * 2 * DH;
DEVFN void st_dn_scan(const P& p, int, long g) {
    const int vc = (int)(g % DH); const int dir = (int)((g / DH) % 2); const int hh = (int)((g / (2 * DH)) % NH); const int seq = (int)(g / (2 * DH * NH));
    const float *QN = WSP(float, WS_QN), *KN = WSP(float, WS_KN), *VV = WSP(float, WS_VV), *G = WSP(float, WS_G), *BT = WSP(float, WS_BETA);
    float* O = WSP(float, dir ? WS_OB : WS_OF);
    float Sx[DH];
#pragma unroll
    for (int d = 0; d < DH; ++d) Sx[d] = 0.f;
    for (int step = 0; step < S; ++step) {
        const int tt = dir ? S - 1 - step : step; const long t = (long)seq * S + tt;
        const float eg = expf(G[(t * 2 + dir) * NH + hh]), b = BT[(t * 2 + dir) * NH + hh];
        const float* kp = KN + ((size_t)t * NH + hh) * DH; const float* qp = QN + ((size_t)t * NH + hh) * DH; const float vv = VV[((size_t)t * NH + hh) * DH + vc];
        float dot = 0.f;
#pragma unroll
        for (int d = 0; d < DH; ++d) { Sx[d] *= eg; dot += Sx[d] * kp[d]; }
        const float delta = b * (vv - dot); float o = 0.f;
#pragma unroll
        for (int d = 0; d < DH; ++d) { Sx[d] += kp[d] * delta; o += Sx[d] * qp[d]; }
        O[((size_t)t * NH + hh) * DH + vc] = o;
    }
}
DEVFN void st_dn_out(const P& p, int layer, long g) {
    const int j = layer / 2; const long t = g / NH; const int hh = (int)(g % NH);
    const float *OF = WSP(float, WS_OF) + (size_t)g * DH, *OB = WSP(float, WS_OB) + (size_t)g * DH; const float* on = p.ab_out_norm + j * DH;
    float ss = 0.f; for (int d = 0; d < DH; ++d) { const float o = OF[d] + OB[d]; ss += o * o; }
    const float r = 1.0f / sqrtf(ss / (float)DH + RMS_EPS);
    const bf16* z = WSP(bf16, WS_PROJ) + (size_t)t * ABINP + COL_Z + hh * DH; bf16* out = WSP(bf16, WS_MIXIN) + (size_t)t * ABMIX + hh * DH;
    for (int d = 0; d < DH; ++d) out[d] = f2bf((OF[d] + OB[d]) * r * on[d] * siluf(bf2f(z[d])));
}
constexpr long N_THD = (long)T * NH * DH;
DEVFN long na_key_token(long t, int jw, int& dr, int& dc) {
    const int tt = (int)(t % S); const long t0 = t - tt; const int r = tt / GW, c = tt % GW;
    const int rs = clampi(r - WR / 2, 0, ROWS - WR), cs = clampi(c - NAC / 2, 0, GW - NAC);
    const int rk = rs + jw / NAC, ck = cs + jw % NAC;
    dr = rk - r + NAR - 1; dc = clampi(ck - c + NAC - 1, 0, 2 * NAC - 2);
    return t0 + (long)rk * GW + ck;
}
DEVFN void st_na_scores(const P& p, int layer, long g) {
    const int j = layer / 2; const int jw = (int)(g % DH); const int hh = (int)((g / DH) % NH); const long t = g / (DH * NH);
    int dr, dc; const long tk = na_key_token(t, jw, dr, dc);
    const bf16* q = WSP(bf16, WS_PROJ) + (size_t)t * ABINP + COL_QB + hh * DH; const bf16* k = WSP(bf16, WS_PROJ) + (size_t)tk * ABINP + COL_KB + hh * DH;
    float dot = 0.f; for (int d = 0; d < DH; ++d) dot += bf2f(q[d]) * bf2f(k[d]);
    WSP(float, WS_NASC)[g] = dot * 0.08838834764831845f + p.ab_rpb[(((size_t)j * NH + hh) * (2 * NAR - 1) + dr) * (2 * NAC - 1) + dc];
}
DEVFN void st_na_out(const P& p, int, long g) {
    const int d = (int)(g % DH); const int hh = (int)((g / DH) % NH); const long t = g / (DH * NH);
    const float* sc = WSP(float, WS_NASC) + ((size_t)t * NH + hh) * DH;
    float m = sc[0]; for (int jw = 1; jw < WR * NAC; ++jw) m = fmaxf(m, sc[jw]);
    float l = 0.f, o = 0.f;
    for (int jw = 0; jw < WR * NAC; ++jw) { int dr, dc; const long tk = na_key_token(t, jw, dr, dc); const float e = expf(sc[jw] - m); l += e;
        o += e * bf2f(WSP(bf16, WS_PROJ)[(size_t)tk * ABINP + COL_VB + hh * DH + d]); }
    WSP(bf16, WS_MIXIN)[(size_t)t * ABMIX + 1024 + hh * DH + d] = f2bf(o / l);
}
DEVFN float lambda_init_of(int layer) { return 0.8f - 0.6f * expf(-0.3f * (float)layer); }
DEVFN void st_lam(const P& p, int layer, long) {
    const float* lp = p.c_lambda + (size_t)(layer / 2) * 4 * DH; float a = 0.f, b = 0.f;
    for (int d = 0; d < DH; ++d) { a += lp[d] * lp[DH + d]; b += lp[2 * DH + d] * lp[3 * DH + d]; }
    WSP(float, WS_LAM)[0] = expf(a) - expf(b) + lambda_init_of(layer);
}
constexpr long N_ROPE = (long)T * 2 * 16 * 16;
DEVFN void st_rope(const P& p, int, long g) {
    const int i = (int)(g % 16); const int hj = (int)((g / 16) % 16); const int which = (int)((g / 256) % 2); const long t = g / 512;
    bf16* x = WSP(bf16, WS_PROJ) + (size_t)t * CIN + which * 2048 + hj * DH;
    const float inv = powf(500000.0f, -(float)(2 * i) / 32.0f); const float ang = (float)(t % S) * inv; const float cs = cosf(ang), sn = sinf(ang);
    const float x1 = bf2f(x[i]), x2 = bf2f(x[16 + i]);
    x[i] = f2bf(x1 * cs - x2 * sn); x[16 + i] = f2bf(x2 * cs + x1 * sn);
}
constexpr int DA_E = 64;
constexpr long N_DATT = (long)NSEQ * NH * 2 * (256 / DA_E) * S;
DEVFN void st_dattn(const P& p, int, long g) {
    const int qi = (int)(g % S); long r = g / S; const int es = (int)(r % (256 / DA_E)); r /= (256 / DA_E); const int jj = (int)(r % 2); r /= 2; const int hh = (int)(r % NH); const int seq = (int)(r / NH);
    const bf16* proj = WSP(bf16, WS_PROJ); const long t = (long)seq * S + qi;
    float q[DH];
#pragma unroll
    for (int d = 0; d < DH; ++d) q[d] = bf2f(proj[(size_t)t * CIN + hh * 256 + jj * DH + d]) * 0.08838834764831845f;
    float o[DA_E];
#pragma unroll
    for (int e = 0; e < DA_E; ++e) o[e] = 0.f;
    float m = -1e30f, l = 0.f;
    for (int kk = 0; kk < S; ++kk) {
        const bf16* kr = proj + (size_t)((long)seq * S + kk) * CIN + 2048 + hh * 256 + jj * DH; const bf16* vr = proj + (size_t)((long)seq * S + kk) * CIN + 4096 + hh * 256 + es * DA_E;
        float s = 0.f;
#pragma unroll
        for (int d = 0; d < DH; ++d) s += q[d] * bf2f(kr[d]);
        const float mn = fmaxf(m, s), al = expf(m - mn), pe = expf(s - mn); m = mn; l = l * al + pe;
#pragma unroll
        for (int e = 0; e < DA_E; ++e) o[e] = o[e] * al + pe * bf2f(vr[e]);
    }
    float* O = WSP(float, jj ? WS_O1 : WS_O0) + (size_t)t * 2048 + hh * 256 + es * DA_E; const float il = 1.0f / l;
#pragma unroll
    for (int e = 0; e < DA_E; ++e) O[e] = o[e] * il;
}
DEVFN void st_c_out(const P& p, int layer, long g) {
    const int j = layer / 2; const long t = g / NH; const int hh = (int)(g % NH); const float lam = WSP(float, WS_LAM)[0], li = lambda_init_of(layer);
    const float *O0 = WSP(float, WS_O0) + (size_t)t * 2048 + hh * 256, *O1 = WSP(float, WS_O1) + (size_t)t * 2048 + hh * 256; const float* sw = p.c_subln + j * 256;
    float ss = 0.f; for (int e = 0; e < 256; ++e) { const float o = O0[e] - lam * O1[e]; ss += o * o; }
    const float r = (1.0f / sqrtf(ss / 256.0f + RMS_EPS)) * (1.0f - li);
    bf16* out = WSP(bf16, WS_MIXIN) + (size_t)t * 2048 + hh * 256;
    for (int e = 0; e < 256; ++e) out[e] = f2bf((O0[e] - lam * O1[e]) * r * sw[e]);
}
constexpr long N_ACT = (long)T * DFF;
DEVFN float gelu_tanh(float x) { return 0.5f * x * (1.0f + tanhf(0.7978845608028654f * (x + 0.044715f * x * x * x))); }
DEVFN void st_ffn_act(const P& p, int layer, long g) {
    const long t = g / DFF; const int c = (int)(g % DFF); const int tt = (int)(t % S);
    const bf16* hid = WSP(bf16, WS_HID); const float* cw = p.ffn_conv_w + (size_t)layer * 3 * 2 * DFF; const float* cb = p.ffn_conv_b + (size_t)layer * 2 * DFF;
    float ga = cb[c], up = cb[DFF + c];
    for (int i = 0; i < 3; ++i) { const int ts = tt + i - 1; if (ts >= 0 && ts < S) { const bf16* r = hid + (size_t)(t - tt + ts) * (2 * DFF);
        ga += bf2f(r[c]) * cw[i * 2 * DFF + c]; up += bf2f(r[DFF + c]) * cw[i * 2 * DFF + DFF + c]; } }
    WSP(bf16, WS_ACT)[g] = f2bf(gelu_tanh(ga) * up);
}
DEVFN void st_ple(const P& p, int, long g) { p.h[g] += sigmoidf(WSP(float, WS_GOUT)[g]) * WSP(float, WS_GOUT2)[g]; }
#ifndef EMU
namespace pg8 {
#define PG8_LAS __attribute__((address_space(3)))
typedef unsigned short bf16_t;
typedef short bf16x8 __attribute__((ext_vector_type(8)));
typedef float f32x4 __attribute__((ext_vector_type(4)));
typedef unsigned u32x4 __attribute__((ext_vector_type(4)));
constexpr int BM = 256, BK = 64, HALF = 128, HTB = HALF * BK * 2  , STAGE_BYTES = 8 * HTB, NXCD = 8, WGM = 8;

__host__ __device__ __forceinline__ int lds_byte(int r, int c) { const int st = (r >> 4) * 2 + (c >> 5), rr = r & 15, cc = c & 31, ob = rr * 64 + cc * 2; return st * 1024 + (ob ^ (((ob >> 9) & 1) << 5)); }
__host__ __device__ __forceinline__ void stage_rc(int b, int& R, int& C) { const int st = b / 1024, sb = b % 1024, swz = sb ^ (((sb >> 9) & 1) << 5); R = (st >> 1) * 16 + swz / 64; C = (st & 1) * 32 + (swz % 64) / 2; }
__host__ __device__ __forceinline__ int perm32(int rho) { const int n = rho >> 4, i = rho & 15; return 8 * (i >> 2) + 4 * n + (i & 3); }

struct Unit { int pm, pn; };
struct Gemm { const bf16_t* A; const bf16_t* Bt; int M, N, K; };

struct StaticOrder {
    int nM, nN, nwg, G, c;
    __host__ __device__ void init(int M, int N, int G_, int c_) { nM = M / BM; nN = N / BM; nwg = nM * nN; G = G_; c = c_; }
    __host__ __device__ bool next(int i, Unit& u) const {
        const long L = (long)i * G + c; if (L >= nwg) return false;
        int wgid = (int)L; { const int q = nwg / NXCD, r = nwg % NXCD, xcd = wgid % NXCD, off = wgid / NXCD; wgid = (xcd < r ? xcd * (q + 1) : r * (q + 1) + (xcd - r) * q) + off; }
        const int nig = WGM * nN, gid = wgid / nig, fm = gid * WGM, gsz = (nM - fm) < WGM ? (nM - fm) : WGM;
        u.pm = fm + ((wgid % nig) % gsz); u.pn = (wgid % nig) / gsz; return true;
    }
    __device__ __forceinline__ void a_ready(const Unit&) const {}
    __device__ __forceinline__ void done(const Unit&) const {}
};

__device__ __forceinline__ unsigned cvt_pk_bf16(float lo, float hi) { unsigned r; asm volatile("v_cvt_pk_bf16_f32 %0, %1, %2" : "=v"(r) : "v"(lo), "v"(hi)); return r; }
struct EpiBf16 {
    static constexpr bool PERM = true, AFTER_DRAIN = false;
    bf16_t* O; int ldc;
    __device__ __forceinline__ void operator()(const f32x4 (&acc)[2][2][4][2], const Unit& u, int wr, int wc, int fr, int fq) const {
        const int row0 = u.pm * BM + wr * 64 + fr; const int col0 = u.pn * BM + wc * 32 + 8 * fq;
#pragma unroll
        for (int ai = 0; ai < 2; ++ai)
#pragma unroll
            for (int m = 0; m < 4; ++m) { bf16_t* rowp = O + (size_t)(row0 + ai * HALF + m * 16) * ldc + col0;
#pragma unroll
                for (int bj = 0; bj < 2; ++bj) { const f32x4 v0 = acc[ai][bj][m][0], v1 = acc[ai][bj][m][1];
                    u32x4 w; w.x = cvt_pk_bf16(v0[0], v0[1]); w.y = cvt_pk_bf16(v0[2], v0[3]); w.z = cvt_pk_bf16(v1[0], v1[1]); w.w = cvt_pk_bf16(v1[2], v1[3]);
                    *(u32x4*)(rowp + bj * HALF) = w; } }
    }
};
struct EpiF32 {
    static constexpr bool PERM = false, AFTER_DRAIN = false;
    float* C; int ldc;
    __device__ __forceinline__ void operator()(const f32x4 (&acc)[2][2][4][2], const Unit& u, int wr, int wc, int fr, int fq) const {
        const int row0 = u.pm * BM + wr * 64 + fr, col0 = u.pn * BM + wc * 32 + 4 * fq;
#pragma unroll
        for (int ai = 0; ai < 2; ++ai)
#pragma unroll
            for (int m = 0; m < 4; ++m) { float* rowp = C + (size_t)(row0 + ai * HALF + m * 16) * ldc + col0;
#pragma unroll
                for (int bj = 0; bj < 2; ++bj)
#pragma unroll
                    for (int n = 0; n < 2; ++n) *(f32x4*)(rowp + bj * HALF + n * 16) = acc[ai][bj][m][n]; }
    }
};
template <class Epi, class Sched, bool ALIGN_EPI = false, bool SP2 = false>
__device__ __forceinline__ void gemm_phase(PG8_LAS unsigned char* lds, const Gemm g, const Sched& S, const Epi& E) {
    const int tid = threadIdx.x, wid = __builtin_amdgcn_readfirstlane(tid >> 6), lane = tid & 63, wr = wid >> 2, wc = wid & 3, fr = lane & 15, fq = lane >> 4;
    const int K = g.K, nt = K / BK;
    unsigned voffA[2], voffB[2];
#pragma unroll
    for (int i = 0; i < 2; ++i) { int R, C; stage_rc(tid * 16 + i * 8192, R, C); const int Rb = Epi::PERM ? ((R & ~31) + perm32(R & 31)) : R;
        voffA[i] = (unsigned)(R * K + C) * 2u; voffB[i] = (unsigned)(Rb * K + C) * 2u; }
    const size_t kstep = (size_t)(BK * 2);
    const size_t hstep = (size_t)HALF * K * 2;
    const size_t tstep = 2 * hstep;
    const unsigned ldsw = (unsigned)wid * 1024u;
    const int aoff = lds_byte(wr * 64 + fr, fq * 8), boff = lds_byte(wc * 32 + fr, fq * 8);
#define PG8_SA(b, h) (((b) * 2 + (h)) * HTB)
#define PG8_SB(b, h) ((4 + (b) * 2 + (h)) * HTB)
#define PG8_STAGE(bufoff, gbase, voff) do { _Pragma("unroll") for (int _i = 0; _i < 2; ++_i) \
        __builtin_amdgcn_global_load_lds((const unsigned*)((const char*)(gbase) + (voff)[_i]), (PG8_LAS unsigned*)(lds + (bufoff) + ldsw + _i * 8192), 16, 0, 0); } while (0)
#define PG8_LDA(dst, b, h) do { _Pragma("unroll") for (int m = 0; m < 4; ++m) _Pragma("unroll") for (int k = 0; k < 2; ++k) dst[m][k] = *(const PG8_LAS bf16x8*)(lds + PG8_SA(b, h) + aoff + m * 2048 + k * 1024); } while (0)
#define PG8_LDB(dst, b, h) do { _Pragma("unroll") for (int n = 0; n < 2; ++n) _Pragma("unroll") for (int k = 0; k < 2; ++k) dst[n][k] = *(const PG8_LAS bf16x8*)(lds + PG8_SB(b, h) + boff + n * 2048 + k * 1024); } while (0)
#define PG8_MMA(ai, bj, At, Bt) do { __builtin_amdgcn_s_setprio(1); _Pragma("unroll") for (int m = 0; m < 4; ++m) _Pragma("unroll") for (int n = 0; n < 2; ++n) _Pragma("unroll") for (int k = 0; k < 2; ++k) \
        acc[ai][bj][m][n] = __builtin_amdgcn_mfma_f32_16x16x32_bf16(Bt[n][k], At[m][k], acc[ai][bj][m][n], 0, 0, 0); __builtin_amdgcn_s_setprio(0); } while (0)
#define PG8_WAIT_V(n) asm volatile("s_waitcnt vmcnt(" #n ")" ::: "memory")
#define PG8_WAIT_L(n) asm volatile("s_waitcnt lgkmcnt(" #n ")" ::: "memory")
#define PG8_BAR __builtin_amdgcn_s_barrier()
#define PG8_SCHED __builtin_amdgcn_sched_barrier(0)
    Unit cur, nxt; int ui = 0;
    if (!S.next(0, cur)) return;
    f32x4 acc[2][2][4][2];
#pragma unroll
    for (int a = 0; a < 2; ++a)
#pragma unroll
        for (int b = 0; b < 2; ++b)
#pragma unroll
            for (int m = 0; m < 4; ++m)
#pragma unroll
                for (int n = 0; n < 2; ++n) acc[a][b][m][n] = (f32x4){0.f, 0.f, 0.f, 0.f};
    bf16x8 At[4][2], B0[2][2], B1[2][2];
    const char* cA = (const char*)g.A + (size_t)cur.pm * tstep; const char* cB = (const char*)g.Bt + (size_t)cur.pn * tstep;
    S.a_ready(cur);
    if constexpr (SP2) {
        PG8_STAGE(PG8_SB(0, 0), cB, voffB); PG8_STAGE(PG8_SB(0, 1), cB + hstep, voffB); PG8_STAGE(PG8_SA(0, 0), cA, voffA); PG8_STAGE(PG8_SA(0, 1), cA + hstep, voffA);
        if (wr == 1) PG8_BAR;
        PG8_WAIT_V(2); PG8_BAR;
        PG8_STAGE(PG8_SB(1, 0), cB + kstep, voffB); PG8_STAGE(PG8_SA(1, 0), cA + kstep, voffA); PG8_STAGE(PG8_SB(1, 1), cB + hstep + kstep, voffB);
        PG8_WAIT_V(6); PG8_BAR;
    } else {
        PG8_STAGE(PG8_SB(0, 0), cB, voffB); PG8_STAGE(PG8_SA(0, 0), cA, voffA); PG8_STAGE(PG8_SB(0, 1), cB + hstep, voffB); PG8_STAGE(PG8_SA(0, 1), cA + hstep, voffA);
        if (wr == 1) PG8_BAR;
        PG8_WAIT_V(4); PG8_BAR;
        PG8_STAGE(PG8_SB(1, 0), cB + kstep, voffB); PG8_STAGE(PG8_SA(1, 0), cA + kstep, voffA); PG8_STAGE(PG8_SB(1, 1), cB + hstep + kstep, voffB);
        PG8_WAIT_V(6); PG8_BAR;
    }
    for (;;) {
        const bool has_next = S.next(ui + 1, nxt);
        const char* nA = has_next ? (const char*)g.A + (size_t)nxt.pm * tstep : cA; const char* nB = has_next ? (const char*)g.Bt + (size_t)nxt.pn * tstep : cB;
        for (int t = 0; t < nt; t += 2) {
            const bool last = (t == nt - 2);
            const char* a1 = cA + (size_t)(t + 1) * kstep;
            const char* a2 = last ? nA : cA + (size_t)(t + 2) * kstep; const char* b2 = last ? nB : cB + (size_t)(t + 2) * kstep;
            const char* a3 = a2 + kstep; const char* b3 = b2 + kstep;
            if (last && has_next) S.a_ready(nxt);
            if constexpr (SP2) {
            PG8_LDB(B0, 0, 0); PG8_LDB(B1, 0, 1); PG8_SCHED; PG8_LDA(At, 0, 0); PG8_STAGE(PG8_SA(1, 1), a1 + hstep, voffA);
            PG8_WAIT_V(8); PG8_WAIT_L(0); PG8_BAR; PG8_MMA(0, 0, At, B0); PG8_MMA(0, 1, At, B1); PG8_BAR; PG8_SCHED;
            PG8_LDA(At, 0, 1); PG8_STAGE(PG8_SB(0, 0), b2, voffB); PG8_STAGE(PG8_SB(0, 1), b2 + hstep, voffB); PG8_STAGE(PG8_SA(0, 0), a2, voffA);
            PG8_WAIT_V(8); PG8_WAIT_L(0); PG8_BAR; PG8_MMA(1, 0, At, B0); PG8_MMA(1, 1, At, B1); PG8_BAR; PG8_SCHED;
            PG8_LDB(B0, 1, 0); PG8_LDB(B1, 1, 1); PG8_SCHED; PG8_LDA(At, 1, 0); PG8_STAGE(PG8_SA(0, 1), a2 + hstep, voffA);
            PG8_WAIT_V(8); PG8_WAIT_L(0); PG8_BAR; PG8_MMA(0, 0, At, B0); PG8_MMA(0, 1, At, B1); PG8_BAR; PG8_SCHED;
            PG8_LDA(At, 1, 1); PG8_STAGE(PG8_SB(1, 0), b3, voffB); PG8_STAGE(PG8_SB(1, 1), b3 + hstep, voffB); PG8_STAGE(PG8_SA(1, 0), a3, voffA);
            PG8_WAIT_V(8); PG8_WAIT_L(0); PG8_BAR; PG8_MMA(1, 0, At, B0); PG8_MMA(1, 1, At, B1); PG8_BAR; PG8_SCHED;
            } else {
            PG8_LDB(B0, 0, 0); PG8_SCHED; PG8_LDA(At, 0, 0); PG8_STAGE(PG8_SA(1, 1), a1 + hstep, voffA);
            PG8_WAIT_L(8); PG8_BAR; PG8_WAIT_L(0); PG8_MMA(0, 0, At, B0); PG8_BAR; PG8_SCHED;
            PG8_LDB(B1, 0, 1); PG8_STAGE(PG8_SB(0, 0), b2, voffB);
            PG8_BAR; PG8_WAIT_L(0); PG8_MMA(0, 1, At, B1); PG8_BAR;
            PG8_LDA(At, 0, 1); PG8_STAGE(PG8_SA(0, 0), a2, voffA);
            PG8_BAR; PG8_WAIT_L(0); PG8_MMA(1, 0, At, B0); PG8_BAR; PG8_SCHED;
            PG8_STAGE(PG8_SB(0, 1), b2 + hstep, voffB);
            PG8_WAIT_V(6); PG8_BAR; PG8_MMA(1, 1, At, B1); PG8_BAR;
            PG8_LDB(B0, 1, 0); PG8_SCHED; PG8_LDA(At, 1, 0); PG8_STAGE(PG8_SA(0, 1), a2 + hstep, voffA);
            PG8_WAIT_L(8); PG8_BAR; PG8_WAIT_L(0); PG8_MMA(0, 0, At, B0); PG8_BAR; PG8_SCHED;
            PG8_LDB(B1, 1, 1); PG8_STAGE(PG8_SB(1, 0), b3, voffB);
            PG8_BAR; PG8_WAIT_L(0); PG8_MMA(0, 1, At, B1); PG8_BAR;
            PG8_LDA(At, 1, 1); PG8_STAGE(PG8_SA(1, 0), a3, voffA);
            PG8_BAR; PG8_WAIT_L(0); PG8_MMA(1, 0, At, B0); PG8_BAR; PG8_SCHED;
            PG8_STAGE(PG8_SB(1, 1), b3 + hstep, voffB);
            PG8_WAIT_V(6); PG8_BAR; PG8_MMA(1, 1, At, B1); PG8_BAR;
            }
        }
        if constexpr (ALIGN_EPI) { if (wr == 0) PG8_BAR; }
        if constexpr (!Epi::AFTER_DRAIN) { E(acc, cur, wr, wc, fr, fq); S.done(cur); }
        if (!has_next) break;
#pragma unroll
        for (int a = 0; a < 2; ++a)
#pragma unroll
            for (int b = 0; b < 2; ++b)
#pragma unroll
                for (int m = 0; m < 4; ++m)
#pragma unroll
                    for (int n = 0; n < 2; ++n) acc[a][b][m][n] = (f32x4){0.f, 0.f, 0.f, 0.f};
        cur = nxt; cA = nA; cB = nB; ++ui;
        if constexpr (ALIGN_EPI) { if (wr == 1) PG8_BAR; }
    }
    PG8_WAIT_V(0);
    if constexpr (!ALIGN_EPI) { if (wr == 0) PG8_BAR; }
    PG8_BAR;
    if constexpr (Epi::AFTER_DRAIN) { E.fused(acc, cur, wr, wc, fr, fq, lds, wid, lane); S.done(cur); }
#undef PG8_SA
#undef PG8_SB
#undef PG8_STAGE
#undef PG8_LDA
#undef PG8_LDB
#undef PG8_MMA
#undef PG8_WAIT_V
#undef PG8_WAIT_L
#undef PG8_BAR
#undef PG8_SCHED
}
}
template <class Epi> __global__ __launch_bounds__(512, 2) void k_gemm(pg8::Gemm g, Epi E) {
    extern __shared__ __attribute__((aligned(16))) unsigned char shm[];
    pg8::StaticOrder S_; S_.init(g.M, g.N, (int)gridDim.x, (int)blockIdx.x);
    pg8::gemm_phase<Epi, pg8::StaticOrder, true, true>((PG8_LAS unsigned char*)shm, g, S_, E);
}
#endif
enum { ST_INIT, ST_PB, ST_WT, ST_ROWSS, ST_NORM, ST_RESID, ST_DNPREP, ST_DNSCAN, ST_DNOUT, ST_NASC, ST_NAOUT, ST_LAM, ST_ROPE, ST_DATTN, ST_COUT, ST_FFNACT, ST_PLE };
struct Job { P p; WT w; const float* a; const float* b; long n; int layer; int flag; };
template <int ST> DEVFN void run_item(const Job& j, long g) {
    if constexpr (ST == ST_INIT) st_init(j.p, j.layer, g);
    else if constexpr (ST == ST_PB) st_pb(j.p, j.layer, g);
    else if constexpr (ST == ST_WT) st_wt(j.w, g);
    else if constexpr (ST == ST_ROWSS) st_rowss(j.p, j.a, g);
    else if constexpr (ST == ST_NORM) st_norm_bf16(j.p, j.a, g);
    else if constexpr (ST == ST_RESID) st_resid(j.p, j.a, j.b, j.flag, g);
    else if constexpr (ST == ST_DNPREP) st_dn_prep(j.p, j.layer, g);
    else if constexpr (ST == ST_DNSCAN) st_dn_scan(j.p, j.layer, g);
    else if constexpr (ST == ST_DNOUT) st_dn_out(j.p, j.layer, g);
    else if constexpr (ST == ST_NASC) st_na_scores(j.p, j.layer, g);
    else if constexpr (ST == ST_NAOUT) st_na_out(j.p, j.layer, g);
    else if constexpr (ST == ST_LAM) st_lam(j.p, j.layer, g);
    else if constexpr (ST == ST_ROPE) st_rope(j.p, j.layer, g);
    else if constexpr (ST == ST_DATTN) st_dattn(j.p, j.layer, g);
    else if constexpr (ST == ST_COUT) st_c_out(j.p, j.layer, g);
    else if constexpr (ST == ST_FFNACT) st_ffn_act(j.p, j.layer, g);
    else if constexpr (ST == ST_PLE) st_ple(j.p, j.layer, g);
}
#ifndef EMU
template <int ST> __global__ void __launch_bounds__(256) kn_stage(Job j) {
    for (long g = (long)blockIdx.x * 256 + threadIdx.x; g < j.n; g += (long)gridDim.x * 256) run_item<ST>(j, g);
}
static hipStream_t g_stream;
template <int ST> static void run_stage(Job j, long n) {
    j.n = n; long blocks = (n + 255) / 256; if (blocks > 256 * 16) blocks = 256 * 16; if (blocks < 1) blocks = 1;
    hipLaunchKernelGGL((kn_stage<ST>), dim3((unsigned)blocks), dim3(256), 0, g_stream, j);
}
template <class Epi> static void run_gemm(const bf16* A, const bf16* Bt, int M, int N, int K, Epi E) {
    static bool attr = false; if (!attr) { (void)hipFuncSetAttribute((const void*)k_gemm<Epi>, hipFuncAttributeMaxDynamicSharedMemorySize, pg8::STAGE_BYTES); attr = true; }
    pg8::Gemm g{A, Bt, M, N, K};
    hipLaunchKernelGGL((k_gemm<Epi>), dim3(256), dim3(512), pg8::STAGE_BYTES, g_stream, g, E);
}
static void gemm_bf16(const bf16* A, const bf16* Bt, int M, int N, int K, bf16* O, int ldc) { run_gemm(A, Bt, M, N, K, pg8::EpiBf16{O, ldc}); }
static void gemm_f32(const bf16* A, const bf16* Bt, int M, int N, int K, float* O, int ldc) { run_gemm(A, Bt, M, N, K, pg8::EpiF32{O, ldc}); }
#else
template <int ST> static void run_stage(Job j, long n) {
    j.n = n;
#pragma omp parallel for schedule(dynamic, 64)
    for (long g = 0; g < n; ++g) run_item<ST>(j, g);
}
static void emu_gemm(const bf16* A, const bf16* Bt, int M, int N, int K, bf16* Ob, float* Of, int ldc) {
    std::vector<float> Af((size_t)M * K), Bf((size_t)N * K);
    for (size_t i = 0; i < Af.size(); ++i) Af[i] = bf2f(A[i]);
    for (size_t i = 0; i < Bf.size(); ++i) Bf[i] = bf2f(Bt[i]);
#pragma omp parallel for schedule(dynamic, 8)
    for (int m = 0; m < M; ++m) for (int n = 0; n < N; ++n) { const float* a = &Af[(size_t)m * K]; const float* b = &Bf[(size_t)n * K]; float s = 0.f;
        for (int k = 0; k < K; ++k) s += a[k] * b[k];
        if (Ob) Ob[(size_t)m * ldc + n] = f2bf(s); else Of[(size_t)m * ldc + n] = s; }
}
static void gemm_bf16(const bf16* A, const bf16* Bt, int M, int N, int K, bf16* O, int ldc) { emu_gemm(A, Bt, M, N, K, O, nullptr, ldc); }
static void gemm_f32(const bf16* A, const bf16* Bt, int M, int N, int K, float* O, int ldc) { emu_gemm(A, Bt, M, N, K, nullptr, O, ldc); }
#endif

static void forward(const P& p) {
    Job j; memset(&j, 0, sizeof(j)); j.p = p;
    auto wt = [&](const float* W, size_t off, int K, int N, int Npad) { j.w.W = W; j.w.O = WSP(bf16, off); j.w.K = K; j.w.N = N; j.w.Npad = Npad; run_stage<ST_WT>(j, (long)Npad * K); };
    for (int i = 0; i < 2; ++i) {
        wt(p.ab_w_in + (size_t)i * D * ABIN, WS_WABIN + (size_t)i * ABINP * D * 2, D, ABIN, ABINP);
        wt(p.ab_w_out + (size_t)i * ABMIX * D, WS_WABOUT + (size_t)i * D * ABMIX * 2, ABMIX, D, D);
        wt(p.c_w_in + (size_t)i * D * CIN, WS_WCIN + (size_t)i * CIN * D * 2, D, CIN, CIN);
        wt(p.c_w_out + (size_t)i * CV * D, WS_WCOUT + (size_t)i * D * CV * 2, CV, D, D);
    }
    for (int l = 0; l < DEPTH; ++l) {
        wt(p.ffn_w_in + (size_t)l * D * 2 * DFF, WS_WFIN + (size_t)l * 2 * DFF * D * 2, D, 2 * DFF, 2 * DFF);
        wt(p.ffn_w_out + (size_t)l * DFF * D, WS_WFOUT + (size_t)l * D * DFF * 2, DFF, D, D);
        wt(p.ple_w_proj + (size_t)l * PLE * D, WS_WPP + (size_t)l * D * PLE * 2, PLE, D, D);
        wt(p.ple_w_gate + (size_t)l * D * D, WS_WPG + (size_t)l * D * D * 2, D, D, D);
    }
    run_stage<ST_INIT>(j, N_INIT);
    for (int layer = 0; layer < DEPTH; ++layer) {
        j.layer = layer; const int jj = layer / 2; const float* nw = p.norms + (size_t)layer * 4 * D;
        j.a = p.h; run_stage<ST_ROWSS>(j, N_ROWS);
        j.a = nw; run_stage<ST_NORM>(j, N_TD);
        if (layer % 2 == 0) {
            gemm_bf16(WSP(bf16, WS_HN), WSP(bf16, WS_WABIN + (size_t)jj * ABINP * D * 2), T, ABINP, D, WSP(bf16, WS_PROJ), ABINP);
            run_stage<ST_DNPREP>(j, N_TH);
            run_stage<ST_DNSCAN>(j, N_SCAN);
            run_stage<ST_DNOUT>(j, N_TH);
            run_stage<ST_NASC>(j, N_THD);
            run_stage<ST_NAOUT>(j, N_THD);
            gemm_f32(WSP(bf16, WS_MIXIN), WSP(bf16, WS_WABOUT + (size_t)jj * D * ABMIX * 2), T, D, ABMIX, WSP(float, WS_GOUT), D);
        } else {
            gemm_bf16(WSP(bf16, WS_HN), WSP(bf16, WS_WCIN + (size_t)jj * CIN * D * 2), T, CIN, D, WSP(bf16, WS_PROJ), CIN);
            run_stage<ST_LAM>(j, 1);
            run_stage<ST_ROPE>(j, N_ROPE);
            run_stage<ST_DATTN>(j, N_DATT);
            run_stage<ST_COUT>(j, N_TH);
            gemm_f32(WSP(bf16, WS_MIXIN), WSP(bf16, WS_WCOUT + (size_t)jj * D * CV * 2), T, D, CV, WSP(float, WS_GOUT), D);
        }
        j.a = WSP(float, WS_GOUT); run_stage<ST_ROWSS>(j, N_ROWS);
        j.a = WSP(float, WS_GOUT); j.b = nw + D; j.flag = 0; run_stage<ST_RESID>(j, N_TD);
        j.a = p.h; run_stage<ST_ROWSS>(j, N_ROWS);
        j.a = nw + 2 * D; run_stage<ST_NORM>(j, N_TD);
        gemm_bf16(WSP(bf16, WS_HN), WSP(bf16, WS_WFIN + (size_t)layer * 2 * DFF * D * 2), T, 2 * DFF, D, WSP(bf16, WS_HID), 2 * DFF);
        run_stage<ST_FFNACT>(j, N_ACT);
        gemm_f32(WSP(bf16, WS_ACT), WSP(bf16, WS_WFOUT + (size_t)layer * D * DFF * 2), T, D, DFF, WSP(float, WS_GOUT), D);
        j.a = WSP(float, WS_GOUT); run_stage<ST_ROWSS>(j, N_ROWS);
        j.a = WSP(float, WS_GOUT); j.b = nw + 3 * D; j.flag = 1; run_stage<ST_RESID>(j, N_TD);
        run_stage<ST_PB>(j, N_PB);
        gemm_f32(WSP(bf16, WS_HN), WSP(bf16, WS_WPG + (size_t)layer * D * D * 2), T, D, D, WSP(float, WS_GOUT), D);
        gemm_f32(WSP(bf16, WS_PB), WSP(bf16, WS_WPP + (size_t)layer * D * PLE * 2), T, D, PLE, WSP(float, WS_GOUT2), D);
        run_stage<ST_PLE>(j, N_TD);
    }
}

#ifndef EMU
extern "C" void kernel_launch(void* const* d_in, const int* in_sizes, int n_in, void* d_out, int out_size, void* d_ws, size_t ws_size, hipStream_t stream) {
    if (n_in != 22 || out_size != T * D || ws_size < WS_END) { fprintf(stderr, "kernel_launch: unexpected shapes n_in %d out %d ws %zu (need %zu)\n", n_in, out_size, ws_size, (size_t)WS_END); return; }
    g_stream = stream;
    P p; memset(&p, 0, sizeof(p));
    const float** f = (const float**)&p;
    for (int i = 0; i < 22; ++i) f[i] = (const float*)d_in[i];
    p.h = (float*)d_out; p.ws = (unsigned char*)d_ws;
    forward(p);
}
#else
int main(int argc, char** argv) {
    FILE* fs = fopen("sizes.txt", "r"); std::vector<long> sizes(22); for (int i = 0; i < 22; ++i) if (fscanf(fs, "%ld", &sizes[i]) != 1) return 1; fclose(fs);
    FILE* fi = fopen("inputs.bin", "rb"); std::vector<std::vector<float>> in(22);
    for (int i = 0; i < 22; ++i) { in[i].resize(sizes[i]); if (fread(in[i].data(), 4, sizes[i], fi) != (size_t)sizes[i]) return 2; } fclose(fi);
    std::vector<float> out((size_t)T * D); std::vector<unsigned char> ws(WS_END, 0xAA);
    printf("T %d D %d WS_END %zu MiB\n", T, D, (size_t)(WS_END / MiB));
    P p; memset(&p, 0, sizeof(p)); const float** f = (const float**)&p; for (int i = 0; i < 22; ++i) f[i] = in[i].data();
    p.h = out.data(); p.ws = ws.data();
    forward(p);
    FILE* fo = fopen("emu_out.bin", "wb"); fwrite(out.data(), 4, out.size(), fo); fclose(fo);
    return 0;
}
#endif
```

```cpp
#ifndef EMU
#include <hip/hip_runtime.h>
#include <cstdio>
#include <cstdint>
#include <cstring>
#define DEVFN __device__ __forceinline__
#define MEMFENCE() asm volatile("" ::: "memory")
#else
#include <cstdio>
#include <cstdint>
#include <cstdlib>
#include <cstring>
#include <cmath>
#include <vector>
#define DEVFN static inline
#define MEMFENCE() do {} while (0)
#endif
#include <cmath>

#ifndef EMU
constexpr int D = 2048, NSEQ = 6, NPROMPT = 2, S = 4096, PLE = 256, DFF = 8192;
#else
constexpr int D = 256, NSEQ = 2, NPROMPT = 1, S = 1024, PLE = 64, DFF = 512;
#endif
constexpr int T = NSEQ * S, DEPTH = 4, NH = 8, DH = 128;
constexpr int AQKV = 3072, ABIN = 7200, ABINP = 7424, ABMIX = 2048, CIN = 6144, CV = 2048;
constexpr int COL_Z = 3072, COL_G = 4096, COL_QB = 4128, COL_KB = 4128 + 1024, COL_VB = 4128 + 2048;
constexpr int GW = 64, ROWS = S / GW, NAR = 8, NAC = 16, WR = (NAR < ROWS ? NAR : ROWS);
constexpr float RMS_EPS = 1e-6f;

typedef unsigned short bf16;
DEVFN float bf2f(bf16 b) { unsigned u = ((unsigned)b) << 16; float f; memcpy(&f, &u, 4); return f; }
DEVFN bf16 f2bf(float f) { unsigned u; memcpy(&u, &f, 4); u += 0x7fffu + ((u >> 16) & 1u); return (bf16)(u >> 16); }
DEVFN float siluf(float x) { return x / (1.f + expf(-x)); }
DEVFN float sigmoidf(float x) { return 1.f / (1.f + expf(-x)); }
DEVFN float softplusf(float x) { if (x > 20.f) return x; const float y = expf(x); return y < 0.01f ? y * (1.f - y * (0.5f - y * 0.33333333f)) : logf(1.f + y); }
DEVFN int clampi(int v, int lo, int hi) { return v < lo ? lo : (v > hi ? hi : v); }

constexpr size_t MiB = 1u << 20;
constexpr size_t SZ_TD2 = (size_t)T * D * 2, SZ_TD4 = (size_t)T * D * 4;
constexpr size_t al(size_t x) { return (x + MiB - 1) / MiB * MiB; }
constexpr size_t WS_CTL = 0;
constexpr size_t WS_PRM = 1 * MiB;
constexpr int PR_ABCONV = 0, PR_ALOG = PR_ABCONV + 2 * 5 * AQKV, PR_DTB = PR_ALOG + 32, PR_ONORM = PR_DTB + 32, PR_RPB = PR_ONORM + 2 * DH, PR_LAMBDA = PR_RPB + 2 * NH * 15 * 31,
    PR_SUBLN = PR_LAMBDA + 2 * 4 * DH, PR_NORMS = PR_SUBLN + 2 * 256, PR_FCW = PR_NORMS + DEPTH * 4 * D, PR_FCB = PR_FCW + DEPTH * 3 * 2 * DFF, PR_END = PR_FCB + DEPTH * 2 * DFF;
static_assert((size_t)PR_END * 4 <= 2 * MiB, "param region");
constexpr size_t WS_WABIN = 3 * MiB;
constexpr size_t WS_WABOUT = WS_WABIN + al((size_t)2 * ABINP * D * 2);
constexpr size_t WS_WCIN = WS_WABOUT + al((size_t)2 * D * ABMIX * 2);
constexpr size_t WS_WCOUT = WS_WCIN + al((size_t)2 * CIN * D * 2);
constexpr size_t WS_WFIN = WS_WCOUT + al((size_t)2 * D * CV * 2);
constexpr size_t WS_WFOUT = WS_WFIN + al((size_t)4 * 2 * DFF * D * 2);
constexpr size_t WS_WPP = WS_WFOUT + al((size_t)4 * D * DFF * 2);
constexpr size_t WS_WPG = WS_WPP + al((size_t)4 * D * PLE * 2);
constexpr size_t WS_HN = WS_WPG + al((size_t)4 * D * D * 2);
#ifdef EMU
constexpr size_t WS_MIXIN = WS_HN + al(SZ_TD2);
#else
constexpr size_t WS_MIXIN = WS_HN;
constexpr size_t WS_H16 = WS_HN + al(SZ_TD2);
#endif
constexpr size_t WS_PB = WS_HN + 2 * al(SZ_TD2);
constexpr size_t SZ_PB = al((size_t)T * PLE * 2);
constexpr size_t WS_SMALL = WS_PB + DEPTH * SZ_PB;
constexpr size_t WS_RSTD = WS_SMALL, WS_G = WS_SMALL + al((size_t)T * 4), WS_BETA = WS_G + al((size_t)T * 16 * 4), WS_LAM = WS_BETA + al((size_t)T * 16 * 4);
constexpr size_t WS_R = WS_LAM + MiB;
constexpr size_t WS_GOUT = WS_R;
constexpr size_t WS_GOUT2 = WS_GOUT + al(SZ_TD4);
constexpr size_t WS_HID = WS_R;
#ifdef EMU
constexpr size_t WS_ACT = WS_HID + al((size_t)T * 2 * DFF * 2);
#else
constexpr size_t WS_ACT = WS_GOUT + al(SZ_TD4);
constexpr size_t WS_PP2 = (size_t)1952 * MiB;
#endif
constexpr size_t WS_HALO = WS_ACT + al((size_t)T * DFF * 2);
constexpr size_t WS_PROJ = WS_GOUT + al(SZ_TD4);
constexpr size_t WS_X1 = WS_PROJ + al((size_t)T * ABINP * 2);
constexpr size_t SZ_HD4 = al((size_t)T * NH * DH * 4);
#ifdef EMU
constexpr size_t WS_QN = WS_X1, WS_KN = WS_QN + SZ_HD4, WS_VV = WS_KN + SZ_HD4, WS_OF = WS_VV + SZ_HD4, WS_OB = WS_OF + SZ_HD4, WS_NASC = WS_OB + SZ_HD4;
constexpr size_t WS_END_AB = WS_NASC + SZ_HD4;
#else
constexpr size_t WS_OF = WS_GOUT, WS_OB = WS_OF + SZ_HD4;
constexpr size_t WS_QN = WS_X1, WS_KN = WS_X1, WS_VV = WS_X1, WS_NASC = WS_X1;
constexpr int NUD_ = NSEQ * NH * (S / 64) * 2;
constexpr size_t WS_DN_UT = WS_X1, WS_DN_WN = WS_DN_UT + al((size_t)NUD_ * 128 * 64 * 4), WS_DN_QE = WS_DN_WN + al((size_t)NUD_ * 16 * 512 * 2), WS_DN_IN = WS_DN_QE + al((size_t)NUD_ * 16 * 512 * 2),
    WS_DN_KD = WS_DN_IN + al((size_t)NUD_ * 8 * 512 * 2), WS_DN_EG = WS_DN_KD + al((size_t)NUD_ * 16 * 512 * 2);
constexpr size_t WS_END_AB = WS_DN_EG + MiB;
#endif
constexpr size_t WS_O0 = WS_X1, WS_O1 = WS_O0 + al((size_t)T * 2048 * 4);
constexpr size_t WS_END_C = WS_O1 + al((size_t)T * 2048 * 4);
constexpr size_t WS_END_F = WS_HALO + 32 * MiB;
constexpr size_t WS_END = (WS_END_AB > WS_END_C ? (WS_END_AB > WS_END_F ? WS_END_AB : WS_END_F) : (WS_END_C > WS_END_F ? WS_END_C : WS_END_F));
#ifndef EMU
static_assert(WS_END <= WS_PP2 && WS_PP2 + SZ_TD2 <= (size_t)2048 * MiB, "workspace map exceeds 2 GiB");
#endif

struct P {
    const float *x_prompt, *x_sample, *p_prompt, *p_sample, *ab_w_in, *ab_conv_w, *ab_a_log, *ab_dt_bias, *ab_out_norm, *ab_rpb, *ab_w_out,
        *c_w_in, *c_lambda, *c_subln, *c_w_out, *norms, *ffn_w_in, *ffn_conv_w, *ffn_conv_b, *ffn_w_out, *ple_w_proj, *ple_w_gate;
    float* h;
    unsigned char* ws;
};
#define WSP(type, off) ((type*)(p.ws + (off)))
#define PRM(off) (WSP(const float, WS_PRM) + (off))
constexpr long N_PRM = PR_END;
DEVFN void st_prm(const P& p, int, long g) {
    const int i = (int)g; float v;
    if (i < PR_ALOG) v = p.ab_conv_w[i - PR_ABCONV]; else if (i < PR_DTB) v = p.ab_a_log[i - PR_ALOG]; else if (i < PR_ONORM) v = p.ab_dt_bias[i - PR_DTB];
    else if (i < PR_RPB) v = p.ab_out_norm[i - PR_ONORM]; else if (i < PR_LAMBDA) v = p.ab_rpb[i - PR_RPB]; else if (i < PR_SUBLN) v = p.c_lambda[i - PR_LAMBDA];
    else if (i < PR_NORMS) v = p.c_subln[i - PR_SUBLN]; else if (i < PR_FCW) v = p.norms[i - PR_NORMS]; else if (i < PR_FCB) v = p.ffn_conv_w[i - PR_FCW]; else v = p.ffn_conv_b[i - PR_FCB];
    WSP(float, WS_PRM)[i] = v;
}
constexpr long N_INIT = (long)T * D / 4;
DEVFN void st_init(const P& p, int, long g) {
    const long i = g * 4, np = (long)NPROMPT * S * D;
    const float* src = i < np ? p.x_prompt + i : p.x_sample + (i - np);
    for (int k = 0; k < 4; ++k) p.h[i + k] = src[k];
}
constexpr long N_PB = (long)T * PLE;
DEVFN void st_pb(const P& p, int layer, long g) {
    const long np = (long)NPROMPT * S * PLE, ns = (long)(NSEQ - NPROMPT) * S * PLE;
    const float v = g < np ? p.p_prompt[(long)layer * np + g] : p.p_sample[(long)layer * ns + (g - np)];
    WSP(bf16, WS_PB + (size_t)layer * SZ_PB)[g] = f2bf(v);
}
struct WT { const float* W; bf16* O; int K, N, Npad; };
DEVFN void st_wt(const WT& w, long g) {
    const int n = (int)(g / w.K), k = (int)(g % w.K);
    w.O[g] = n < w.N ? f2bf(w.W[(size_t)k * w.N + n]) : (bf16)0;
}
constexpr long N_ROWS = T;
DEVFN void st_rowss(const P& p, const float* x, long g) {
    const float* r = x + (size_t)g * D; float s = 0.f;
    for (int c = 0; c < D; ++c) s += r[c] * r[c];
    WSP(float, WS_RSTD)[g] = 1.0f / sqrtf(s / (float)D + RMS_EPS);
}
constexpr long N_TD = (long)T * D;
DEVFN void st_norm_bf16(const P& p, const float* w, long g) {
    const long t = g / D; const int c = (int)(g % D);
    WSP(bf16, WS_HN)[g] = f2bf(p.h[g] * WSP(float, WS_RSTD)[t] * w[c]);
}
DEVFN void st_resid(const P& p, const float* y, const float* w, int write_hb, long g) {
    const long t = g / D; const int c = (int)(g % D);
    const float v = p.h[g] + y[g] * WSP(float, WS_RSTD)[t] * w[c];
    p.h[g] = v; if (write_hb) WSP(bf16, WS_HN)[g] = f2bf(v);
}
constexpr long N_TH = (long)T * NH;
DEVFN void st_dn_prep(const P& p, int layer, long g) {
    const int j = layer / 2; const long t = g / NH; const int hh = (int)(g % NH); const int tt = (int)(t % S); const long t0 = t - tt;
    const bf16* proj = WSP(bf16, WS_PROJ); const float* cw = PRM(PR_ABCONV) + (size_t)j * 5 * AQKV;
    for (int part = 0; part < 3; ++part) {
        float* o = (part == 0 ? WSP(float, WS_QN) : (part == 1 ? WSP(float, WS_KN) : WSP(float, WS_VV))) + (size_t)g * DH; float ss = 0.f;
        for (int d = 0; d < DH; ++d) {
            const int col = part * 1024 + hh * DH + d; float acc = 0.f;
            for (int i = 0; i < 5; ++i) { const int ts = tt + i - 2; if (ts >= 0 && ts < S) acc += bf2f(proj[(size_t)(t0 + ts) * ABINP + col]) * cw[i * AQKV + col]; }
            const float y = siluf(acc); ss += y * y; o[d] = y;
        }
        if (part < 2) { const float r = (1.0f / sqrtf(ss + 1e-6f)) * (part == 0 ? 0.08838834764831845f : 1.f); for (int d = 0; d < DH; ++d) o[d] *= r; }
    }
    for (int dir = 0; dir < 2; ++dir) {
        const float graw = bf2f(proj[(size_t)t * ABINP + COL_G + dir * NH + hh]), braw = bf2f(proj[(size_t)t * ABINP + COL_G + 16 + dir * NH + hh]);
        const float a = expf(PRM(PR_ALOG)[(j * 2 + dir) * NH + hh]), dtb = PRM(PR_DTB)[(j * 2 + dir) * NH + hh];
        WSP(float, WS_G)[(t * 2 + dir) * NH + hh] = -a * softplusf(graw + dtb);
        WSP(float, WS_BETA)[(t * 2 + dir) * NH + hh] = sigmoidf(braw);
    }
}
constexpr long N_SCAN = (long)NSEQ * NH * 2 * DH;
DEVFN void st_dn_scan(const P& p, int, long g) {
    const int vc = (int)(g % DH); const int dir = (int)((g / DH) % 2); const int hh = (int)((g / (2 * DH)) % NH); const int seq = (int)(g / (2 * DH * NH));
    const float *QN = WSP(float, WS_QN), *KN = WSP(float, WS_KN), *VV = WSP(float, WS_VV), *G = WSP(float, WS_G), *BT = WSP(float, WS_BETA);
    float* O = WSP(float, dir ? WS_OB : WS_OF);
    float Sx[DH];
#pragma unroll
    for (int d = 0; d < DH; ++d) Sx[d] = 0.f;
    for (int step = 0; step < S; ++step) {
        const int tt = dir ? S - 1 - step : step; const long t = (long)seq * S + tt;
        const float eg = expf(G[(t * 2 + dir) * NH + hh]), b = BT[(t * 2 + dir) * NH + hh];
        const float* kp = KN + ((size_t)t * NH + hh) * DH; const float* qp = QN + ((size_t)t * NH + hh) * DH; const float vv = VV[((size_t)t * NH + hh) * DH + vc];
        float dot = 0.f;
#pragma unroll
        for (int d0 = 0; d0 < DH; d0 += 16) { MEMFENCE();
#pragma unroll
            for (int d = d0; d < d0 + 16; ++d) { Sx[d] *= eg; dot += Sx[d] * kp[d]; } }
        const float delta = b * (vv - dot); float o = 0.f;
#pragma unroll
        for (int d0 = 0; d0 < DH; d0 += 16) { MEMFENCE();
#pragma unroll
            for (int d = d0; d < d0 + 16; ++d) { Sx[d] += kp[d] * delta; o += Sx[d] * qp[d]; } }
        MEMFENCE();
        O[((size_t)t * NH + hh) * DH + vc] = o;
    }
}
DEVFN void st_dn_out(const P& p, int layer, long g) {
    const int j = layer / 2; const long t = g / NH; const int hh = (int)(g % NH);
    const float *OF = WSP(float, WS_OF) + (size_t)g * DH, *OB = WSP(float, WS_OB) + (size_t)g * DH; const float* on = PRM(PR_ONORM) + j * DH;
    float ss = 0.f; for (int d = 0; d < DH; ++d) { const float o = OF[d] + OB[d]; ss += o * o; }
    const float r = 1.0f / sqrtf(ss / (float)DH + RMS_EPS);
    const bf16* z = WSP(bf16, WS_PROJ) + (size_t)t * ABINP + COL_Z + hh * DH; bf16* out = WSP(bf16, WS_MIXIN) + (size_t)t * ABMIX + hh * DH;
    for (int d = 0; d < DH; ++d) out[d] = f2bf((OF[d] + OB[d]) * r * on[d] * siluf(bf2f(z[d])));
}
constexpr long N_THD = (long)T * NH * DH;
DEVFN long na_key_token(long t, int jw, int& dr, int& dc) {
    const int tt = (int)(t % S); const long t0 = t - tt; const int r = tt / GW, c = tt % GW;
    const int rs = clampi(r - WR / 2, 0, ROWS - WR), cs = clampi(c - NAC / 2, 0, GW - NAC);
    const int rk = rs + jw / NAC, ck = cs + jw % NAC;
    dr = rk - r + NAR - 1; dc = clampi(ck - c + NAC - 1, 0, 2 * NAC - 2);
    return t0 + (long)rk * GW + ck;
}
DEVFN void st_na_scores(const P& p, int layer, long g) {
    const int j = layer / 2; const int jw = (int)(g % DH); const int hh = (int)((g / DH) % NH); const long t = g / (DH * NH);
    int dr, dc; const long tk = na_key_token(t, jw, dr, dc);
    const bf16* q = WSP(bf16, WS_PROJ) + (size_t)t * ABINP + COL_QB + hh * DH; const bf16* k = WSP(bf16, WS_PROJ) + (size_t)tk * ABINP + COL_KB + hh * DH;
    float dot = 0.f; for (int d = 0; d < DH; ++d) dot += bf2f(q[d]) * bf2f(k[d]);
    WSP(float, WS_NASC)[g] = dot * 0.08838834764831845f + PRM(PR_RPB)[(((size_t)j * NH + hh) * (2 * NAR - 1) + dr) * (2 * NAC - 1) + dc];
}
DEVFN void st_na_out(const P& p, int, long g) {
    const int d = (int)(g % DH); const int hh = (int)((g / DH) % NH); const long t = g / (DH * NH);
    const float* sc = WSP(float, WS_NASC) + ((size_t)t * NH + hh) * DH;
    float m = sc[0]; for (int jw = 1; jw < WR * NAC; ++jw) m = fmaxf(m, sc[jw]);
    float l = 0.f, o = 0.f;
    for (int jw = 0; jw < WR * NAC; ++jw) { int dr, dc; const long tk = na_key_token(t, jw, dr, dc); const float e = expf(sc[jw] - m); l += e;
        o += e * bf2f(WSP(bf16, WS_PROJ)[(size_t)tk * ABINP + COL_VB + hh * DH + d]); }
    WSP(bf16, WS_MIXIN)[(size_t)t * ABMIX + 1024 + hh * DH + d] = f2bf(o / l);
}
DEVFN float lambda_init_of(int layer) { return 0.8f - 0.6f * expf(-0.3f * (float)layer); }
DEVFN void st_lam(const P& p, int layer, long) {
    const float* lp = PRM(PR_LAMBDA) + (size_t)(layer / 2) * 4 * DH; float a = 0.f, b = 0.f;
    for (int d = 0; d < DH; ++d) { a += lp[d] * lp[DH + d]; b += lp[2 * DH + d] * lp[3 * DH + d]; }
    const float li = lambda_init_of(layer); WSP(float, WS_LAM)[0] = expf(a) - expf(b) + li; WSP(float, WS_LAM)[1] = li;
}
constexpr long N_ROPE = (long)T * 2 * 16 * 16;
DEVFN void st_rope(const P& p, int, long g) {
    const int i = (int)(g % 16); const int hj = (int)((g / 16) % 16); const int which = (int)((g / 256) % 2); const long t = g / 512;
    bf16* x = WSP(bf16, WS_PROJ) + (size_t)t * CIN + which * 2048 + hj * DH;
    const float inv = powf(500000.0f, -(float)(2 * i) / 32.0f); const float ang = (float)(t % S) * inv; const float cs = cosf(ang), sn = sinf(ang);
    const float x1 = bf2f(x[i]), x2 = bf2f(x[16 + i]);
    x[i] = f2bf(x1 * cs - x2 * sn); x[16 + i] = f2bf(x2 * cs + x1 * sn);
}
constexpr int DA_E = 64;
constexpr long N_DATT = (long)NSEQ * NH * 2 * (256 / DA_E) * S;
DEVFN void st_dattn(const P& p, int, long g) {
    const int qi = (int)(g % S); long r = g / S; const int es = (int)(r % (256 / DA_E)); r /= (256 / DA_E); const int jj = (int)(r % 2); r /= 2; const int hh = (int)(r % NH); const int seq = (int)(r / NH);
    const bf16* proj = WSP(bf16, WS_PROJ); const long t = (long)seq * S + qi;
    float q[DH];
#pragma unroll
    for (int d = 0; d < DH; ++d) q[d] = bf2f(proj[(size_t)t * CIN + hh * 256 + jj * DH + d]) * 0.08838834764831845f;
    float o[DA_E];
#pragma unroll
    for (int e = 0; e < DA_E; ++e) o[e] = 0.f;
    float m = -1e30f, l = 0.f;
    for (int kk = 0; kk < S; ++kk) {
        const bf16* kr = proj + (size_t)((long)seq * S + kk) * CIN + 2048 + hh * 256 + jj * DH; const bf16* vr = proj + (size_t)((long)seq * S + kk) * CIN + 4096 + hh * 256 + es * DA_E;
        float s = 0.f;
#pragma unroll
        for (int d0 = 0; d0 < DH; d0 += 32) { MEMFENCE();
#pragma unroll
            for (int d = d0; d < d0 + 32; ++d) s += q[d] * bf2f(kr[d]); }
        MEMFENCE();
        const float mn = fmaxf(m, s), al = expf(m - mn), pe = expf(s - mn); m = mn; l = l * al + pe;
#pragma unroll
        for (int e = 0; e < DA_E; ++e) o[e] = o[e] * al + pe * bf2f(vr[e]);
    }
    float* O = WSP(float, jj ? WS_O1 : WS_O0) + (size_t)t * 2048 + hh * 256 + es * DA_E; const float il = 1.0f / l;
#pragma unroll
    for (int e = 0; e < DA_E; ++e) O[e] = o[e] * il;
}
DEVFN void st_c_out(const P& p, int layer, long g) {
    const int j = layer / 2; const long t = g / NH; const int hh = (int)(g % NH); const float lam = WSP(float, WS_LAM)[0], li = WSP(float, WS_LAM)[1];
    const float *O0 = WSP(float, WS_O0) + (size_t)t * 2048 + hh * 256, *O1 = WSP(float, WS_O1) + (size_t)t * 2048 + hh * 256; const float* sw = PRM(PR_SUBLN) + j * 256;
    float ss = 0.f; for (int e = 0; e < 256; ++e) { const float o = O0[e] - lam * O1[e]; ss += o * o; }
    const float r = (1.0f / sqrtf(ss / 256.0f + RMS_EPS)) * (1.0f - li);
    bf16* out = WSP(bf16, WS_MIXIN) + (size_t)t * 2048 + hh * 256;
    for (int e = 0; e < 256; ++e) out[e] = f2bf((O0[e] - lam * O1[e]) * r * sw[e]);
}
constexpr long N_ACT = (long)T * DFF;
DEVFN float gelu_tanh(float x) { return 0.5f * x * (1.0f + tanhf(0.7978845608028654f * (x + 0.044715f * x * x * x))); }
DEVFN void st_ffn_act(const P& p, int layer, long g) {
    const long t = g / DFF; const int c = (int)(g % DFF); const int tt = (int)(t % S);
    const bf16* hid = WSP(bf16, WS_HID); const float* cw = PRM(PR_FCW) + (size_t)layer * 3 * 2 * DFF; const float* cb = PRM(PR_FCB) + (size_t)layer * 2 * DFF;
    float ga = cb[c], up = cb[DFF + c];
    for (int i = 0; i < 3; ++i) { const int ts = tt + i - 1; if (ts >= 0 && ts < S) { const bf16* r = hid + (size_t)(t - tt + ts) * (2 * DFF);
        ga += bf2f(r[c]) * cw[i * 2 * DFF + c]; up += bf2f(r[DFF + c]) * cw[i * 2 * DFF + DFF + c]; } }
    WSP(bf16, WS_ACT)[g] = f2bf(gelu_tanh(ga) * up);
}
DEVFN void st_ple(const P& p, int, long g) { p.h[g] += sigmoidf(WSP(float, WS_GOUT)[g]) * WSP(float, WS_GOUT2)[g]; }
#ifndef EMU
namespace pg8 {
#define PG8_LAS __attribute__((address_space(3)))
typedef unsigned short bf16_t;
typedef short bf16x8 __attribute__((ext_vector_type(8)));
typedef float f32x4 __attribute__((ext_vector_type(4)));
typedef unsigned u32x4 __attribute__((ext_vector_type(4)));
constexpr int BM = 256, BK = 64, HALF = 128, HTB = HALF * BK * 2  , STAGE_BYTES = 8 * HTB, NXCD = 8, WGM = 4;

__host__ __device__ __forceinline__ int lds_byte(int r, int c) { const int st = (r >> 4) * 2 + (c >> 5), rr = r & 15, cc = c & 31, ob = rr * 64 + cc * 2; return st * 1024 + (ob ^ (((ob >> 9) & 1) << 5)); }
__host__ __device__ __forceinline__ void stage_rc(int b, int& R, int& C) { const int st = b / 1024, sb = b % 1024, swz = sb ^ (((sb >> 9) & 1) << 5); R = (st >> 1) * 16 + swz / 64; C = (st & 1) * 32 + (swz % 64) / 2; }
__host__ __device__ __forceinline__ int perm32(int rho) { const int n = rho >> 4, i = rho & 15; return 8 * (i >> 2) + 4 * n + (i & 3); }

struct Unit { int pm, pn; };
struct Gemm { const bf16_t* A; const bf16_t* Bt; int M, N, K; };

struct StaticOrder {
    int nM, nN, nwg, G, c;
    __host__ __device__ void init(int M, int N, int G_, int c_) { nM = M / BM; nN = N / BM; nwg = nM * nN; G = G_; c = c_; }
    __host__ __device__ bool next(int i, Unit& u) const {
        const long L = (long)i * G + c; if (L >= nwg) return false;
        int wgid = (int)L; { const int q = nwg / NXCD, r = nwg % NXCD, xcd = wgid % NXCD, off = wgid / NXCD; wgid = (xcd < r ? xcd * (q + 1) : r * (q + 1) + (xcd - r) * q) + off; }
        const int nig = WGM * nN, gid = wgid / nig, fm = gid * WGM, gsz = (nM - fm) < WGM ? (nM - fm) : WGM;
        u.pm = fm + ((wgid % nig) % gsz); u.pn = (wgid % nig) / gsz; return true;
    }
    __device__ __forceinline__ void a_ready(const Unit&) const {}
    __device__ __forceinline__ void done(const Unit&) const {}
};

__device__ __forceinline__ unsigned cvt_pk_bf16(float lo, float hi) { unsigned r; asm volatile("v_cvt_pk_bf16_f32 %0, %1, %2" : "=v"(r) : "v"(lo), "v"(hi)); return r; }
struct EpiBf16 {
    static constexpr bool PERM = true, AFTER_DRAIN = false;
    bf16_t* O; int ldc;
    __device__ __forceinline__ void operator()(const f32x4 (&acc)[2][2][4][2], const Unit& u, int wr, int wc, int fr, int fq) const {
        const int row0 = u.pm * BM + wr * 64 + fr; const int col0 = u.pn * BM + wc * 32 + 8 * fq;
#pragma unroll
        for (int ai = 0; ai < 2; ++ai)
#pragma unroll
            for (int m = 0; m < 4; ++m) { bf16_t* rowp = O + (size_t)(row0 + ai * HALF + m * 16) * ldc + col0;
#pragma unroll
                for (int bj = 0; bj < 2; ++bj) { const f32x4 v0 = acc[ai][bj][m][0], v1 = acc[ai][bj][m][1];
                    u32x4 w; w.x = cvt_pk_bf16(v0[0], v0[1]); w.y = cvt_pk_bf16(v0[2], v0[3]); w.z = cvt_pk_bf16(v1[0], v1[1]); w.w = cvt_pk_bf16(v1[2], v1[3]);
                    *(u32x4*)(rowp + bj * HALF) = w; } }
    }
};
struct EpiBf16Ro {
    static constexpr bool PERM = true, AFTER_DRAIN = false;
    bf16_t* O; int ldc; const float* tab; int seqlen;
    __device__ __forceinline__ void operator()(const f32x4 (&acc)[2][2][4][2], const Unit& u, int wr, int wc, int fr, int fq) const {
        const int row0 = u.pm * BM + wr * 64 + fr; const int col0 = u.pn * BM + wc * 32 + 8 * fq;
        const bool rope = tab != nullptr && u.pn < 16 && wc == 0;
#pragma unroll
        for (int ai = 0; ai < 2; ++ai)
#pragma unroll
            for (int m = 0; m < 4; ++m) { const int row = row0 + ai * HALF + m * 16; bf16_t* rowp = O + (size_t)row * ldc + col0;
#pragma unroll
                for (int bj = 0; bj < 2; ++bj) { f32x4 v0 = acc[ai][bj][m][0], v1 = acc[ai][bj][m][1];
                    if (rope) { const float* cs = tab + ((size_t)(row % seqlen) * 16 + 8 * (fq & 1)) * 2; const float sgn = fq < 2 ? -1.f : 1.f;
                        const f32x4 c0 = *(const f32x4*)cs, c1 = *(const f32x4*)(cs + 4), c2 = *(const f32x4*)(cs + 8), c3 = *(const f32x4*)(cs + 12);
#pragma unroll
                        for (int e = 0; e < 4; ++e) { const float o0 = __shfl_xor(v0[e], 32), o1 = __shfl_xor(v1[e], 32);
                            const float cs0 = (e < 2 ? c0 : c1)[2 * (e & 1)], sn0 = (e < 2 ? c0 : c1)[2 * (e & 1) + 1], cs1 = (e < 2 ? c2 : c3)[2 * (e & 1)], sn1 = (e < 2 ? c2 : c3)[2 * (e & 1) + 1];
                            v0[e] = v0[e] * cs0 + sgn * o0 * sn0; v1[e] = v1[e] * cs1 + sgn * o1 * sn1; } }
                    u32x4 w; w.x = cvt_pk_bf16(v0[0], v0[1]); w.y = cvt_pk_bf16(v0[2], v0[3]); w.z = cvt_pk_bf16(v1[0], v1[1]); w.w = cvt_pk_bf16(v1[2], v1[3]);
                    *(u32x4*)(rowp + bj * HALF) = w; } }
    }
};
__device__ __forceinline__ float dpp_prev(float oldv, float x) { return __int_as_float(__builtin_amdgcn_update_dpp(__float_as_int(oldv), __float_as_int(x), 0x111, 0xf, 0xf, false)); }
__device__ __forceinline__ float dpp_next(float oldv, float x) { return __int_as_float(__builtin_amdgcn_update_dpp(__float_as_int(oldv), __float_as_int(x), 0x101, 0xf, 0xf, false)); }
__device__ __forceinline__ float dpp_ror1(float x) { return __int_as_float(__builtin_amdgcn_update_dpp(__float_as_int(x), __float_as_int(x), 0x121, 0xf, 0xf, false)); }
__device__ __forceinline__ float dpp_rol1(float x) { return __int_as_float(__builtin_amdgcn_update_dpp(__float_as_int(x), __float_as_int(x), 0x12F, 0xf, 0xf, false)); }
__device__ __forceinline__ float gelu_t(float x) { const float u = 0.7978845608028654f * (x + 0.044715f * x * x * x); return x * __builtin_amdgcn_rcpf(1.0f + __builtin_amdgcn_exp2f(-2.885390081777927f * u)); }
struct EpiConvAct {
    static constexpr bool PERM = true, AFTER_DRAIN = false;
    bf16_t* ACT; float* HALO; float* HDUMP; const float* cw; const float* cb; PG8_LAS float* EX;
    __device__ __forceinline__ void operator()(const f32x4 (&acc)[2][2][4][2], const Unit& u, int wr, int wc, int fr, int fq) const {
        const int ch0 = u.pn * 128 + wc * 32 + 8 * fq;
#pragma unroll
        for (int ai = 0; ai < 2; ++ai) { const int sg = 2 * ai + wr;
            PG8_LAS float* d0 = EX + ((fr == 0) ? ((((sg * 2 + 0) * 4 + wc) * 4 + fq) * 16) : (2048 + wc * 64 + fq * 16));
            PG8_LAS float* d1 = EX + ((fr == 15) ? ((((sg * 2 + 1) * 4 + wc) * 4 + fq) * 16) : (2048 + wc * 64 + fq * 16));
#pragma unroll
            for (int bj = 0; bj < 2; ++bj)
#pragma unroll
                for (int n = 0; n < 2; ++n) { *(PG8_LAS f32x4*)(d0 + (bj * 2 + n) * 4) = acc[ai][bj][0][n]; *(PG8_LAS f32x4*)(d1 + (bj * 2 + n) * 4) = acc[ai][bj][3][n]; } }
        if (wr == 0) { float* hp = (fr < 2) ? HALO + (((size_t)u.pm * 4 + fr) * 2) * DFF + ch0 : HDUMP + (size_t)(wc * 4 + fq) * 16;
            const size_t bs = (fr < 2) ? (size_t)DFF : (size_t)8;
#pragma unroll
            for (int bj = 0; bj < 2; ++bj)
#pragma unroll
                for (int n = 0; n < 2; ++n) *(f32x4*)(hp + bj * bs + 4 * n) = acc[0][bj][0][n]; }
        else { float* hp = (fr >= 14) ? HALO + (((size_t)u.pm * 4 + 2 + (fr - 14)) * 2) * DFF + ch0 : HDUMP + (size_t)(wc * 4 + fq) * 16;
            const size_t bs = (fr >= 14) ? (size_t)DFF : (size_t)8;
#pragma unroll
            for (int bj = 0; bj < 2; ++bj)
#pragma unroll
                for (int n = 0; n < 2; ++n) *(f32x4*)(hp + bj * bs + 4 * n) = acc[1][bj][3][n]; }
        asm volatile("s_waitcnt lgkmcnt(0)" ::: "memory"); __builtin_amdgcn_s_barrier(); asm volatile("" ::: "memory");
        unsigned W[2][4][4];
#pragma unroll
        for (int n = 0; n < 2; ++n)
#pragma unroll
            for (int e2 = 0; e2 < 4; e2 += 2) {
                float wg[3][2], wu[3][2], bg[2], bu[2];
#pragma unroll
                for (int k = 0; k < 2; ++k) { const int ch = ch0 + 4 * n + e2 + k;
#pragma unroll
                    for (int t = 0; t < 3; ++t) { wg[t][k] = cw[t * 2 * DFF + ch]; wu[t][k] = cw[t * 2 * DFF + DFF + ch]; }
                    bg[k] = cb[ch]; bu[k] = cb[DFF + ch]; }
#pragma unroll
                for (int ai = 0; ai < 2; ++ai) { const int sg = 2 * ai + wr;
                    float pg[2] = {0.f, 0.f}, pu[2] = {0.f, 0.f}, ng[2] = {0.f, 0.f}, nu[2] = {0.f, 0.f};
                    if (sg > 0) { const PG8_LAS float* d = EX + ((((sg - 1) * 2 + 1) * 4 + wc) * 4 + fq) * 16 + n * 4 + e2; pg[0] = d[0]; pg[1] = d[1]; pu[0] = d[8]; pu[1] = d[9]; }
                    if (sg < 3) { const PG8_LAS float* d = EX + ((((sg + 1) * 2 + 0) * 4 + wc) * 4 + fq) * 16 + n * 4 + e2; ng[0] = d[0]; ng[1] = d[1]; nu[0] = d[8]; nu[1] = d[9]; }
#pragma unroll
                    for (int m = 0; m < 4; ++m) { float o[2];
#pragma unroll
                        for (int k = 0; k < 2; ++k) { const int e = e2 + k;
                            const float xg = acc[ai][0][m][n][e], xu = acc[ai][1][m][n][e];
                            const float og_p = m > 0 ? dpp_ror1(acc[ai][0][m - 1][n][e]) : pg[k], ou_p = m > 0 ? dpp_ror1(acc[ai][1][m - 1][n][e]) : pu[k];
                            const float og_n = m < 3 ? dpp_rol1(acc[ai][0][m + 1][n][e]) : ng[k], ou_n = m < 3 ? dpp_rol1(acc[ai][1][m + 1][n][e]) : nu[k];
                            const float gp = dpp_prev(og_p, xg), gn = dpp_next(og_n, xg), up = dpp_prev(ou_p, xu), un = dpp_next(ou_n, xu);
                            const float cg = bg[k] + wg[0][k] * gp + wg[1][k] * xg + wg[2][k] * gn, cu = bu[k] + wu[0][k] * up + wu[1][k] * xu + wu[2][k] * un;
                            o[k] = gelu_t(cg) * cu; }
                        W[ai][m][n * 2 + (e2 >> 1)] = cvt_pk_bf16(o[0], o[1]); } }
            }
        const int row0 = u.pm * BM + wr * 64 + fr;
#pragma unroll
        for (int ai = 0; ai < 2; ++ai)
#pragma unroll
            for (int m = 0; m < 4; ++m) { u32x4 w; w.x = W[ai][m][0]; w.y = W[ai][m][1]; w.z = W[ai][m][2]; w.w = W[ai][m][3];
                *(u32x4*)(ACT + (size_t)(row0 + ai * HALF + m * 16) * DFF + ch0) = w; }
    }
};
struct EpiF32 {
    static constexpr bool PERM = false, AFTER_DRAIN = false;
    float* C; int ldc;
    __device__ __forceinline__ void operator()(const f32x4 (&acc)[2][2][4][2], const Unit& u, int wr, int wc, int fr, int fq) const {
        const int row0 = u.pm * BM + wr * 64 + fr, col0 = u.pn * BM + wc * 32 + 4 * fq;
#pragma unroll
        for (int ai = 0; ai < 2; ++ai)
#pragma unroll
            for (int m = 0; m < 4; ++m) { float* rowp = C + (size_t)(row0 + ai * HALF + m * 16) * ldc + col0;
#pragma unroll
                for (int bj = 0; bj < 2; ++bj)
#pragma unroll
                    for (int n = 0; n < 2; ++n) *(f32x4*)(rowp + bj * HALF + n * 16) = acc[ai][bj][m][n]; }
    }
};
template <class Epi, class Sched, bool ALIGN_EPI = false, bool SP2 = false>
__device__ __forceinline__ void gemm_phase(PG8_LAS unsigned char* lds, const Gemm g, const Sched& S, const Epi& E, int tid_in) {
    int tid_ = tid_in; asm volatile("" : "+v"(tid_));
    const int tid = tid_, wid = __builtin_amdgcn_readfirstlane(tid >> 6), lane = tid & 63, wr = wid >> 2, wc = wid & 3, fr = lane & 15, fq = lane >> 4;
    const int K = g.K, nt = K / BK;
    unsigned voffA[2], voffB[2];
#pragma unroll
    for (int i = 0; i < 2; ++i) { int R, C; stage_rc(tid * 16 + i * 8192, R, C); const int Rb = Epi::PERM ? ((R & ~31) + perm32(R & 31)) : R;
        voffA[i] = (unsigned)(R * K + C) * 2u; voffB[i] = (unsigned)(Rb * K + C) * 2u; }
    const size_t kstep = (size_t)(BK * 2);
    const size_t hstep = (size_t)HALF * K * 2;
    const size_t tstep = 2 * hstep;
    const unsigned ldsw = (unsigned)wid * 1024u;
    const int aoff = lds_byte(wr * 64 + fr, fq * 8), boff = lds_byte(wc * 32 + fr, fq * 8);
#define PG8_SA(b, h) (((b) * 2 + (h)) * HTB)
#define PG8_SB(b, h) ((4 + (b) * 2 + (h)) * HTB)
#define PG8_STAGE(bufoff, gbase, voff) do { _Pragma("unroll") for (int _i = 0; _i < 2; ++_i) \
        __builtin_amdgcn_global_load_lds((const unsigned*)((const char*)(gbase) + (voff)[_i]), (PG8_LAS unsigned*)(lds + (bufoff) + ldsw + _i * 8192), 16, 0, 0); } while (0)
#define PG8_LDA(dst, b, h) do { _Pragma("unroll") for (int m = 0; m < 4; ++m) _Pragma("unroll") for (int k = 0; k < 2; ++k) dst[m][k] = *(const PG8_LAS bf16x8*)(lds + PG8_SA(b, h) + aoff + m * 2048 + k * 1024); } while (0)
#define PG8_LDB(dst, b, h) do { _Pragma("unroll") for (int n = 0; n < 2; ++n) _Pragma("unroll") for (int k = 0; k < 2; ++k) dst[n][k] = *(const PG8_LAS bf16x8*)(lds + PG8_SB(b, h) + boff + n * 2048 + k * 1024); } while (0)
#define PG8_MMA(ai, bj, At, Bt) do { __builtin_amdgcn_s_setprio(1); _Pragma("unroll") for (int m = 0; m < 4; ++m) _Pragma("unroll") for (int n = 0; n < 2; ++n) _Pragma("unroll") for (int k = 0; k < 2; ++k) \
        acc[ai][bj][m][n] = __builtin_amdgcn_mfma_f32_16x16x32_bf16(Bt[n][k], At[m][k], acc[ai][bj][m][n], 0, 0, 0); __builtin_amdgcn_s_setprio(0); } while (0)
#define PG8_WAIT_V(n) asm volatile("s_waitcnt vmcnt(" #n ")" ::: "memory")
#define PG8_WAIT_L(n) asm volatile("s_waitcnt lgkmcnt(" #n ")" ::: "memory")
#define PG8_BAR __builtin_amdgcn_s_barrier()
#define PG8_SCHED __builtin_amdgcn_sched_barrier(0)
    Unit cur, nxt; int ui = 0;
    if (!S.next(0, cur)) return;
    f32x4 acc[2][2][4][2];
#pragma unroll
    for (int a = 0; a < 2; ++a)
#pragma unroll
        for (int b = 0; b < 2; ++b)
#pragma unroll
            for (int m = 0; m < 4; ++m)
#pragma unroll
                for (int n = 0; n < 2; ++n) acc[a][b][m][n] = (f32x4){0.f, 0.f, 0.f, 0.f};
    bf16x8 At[4][2], B0[2][2], B1[2][2];
    const char* cA = (const char*)g.A + (size_t)cur.pm * tstep; const char* cB = (const char*)g.Bt + (size_t)cur.pn * tstep;
    S.a_ready(cur);
    if constexpr (SP2) {
        PG8_STAGE(PG8_SB(0, 0), cB, voffB); PG8_STAGE(PG8_SB(0, 1), cB + hstep, voffB); PG8_STAGE(PG8_SA(0, 0), cA, voffA); PG8_STAGE(PG8_SA(0, 1), cA + hstep, voffA);
        if (wr == 1) PG8_BAR;
        PG8_WAIT_V(2); PG8_BAR;
        PG8_STAGE(PG8_SB(1, 0), cB + kstep, voffB); PG8_STAGE(PG8_SA(1, 0), cA + kstep, voffA); PG8_STAGE(PG8_SB(1, 1), cB + hstep + kstep, voffB);
        PG8_WAIT_V(6); PG8_BAR;
    } else {
        PG8_STAGE(PG8_SB(0, 0), cB, voffB); PG8_STAGE(PG8_SA(0, 0), cA, voffA); PG8_STAGE(PG8_SB(0, 1), cB + hstep, voffB); PG8_STAGE(PG8_SA(0, 1), cA + hstep, voffA);
        if (wr == 1) PG8_BAR;
        PG8_WAIT_V(4); PG8_BAR;
        PG8_STAGE(PG8_SB(1, 0), cB + kstep, voffB); PG8_STAGE(PG8_SA(1, 0), cA + kstep, voffA); PG8_STAGE(PG8_SB(1, 1), cB + hstep + kstep, voffB);
        PG8_WAIT_V(6); PG8_BAR;
    }
    for (;;) {
        const bool has_next = S.next(ui + 1, nxt);
        const char* nA = has_next ? (const char*)g.A + (size_t)nxt.pm * tstep : cA; const char* nB = has_next ? (const char*)g.Bt + (size_t)nxt.pn * tstep : cB;
        for (int t = 0; t < nt; t += 2) {
            const bool last = (t == nt - 2);
            const char* a1 = cA + (size_t)(t + 1) * kstep;
            const char* a2 = last ? nA : cA + (size_t)(t + 2) * kstep; const char* b2 = last ? nB : cB + (size_t)(t + 2) * kstep;
            const char* a3 = a2 + kstep; const char* b3 = b2 + kstep;
            if (last && has_next) S.a_ready(nxt);
            if constexpr (SP2) {
            PG8_LDB(B0, 0, 0); PG8_LDB(B1, 0, 1); PG8_SCHED; PG8_LDA(At, 0, 0); PG8_STAGE(PG8_SA(1, 1), a1 + hstep, voffA);
            PG8_WAIT_V(8); PG8_WAIT_L(0); PG8_BAR; PG8_MMA(0, 0, At, B0); PG8_MMA(0, 1, At, B1); PG8_BAR; PG8_SCHED;
            PG8_LDA(At, 0, 1); PG8_STAGE(PG8_SB(0, 0), b2, voffB); PG8_STAGE(PG8_SB(0, 1), b2 + hstep, voffB); PG8_STAGE(PG8_SA(0, 0), a2, voffA);
            PG8_WAIT_V(8); PG8_WAIT_L(0); PG8_BAR; PG8_MMA(1, 0, At, B0); PG8_MMA(1, 1, At, B1); PG8_BAR; PG8_SCHED;
            PG8_LDB(B0, 1, 0); PG8_LDB(B1, 1, 1); PG8_SCHED; PG8_LDA(At, 1, 0); PG8_STAGE(PG8_SA(0, 1), a2 + hstep, voffA);
            PG8_WAIT_V(8); PG8_WAIT_L(0); PG8_BAR; PG8_MMA(0, 0, At, B0); PG8_MMA(0, 1, At, B1); PG8_BAR; PG8_SCHED;
            PG8_LDA(At, 1, 1); PG8_STAGE(PG8_SB(1, 0), b3, voffB); PG8_STAGE(PG8_SB(1, 1), b3 + hstep, voffB); PG8_STAGE(PG8_SA(1, 0), a3, voffA);
            PG8_WAIT_V(8); PG8_WAIT_L(0); PG8_BAR; PG8_MMA(1, 0, At, B0); PG8_MMA(1, 1, At, B1); PG8_BAR; PG8_SCHED;
            } else {
            PG8_LDB(B0, 0, 0); PG8_SCHED; PG8_LDA(At, 0, 0); PG8_STAGE(PG8_SA(1, 1), a1 + hstep, voffA);
            PG8_WAIT_L(8); PG8_BAR; PG8_WAIT_L(0); PG8_MMA(0, 0, At, B0); PG8_BAR; PG8_SCHED;
            PG8_LDB(B1, 0, 1); PG8_STAGE(PG8_SB(0, 0), b2, voffB);
            PG8_BAR; PG8_WAIT_L(0); PG8_MMA(0, 1, At, B1); PG8_BAR;
            PG8_LDA(At, 0, 1); PG8_STAGE(PG8_SA(0, 0), a2, voffA);
            PG8_BAR; PG8_WAIT_L(0); PG8_MMA(1, 0, At, B0); PG8_BAR; PG8_SCHED;
            PG8_STAGE(PG8_SB(0, 1), b2 + hstep, voffB);
            PG8_WAIT_V(6); PG8_BAR; PG8_MMA(1, 1, At, B1); PG8_BAR;
            PG8_LDB(B0, 1, 0); PG8_SCHED; PG8_LDA(At, 1, 0); PG8_STAGE(PG8_SA(0, 1), a2 + hstep, voffA);
            PG8_WAIT_L(8); PG8_BAR; PG8_WAIT_L(0); PG8_MMA(0, 0, At, B0); PG8_BAR; PG8_SCHED;
            PG8_LDB(B1, 1, 1); PG8_STAGE(PG8_SB(1, 0), b3, voffB);
            PG8_BAR; PG8_WAIT_L(0); PG8_MMA(0, 1, At, B1); PG8_BAR;
            PG8_LDA(At, 1, 1); PG8_STAGE(PG8_SA(1, 0), a3, voffA);
            PG8_BAR; PG8_WAIT_L(0); PG8_MMA(1, 0, At, B0); PG8_BAR; PG8_SCHED;
            PG8_STAGE(PG8_SB(1, 1), b3 + hstep, voffB);
            PG8_WAIT_V(6); PG8_BAR; PG8_MMA(1, 1, At, B1); PG8_BAR;
            }
        }
        if constexpr (ALIGN_EPI) { if (wr == 0) PG8_BAR; }
        if constexpr (!Epi::AFTER_DRAIN) { E(acc, cur, wr, wc, fr, fq); S.done(cur); }
        if (!has_next) break;
#pragma unroll
        for (int a = 0; a < 2; ++a)
#pragma unroll
            for (int b = 0; b < 2; ++b)
#pragma unroll
                for (int m = 0; m < 4; ++m)
#pragma unroll
                    for (int n = 0; n < 2; ++n) acc[a][b][m][n] = (f32x4){0.f, 0.f, 0.f, 0.f};
        cur = nxt; cA = nA; cB = nB; ++ui;
        if constexpr (ALIGN_EPI) { if (wr == 1) PG8_BAR; }
    }
    PG8_WAIT_V(0);
    if constexpr (!ALIGN_EPI) { if (wr == 0) PG8_BAR; }
    PG8_BAR;
    if constexpr (Epi::AFTER_DRAIN) { E.fused(acc, cur, wr, wc, fr, fq, lds, wid, lane); S.done(cur); }
#undef PG8_SA
#undef PG8_SB
#undef PG8_STAGE
#undef PG8_LDA
#undef PG8_LDB
#undef PG8_MMA
#undef PG8_WAIT_V
#undef PG8_WAIT_L
#undef PG8_BAR
#undef PG8_SCHED
}
}
#endif
enum { ST_PRM = 100, ST_INIT = 0, ST_PB, ST_WT, ST_ROWSS, ST_NORM, ST_RESID, ST_DNPREP, ST_DNSCAN, ST_DNOUT, ST_NASC, ST_NAOUT, ST_LAM, ST_ROPE, ST_DATTN, ST_COUT, ST_FFNACT, ST_PLE };
struct Job { P p; WT w; const float* a; const float* b; long n; int layer; int flag; };
template <int ST> DEVFN void run_item(const Job& j, long g) {
    if constexpr (ST == ST_PRM) st_prm(j.p, j.layer, g);
    else if constexpr (ST == ST_INIT) st_init(j.p, j.layer, g);
    else if constexpr (ST == ST_PB) st_pb(j.p, j.layer, g);
    else if constexpr (ST == ST_WT) st_wt(j.w, g);
    else if constexpr (ST == ST_ROWSS) st_rowss(j.p, j.a, g);
    else if constexpr (ST == ST_NORM) st_norm_bf16(j.p, j.a, g);
    else if constexpr (ST == ST_RESID) st_resid(j.p, j.a, j.b, j.flag, g);
    else if constexpr (ST == ST_DNPREP) st_dn_prep(j.p, j.layer, g);
    else if constexpr (ST == ST_DNSCAN) st_dn_scan(j.p, j.layer, g);
    else if constexpr (ST == ST_DNOUT) st_dn_out(j.p, j.layer, g);
    else if constexpr (ST == ST_NASC) st_na_scores(j.p, j.layer, g);
    else if constexpr (ST == ST_NAOUT) st_na_out(j.p, j.layer, g);
    else if constexpr (ST == ST_LAM) st_lam(j.p, j.layer, g);
    else if constexpr (ST == ST_ROPE) st_rope(j.p, j.layer, g);
    else if constexpr (ST == ST_DATTN) st_dattn(j.p, j.layer, g);
    else if constexpr (ST == ST_COUT) st_c_out(j.p, j.layer, g);
    else if constexpr (ST == ST_FFNACT) st_ffn_act(j.p, j.layer, g);
    else if constexpr (ST == ST_PLE) st_ple(j.p, j.layer, g);
}
#ifdef EMU
template <int ST> static void run_stage(Job j, long n) {
    j.n = n;
#pragma omp parallel for schedule(dynamic, 64)
    for (long g = 0; g < n; ++g) run_item<ST>(j, g);
}
static void emu_gemm(const bf16* A, const bf16* Bt, int M, int N, int K, bf16* Ob, float* Of, int ldc) {
    std::vector<float> Af((size_t)M * K), Bf((size_t)N * K);
    for (size_t i = 0; i < Af.size(); ++i) Af[i] = bf2f(A[i]);
    for (size_t i = 0; i < Bf.size(); ++i) Bf[i] = bf2f(Bt[i]);
#pragma omp parallel for schedule(dynamic, 8)
    for (int m = 0; m < M; ++m) for (int n = 0; n < N; ++n) { const float* a = &Af[(size_t)m * K]; const float* b = &Bf[(size_t)n * K]; float s = 0.f;
        for (int k = 0; k < K; ++k) s += a[k] * b[k];
        if (Ob) Ob[(size_t)m * ldc + n] = f2bf(s); else Of[(size_t)m * ldc + n] = s; }
}
static void gemm_bf16(const bf16* A, const bf16* Bt, int M, int N, int K, bf16* O, int ldc) { emu_gemm(A, Bt, M, N, K, O, nullptr, ldc); }
static void gemm_f32(const bf16* A, const bf16* Bt, int M, int N, int K, float* O, int ldc) { emu_gemm(A, Bt, M, N, K, nullptr, O, ldc); }

static void forward(const P& p) {
    Job j; memset(&j, 0, sizeof(j)); j.p = p;
    auto wt = [&](const float* W, size_t off, int K, int N, int Npad) { j.w.W = W; j.w.O = WSP(bf16, off); j.w.K = K; j.w.N = N; j.w.Npad = Npad; run_stage<ST_WT>(j, (long)Npad * K); };
    for (int i = 0; i < 2; ++i) {
        wt(p.ab_w_in + (size_t)i * D * ABIN, WS_WABIN + (size_t)i * ABINP * D * 2, D, ABIN, ABINP);
        wt(p.ab_w_out + (size_t)i * ABMIX * D, WS_WABOUT + (size_t)i * D * ABMIX * 2, ABMIX, D, D);
        wt(p.c_w_in + (size_t)i * D * CIN, WS_WCIN + (size_t)i * CIN * D * 2, D, CIN, CIN);
        wt(p.c_w_out + (size_t)i * CV * D, WS_WCOUT + (size_t)i * D * CV * 2, CV, D, D);
    }
    for (int l = 0; l < DEPTH; ++l) {
        wt(p.ffn_w_in + (size_t)l * D * 2 * DFF, WS_WFIN + (size_t)l * 2 * DFF * D * 2, D, 2 * DFF, 2 * DFF);
        wt(p.ffn_w_out + (size_t)l * DFF * D, WS_WFOUT + (size_t)l * D * DFF * 2, DFF, D, D);
        wt(p.ple_w_proj + (size_t)l * PLE * D, WS_WPP + (size_t)l * D * PLE * 2, PLE, D, D);
        wt(p.ple_w_gate + (size_t)l * D * D, WS_WPG + (size_t)l * D * D * 2, D, D, D);
    }
    run_stage<ST_PRM>(j, N_PRM);
    for (int l = 0; l < DEPTH; ++l) { j.layer = l; run_stage<ST_PB>(j, N_PB); }
    run_stage<ST_INIT>(j, N_INIT);
    for (int layer = 0; layer < DEPTH; ++layer) {
        j.layer = layer; const int jj = layer / 2; const float* nw = PRM(PR_NORMS) + (size_t)layer * 4 * D;
        j.a = p.h; run_stage<ST_ROWSS>(j, N_ROWS);
        j.a = nw; run_stage<ST_NORM>(j, N_TD);
        if (layer % 2 == 0) {
            gemm_bf16(WSP(bf16, WS_HN), WSP(bf16, WS_WABIN + (size_t)jj * ABINP * D * 2), T, ABINP, D, WSP(bf16, WS_PROJ), ABINP);
            run_stage<ST_DNPREP>(j, N_TH);
            run_stage<ST_DNSCAN>(j, N_SCAN);
            run_stage<ST_DNOUT>(j, N_TH);
            run_stage<ST_NASC>(j, N_THD);
            run_stage<ST_NAOUT>(j, N_THD);
            gemm_f32(WSP(bf16, WS_MIXIN), WSP(bf16, WS_WABOUT + (size_t)jj * D * ABMIX * 2), T, D, ABMIX, WSP(float, WS_GOUT), D);
        } else {
            gemm_bf16(WSP(bf16, WS_HN), WSP(bf16, WS_WCIN + (size_t)jj * CIN * D * 2), T, CIN, D, WSP(bf16, WS_PROJ), CIN);
            run_stage<ST_LAM>(j, 1);
            run_stage<ST_ROPE>(j, N_ROPE);
            run_stage<ST_DATTN>(j, N_DATT);
            run_stage<ST_COUT>(j, N_TH);
            gemm_f32(WSP(bf16, WS_MIXIN), WSP(bf16, WS_WCOUT + (size_t)jj * D * CV * 2), T, D, CV, WSP(float, WS_GOUT), D);
        }
        j.a = WSP(float, WS_GOUT); run_stage<ST_ROWSS>(j, N_ROWS);
        j.a = WSP(float, WS_GOUT); j.b = nw + D; j.flag = 0; run_stage<ST_RESID>(j, N_TD);
        j.a = p.h; run_stage<ST_ROWSS>(j, N_ROWS);
        j.a = nw + 2 * D; run_stage<ST_NORM>(j, N_TD);
        gemm_bf16(WSP(bf16, WS_HN), WSP(bf16, WS_WFIN + (size_t)layer * 2 * DFF * D * 2), T, 2 * DFF, D, WSP(bf16, WS_HID), 2 * DFF);
        run_stage<ST_FFNACT>(j, N_ACT);
        gemm_f32(WSP(bf16, WS_ACT), WSP(bf16, WS_WFOUT + (size_t)layer * D * DFF * 2), T, D, DFF, WSP(float, WS_GOUT), D);
        j.a = WSP(float, WS_GOUT); run_stage<ST_ROWSS>(j, N_ROWS);
        j.a = WSP(float, WS_GOUT); j.b = nw + 3 * D; j.flag = 1; run_stage<ST_RESID>(j, N_TD);
        gemm_f32(WSP(bf16, WS_HN), WSP(bf16, WS_WPG + (size_t)layer * D * D * 2), T, D, D, WSP(float, WS_GOUT), D);
        gemm_f32(WSP(bf16, WS_PB + (size_t)layer * SZ_PB), WSP(bf16, WS_WPP + (size_t)layer * D * PLE * 2), T, D, PLE, WSP(float, WS_GOUT2), D);
        run_stage<ST_PLE>(j, N_TD);
    }
}
#endif

#ifndef EMU
namespace att {
using bf16x8 = __attribute__((ext_vector_type(8))) short;
using s16x4  = __attribute__((ext_vector_type(4))) short;
using f32x16 = __attribute__((ext_vector_type(16))) float;
using u32x4  = __attribute__((ext_vector_type(4))) unsigned;
constexpr int DA = 128, NW = 8, QBLK = 32, KVBLK = 64;
constexpr float SCALE = 0.088388347648318440f;
constexpr float THR = 8.f;
constexpr size_t SHM_V = KVBLK * DA * 2, SHM_K = KVBLK * DA * 2, SHM_ATTN = 2 * SHM_V + 2 * SHM_K + NW * 64 * 4;
#define KSWZ(row, colB) ((row) * 256 + ((colB) ^ (((row) & 15) << 4)))
#define SBAR() __builtin_amdgcn_sched_barrier(0)
__device__ __forceinline__ int crow(int r, int hi) { return (r & 3) + 8 * (r >> 2) + 4 * hi; }
__device__ __forceinline__ unsigned cvtpk(float lo, float hi) { unsigned r; asm volatile("v_cvt_pk_bf16_f32 %0, %1, %2" : "=v"(r) : "v"(lo), "v"(hi)); return r; }
__device__ __forceinline__ bf16x8 ld8(const bf16* p) { return *reinterpret_cast<const bf16x8*>(p); }
__device__ __forceinline__ void partialSM(f32x16& p0, f32x16& p1, float& m_reg, float& mn, float& alpha) {
  constexpr float C = SCALE * 1.4426950408889634f;
  float pmax = p0[0]; for (int r = 1; r < 16; ++r) pmax = fmaxf(pmax, p0[r]); for (int r = 0; r < 16; ++r) pmax = fmaxf(pmax, p1[r]);
  { auto rr = __builtin_amdgcn_permlane32_swap(__float_as_uint(pmax), __float_as_uint(pmax), false, false);
    pmax = fmaxf(__uint_as_float(rr[0]), __uint_as_float(rr[1])); }
  if (__builtin_expect(__all(pmax - m_reg <= THR / SCALE), 1)) { mn = m_reg; alpha = 1.f; }
  else { mn = fmaxf(m_reg, pmax); alpha = __builtin_amdgcn_exp2f((m_reg - mn) * C); m_reg = mn; }
  float mnC = -mn * C;
  for (int r = 0; r < 16; ++r) p0[r] = fmaf(p0[r], C, mnC); for (int r = 0; r < 16; ++r) p1[r] = fmaf(p1[r], C, mnC);
  for (int r = 0; r < 16; ++r) p0[r] = __builtin_amdgcn_exp2f(p0[r]);
}
__device__ __forceinline__ void finishSM(f32x16& p0, f32x16& p1, float alpha, float& l_reg, bf16x8& pa0, bf16x8& pa1, bf16x8& pa2, bf16x8& pa3) {
  for (int r = 0; r < 16; ++r) p1[r] = __builtin_amdgcn_exp2f(p1[r]);
  float ps = 0; for (int r = 0; r < 16; ++r) ps += p0[r]; for (int r = 0; r < 16; ++r) ps += p1[r];
  { auto rr = __builtin_amdgcn_permlane32_swap(__float_as_uint(ps), __float_as_uint(ps), false, false);
    ps = __uint_as_float(rr[0]) + __uint_as_float(rr[1]); }
  l_reg = l_reg * alpha + ps;
#define PK4(P, BASE, OUT) do { unsigned a0 = cvtpk(P[BASE + 0], P[BASE + 1]), a1 = cvtpk(P[BASE + 2], P[BASE + 3]);   \
    unsigned b0 = cvtpk(P[BASE + 4], P[BASE + 5]), b1 = cvtpk(P[BASE + 6], P[BASE + 7]);                              \
    auto r0 = __builtin_amdgcn_permlane32_swap(a0, b0, false, false); auto r1 = __builtin_amdgcn_permlane32_swap(a1, b1, false, false); \
    u32x4 w = {r0[0], r1[0], r0[1], r1[1]}; OUT = *reinterpret_cast<bf16x8*>(&w); } while (0)
  PK4(p0, 0, pa0); PK4(p0, 8, pa1); PK4(p1, 0, pa2); PK4(p1, 8, pa3);
#undef PK4
}
__device__ __forceinline__ void qkt(f32x16& p0, f32x16& p1, const bf16* Ks, const bf16x8* qr, int r32, int hi) {
  p0 = f32x16{}; p1 = f32x16{};
  for (int d0 = 0; d0 < 8; ++d0) { int cb = (d0 * 16 + hi * 8) * 2;
    bf16x8 b0 = *reinterpret_cast<const bf16x8*>((const char*)Ks + KSWZ(r32, cb));
    bf16x8 b1 = *reinterpret_cast<const bf16x8*>((const char*)Ks + KSWZ(32 + r32, cb));
    p0 = __builtin_amdgcn_mfma_f32_32x32x16_bf16(b0, qr[d0], p0, 0, 0, 0);
    p1 = __builtin_amdgcn_mfma_f32_32x32x16_bf16(b1, qr[d0], p1, 0, 0, 0); }
}
__device__ __forceinline__ int v_st(int k, int c) { const int kk = (k & ~0xC) | ((k & 4) << 1) | ((k & 8) >> 1); return ((kk >> 3) * 4 + (c >> 5)) * 512 + ((kk & 7) * 32 + (c & 31)) * 2; }
__device__ __forceinline__ int v_rd_base(int lane) { return ((lane & 3) << 3) | (((lane >> 2) & 3) << 6) | (((lane >> 4) & 1) << 5) | (((lane >> 5) & 1) << 8); }
constexpr int v_rd_off(int d0, int ks, int half) { return d0 * 512 + ks * 4096 + half * 2048; }
template <int OFF> __device__ __forceinline__ s16x4 tr_read(int vb) {
  s16x4 r; asm volatile("ds_read_b64_tr_b16 %0, %1 offset:%2" : "=&v"(r) : "v"(vb), "i"(OFF) : "memory"); return r;
}
template <int D0> __device__ __forceinline__ void pv_one(f32x16& od, int vb, bf16x8 pa0, bf16x8 pa1, bf16x8 pa2, bf16x8 pa3) {
  const s16x4 l0 = tr_read<v_rd_off(D0, 0, 0)>(vb), h0 = tr_read<v_rd_off(D0, 0, 1)>(vb), l1 = tr_read<v_rd_off(D0, 1, 0)>(vb), h1 = tr_read<v_rd_off(D0, 1, 1)>(vb);
  const s16x4 l2 = tr_read<v_rd_off(D0, 2, 0)>(vb), h2 = tr_read<v_rd_off(D0, 2, 1)>(vb), l3 = tr_read<v_rd_off(D0, 3, 0)>(vb), h3 = tr_read<v_rd_off(D0, 3, 1)>(vb);
  asm volatile("s_waitcnt lgkmcnt(0)" ::: "memory"); SBAR();
#define PK(L, H) (bf16x8){L[0], L[1], L[2], L[3], H[0], H[1], H[2], H[3]}
  od = __builtin_amdgcn_mfma_f32_32x32x16_bf16(pa0, PK(l0, h0), od, 0, 0, 0);
  od = __builtin_amdgcn_mfma_f32_32x32x16_bf16(pa1, PK(l1, h1), od, 0, 0, 0);
  od = __builtin_amdgcn_mfma_f32_32x32x16_bf16(pa2, PK(l2, h2), od, 0, 0, 0);
  od = __builtin_amdgcn_mfma_f32_32x32x16_bf16(pa3, PK(l3, h3), od, 0, 0, 0);
#undef PK
}
__device__ __forceinline__ void pv_d0(f32x16* o, int vb, bf16x8 pa0, bf16x8 pa1, bf16x8 pa2, bf16x8 pa3) {
  pv_one<0>(o[0], vb, pa0, pa1, pa2, pa3); pv_one<1>(o[1], vb, pa0, pa1, pa2, pa3); pv_one<2>(o[2], vb, pa0, pa1, pa2, pa3); pv_one<3>(o[3], vb, pa0, pa1, pa2, pa3);
}
struct NaInfo { int rq0, kr0; const float* tab; };
__device__ __forceinline__ void na_mask(f32x16& p0, f32x16& p1, int rk, int rq, int rs, int cq, int cs, int hi, const float* tab) {
  const bool rowok = (rk >= rs) && (rk < rs + NAR);
  int dr = rk - rq + NAR - 1; dr = dr < 0 ? 0 : (dr > 2 * NAR - 2 ? 2 * NAR - 2 : dr);
  const float* trow = tab + dr * (2 * NAC - 1); const float ninf = -__builtin_inff();
#pragma unroll
  for (int r = 0; r < 16; ++r) { const int ck = crow(r, hi); int dc = ck - cq + NAC - 1; dc = dc < 0 ? 0 : (dc > 2 * NAC - 2 ? 2 * NAC - 2 : dc);
    const bool ok = rowok && ck >= cs && ck < cs + NAC; const float b = trow[dc]; p0[r] = ok ? p0[r] + b : ninf; }
#pragma unroll
  for (int r = 0; r < 16; ++r) { const int ck = 32 + crow(r, hi); int dc = ck - cq + NAC - 1; dc = dc < 0 ? 0 : (dc > 2 * NAC - 2 ? 2 * NAC - 2 : dc);
    const bool ok = rowok && ck >= cs && ck < cs + NAC; const float b = trow[dc]; p1[r] = ok ? p1[r] + b : ninf; }
}
template <int LDQ, int LDK, int LDO, int MODE>
__device__ __forceinline__ void attn_dense_body(const bf16* __restrict__ Qb, const bf16* __restrict__ Kh, const bf16* __restrict__ Vh, void* __restrict__ Ob_, int seq, char* lds, NaInfo na, int tid_in) {
  constexpr int SDEPTH = 2;
  int tid_ = tid_in; asm volatile("" : "+v"(tid_));
  const int tid = tid_, wid = tid >> 6, lane = tid & 63, r32 = lane & 31, hi = lane >> 5;
  const int na_rq = na.rq0 + (wid >> 1), na_cq = (wid & 1) * 32 + r32, na_rs = clampi(na_rq - WR / 2, 0, ROWS - WR), na_cs = clampi(na_cq - NAC / 2, 0, GW - NAC);
#define NAMASK(P0, P1, jt) do { if constexpr (MODE == 1) na_mask(P0, P1, na.kr0 + (jt), na_rq, na_rs, na_cq, na_cs, hi, na.tab); } while (0)
  bf16* V_lds = (bf16*)lds; bf16* K_lds = (bf16*)(lds + 2 * SHM_V);
  float* ws = (float*)(lds + 2 * SHM_V + 2 * SHM_K) + wid * 64; float* li_l = ws; float* al_l = ws + 32;
  float m_reg = -1e30f, l_reg = 0; f32x16 o[4] = {}; bf16x8 qr[8];
  const bf16* Qw = Qb + (long)(wid * QBLK + r32) * LDQ + hi * 8;
#pragma unroll
  for (int d0 = 0; d0 < 8; ++d0) qr[d0] = ld8(Qw + d0 * 16);
  const int sr = tid >> 4, sc = (tid & 15) * 8, vst0 = v_st(sr, sc), vst1 = v_st(32 + sr, sc);
  const int vb0 = (int)(uintptr_t)V_lds + v_rd_base(lane);
  struct { bf16x8 vs0, vs1, ks0, ks1; } sr_[SDEPTH];
#define SLOAD(i, k0) do { sr_[i].vs0 = ld8(&Vh[(long)((k0) + sr) * LDK + sc]); sr_[i].vs1 = ld8(&Vh[(long)((k0) + 32 + sr) * LDK + sc]); \
    sr_[i].ks0 = ld8(&Kh[(long)((k0) + sr) * LDK + sc]); sr_[i].ks1 = ld8(&Kh[(long)((k0) + 32 + sr) * LDK + sc]); } while (0)
#define SWRITE(b, i) do { *(bf16x8*)((char*)V_lds + (b) * SHM_V + vst0) = sr_[i].vs0;          \
    *(bf16x8*)((char*)V_lds + (b) * SHM_V + vst1) = sr_[i].vs1; int kc = sc * 2;               \
    *(bf16x8*)((char*)K_lds + (b) * SHM_K + KSWZ(sr, kc)) = sr_[i].ks0;                       \
    *(bf16x8*)((char*)K_lds + (b) * SHM_K + KSWZ(32 + sr, kc)) = sr_[i].ks1; } while (0)
#define SWAIT() asm volatile("s_waitcnt vmcnt(4)" ::: "memory")
#define RESC(a) do { if (__any((a) < 1.f)) { if (hi == 0) al_l[r32] = (a); asm volatile("s_waitcnt lgkmcnt(0)" ::: "memory"); \
    for (int d = 0; d < 4; ++d) for (int r = 0; r < 16; ++r) o[d][r] *= al_l[crow(r, hi)]; } } while (0)
  f32x16 pA0, pA1, pB0, pB1; float mnA, mnB, alA, alB; bf16x8 pa0, pa1, pa2, pa3; const int NT = seq / KVBLK;
  constexpr int SE = 0, SO = SDEPTH - 1;
  SLOAD(SE, 0); asm volatile("s_waitcnt vmcnt(0)" ::: "memory"); SWRITE(0, SE); __syncthreads();
  qkt(pA0, pA1, K_lds, qr, r32, hi); NAMASK(pA0, pA1, 0); partialSM(pA0, pA1, m_reg, mnA, alA);
  SLOAD(SO, KVBLK); if (2 < NT) SLOAD(SE, 2 * KVBLK);
  SWAIT(); SWRITE(1, SO); __syncthreads();
  for (int j = 1; j + 1 < NT; j += 2) {
    SBAR(); qkt(pB0, pB1, (bf16*)((char*)K_lds + SHM_K), qr, r32, hi); NAMASK(pB0, pB1, j);
    finishSM(pA0, pA1, alA, l_reg, pa0, pa1, pa2, pa3); SBAR();
    SLOAD(SO, (j + SDEPTH) * KVBLK); SBAR();
    pv_d0(o, vb0, pa0, pa1, pa2, pa3); partialSM(pB0, pB1, m_reg, mnB, alB);
    __syncthreads(); SWAIT(); SWRITE(0, SE);
    RESC(alB); __syncthreads();
    SBAR(); qkt(pA0, pA1, K_lds, qr, r32, hi); NAMASK(pA0, pA1, j + 1);
    finishSM(pB0, pB1, alB, l_reg, pa0, pa1, pa2, pa3); SBAR();
    if (j + 3 < NT) SLOAD(SE, (j + 1 + SDEPTH) * KVBLK); SBAR();
    pv_d0(o, vb0 + (int)SHM_V, pa0, pa1, pa2, pa3); partialSM(pA0, pA1, m_reg, mnA, alA);
    __syncthreads(); SWAIT(); SWRITE(1, SO);
    RESC(alA); __syncthreads();
  }
  SBAR(); qkt(pB0, pB1, (bf16*)((char*)K_lds + SHM_K), qr, r32, hi); NAMASK(pB0, pB1, NT - 1);
  finishSM(pA0, pA1, alA, l_reg, pa0, pa1, pa2, pa3); SBAR();
  pv_d0(o, vb0, pa0, pa1, pa2, pa3); partialSM(pB0, pB1, m_reg, mnB, alB);
  __syncthreads(); RESC(alB);
  finishSM(pB0, pB1, alB, l_reg, pa0, pa1, pa2, pa3); SBAR();
  pv_d0(o, vb0 + (int)SHM_V, pa0, pa1, pa2, pa3);
  if (hi == 0) li_l[r32] = l_reg; asm volatile("s_waitcnt lgkmcnt(0)" ::: "memory");
  float rli[16];
#pragma unroll
  for (int r = 0; r < 16; ++r) rli[r] = __builtin_amdgcn_rcpf(li_l[crow(r, hi)]);
  if constexpr (MODE == 2) { float* Ow = (float*)Ob_ + (long)(wid * QBLK) * LDO;
#pragma unroll
    for (int r = 0; r < 16; ++r) { int orow = crow(r, hi);
      for (int d0 = 0; d0 < 4; ++d0) Ow[(long)orow * LDO + d0 * 32 + r32] = o[d0][r] * rli[r]; }
  } else { bf16* Ow = (bf16*)Ob_ + (long)(wid * QBLK) * LDO;
#pragma unroll
    for (int r = 0; r < 16; ++r) { int orow = crow(r, hi);
      for (int d0 = 0; d0 < 4; ++d0) Ow[(long)orow * LDO + d0 * 32 + r32] = f2bf(o[d0][r] * rli[r]); } }
#undef NAMASK
#undef SLOAD
#undef SWRITE
#undef SWAIT
#undef RESC
}
template <int LDQ, int LDK, int LDO>
__device__ __forceinline__ void na_body(const bf16* __restrict__ Qb, const bf16* __restrict__ Kh, const bf16* __restrict__ Vh, bf16* __restrict__ Ob, int ntiles, char* lds, NaInfo na, int tid_in) {
  int tid_ = tid_in; asm volatile("" : "+v"(tid_));
  const int tid = tid_, wid = tid >> 6, lane = tid & 63, r32 = lane & 31, hi = lane >> 5;
  const int na_rq = na.rq0 + (wid >> 1), na_cq = (wid & 1) * 32 + r32, na_rs = clampi(na_rq - WR / 2, 0, ROWS - WR), na_cs = clampi(na_cq - NAC / 2, 0, GW - NAC);
  bf16* V_lds = (bf16*)lds; bf16* K_lds = (bf16*)(lds + 2 * SHM_V);
  float* ws = (float*)(lds + 2 * SHM_V + 2 * SHM_K) + wid * 64; float* li_l = ws; float* al_l = ws + 32;
  float m_reg = -1e30f, l_reg = 0; f32x16 o[4] = {}; bf16x8 qr[8];
  const bf16* Qw = Qb + (long)(wid * QBLK + r32) * LDQ + hi * 8;
#pragma unroll
  for (int d0 = 0; d0 < 8; ++d0) qr[d0] = ld8(Qw + d0 * 16);
  const int sr = tid >> 4, sc = (tid & 15) * 8, vst0 = v_st(sr, sc), vst1 = v_st(32 + sr, sc);
  const int vb0 = (int)(uintptr_t)V_lds + v_rd_base(lane);
  bf16x8 vs0 = ld8(&Vh[(long)sr * LDK + sc]), vs1 = ld8(&Vh[(long)(32 + sr) * LDK + sc]), ks0 = ld8(&Kh[(long)sr * LDK + sc]), ks1 = ld8(&Kh[(long)(32 + sr) * LDK + sc]);
  for (int jt = 0; jt < ntiles; ++jt) {
    __syncthreads();
    *(bf16x8*)((char*)V_lds + vst0) = vs0; *(bf16x8*)((char*)V_lds + vst1) = vs1;
    *(bf16x8*)((char*)K_lds + KSWZ(sr, sc * 2)) = ks0; *(bf16x8*)((char*)K_lds + KSWZ(32 + sr, sc * 2)) = ks1;
    __syncthreads();
    if (jt + 1 < ntiles) { const int k0 = (jt + 1) * KVBLK;
      vs0 = ld8(&Vh[(long)(k0 + sr) * LDK + sc]); vs1 = ld8(&Vh[(long)(k0 + 32 + sr) * LDK + sc]); ks0 = ld8(&Kh[(long)(k0 + sr) * LDK + sc]); ks1 = ld8(&Kh[(long)(k0 + 32 + sr) * LDK + sc]); }
    f32x16 p0, p1; float mn, al; bf16x8 pa0, pa1, pa2, pa3;
    qkt(p0, p1, K_lds, qr, r32, hi);
    na_mask(p0, p1, na.kr0 + jt, na_rq, na_rs, na_cq, na_cs, hi, na.tab);
    partialSM(p0, p1, m_reg, mn, al);
    if (__any(al < 1.f)) { if (hi == 0) al_l[r32] = al; asm volatile("s_waitcnt lgkmcnt(0)" ::: "memory");
      for (int d = 0; d < 4; ++d) for (int r = 0; r < 16; ++r) o[d][r] *= al_l[crow(r, hi)]; }
    finishSM(p0, p1, al, l_reg, pa0, pa1, pa2, pa3); SBAR();
    pv_d0(o, vb0, pa0, pa1, pa2, pa3);
  }
  if (hi == 0) li_l[r32] = l_reg; asm volatile("s_waitcnt lgkmcnt(0)" ::: "memory");
  float rli[16];
#pragma unroll
  for (int r = 0; r < 16; ++r) rli[r] = __builtin_amdgcn_rcpf(li_l[crow(r, hi)]);
  bf16* Ow = Ob + (long)(wid * QBLK) * LDO;
#pragma unroll
  for (int r = 0; r < 16; ++r) { int orow = crow(r, hi);
    for (int d0 = 0; d0 < 4; ++d0) Ow[(long)orow * LDO + d0 * 32 + r32] = f2bf(o[d0][r] * rli[r]); }
}
template <int LDQ, int LDK, int LDO>
__device__ __forceinline__ void dattn256_body(const bf16* __restrict__ Qb, const bf16* __restrict__ Kh, const bf16* __restrict__ Vh, bf16* Ob, int ntiles, char* lds, int tid_in,
                                              int mode = 0, bf16* Mx = nullptr, float lam = 0.f, float scale = 0.f, const float* sw = nullptr) {
  typedef __attribute__((address_space(3))) unsigned lds_u32;
  int tid_ = tid_in; asm volatile("" : "+v"(tid_));
  const int tid = tid_, wid = __builtin_amdgcn_readfirstlane(tid >> 6), lane = tid & 63, r32 = lane & 31, hi = lane >> 5;
  constexpr int VB = 2 * (int)SHM_V, KB = (int)SHM_K;
  char* V_lds = lds; char* K_lds = lds + 2 * VB;
  float* ws = (float*)(lds + 2 * VB + 2 * KB) + wid * 64; float* li_l = ws; float* al_l = ws + 32;
  float m_reg = -1e30f, l_reg = 0; f32x16 o[8] = {}; bf16x8 qr[8];
  const bf16* Qw = Qb + (long)(wid * QBLK + r32) * LDQ + hi * 8;
#pragma unroll
  for (int d0 = 0; d0 < 8; ++d0) qr[d0] = ld8(Qw + d0 * 16);
  unsigned koff[2], voff[2];
#pragma unroll
  for (int i = 0; i < 2; ++i) { const int kp = 2 * wid + i; const int row = 4 * kp + (lane >> 4), c = (lane & 15) ^ (row & 15); koff[i] = (unsigned)(row * LDK + c * 8);
    const int st = 2 * kp + (lane >> 5), within = lane & 31, kk = (st >> 2) * 8 + (within >> 2), k = (kk & ~0xC) | ((kk & 4) << 1) | ((kk & 8) >> 1); voff[i] = (unsigned)(k * LDK + (st & 3) * 32 + (within & 3) * 8); }
  const int vbase = (int)(uintptr_t)V_lds + v_rd_base(lane);
#define DA_DMA(t, b) do { const bf16* kt_ = Kh + (long)(t) * KVBLK * LDK; const bf16* vt_ = Vh + (long)(t) * KVBLK * LDK; \
      _Pragma("unroll") for (int i = 0; i < 2; ++i) { \
        __builtin_amdgcn_global_load_lds((const unsigned*)(kt_ + koff[i]), (lds_u32*)(K_lds + (b) * KB + (2 * wid + i) * 1024), 16, 0, 0); \
        __builtin_amdgcn_global_load_lds((const unsigned*)(vt_ + voff[i]), (lds_u32*)(V_lds + (b) * VB + (2 * wid + i) * 1024), 16, 0, 0); \
        __builtin_amdgcn_global_load_lds((const unsigned*)(vt_ + voff[i] + 128), (lds_u32*)(V_lds + (b) * VB + (int)SHM_V + (2 * wid + i) * 1024), 16, 0, 0); } } while (0)
  __syncthreads();
  DA_DMA(0, 0);
  for (int jt = 0; jt < ntiles; ++jt) {
    const int b = jt & 1;
    asm volatile("s_waitcnt vmcnt(0)" ::: "memory");
    __syncthreads();
    if (jt + 1 < ntiles) DA_DMA(jt + 1, b ^ 1);
    const char* Kb = K_lds + b * KB;
    f32x16 p0, p1; float mn, al; bf16x8 pa0, pa1, pa2, pa3;
    p0 = f32x16{}; p1 = f32x16{};
#pragma unroll
    for (int d0 = 0; d0 < 8; ++d0) { const int cb = (d0 * 16 + hi * 8) * 2;
      const bf16x8 b0 = *reinterpret_cast<const bf16x8*>(Kb + KSWZ(r32, cb)), b1 = *reinterpret_cast<const bf16x8*>(Kb + KSWZ(32 + r32, cb));
      p0 = __builtin_amdgcn_mfma_f32_32x32x16_bf16(b0, qr[d0], p0, 0, 0, 0); p1 = __builtin_amdgcn_mfma_f32_32x32x16_bf16(b1, qr[d0], p1, 0, 0, 0); }
    partialSM(p0, p1, m_reg, mn, al);
    if (__any(al < 1.f)) { if (hi == 0) al_l[r32] = al; asm volatile("s_waitcnt lgkmcnt(0)" ::: "memory");
      for (int d = 0; d < 8; ++d) for (int r = 0; r < 16; ++r) o[d][r] *= al_l[crow(r, hi)]; }
    finishSM(p0, p1, al, l_reg, pa0, pa1, pa2, pa3); SBAR();
    pv_d0(o, vbase + b * VB, pa0, pa1, pa2, pa3);
    pv_d0(o + 4, vbase + b * VB + (int)SHM_V, pa0, pa1, pa2, pa3);
  }
#undef DA_DMA
  if (hi == 0) li_l[r32] = l_reg; asm volatile("s_waitcnt lgkmcnt(0)" ::: "memory");
  float rli[16];
#pragma unroll
  for (int r = 0; r < 16; ++r) rli[r] = __builtin_amdgcn_rcpf(li_l[crow(r, hi)]);
  bf16* Ow = Ob + (long)(wid * QBLK) * LDO;
  if (mode == 0) {
#pragma unroll
    for (int r = 0; r < 16; ++r) { int orow = crow(r, hi);
      for (int d0 = 0; d0 < 8; ++d0) Ow[(long)orow * LDO + d0 * 32 + r32] = f2bf(o[d0][r] * rli[r]); }
  } else {
    bf16* Mw = Mx + (long)(wid * QBLK) * LDO;
    float swv[8];
#pragma unroll
    for (int d0 = 0; d0 < 8; ++d0) swv[d0] = sw[d0 * 32 + r32] * scale;
#pragma unroll
    for (int r = 0; r < 16; ++r) { const int orow = crow(r, hi); float ss = 0.f; const float nl = -lam * rli[r];
#pragma unroll
      for (int d0 = 0; d0 < 8; ++d0) { const float x = bf2f(Ow[(long)orow * LDO + d0 * 32 + r32]) + nl * o[d0][r]; o[d0][r] = x; ss += x * x; }
      ss += __shfl_xor(ss, 1); ss += __shfl_xor(ss, 2); ss += __shfl_xor(ss, 4); ss += __shfl_xor(ss, 8); ss += __shfl_xor(ss, 16);
      const float rs = 1.0f / sqrtf(ss * (1.0f / 256.0f) + RMS_EPS);
#pragma unroll
      for (int d0 = 0; d0 < 8; ++d0) Mw[(long)orow * LDO + d0 * 32 + r32] = f2bf(o[d0][r] * rs * swv[d0]); }
  }
}
}
namespace dn {
using bf16x8 = __attribute__((ext_vector_type(8))) short;
using f32x4v = __attribute__((ext_vector_type(4))) float;
using f32x2v = __attribute__((ext_vector_type(2))) float;
using bf16x2v = __attribute__((ext_vector_type(2))) __bf16;
using u32x4 = __attribute__((ext_vector_type(4))) unsigned;
constexpr int KP = 136;
constexpr int L_K = 0, L_Q = 17408, L_V = 34816, L_AKK = 67584, L_AQK = 84224, L_L0 = 100864, L_L1 = 117248, L_SM = 133632, L_DB = 135680, L_END = 143872;
__device__ __forceinline__ unsigned pk(float lo, float hi) { const f32x2v v = {lo, hi}; return __builtin_bit_cast(unsigned, __builtin_convertvector(v, bf16x2v)); }
__device__ __forceinline__ bf16x8 pack8(f32x4v a, f32x4v b) { u32x4 w = {pk(a[0], a[1]), pk(a[2], a[3]), pk(b[0], b[1]), pk(b[2], b[3])}; return __builtin_bit_cast(bf16x8, w); }
__device__ __forceinline__ int kperm(int s, int q, int j) { return 32 * s + 16 * (j >> 2) + 4 * q + (j & 3); }
#define MFMA16(a, b, c) __builtin_amdgcn_mfma_f32_16x16x32_bf16((a), (b), (c), 0, 0, 0)

__device__ __forceinline__ float fexp(float x) { return __builtin_amdgcn_exp2f(x * 1.4426950408889634f); }
__device__ __forceinline__ float fsilu(float x) { return x * __builtin_amdgcn_rcpf(1.0f + fexp(-x)); }
template <int C> __device__ __forceinline__ float dpp_bc(int v) { return __int_as_float(__builtin_amdgcn_update_dpp(0, v, C, 0xf, 0xf, false)); }
template <int I, int J> __device__ __forceinline__ void inv16_terms(float& r, int lk, const float (&x)[16]) {
    if constexpr (J < I) { r -= dpp_bc<0x150 + J>(lk) * x[J]; inv16_terms<I, J + 1>(r, lk, x); }
}
template <int I> __device__ __forceinline__ void inv16_rows(float (&x)[16], const float* Lbb, int c) {
    if constexpr (I < 16) { float r = (I == c) ? 1.f : 0.f; const int lk = __float_as_int(Lbb[I * 64 + c]); inv16_terms<I, 0>(r, lk, x); x[I] = r; inv16_rows<I + 1>(x, Lbb, c); }
}
__device__ __forceinline__ void dn1_unit(const P& p, int jl, int seq, int hh, int chunk, char* lds, int tid_in) {
    int tid_ = tid_in; asm volatile("" : "+v"(tid_));
    const int tid = tid_, lane = tid & 63, wave = tid >> 6;
    bf16* Kl = (bf16*)(lds + L_K); bf16* Ql = (bf16*)(lds + L_Q); float* Vl = (float*)(lds + L_V); float* AKK = (float*)(lds + L_AKK); float* AQK = (float*)(lds + L_AQK);
    float* L0 = (float*)(lds + L_L0); float* L1 = (float*)(lds + L_L1); float* g_l = (float*)(lds + L_SM); float* beta_l = g_l + 128; float* gc_l = g_l + 256; float* bk_l = g_l + 384;
    const int tt0 = chunk * 64; const long tb = (long)seq * S; const bf16* PROJ = WSP(bf16, WS_PROJ);
    const size_t unit = ((size_t)(seq * NH + hh) * (S / 64) + chunk);
    if (tid < 384) {
        const int cgi = tid & 15, part = (tid >> 4) % 3, oct = tid / 48, i0 = 8 * oct; const int coff = part * 1024 + hh * DH + 8 * cgi;
        bf16x8 x[12]; float w[5][8];
#pragma unroll
        for (int k = 0; k < 12; ++k) { const int ts = tt0 + i0 + k - 2; x[k] = (ts >= 0 && ts < S) ? *(const bf16x8*)(PROJ + (size_t)(tb + ts) * ABINP + coff) : (bf16x8){0, 0, 0, 0, 0, 0, 0, 0}; }
#pragma unroll
        for (int tap = 0; tap < 5; ++tap) { const float* cw = PRM(PR_ABCONV) + (size_t)(jl * 5 + tap) * AQKV + coff; const f32x4v a = *(const f32x4v*)cw, b = *(const f32x4v*)(cw + 4);
#pragma unroll
            for (int e = 0; e < 4; ++e) { w[tap][e] = a[e]; w[tap][4 + e] = b[e]; } }
#pragma unroll
        for (int kk = 0; kk < 8; ++kk) { float y[8]; float ss = 0.f;
#pragma unroll
            for (int c = 0; c < 8; ++c) { float acc = 0.f;
#pragma unroll
                for (int tap = 0; tap < 5; ++tap) acc += bf2f((bf16)x[kk + tap][c]) * w[tap][c];
                y[c] = fsilu(acc); ss += y[c] * y[c]; }
            ss += __shfl_xor(ss, 1); ss += __shfl_xor(ss, 2); ss += __shfl_xor(ss, 4); ss += __shfl_xor(ss, 8);
            const float rn = 1.0f / sqrtf(ss + 1e-6f); const float sc_ = part == 0 ? rn * 0.08838834764831845f : (part == 1 ? rn : 1.0f); const int i = i0 + kk;
            if (part < 2) { u32x4 wv; wv[0] = pk(y[0] * sc_, y[1] * sc_); wv[1] = pk(y[2] * sc_, y[3] * sc_); wv[2] = pk(y[4] * sc_, y[5] * sc_); wv[3] = pk(y[6] * sc_, y[7] * sc_);
                *(u32x4*)((part ? Kl : Ql) + i * KP + 8 * cgi) = wv; }
            else { *(f32x4v*)(Vl + i * 128 + 8 * cgi) = (f32x4v){y[0], y[1], y[2], y[3]}; *(f32x4v*)(Vl + i * 128 + 8 * cgi + 4) = (f32x4v){y[4], y[5], y[6], y[7]}; } }
    } else { const int gt = tid - 384; const int dir = gt >> 6, il = gt & 63, ti = dir ? 63 - il : il; const bf16* gr = PROJ + (size_t)(tb + tt0 + ti) * ABINP + COL_G;
        const float graw = bf2f(gr[dir * NH + hh]), braw = bf2f(gr[16 + dir * NH + hh]);
        const float a = expf(PRM(PR_ALOG)[(jl * 2 + dir) * NH + hh]), dtb = PRM(PR_DTB)[(jl * 2 + dir) * NH + hh];
        g_l[dir * 64 + il] = -a * softplusf(graw + dtb); beta_l[dir * 64 + il] = sigmoidf(braw); }
    __syncthreads();
    if (wave < 2) { const int dir = wave; float c = g_l[dir * 64 + lane];
#pragma unroll
        for (int o = 1; o < 64; o <<= 1) { const float t = __shfl_up(c, o); if (lane >= o) c += t; }
        gc_l[dir * 64 + lane] = c; bk_l[dir * 64 + lane] = beta_l[dir * 64 + lane] * fexp(c); }
    {
        const int r = lane & 15, q = lane >> 4;
#pragma unroll
        for (int tt = 0; tt < 2; ++tt) { const int tile = 2 * wave + tt, ti_ = tile >> 2, tj_ = tile & 3; f32x4v ck = {0.f, 0.f, 0.f, 0.f}, cq = {0.f, 0.f, 0.f, 0.f};
#pragma unroll
            for (int s = 0; s < 4; ++s) { const bf16x8 ak = *(const bf16x8*)(Kl + (16 * ti_ + r) * KP + 32 * s + 8 * q), aq = *(const bf16x8*)(Ql + (16 * ti_ + r) * KP + 32 * s + 8 * q), b = *(const bf16x8*)(Kl + (16 * tj_ + r) * KP + 32 * s + 8 * q);
                ck = MFMA16(ak, b, ck); cq = MFMA16(aq, b, cq); }
#pragma unroll
            for (int rr = 0; rr < 4; ++rr) { AKK[(16 * ti_ + 4 * q + rr) * 65 + 16 * tj_ + r] = ck[rr]; AQK[(16 * ti_ + 4 * q + rr) * 65 + 16 * tj_ + r] = cq[rr]; } }
    }
    __syncthreads();
    for (int e = tid; e < 8192; e += 512) { const int dir = e >> 12, i = (e >> 6) & 63, jx = e & 63; float v = 0.f;
        if (jx < i) { const int ti = dir ? 63 - i : i, tj = dir ? 63 - jx : jx; v = beta_l[dir * 64 + i] * AKK[ti * 65 + tj] * fexp(gc_l[dir * 64 + i] - gc_l[dir * 64 + jx]); }
        (dir ? L1 : L0)[i * 64 + jx] = v; }
#pragma unroll
    for (int dir = 0; dir < 2; ++dir) {
        const size_t ud = unit * 2 + dir; const float* gc = gc_l + dir * 64; const float glast = gc[63];
        {
            const int frag = tid >> 6, mt = frag >> 1, s = frag & 1, i = 16 * mt + (lane & 15), q = lane >> 4, ti = dir ? 63 - i : i; const float gi = gc[i]; float v[8];
#pragma unroll
            for (int jv = 0; jv < 8; ++jv) { const int jx = kperm(s, q, jv); v[jv] = (jx <= i) ? AQK[ti * 65 + (dir ? 63 - jx : jx)] * fexp(gi - gc[jx]) : 0.f; }
            u32x4 w = {pk(v[0], v[1]), pk(v[2], v[3]), pk(v[4], v[5]), pk(v[6], v[7])};
            *(u32x4*)(WSP(bf16, WS_DN_IN) + ((ud * 8 + frag) * 64 + lane) * 8) = w;
        }
#pragma unroll
        for (int rep = 0; rep < 2; ++rep) {
            const int fl = tid + 512 * rep, frag = fl >> 6, q = lane >> 4;
            { const int mt = frag >> 2, s = frag & 3, i = 16 * mt + (lane & 15), ti = dir ? 63 - i : i; const float eg = fexp(gc[i]); float v[8];
#pragma unroll
              for (int jv = 0; jv < 8; ++jv) v[jv] = bf2f(Ql[ti * KP + kperm(s, q, jv)]) * eg;
              u32x4 w = {pk(v[0], v[1]), pk(v[2], v[3]), pk(v[4], v[5]), pk(v[6], v[7])};
              *(u32x4*)(WSP(bf16, WS_DN_QE) + ((ud * 16 + frag) * 64 + lane) * 8) = w; }
            { const int mt = frag >> 1, s = frag & 1, d = 16 * mt + (lane & 15); float v[8];
#pragma unroll
              for (int jv = 0; jv < 8; ++jv) { const int jx = kperm(s, q, jv), tj = dir ? 63 - jx : jx; v[jv] = bf2f(Kl[tj * KP + d]) * fexp(glast - gc[jx]); }
              u32x4 w = {pk(v[0], v[1]), pk(v[2], v[3]), pk(v[4], v[5]), pk(v[6], v[7])};
              *(u32x4*)(WSP(bf16, WS_DN_KD) + ((ud * 16 + frag) * 64 + lane) * 8) = w; }
        }
        if (tid == 0) WSP(float, WS_DN_EG)[ud] = fexp(glast);
    }
    __syncthreads();
    {
        float* DB = (float*)(lds + L_DB);
        if (wave < 2) { const int b = lane >> 4, c = lane & 15; const float* Lbb = (wave ? L1 : L0) + (16 * b) * 64 + 16 * b; float x[16];
            inv16_rows<0>(x, Lbb, c);
#pragma unroll
            for (int i = 0; i < 16; ++i) DB[((wave * 4 + b) * 16 + i) * 16 + c] = x[i]; }
        __syncthreads();
        const int dir = __builtin_amdgcn_readfirstlane(tid >> 8), wq = __builtin_amdgcn_readfirstlane((tid >> 6) & 3); const float* L = dir ? L1 : L0; const size_t ud = unit * 2 + dir;
        const float* bv = beta_l + dir * 64; const float* bk = bk_l + dir * 64; const int m = lane & 15, q = lane >> 4;
        const f32x4v zero4 = {0.f, 0.f, 0.f, 0.f};
        bf16x8 A01[3], A23, Ad[4];
#pragma unroll
        for (int b = 1; b < 4; ++b) { const float* lr = L + (16 * b + m) * 64 + 4 * q; const f32x4v l0 = *(const f32x4v*)lr, l1 = (b >= 2) ? *(const f32x4v*)(lr + 16) : zero4; A01[b - 1] = pack8(-l0, -l1); }
        { const float* lr = L + (48 + m) * 64 + 32 + 4 * q; A23 = pack8(-*(const f32x4v*)lr, zero4); }
#pragma unroll
        for (int b = 0; b < 4; ++b) Ad[b] = pack8(*(const f32x4v*)(DB + ((dir * 4 + b) * 16 + m) * 16 + 4 * q), zero4);
#pragma unroll
        for (int nt4 = 0; nt4 < 4; ++nt4) { const int col = 64 * wq + 16 * nt4 + m; f32x4v X[4];
#pragma unroll
            for (int b = 0; b < 4; ++b) { f32x4v acc;
#pragma unroll
                for (int r = 0; r < 4; ++r) { const int i = 16 * b + 4 * q + r, ti = dir ? 63 - i : i; acc[r] = (wq < 2) ? bv[i] * Vl[ti * 128 + col] : bk[i] * bf2f(Kl[ti * KP + (col - 128)]); }
                if (b >= 1) acc = MFMA16(A01[b - 1], pack8(X[0], b >= 2 ? X[1] : zero4), acc);
                if (b == 3) acc = MFMA16(A23, pack8(X[2], zero4), acc);
                X[b] = MFMA16(Ad[b], pack8(acc, zero4), zero4); }
            if (wq < 2) { float* o = WSP(float, WS_DN_UT) + (ud * 128 + col) * 64 + 4 * q;
#pragma unroll
                for (int b = 0; b < 4; ++b) *(f32x4v*)(o + 16 * b) = X[b];
            } else { const int d = col - 128, s = d >> 5, qd = (d >> 2) & 3, jv = 4 * ((d >> 4) & 1) + (d & 3); bf16* o = (bf16*)(lds + L_AKK) + dir * 16 * 512;
#pragma unroll
                for (int b = 0; b < 4; ++b)
#pragma unroll
                    for (int r = 0; r < 4; ++r) o[((b * 4 + s) * 64 + (4 * q + r) + 16 * qd) * 8 + jv] = f2bf(-X[b][r]); }
        }
    }
    __syncthreads();
    {
        u32x4* dst = (u32x4*)(WSP(bf16, WS_DN_WN) + unit * 2 * 16 * 512); const u32x4* src = (const u32x4*)(lds + L_AKK);
#pragma unroll
        for (int e = 0; e < 4; ++e) dst[tid + 512 * e] = src[tid + 512 * e];
    }
}
constexpr int SC_WN = 0, SC_QE = 16384, SC_IN = 32768, SC_KD = 40960, SC_BUF = 57344;
__device__ __forceinline__ void dn_scan_chain(const P& p, int chain, char* lds, int tid_in) {
    int tid_ = tid_in; asm volatile("" : "+v"(tid_));
    const int tid = tid_, lane = tid & 63, wave = tid >> 6, n = lane & 15, q = lane >> 4, n0 = wave * 16;
    const int dir = chain & 1, sh = chain >> 1, hh = sh % NH, seq = sh / NH;
    f32x4v Sacc[8];
#pragma unroll
    for (int mt = 0; mt < 8; ++mt) Sacc[mt] = (f32x4v){0.f, 0.f, 0.f, 0.f};
    bf16* O = WSP(bf16, dir ? WS_OB : WS_OF);
    u32x4 st0[7], st1[7];
#define SC_UD(step) (((size_t)sh * (S / 64) + (dir ? S / 64 - 1 - (step) : (step))) * 2 + dir)
#define SC_LOAD(st, ud) do { const u32x4* a = (const u32x4*)WSP(bf16, WS_DN_WN) + (ud) * 1024 + tid; const u32x4* b = (const u32x4*)WSP(bf16, WS_DN_QE) + (ud) * 1024 + tid; \
        const u32x4* c = (const u32x4*)WSP(bf16, WS_DN_IN) + (ud) * 512 + tid; const u32x4* d = (const u32x4*)WSP(bf16, WS_DN_KD) + (ud) * 1024 + tid; \
        st[0] = a[0]; st[1] = a[512]; st[2] = b[0]; st[3] = b[512]; st[4] = c[0]; st[5] = d[0]; st[6] = d[512]; } while (0)
#define SC_WRITE(st, buf) do { char* b_ = lds + (buf) * SC_BUF + tid * 16; *(u32x4*)(b_ + SC_WN) = st[0]; *(u32x4*)(b_ + SC_WN + 8192) = st[1]; *(u32x4*)(b_ + SC_QE) = st[2]; *(u32x4*)(b_ + SC_QE + 8192) = st[3]; \
        *(u32x4*)(b_ + SC_IN) = st[4]; *(u32x4*)(b_ + SC_KD) = st[5]; *(u32x4*)(b_ + SC_KD + 8192) = st[6]; } while (0)
    f32x4v ut0[4], ut1[4]; float eg0, eg1;
#define SC_LOADU(ut, egv, ud) do { const float* u_ = WSP(float, WS_DN_UT) + ((ud) * 128 + n0 + n) * 64 + 4 * q; _Pragma("unroll") for (int mt = 0; mt < 4; ++mt) ut[mt] = *(const f32x4v*)(u_ + 16 * mt); egv = WSP(float, WS_DN_EG)[ud]; } while (0)
    { const size_t ud0 = SC_UD(0), ud1 = SC_UD(1), ud2 = SC_UD(2); SC_LOAD(st0, ud0); SC_LOADU(ut0, eg0, ud0); SC_LOAD(st1, ud1); SC_LOADU(ut1, eg1, ud1); SC_WRITE(st0, 0); SC_LOAD(st0, ud2); }
    __syncthreads();
#define SC_STEP(step, stY, utX, egX) do { \
        const int c = dir ? S / 64 - 1 - (step) : (step); \
        if ((step) + 1 < S / 64) SC_WRITE(stY, ((step) + 1) & 1);                                       \
        if ((step) + 3 < S / 64) { const size_t udn = SC_UD((step) + 3); SC_LOAD(stY, udn); } \
        f32x4v vn[4], o[4]; const float eg = egX; \
        _Pragma("unroll") for (int mt = 0; mt < 4; ++mt) { vn[mt] = utX[mt]; o[mt] = (f32x4v){0.f, 0.f, 0.f, 0.f}; } \
        if ((step) + 2 < S / 64) { const size_t udu = SC_UD((step) + 2); SC_LOADU(utX, egX, udu); } \
        const char* fb = lds + ((step) & 1) * SC_BUF + lane * 16; \
        bf16x8 Sb[4]; \
        _Pragma("unroll") for (int s = 0; s < 4; ++s) Sb[s] = pack8(Sacc[2 * s], Sacc[2 * s + 1]); \
        _Pragma("unroll") for (int mt = 0; mt < 4; ++mt) \
            _Pragma("unroll") for (int s = 0; s < 4; ++s) { vn[mt] = MFMA16(*(const bf16x8*)(fb + SC_WN + (mt * 4 + s) * 1024), Sb[s], vn[mt]); o[mt] = MFMA16(*(const bf16x8*)(fb + SC_QE + (mt * 4 + s) * 1024), Sb[s], o[mt]); } \
        bf16x8 Vb[2]; \
        _Pragma("unroll") for (int s = 0; s < 2; ++s) Vb[s] = pack8(vn[2 * s], vn[2 * s + 1]); \
        _Pragma("unroll") for (int mt = 0; mt < 4; ++mt) \
            _Pragma("unroll") for (int s = 0; s < 2; ++s) o[mt] = MFMA16(*(const bf16x8*)(fb + SC_IN + (mt * 2 + s) * 1024), Vb[s], o[mt]); \
        const long tbase = (long)seq * S + (long)c * 64; \
        _Pragma("unroll") for (int mt = 0; mt < 4; ++mt) \
            _Pragma("unroll") for (int r = 0; r < 4; ++r) { const int i = 16 * mt + 4 * q + r, ti = dir ? 63 - i : i; O[((size_t)(tbase + ti) * NH + hh) * DH + n0 + n] = f2bf(o[mt][r]); } \
        _Pragma("unroll") for (int mt = 0; mt < 8; ++mt) { f32x4v a = Sacc[mt] * eg; \
            _Pragma("unroll") for (int s = 0; s < 2; ++s) a = MFMA16(*(const bf16x8*)(fb + SC_KD + (mt * 2 + s) * 1024), Vb[s], a); \
            Sacc[mt] = a; } \
        __syncthreads(); } while (0)
#pragma unroll 1
    SC_STEP(0, st1, ut0, eg0); SC_STEP(1, st0, ut1, eg1);
#pragma unroll 1
    for (int step = 2; step < S / 64; step += 2) { SC_STEP(step, st1, ut0, eg0); SC_STEP(step + 1, st0, ut1, eg1); }
#undef SC_STEP
#undef SC_UD
#undef SC_LOAD
#undef SC_LOADU
#undef SC_WRITE
}
#undef MFMA16
}
constexpr int NWAVES = 8, NTHR = 512;
constexpr int RING_BYTES = 131072, LDSCTL_OFF = 158720, MISC_OFF = LDSCTL_OFF + 320, LDS_BYTES = 159744;
#define LAS __attribute__((address_space(3)))
#define GAS __attribute__((address_space(1)))
typedef unsigned v4u __attribute__((ext_vector_type(4)));
typedef float f32x4 __attribute__((ext_vector_type(4)));
#define LDS_WAIT() asm volatile("s_waitcnt lgkmcnt(0)" ::: "memory")
#define XB_TMO      128
#define XB_XCNT(j)  (256  + 64 * (j))
#define XB_XSUB(j)  (1280 + 64 * (j))
#define XB_XGEN(j)  (2304 + 64 * (j))
#define XB_TOP      3328
#define XB_TOPGEN   3392
#define XCD_BAR_WORDS 3456
#define XB_SPIN_CAP (1u << 22)
__device__ __forceinline__ unsigned xb_ld(unsigned* p)              { return __hip_atomic_load(p, __ATOMIC_RELAXED, __HIP_MEMORY_SCOPE_AGENT); }
__device__ __forceinline__ unsigned xb_add(unsigned* p, unsigned v) { return __hip_atomic_fetch_add(p, v, __ATOMIC_RELAXED, __HIP_MEMORY_SCOPE_AGENT); }
__device__ __forceinline__ unsigned xb_xcc_id() { return (unsigned)__builtin_amdgcn_s_getreg((3 << 11) | 20) & 0xFu; }
#define XB_SPIN(cond, bar) do { unsigned _sp = 0; while (cond) { __builtin_amdgcn_s_sleep(1); \
    if ((++_sp & 255u) == 0u) { if (xb_ld(&(bar)[XB_TMO])) break; if (_sp > XB_SPIN_CAP) { atomicAdd(&(bar)[XB_TMO], 1u); break; } } } } while (0)
struct XcdBarrier { unsigned* bar; unsigned x; volatile LAS unsigned* st; };
__device__ __forceinline__ XcdBarrier xcd_barrier_post(unsigned* bar, volatile LAS unsigned* st) {
    XcdBarrier b; b.bar = bar; b.x = xb_xcc_id(); b.st = st;
    if (threadIdx.x == 0) (void)xb_add(&bar[XB_XCNT(b.x)], 1u);
    return b;
}
__device__ __forceinline__ void xcd_barrier_complete(unsigned* bar, unsigned x, unsigned& nloc, unsigned& nx) {
    const unsigned G = gridDim.x * gridDim.y * gridDim.z;
    unsigned sum, cnt, mine, sp = 0u;
    for (;;) {
        sum = 0u; cnt = 0u; mine = 0u;
#pragma unroll
        for (unsigned j = 0; j < 16; ++j) { const unsigned c = xb_ld(&bar[XB_XCNT(j)]); sum += c; cnt += (c > 0u) ? 1u : 0u; mine = (j == x) ? c : mine; }
        if (sum == G) break;
        __builtin_amdgcn_s_sleep(1);
        if ((++sp & 255u) == 0u) { if (xb_ld(&bar[XB_TMO])) break; if (sp > XB_SPIN_CAP) { atomicAdd(&bar[XB_TMO], 1u); break; } }
    }
    nloc = mine > 0u ? mine : 1u; nx = cnt > 0u ? cnt : 1u;
}
__device__ __forceinline__ void xcd_barrier(const XcdBarrier& b, int tid_in) {
    asm volatile("s_waitcnt vmcnt(0)" ::: "memory");
    __syncthreads();
    if (tid_in == 0) {
        unsigned* bar = b.bar; const unsigned bx = xb_xcc_id();
        __builtin_amdgcn_s_waitcnt(0);
        unsigned nloc = b.st[0], nx = b.st[1];
        if (nloc == 0u) { xcd_barrier_complete(bar, bx, nloc, nx); b.st[0] = nloc; b.st[1] = nx; }
        const unsigned old = xb_add(&bar[XB_XSUB(bx)], 1u);
        const unsigned gen = old / nloc;
        if (old + 1u == (gen + 1u) * nloc) {
            __builtin_amdgcn_fence(__ATOMIC_RELEASE, "agent");
            asm volatile("s_waitcnt vmcnt(0)" ::: "memory");
            const unsigned og = xb_add(&bar[XB_TOP], 1u);
            const unsigned tg = og / nx;
            if (og + 1u == (tg + 1u) * nx) xb_add(&bar[XB_TOPGEN], 1u);
            else XB_SPIN(xb_ld(&bar[XB_TOPGEN]) == tg, bar);
            __builtin_amdgcn_fence(__ATOMIC_ACQUIRE, "agent");
            xb_add(&bar[XB_XGEN(bx)], 1u);
            asm volatile("s_waitcnt vmcnt(0)" ::: "memory");
        } else {
            XB_SPIN(xb_ld(&bar[XB_XGEN(bx)]) == gen, bar);
            __builtin_amdgcn_fence(__ATOMIC_ACQUIRE, "agent");
            asm volatile("s_waitcnt vmcnt(0)" ::: "memory");
        }
    }
    __syncthreads();
}
constexpr size_t CTL_ZERO_BYTES = 65536; constexpr int CW_BAR = 1024;

__device__ __forceinline__ float wave_sum(float v) {
#pragma unroll
    for (int o = 1; o < 64; o <<= 1) v += __shfl_xor(v, o);
    return v;
}
constexpr long N_SCAN4 = N_SCAN * 4;
__device__ __forceinline__ void st_dn_scan4(const P& p, long g) {
    const int part = (int)(g & 3); const long g1 = g >> 2;
    const int vc = (int)(g1 % DH); const int dir = (int)((g1 / DH) % 2); const int hh = (int)((g1 / (2 * DH)) % NH); const int seq = (int)(g1 / (2 * DH * NH));
    const float *QN = WSP(float, WS_QN), *KN = WSP(float, WS_KN), *VV = WSP(float, WS_VV), *G = WSP(float, WS_G), *BT = WSP(float, WS_BETA);
    float* O = WSP(float, dir ? WS_OB : WS_OF);
    float Sx[32];
#pragma unroll
    for (int d = 0; d < 32; ++d) Sx[d] = 0.f;
    for (int step = 0; step < S; ++step) {
        const int tt = dir ? S - 1 - step : step; const long t = (long)seq * S + tt;
        const float eg = expf(G[(t * 2 + dir) * NH + hh]), b = BT[(t * 2 + dir) * NH + hh];
        const float* kp = KN + ((size_t)t * NH + hh) * DH + part * 32; const float* qp = QN + ((size_t)t * NH + hh) * DH + part * 32; const float vv = VV[((size_t)t * NH + hh) * DH + vc];
        float dot = 0.f;
#pragma unroll
        for (int d = 0; d < 32; ++d) { Sx[d] *= eg; dot += Sx[d] * kp[d]; }
        dot += __shfl_xor(dot, 1); dot += __shfl_xor(dot, 2);
        const float delta = b * (vv - dot); float o = 0.f;
#pragma unroll
        for (int d = 0; d < 32; ++d) { Sx[d] += kp[d] * delta; o += Sx[d] * qp[d]; }
        o += __shfl_xor(o, 1); o += __shfl_xor(o, 2);
        if (part == 0) O[((size_t)t * NH + hh) * DH + vc] = o;
    }
}
__device__ __forceinline__ unsigned pk2(float lo, float hi) { return (unsigned)f2bf(lo) | ((unsigned)f2bf(hi) << 16); }
template <int ST> __device__ __forceinline__ void grid_items(const Job& j, long n, int tid_in) {
    int t_ = tid_in; asm volatile("" : "+v"(t_));
    for (long g = (long)blockIdx.x * NTHR + t_; g < n; g += (long)gridDim.x * NTHR) run_item<ST>(j, g);
}
__device__ __forceinline__ void transpose_item(const float* W, int K, int N, bf16* WT, LAS float* scr, int item, int lane, int GU = 0) {
    const int nblk_src = (N + 63) / 64; const int kblks = K / 64; const int KBL = kblks < 16 ? kblks : 16, NBL = 64 / KBL, kbb = kblks / KBL;
    const int blk = item >> 6, within = item & 63; const int kb = (blk % kbb) * KBL + (within % KBL), nb = (blk / kbb) * NBL + (within / KBL), k0 = 64 * kb, n0 = 64 * nb;
    const int n0s = GU ? (((n0 >> 7) & 1) * DFF + (n0 >> 8) * 128 + (n0 & 127)) : n0;
    const int c = lane & 7;
    if (nb >= nblk_src) {
#pragma unroll
        for (int jj = 0; jj < 8; ++jj) { const int n = (lane >> 3) + 8 * jj; *(GAS v4u*)(WT + (size_t)(n0 + n) * K + k0 + 8 * c) = (v4u){0u, 0u, 0u, 0u}; }
        return;
    }
    {
        f32x4 v[16]; const int kq = lane >> 4, nn = (lane & 15) * 4;
#pragma unroll
        for (int i = 0; i < 16; ++i) v[i] = (n0s + nn < N) ? *(const f32x4*)(W + (size_t)(k0 + 4 * i + kq) * N + n0s + nn) : (f32x4){0.f, 0.f, 0.f, 0.f};
#pragma unroll
        for (int i = 0; i < 16; ++i) { LAS float* d = scr + (4 * i + kq) * 65 + nn; d[0] = v[i].x; d[1] = v[i].y; d[2] = v[i].z; d[3] = v[i].w; }
    }
    LDS_WAIT(); asm volatile("" ::: "memory");
#pragma unroll
    for (int jj = 0; jj < 8; ++jj) { const int n = (lane >> 3) + 8 * jj; const LAS float* s_ = scr + (8 * c) * 65 + n;
        v4u o; o.x = pk2(s_[0 * 65], s_[1 * 65]); o.y = pk2(s_[2 * 65], s_[3 * 65]); o.z = pk2(s_[4 * 65], s_[5 * 65]); o.w = pk2(s_[6 * 65], s_[7 * 65]);
        *(GAS v4u*)(WT + (size_t)(n0 + n) * K + k0 + 8 * c) = o; }
    LDS_WAIT(); asm volatile("" ::: "memory");
}
__device__ __forceinline__ void pb_phase(const P& p, int tid_in) {
    int t_ = tid_in; asm volatile("" : "+v"(t_));
    constexpr long np8 = (long)NPROMPT * S * PLE / 8, ns8 = (long)(NSEQ - NPROMPT) * S * PLE / 8, n8 = np8 + ns8;
    for (int layer = 0; layer < DEPTH; ++layer) {
        const float* pp = p.p_prompt + (size_t)layer * np8 * 8; const float* ps = p.p_sample + (size_t)layer * ns8 * 8; bf16* o = WSP(bf16, WS_PB + (size_t)layer * SZ_PB);
#pragma unroll 2
        for (long g = (long)blockIdx.x * NTHR + t_; g < n8; g += (long)gridDim.x * NTHR) { const float* src = g < np8 ? pp + g * 8 : ps + (g - np8) * 8;
            const f32x4 a = *(const f32x4*)src, b = *(const f32x4*)(src + 4); v4u w; w.x = pk2(a.x, a.y); w.y = pk2(a.z, a.w); w.z = pk2(b.x, b.y); w.w = pk2(b.z, b.w); *(v4u*)(o + g * 8) = w; }
    }
}
__device__ __forceinline__ float fast_sigmoid(float x) { return __builtin_amdgcn_rcpf(1.0f + __builtin_amdgcn_exp2f(-1.4426950408889634f * x)); }
template <int MODE> __device__ __forceinline__ void row_phase(const P& p, const float* wa, const float* wn, int gw, int ngw, int lane) {
    constexpr int NV = D / 256;
    asm volatile("" : "+v"(lane));
    f32x4 hN[NV]; unsigned long long hB[NV], yN[NV], pN[NV];
#define ROW_LOAD(t_) do { const long tt_ = (t_); \
        if (MODE == 0) { const long np = (long)NPROMPT * S * D; const float* src = (tt_ * D < np) ? p.x_prompt + (size_t)tt_ * D : p.x_sample + ((size_t)tt_ * D - np); \
            _Pragma("unroll") for (int i = 0; i < NV; ++i) hN[i] = *(const f32x4*)(src + (i * 64 + lane) * 4); } \
        else { const bf16* hr_ = WSP(bf16, WS_H16) + (size_t)tt_ * D; const bf16* yr_ = WSP(bf16, WS_GOUT) + (size_t)tt_ * D; \
            _Pragma("unroll") for (int i = 0; i < NV; ++i) { hB[i] = *(const unsigned long long*)(hr_ + (i * 64 + lane) * 4); yN[i] = *(const unsigned long long*)(yr_ + (i * 64 + lane) * 4); } \
            if (MODE == 3) { const bf16* pr_ = WSP(bf16, WS_PP2) + (size_t)tt_ * D; _Pragma("unroll") for (int i = 0; i < NV; ++i) pN[i] = *(const unsigned long long*)(pr_ + (i * 64 + lane) * 4); } } } while (0)
#define UNPK(q_) (f32x4){bf2f((bf16)((q_) & 0xffff)), bf2f((bf16)(((q_) >> 16) & 0xffff)), bf2f((bf16)(((q_) >> 32) & 0xffff)), bf2f((bf16)((q_) >> 48))}
    if (gw < T) ROW_LOAD(gw);
    for (int t = gw; t < T; t += ngw) {
        f32x4 h[NV], y[NV], pp[NV];
#pragma unroll
        for (int i = 0; i < NV; ++i) { if (MODE == 0) h[i] = hN[i]; else { h[i] = UNPK(hB[i]); y[i] = UNPK(yN[i]); } if (MODE == 3) pp[i] = UNPK(pN[i]); }
        if (t + ngw < T) ROW_LOAD(t + ngw);
        if (MODE == 1 || MODE == 2) {
            float ss = 0.f;
#pragma unroll
            for (int i = 0; i < NV; ++i) ss += (y[i].x * y[i].x + y[i].y * y[i].y) + (y[i].z * y[i].z + y[i].w * y[i].w);
            const float r = 1.0f / sqrtf(wave_sum(ss) * (1.0f / D) + RMS_EPS);
#pragma unroll
            for (int i = 0; i < NV; ++i) { const f32x4 w = *(const f32x4*)(wa + (i * 64 + lane) * 4); h[i] = h[i] + y[i] * r * w; }
        } else if (MODE == 3) {
#pragma unroll
            for (int i = 0; i < NV; ++i) { h[i].x += fast_sigmoid(y[i].x) * pp[i].x; h[i].y += fast_sigmoid(y[i].y) * pp[i].y; h[i].z += fast_sigmoid(y[i].z) * pp[i].z; h[i].w += fast_sigmoid(y[i].w) * pp[i].w; }
        }
        if (MODE == 3 && wn == nullptr) { float* hr = p.h + (size_t)t * D;
#pragma unroll
            for (int i = 0; i < NV; ++i) *(f32x4*)(hr + (i * 64 + lane) * 4) = h[i];
            continue; }
        { bf16* hw = WSP(bf16, WS_H16) + (size_t)t * D;
#pragma unroll
            for (int i = 0; i < NV; ++i) *(unsigned long long*)(hw + (i * 64 + lane) * 4) = (unsigned long long)pk2(h[i].x, h[i].y) | ((unsigned long long)pk2(h[i].z, h[i].w) << 32); }
        if (MODE == 2) continue;
        float r2 = 1.f;
        if (MODE != 2) { float ss = 0.f;
#pragma unroll
            for (int i = 0; i < NV; ++i) ss += (h[i].x * h[i].x + h[i].y * h[i].y) + (h[i].z * h[i].z + h[i].w * h[i].w);
            r2 = 1.0f / sqrtf(wave_sum(ss) * (1.0f / D) + RMS_EPS); }
        bf16* o = WSP(bf16, WS_HN) + (size_t)t * D;
#pragma unroll
        for (int i = 0; i < NV; ++i) { f32x4 v = h[i] * r2; if (MODE != 2) { const f32x4 w = *(const f32x4*)(wn + (i * 64 + lane) * 4); v = v * w; }
            *(unsigned long long*)(o + (i * 64 + lane) * 4) = (unsigned long long)pk2(v.x, v.y) | ((unsigned long long)pk2(v.z, v.w) << 32); }
    }
#undef ROW_LOAD
#undef UNPK
}

typedef short bf16x8_t __attribute__((ext_vector_type(8)));
__device__ __forceinline__ float gelu_fast(float x) { const float u = 0.7978845608028654f * (x + 0.044715f * x * x * x); return x * __builtin_amdgcn_rcpf(1.0f + __builtin_amdgcn_exp2f(-2.885390081777927f * u)); }
__device__ __forceinline__ void ffn_act_phase(const P& p, int layer, int gw, int ngw, int lane) {
    asm volatile("" : "+v"(lane));
    constexpr int TT = 32, NCB = DFF / 512, NIT = (T / TT) * NCB;
    const bf16* hid = WSP(bf16, WS_HID); bf16* act = WSP(bf16, WS_ACT);
    const float* cw = PRM(PR_FCW) + (size_t)layer * 3 * 2 * DFF; const float* cb = PRM(PR_FCB) + (size_t)layer * 2 * DFF;
    for (int it = gw; it < NIT; it += ngw) {
        const int cblk = it % NCB, tile = it / NCB; const int c0 = cblk * 512 + lane * 8; const long t0 = (long)tile * TT; const int tt0 = (int)(t0 % S);
        float wg[3][8], wu[3][8], bg[8], bu[8];
#pragma unroll
        for (int i = 0; i < 3; ++i)
#pragma unroll
            for (int e = 0; e < 8; ++e) { wg[i][e] = cw[i * 2 * DFF + c0 + e]; wu[i][e] = cw[i * 2 * DFF + DFF + c0 + e]; }
#pragma unroll
        for (int e = 0; e < 8; ++e) { bg[e] = cb[c0 + e]; bu[e] = cb[DFF + c0 + e]; }
        const bf16x8_t zero8 = {0, 0, 0, 0, 0, 0, 0, 0};
        bf16x8_t g0 = zero8, u0 = zero8, g1, u1, g2, u2;
        if (tt0 > 0) { g0 = *(const bf16x8_t*)(hid + (size_t)(t0 - 1) * (2 * DFF) + c0); u0 = *(const bf16x8_t*)(hid + (size_t)(t0 - 1) * (2 * DFF) + DFF + c0); }
        g1 = *(const bf16x8_t*)(hid + (size_t)t0 * (2 * DFF) + c0); u1 = *(const bf16x8_t*)(hid + (size_t)t0 * (2 * DFF) + DFF + c0);
        for (int k = 0; k < TT; ++k) {
            const long t = t0 + k;
            if (tt0 + k + 1 < S) { g2 = *(const bf16x8_t*)(hid + (size_t)(t + 1) * (2 * DFF) + c0); u2 = *(const bf16x8_t*)(hid + (size_t)(t + 1) * (2 * DFF) + DFF + c0); } else { g2 = zero8; u2 = zero8; }
            float o[8];
#pragma unroll
            for (int e = 0; e < 8; ++e) {
                const float ga = bg[e] + bf2f((bf16)g0[e]) * wg[0][e] + bf2f((bf16)g1[e]) * wg[1][e] + bf2f((bf16)g2[e]) * wg[2][e];
                const float up = bu[e] + bf2f((bf16)u0[e]) * wu[0][e] + bf2f((bf16)u1[e]) * wu[1][e] + bf2f((bf16)u2[e]) * wu[2][e];
                o[e] = gelu_fast(ga) * up; }
            v4u w; w.x = pk2(o[0], o[1]); w.y = pk2(o[2], o[3]); w.z = pk2(o[4], o[5]); w.w = pk2(o[6], o[7]);
            *(v4u*)(act + (size_t)t * DFF + c0) = w;
            g0 = g1; u0 = u1; g1 = g2; u1 = u2;
        }
    }
}
__device__ __forceinline__ void dn_out_phase(const P& p, int jl, int gw, int ngw, int lane) {
    asm volatile("" : "+v"(lane));
    const int hh = lane >> 3, d0 = (lane & 7) * 16; const float* on = PRM(PR_ONORM) + jl * DH + d0;
    bf16x8_t aN[2], bN[2], zN0, zN1;
#define DNO_LOAD(t_) do { const bf16* of_ = WSP(bf16, WS_OF) + ((size_t)(t_) * NH + hh) * DH + d0; const bf16* ob_ = WSP(bf16, WS_OB) + ((size_t)(t_) * NH + hh) * DH + d0; \
        const bf16* z_ = WSP(bf16, WS_PROJ) + (size_t)(t_) * ABINP + COL_Z + hh * DH + d0; \
        aN[0] = *(const bf16x8_t*)of_; aN[1] = *(const bf16x8_t*)(of_ + 8); bN[0] = *(const bf16x8_t*)ob_; bN[1] = *(const bf16x8_t*)(ob_ + 8); zN0 = *(const bf16x8_t*)z_; zN1 = *(const bf16x8_t*)(z_ + 8); } while (0)
    if (gw < T) DNO_LOAD(gw);
    for (int t = gw; t < T; t += ngw) {
        float o[16]; float ss = 0.f; const bf16x8_t z0 = zN0, z1 = zN1;
#pragma unroll
        for (int c8 = 0; c8 < 2; ++c8)
#pragma unroll
            for (int e = 0; e < 8; ++e) { o[8 * c8 + e] = bf2f((bf16)aN[c8][e]) + bf2f((bf16)bN[c8][e]); ss += o[8 * c8 + e] * o[8 * c8 + e]; }
        if (t + ngw < T) DNO_LOAD(t + ngw);
        ss += __shfl_xor(ss, 1); ss += __shfl_xor(ss, 2); ss += __shfl_xor(ss, 4);
        const float r = 1.0f / sqrtf(ss * (1.0f / DH) + RMS_EPS); float v[16];
#pragma unroll
        for (int e = 0; e < 16; ++e) { const float zz = bf2f((bf16)(e < 8 ? z0[e] : z1[e - 8])); v[e] = o[e] * r * on[e] * zz * fast_sigmoid(zz); }
        bf16* out = WSP(bf16, WS_MIXIN) + (size_t)t * ABMIX + hh * DH + d0;
        v4u w0, w1; w0.x = pk2(v[0], v[1]); w0.y = pk2(v[2], v[3]); w0.z = pk2(v[4], v[5]); w0.w = pk2(v[6], v[7]); w1.x = pk2(v[8], v[9]); w1.y = pk2(v[10], v[11]); w1.z = pk2(v[12], v[13]); w1.w = pk2(v[14], v[15]);
        *(v4u*)out = w0; *(v4u*)(out + 8) = w1;
    }
#undef DNO_LOAD
}
__device__ __forceinline__ void c_out_phase(const P& p, int jl, int gw, int ngw, int lane) {
    asm volatile("" : "+v"(lane));
    const int hh = lane >> 3, e0 = (lane & 7) * 32; const float lam = WSP(float, WS_LAM)[0], li = WSP(float, WS_LAM)[1]; const float* sw = PRM(PR_SUBLN) + jl * 256 + e0;
    bf16x8_t aN[4], bN[4];
#define CO_LOAD(t_) do { const bf16* o0_ = WSP(bf16, WS_O0) + (size_t)(t_) * 2048 + hh * 256 + e0; const bf16* o1_ = WSP(bf16, WS_O1) + (size_t)(t_) * 2048 + hh * 256 + e0; \
        _Pragma("unroll") for (int c8 = 0; c8 < 4; ++c8) { aN[c8] = *(const bf16x8_t*)(o0_ + 8 * c8); bN[c8] = *(const bf16x8_t*)(o1_ + 8 * c8); } } while (0)
    if (gw < T) CO_LOAD(gw);
    for (int t = gw; t < T; t += ngw) {
        float o[32]; float ss = 0.f;
#pragma unroll
        for (int c8 = 0; c8 < 4; ++c8)
#pragma unroll
            for (int e = 0; e < 8; ++e) { o[8 * c8 + e] = bf2f((bf16)aN[c8][e]) - lam * bf2f((bf16)bN[c8][e]); ss += o[8 * c8 + e] * o[8 * c8 + e]; }
        if (t + ngw < T) CO_LOAD(t + ngw);
        ss += __shfl_xor(ss, 1); ss += __shfl_xor(ss, 2); ss += __shfl_xor(ss, 4);
        const float r = (1.0f / sqrtf(ss * (1.0f / 256.0f) + RMS_EPS)) * (1.0f - li);
        bf16* out = WSP(bf16, WS_MIXIN) + (size_t)t * 2048 + hh * 256 + e0;
#pragma unroll
        for (int c8 = 0; c8 < 4; ++c8) { v4u w; w.x = pk2(o[8 * c8] * r * sw[8 * c8], o[8 * c8 + 1] * r * sw[8 * c8 + 1]); w.y = pk2(o[8 * c8 + 2] * r * sw[8 * c8 + 2], o[8 * c8 + 3] * r * sw[8 * c8 + 3]);
            w.z = pk2(o[8 * c8 + 4] * r * sw[8 * c8 + 4], o[8 * c8 + 5] * r * sw[8 * c8 + 5]); w.w = pk2(o[8 * c8 + 6] * r * sw[8 * c8 + 6], o[8 * c8 + 7] * r * sw[8 * c8 + 7]); *(v4u*)(out + 8 * c8) = w; }
    }
#undef CO_LOAD
}
__device__ __forceinline__ void rope_table_phase(const P& p, int tid_in) {
    int t_ = tid_in; asm volatile("" : "+v"(t_));
    float* tab = WSP(float, WS_LAM) + 16;
    for (int g = (int)blockIdx.x * NTHR + t_; g < S * 16; g += (int)gridDim.x * NTHR) { const int i = g & 15, pos = g >> 4;
        const float inv = powf(500000.0f, -(float)(2 * i) / 32.0f); const float ang = (float)pos * inv; tab[2 * g] = cosf(ang); tab[2 * g + 1] = sinf(ang); }
}
__device__ __forceinline__ void rope_phase(const P& p, int tid_in) {
    int t_ = tid_in; asm volatile("" : "+v"(t_));
    const float* tab = WSP(const float, WS_LAM) + 16;
    for (long g = (long)blockIdx.x * NTHR + t_; g < (long)T * 32; g += (long)gridDim.x * NTHR) {
        const int hj = (int)(g & 15), which = (int)((g >> 4) & 1); const long t = g >> 5; const float* cs_ = tab + (size_t)(t % S) * 32;
        bf16* x = WSP(bf16, WS_PROJ) + (size_t)t * CIN + which * 2048 + hj * DH;
        bf16x8_t a0 = *(const bf16x8_t*)x, a1 = *(const bf16x8_t*)(x + 8), b0 = *(const bf16x8_t*)(x + 16), b1 = *(const bf16x8_t*)(x + 24); float r1[16], r2[16];
#pragma unroll
        for (int i = 0; i < 16; ++i) { const float cs = cs_[2 * i], sn = cs_[2 * i + 1];
            const float x1 = bf2f((bf16)(i < 8 ? a0[i] : a1[i - 8])), x2 = bf2f((bf16)(i < 8 ? b0[i] : b1[i - 8])); r1[i] = x1 * cs - x2 * sn; r2[i] = x2 * cs + x1 * sn; }
        v4u w;
        w.x = pk2(r1[0], r1[1]); w.y = pk2(r1[2], r1[3]); w.z = pk2(r1[4], r1[5]); w.w = pk2(r1[6], r1[7]); *(v4u*)x = w;
        w.x = pk2(r1[8], r1[9]); w.y = pk2(r1[10], r1[11]); w.z = pk2(r1[12], r1[13]); w.w = pk2(r1[14], r1[15]); *(v4u*)(x + 8) = w;
        w.x = pk2(r2[0], r2[1]); w.y = pk2(r2[2], r2[3]); w.z = pk2(r2[4], r2[5]); w.w = pk2(r2[6], r2[7]); *(v4u*)(x + 16) = w;
        w.x = pk2(r2[8], r2[9]); w.y = pk2(r2[10], r2[11]); w.z = pk2(r2[12], r2[13]); w.w = pk2(r2[14], r2[15]); *(v4u*)(x + 24) = w;
    }
}
__device__ __forceinline__ void ffn_fix_phase(const P& p, int layer, int tid_in) {
    int t_ = tid_in; asm volatile("" : "+v"(t_));
    const int ln = t_ & 63, gwv = (int)blockIdx.x * NWAVES + __builtin_amdgcn_readfirstlane(t_ >> 6), ngwv = (int)gridDim.x * NWAVES;
    const float* cw = PRM(PR_FCW) + (size_t)layer * 3 * 2 * DFF; const float* cb = PRM(PR_FCB) + (size_t)layer * 2 * DFF; const float* HALO = WSP(float, WS_HALO);
    constexpr int NP = T / 256, PPS = S / 256, NCB = DFF / 256;
    for (int g = gwv; g < NP * 2 * NCB; g += ngwv) {
        const int c0 = (g % NCB) * 256 + ln * 4; const int edge = (g / NCB) & 1; const int pm = g / (2 * NCB);
        const bool has_prev = edge ? true : (pm % PPS != 0), has_next = edge ? (pm % PPS != PPS - 1) : true;
        const float* rp = HALO + (((size_t)(edge ? pm : pm - 1) * 4 + (edge ? 2 : 3)) * 2) * DFF + c0;
        const float* rc = HALO + (((size_t)pm * 4 + (edge ? 3 : 0)) * 2) * DFF + c0;
        const float* rn = HALO + (((size_t)(edge ? pm + 1 : pm) * 4 + (edge ? 0 : 1)) * 2) * DFF + c0;
        const f32x4 z4 = {0.f, 0.f, 0.f, 0.f};
        f32x4 gp = z4, up = z4, gn = z4, un = z4;
        if (has_prev) { gp = *(const f32x4*)rp; up = *(const f32x4*)(rp + DFF); }
        if (has_next) { gn = *(const f32x4*)rn; un = *(const f32x4*)(rn + DFF); }
        const f32x4 gc = *(const f32x4*)rc, uc = *(const f32x4*)(rc + DFF);
        const f32x4 bg = *(const f32x4*)(cb + c0), bu = *(const f32x4*)(cb + DFF + c0);
        const f32x4 wg0 = *(const f32x4*)(cw + c0), wu0 = *(const f32x4*)(cw + DFF + c0), wg1 = *(const f32x4*)(cw + 2 * DFF + c0), wu1 = *(const f32x4*)(cw + 3 * DFF + c0),
                    wg2 = *(const f32x4*)(cw + 4 * DFF + c0), wu2 = *(const f32x4*)(cw + 5 * DFF + c0);
        float o[4];
#pragma unroll
        for (int e = 0; e < 4; ++e) {
            const float cg = bg[e] + wg0[e] * gp[e] + wg1[e] * gc[e] + wg2[e] * gn[e];
            const float cu = bu[e] + wu0[e] * up[e] + wu1[e] * uc[e] + wu2[e] * un[e];
            o[e] = pg8::gelu_t(cg) * cu; }
        *(unsigned long long*)(WSP(bf16, WS_ACT) + ((size_t)pm * 256 + (edge ? 255 : 0)) * DFF + c0) = (unsigned long long)pk2(o[0], o[1]) | ((unsigned long long)pk2(o[2], o[3]) << 32);
    }
}
__device__ __forceinline__ int hw_lane() { int l; asm volatile("v_mbcnt_lo_u32_b32 %0, -1, 0\n\tv_mbcnt_hi_u32_b32 %0, -1, %0" : "=v"(l)); return l; }
struct Args { P p; };
__global__ void __launch_bounds__(NTHR, 2) mega_fwd(Args args) {
    extern __shared__ __attribute__((aligned(16))) unsigned char lds_raw[];
    LAS unsigned char* lds = (LAS unsigned char*)lds_raw;
    const P& p = args.p;
    const int tid = threadIdx.x, wave = __builtin_amdgcn_readfirstlane(tid >> 6);
#define HWLANE hw_lane()
#define HWTID ((wave << 6) | HWLANE)
#define lane HWLANE
    const int G = gridDim.x; const int gw = blockIdx.x * NWAVES + wave, ngw = G * NWAVES;
    volatile LAS unsigned* MISC = (volatile LAS unsigned*)(lds + MISC_OFF);
    for (int u = tid; u < (LDS_BYTES - LDSCTL_OFF) / 4; u += NTHR) ((LAS unsigned*)(lds + LDSCTL_OFF))[u] = 0u;
    __syncthreads();
    XcdBarrier bar = xcd_barrier_post(WSP(unsigned, WS_CTL) + CW_BAR, MISC + 8);
    Job j; j.p = p; j.w.W = nullptr; j.w.O = nullptr; j.w.K = 0; j.w.N = 0; j.w.Npad = 0; j.a = nullptr; j.b = nullptr; j.n = 0; j.layer = 0; j.flag = 0;

    {
        LAS float* scr = (LAS float*)(lds + wave * 16640);
        for (int m = 0; m < 24; ++m) {
            const float* W; bf16* O; int K, N, Npad; const int i = m & 1, l = m & 3;
            if (m < 2)       { W = p.ab_w_in + (size_t)i * D * ABIN;  O = WSP(bf16, WS_WABIN + (size_t)i * ABINP * D * 2); K = D; N = ABIN; Npad = ABINP; }
            else if (m < 4)  { W = p.ab_w_out + (size_t)i * ABMIX * D; O = WSP(bf16, WS_WABOUT + (size_t)i * D * ABMIX * 2); K = ABMIX; N = D; Npad = D; }
            else if (m < 6)  { W = p.c_w_in + (size_t)i * D * CIN;    O = WSP(bf16, WS_WCIN + (size_t)i * CIN * D * 2); K = D; N = CIN; Npad = CIN; }
            else if (m < 8)  { W = p.c_w_out + (size_t)i * CV * D;    O = WSP(bf16, WS_WCOUT + (size_t)i * D * CV * 2); K = CV; N = D; Npad = D; }
            else if (m < 12) { W = p.ffn_w_in + (size_t)l * D * 2 * DFF; O = WSP(bf16, WS_WFIN + (size_t)l * 2 * DFF * D * 2); K = D; N = 2 * DFF; Npad = 2 * DFF; }
            else if (m < 16) { W = p.ffn_w_out + (size_t)l * DFF * D;  O = WSP(bf16, WS_WFOUT + (size_t)l * D * DFF * 2); K = DFF; N = D; Npad = D; }
            else if (m < 20) { W = p.ple_w_proj + (size_t)l * PLE * D; O = WSP(bf16, WS_WPP + (size_t)l * D * PLE * 2); K = PLE; N = D; Npad = D; }
            else             { W = p.ple_w_gate + (size_t)l * D * D;   O = WSP(bf16, WS_WPG + (size_t)l * D * D * 2); K = D; N = D; Npad = D; }
            const int nitems = (K / 64) * (Npad / 64);
            for (int it = gw; it < nitems; it += ngw) transpose_item(W, K, N, O, scr, it, lane, (m >= 8 && m < 12) ? 1 : 0);
        }
        rope_table_phase(p, HWTID);
        {
            int t_ = HWTID; asm volatile("" : "+v"(t_));
            if (blockIdx.x == 0 && t_ < 2) { const float* lp = p.c_lambda + (size_t)t_ * 4 * DH; float a = 0.f, b = 0.f;
                for (int d = 0; d < DH; ++d) { a += lp[d] * lp[DH + d]; b += lp[2 * DH + d] * lp[3 * DH + d]; }
                const float li = lambda_init_of(2 * t_ + 1); WSP(float, WS_LAM)[2 * t_] = expf(a) - expf(b) + li; WSP(float, WS_LAM)[2 * t_ + 1] = li; }
        }
        grid_items<ST_PRM>(j, N_PRM, HWTID);
        pb_phase(p, HWTID);
        row_phase<0>(p, nullptr, p.norms, gw, ngw, lane);
    }
    xcd_barrier(bar, HWTID);

    for (int layer = 0; layer < DEPTH; ++layer) {
        j.layer = layer; const int jj = layer >> 1; const float* nw = PRM(PR_NORMS) + (size_t)layer * 4 * D;
        {
            const bool ab = (layer & 1) == 0; const int N = ab ? ABINP : CIN;
            const bf16* Bt = ab ? WSP(bf16, WS_WABIN + (size_t)jj * ABINP * D * 2) : WSP(bf16, WS_WCIN + (size_t)jj * CIN * D * 2);
            pg8::Gemm g{WSP(bf16, WS_HN), Bt, T, N, D}; pg8::StaticOrder S_; S_.init(T, N, G, (int)blockIdx.x);
            pg8::EpiBf16Ro E{WSP(bf16, WS_PROJ), N, ab ? nullptr : WSP(const float, WS_LAM) + 16, S};
            pg8::gemm_phase<pg8::EpiBf16Ro, pg8::StaticOrder, true, true>(lds, g, S_, E, HWTID);
        }
        xcd_barrier(bar, HWTID);
        int pp_first = (int)blockIdx.x, pp_stride = G; bool pp_run = true;
        if ((layer & 1) == 0) {
            {
                constexpr int NU = NSEQ * NH * (S / 64);
                for (int u = (int)blockIdx.x; u < NU; u += G) dn::dn1_unit(p, jj, u / (NH * (S / 64)), (u / (S / 64)) % NH, u % (S / 64), (char*)lds_raw, HWTID);
            }
            xcd_barrier(bar, HWTID);
            constexpr int NSC = NSEQ * NH * 2; const bool split = G >= 2 * NSC; const int na_first = split ? (int)blockIdx.x - NSC : (int)blockIdx.x, na_stride = split ? G - NSC : G;
            if (!split || (int)blockIdx.x < NSC) { for (int ch = (int)blockIdx.x; ch < NSC; ch += G) dn::dn_scan_chain(p, ch, (char*)lds_raw, HWTID); }
            if (!split || (int)blockIdx.x >= NSC)
            {
                constexpr int NU = NSEQ * NH * (ROWS / 4);
                float* tab = (float*)((char*)lds_raw + att::SHM_ATTN);
                for (int u = na_first; u < NU; u += na_stride) {
                    const int rg = u % (ROWS / 4); const int hh = (u / (ROWS / 4)) % NH, seq = u / ((ROWS / 4) * NH); const int r0 = rg * 4;
                    const int kr0 = clampi(r0 - WR / 2, 0, ROWS - WR), krl = clampi(r0 + 3 - WR / 2, 0, ROWS - WR) + WR - 1; const int nt = krl - kr0 + 1;
                    { int t_ = HWTID; asm volatile("" : "+v"(t_)); if (t_ < 15 * 31) tab[t_] = PRM(PR_RPB)[((size_t)jj * NH + hh) * 15 * 31 + t_] * 11.313708498984761f; }
                    const bf16* base = WSP(bf16, WS_PROJ) + (size_t)seq * S * ABINP;
                    att::na_body<ABINP, ABINP, ABMIX>(base + (size_t)r0 * GW * ABINP + COL_QB + hh * DH, base + (size_t)kr0 * GW * ABINP + COL_KB + hh * DH, base + (size_t)kr0 * GW * ABINP + COL_VB + hh * DH,
                        WSP(bf16, WS_MIXIN) + ((size_t)seq * S + (size_t)r0 * GW) * ABMIX + 1024 + hh * DH, nt, (char*)lds_raw, att::NaInfo{r0, kr0, tab}, HWTID);
                    __syncthreads();
                }
            }
            pp_first = na_first; pp_stride = na_stride; pp_run = !split || (int)blockIdx.x >= NSC;
        } else {
            {
                constexpr int NU = NSEQ * NH * (S / 256);
                const int vcu = (G % 8 == 0) ? ((int)blockIdx.x % 8) * (G / 8) + (int)blockIdx.x / 8 : (int)blockIdx.x;
                const float lam = WSP(float, WS_LAM)[2 * jj], li = WSP(float, WS_LAM)[2 * jj + 1];
                for (int u = vcu; u < NU; u += G) {
                    const int qb = u % (S / 256); const int r_ = u / (S / 256); const int hh = r_ % NH, seq = r_ / NH;
                    const bf16* base = WSP(bf16, WS_PROJ) + (size_t)seq * S * CIN; const size_t oo = ((size_t)seq * S + (size_t)qb * 256) * 2048 + hh * 256;
#pragma unroll 1
                    for (int jj2 = 0; jj2 < 2; ++jj2) {
                        att::dattn256_body<CIN, CIN, 2048>(base + (size_t)qb * 256 * CIN + hh * 256 + jj2 * DH, base + 2048 + hh * 256 + jj2 * DH, base + 4096 + hh * 256,
                            WSP(bf16, WS_O0) + oo, S / 64, (char*)lds_raw, HWTID, jj2, WSP(bf16, WS_MIXIN) + oo, lam, 1.0f - li, PRM(PR_SUBLN) + jj * 256);
                        __syncthreads();
                    }
                }
            }
        }
        if (pp_run) {
            pg8::Gemm g{WSP(bf16, WS_PB + (size_t)layer * SZ_PB), WSP(bf16, WS_WPP + (size_t)layer * D * PLE * 2), T, D, PLE}; pg8::StaticOrder S_; S_.init(T, D, pp_stride, pp_first);
            pg8::EpiBf16 E{WSP(bf16, WS_PP2), D};
            pg8::gemm_phase<pg8::EpiBf16, pg8::StaticOrder, true, true>(lds, g, S_, E, HWTID);
        }
        xcd_barrier(bar, HWTID);
        if ((layer & 1) == 0) { dn_out_phase(p, jj, gw, ngw, lane); xcd_barrier(bar, HWTID); }
        {
            const bf16* Bt = (layer & 1) == 0 ? WSP(bf16, WS_WABOUT + (size_t)jj * D * ABMIX * 2) : WSP(bf16, WS_WCOUT + (size_t)jj * D * CV * 2);
            pg8::Gemm g{WSP(bf16, WS_MIXIN), Bt, T, D, 2048}; pg8::StaticOrder S_; S_.init(T, D, G, (int)blockIdx.x);
            pg8::EpiBf16 E{WSP(bf16, WS_GOUT), D};
            pg8::gemm_phase<pg8::EpiBf16, pg8::StaticOrder, true, true>(lds, g, S_, E, HWTID);
        }
        xcd_barrier(bar, HWTID);
        row_phase<1>(p, nw + D, nw + 2 * D, gw, ngw, lane);
        xcd_barrier(bar, HWTID);
        {
            pg8::Gemm g{WSP(bf16, WS_HN), WSP(bf16, WS_WFIN + (size_t)layer * 2 * DFF * D * 2), T, 2 * DFF, D}; pg8::StaticOrder S_; S_.init(T, 2 * DFF, G, (int)blockIdx.x);
            pg8::EpiConvAct E{WSP(bf16, WS_ACT), WSP(float, WS_HALO), WSP(float, WS_HALO) + (size_t)(T / 256) * 4 * 2 * DFF + 4096 * (int)blockIdx.x, PRM(PR_FCW) + (size_t)layer * 3 * 2 * DFF, PRM(PR_FCB) + (size_t)layer * 2 * DFF, (PG8_LAS float*)(lds + RING_BYTES)};
            pg8::gemm_phase<pg8::EpiConvAct, pg8::StaticOrder, true, true>(lds, g, S_, E, HWTID);
        }
        xcd_barrier(bar, HWTID);
        ffn_fix_phase(p, layer, HWTID);
        xcd_barrier(bar, HWTID);
        {
            pg8::Gemm g{WSP(bf16, WS_ACT), WSP(bf16, WS_WFOUT + (size_t)layer * D * DFF * 2), T, D, DFF}; pg8::StaticOrder S_; S_.init(T, D, G, (int)blockIdx.x);
            pg8::EpiBf16 E{WSP(bf16, WS_GOUT), D};
            pg8::gemm_phase<pg8::EpiBf16, pg8::StaticOrder, true, true>(lds, g, S_, E, HWTID);
        }
        xcd_barrier(bar, HWTID);
        row_phase<2>(p, nw + 3 * D, nullptr, gw, ngw, lane);
        xcd_barrier(bar, HWTID);
        {
            pg8::Gemm g{WSP(bf16, WS_H16), WSP(bf16, WS_WPG + (size_t)layer * D * D * 2), T, D, D}; pg8::StaticOrder S_; S_.init(T, D, G, (int)blockIdx.x);
            pg8::EpiBf16 E{WSP(bf16, WS_GOUT), D};
            pg8::gemm_phase<pg8::EpiBf16, pg8::StaticOrder, true, true>(lds, g, S_, E, HWTID);
        }
        xcd_barrier(bar, HWTID);
        row_phase<3>(p, nullptr, layer + 1 < DEPTH ? PRM(PR_NORMS) + (size_t)(layer + 1) * 4 * D : nullptr, gw, ngw, lane);
        if (layer + 1 < DEPTH) xcd_barrier(bar, HWTID);
    }
}

#undef lane
#undef HWTID
#undef HWLANE
extern "C" void kernel_launch(void* const* d_in, const int* in_sizes, int n_in, void* d_out, int out_size, void* d_ws, size_t ws_size, hipStream_t stream) {
    static int grid = 0;
    if (grid == 0) {
        if (n_in != 22 || out_size != T * D || ws_size < WS_END) { fprintf(stderr, "kernel_launch: unexpected shapes n_in %d out %d ws %zu (need %zu)\n", n_in, out_size, ws_size, (size_t)WS_END); grid = -1; return; }
        int dev = 0, cus = 0, per_cu = 0;
        if (hipGetDevice(&dev) != hipSuccess || hipDeviceGetAttribute(&cus, hipDeviceAttributeMultiprocessorCount, dev) != hipSuccess) { grid = -1; return; }
        if (hipFuncSetAttribute((const void*)mega_fwd, hipFuncAttributeMaxDynamicSharedMemorySize, LDS_BYTES) != hipSuccess) { fprintf(stderr, "kernel_launch: hipFuncSetAttribute failed\n"); grid = -1; return; }
        if (hipOccupancyMaxActiveBlocksPerMultiprocessor(&per_cu, (const void*)mega_fwd, NTHR, LDS_BYTES) != hipSuccess || per_cu < 1) fprintf(stderr, "kernel_launch: occupancy query reports %d blocks per CU\n", per_cu);
        (void)hipGetLastError();
        grid = cus;
    }
    if (grid < 0) return;
    if (hipMemsetAsync((char*)d_ws + WS_CTL, 0, CTL_ZERO_BYTES, stream) != hipSuccess) { fprintf(stderr, "kernel_launch: memset failed\n"); return; }
    Args a; memset(&a, 0, sizeof(a));
    const float** f = (const float**)&a.p;
    for (int i = 0; i < 22; ++i) f[i] = (const float*)d_in[i];
    a.p.h = (float*)d_out; a.p.ws = (unsigned char*)d_ws;
    hipLaunchKernelGGL(mega_fwd, dim3(grid), dim3(NTHR), LDS_BYTES, stream, a);
    const hipError_t le = hipPeekAtLastError();
    if (le != hipSuccess) fprintf(stderr, "kernel_launch: launch failed: %s\n", hipGetErrorName(le));
}
#else
int main(int argc, char** argv) {
    FILE* fs = fopen("sizes.txt", "r"); std::vector<long> sizes(22); for (int i = 0; i < 22; ++i) if (fscanf(fs, "%ld", &sizes[i]) != 1) return 1; fclose(fs);
    FILE* fi = fopen("inputs.bin", "rb"); std::vector<std::vector<float>> in(22);
    for (int i = 0; i < 22; ++i) { in[i].resize(sizes[i]); if (fread(in[i].data(), 4, sizes[i], fi) != (size_t)sizes[i]) return 2; } fclose(fi);
    std::vector<float> out((size_t)T * D); std::vector<unsigned char> ws(WS_END, 0xAA);
    printf("T %d D %d WS_END %zu MiB\n", T, D, (size_t)(WS_END / MiB));
    P p; memset(&p, 0, sizeof(p)); const float** f = (const float**)&p; for (int i = 0; i < 22; ++i) f[i] = in[i].data();
    p.h = out.data(); p.ws = ws.data();
    forward(p);
    FILE* fo = fopen("emu_out.bin", "wb"); fwrite(out.data(), 4, out.size(), fo); fclose(fo);
    return 0;
}
#endif
```

```cpp
#ifndef EMU
#include <hip/hip_runtime.h>
#include <cstdio>
#include <cstdint>
#include <cstring>
#define DEVFN __device__ __forceinline__
#define MEMFENCE() asm volatile("" ::: "memory")
#else
#include <cstdio>
#include <cstdint>
#include <cstdlib>
#include <cstring>
#include <cmath>
#include <vector>
#define DEVFN static inline
#define MEMFENCE() do {} while (0)
#endif
#include <cmath>

#ifndef EMU
constexpr int D = 2048, NSEQ = 6, NPROMPT = 2, S = 4096, PLE = 256, DFF = 8192;
#else
constexpr int D = 256, NSEQ = 2, NPROMPT = 1, S = 1024, PLE = 64, DFF = 512;
#endif
constexpr int T = NSEQ * S, DEPTH = 4, NH = 8, DH = 128;
constexpr int AQKV = 3072, ABIN = 7200, ABINP = 7424, ABMIX = 2048, CIN = 6144, CV = 2048;
constexpr int COL_Z = 3072, COL_G = 4096, COL_QB = 4128, COL_KB = 4128 + 1024, COL_VB = 4128 + 2048;
constexpr int GW = 64, ROWS = S / GW, NAR = 8, NAC = 16, WR = (NAR < ROWS ? NAR : ROWS);
constexpr float RMS_EPS = 1e-6f;

typedef unsigned short bf16;
DEVFN float bf2f(bf16 b) { unsigned u = ((unsigned)b) << 16; float f; memcpy(&f, &u, 4); return f; }
DEVFN bf16 f2bf(float f) { unsigned u; memcpy(&u, &f, 4); u += 0x7fffu + ((u >> 16) & 1u); return (bf16)(u >> 16); }
DEVFN float siluf(float x) { return x / (1.f + expf(-x)); }
DEVFN float sigmoidf(float x) { return 1.f / (1.f + expf(-x)); }
DEVFN float softplusf(float x) { if (x > 20.f) return x; const float y = expf(x); return y < 0.01f ? y * (1.f - y * (0.5f - y * 0.33333333f)) : logf(1.f + y); }
DEVFN int clampi(int v, int lo, int hi) { return v < lo ? lo : (v > hi ? hi : v); }

constexpr size_t MiB = 1u << 20;
constexpr size_t SZ_TD2 = (size_t)T * D * 2, SZ_TD4 = (size_t)T * D * 4;
constexpr size_t al(size_t x) { return (x + MiB - 1) / MiB * MiB; }
constexpr size_t WS_CTL = 0;
constexpr size_t WS_PRM = 1 * MiB;
constexpr int PR_ABCONV = 0, PR_ALOG = PR_ABCONV + 2 * 5 * AQKV, PR_DTB = PR_ALOG + 32, PR_ONORM = PR_DTB + 32, PR_RPB = PR_ONORM + 2 * DH, PR_LAMBDA = PR_RPB + 2 * NH * 15 * 31,
    PR_SUBLN = PR_LAMBDA + 2 * 4 * DH, PR_NORMS = PR_SUBLN + 2 * 256, PR_FCW = PR_NORMS + DEPTH * 4 * D, PR_FCB = PR_FCW + DEPTH * 3 * 2 * DFF, PR_END = PR_FCB + DEPTH * 2 * DFF;
static_assert((size_t)PR_END * 4 <= 2 * MiB, "param region");
constexpr size_t WS_WABIN = 3 * MiB;
constexpr size_t WS_WABOUT = WS_WABIN + al((size_t)2 * ABINP * D * 2);
constexpr size_t WS_WCIN = WS_WABOUT + al((size_t)2 * D * ABMIX * 2);
constexpr size_t WS_WCOUT = WS_WCIN + al((size_t)2 * CIN * D * 2);
constexpr size_t WS_WFIN = WS_WCOUT + al((size_t)2 * D * CV * 2);
constexpr size_t WS_WFOUT = WS_WFIN + al((size_t)4 * 2 * DFF * D * 2);
constexpr size_t WS_WPP = WS_WFOUT + al((size_t)4 * D * DFF * 2);
constexpr size_t WS_WPG = WS_WPP + al((size_t)4 * D * PLE * 2);
constexpr size_t WS_HN = WS_WPG + al((size_t)4 * D * D * 2);
#ifdef EMU
constexpr size_t WS_MIXIN = WS_HN + al(SZ_TD2);
#else
constexpr size_t WS_MIXIN = WS_HN;
constexpr size_t WS_H16 = WS_HN + al(SZ_TD2);
#endif
constexpr size_t WS_PB = WS_HN + 2 * al(SZ_TD2);
constexpr size_t SZ_PB = al((size_t)T * PLE * 2);
constexpr size_t WS_SMALL = WS_PB + DEPTH * SZ_PB;
constexpr size_t WS_RSTD = WS_SMALL, WS_G = WS_SMALL + al((size_t)T * 4), WS_BETA = WS_G + al((size_t)T * 16 * 4), WS_LAM = WS_BETA + al((size_t)T * 16 * 4);
constexpr size_t WS_R = WS_LAM + MiB;
constexpr size_t WS_GOUT = WS_R;
constexpr size_t WS_GOUT2 = WS_GOUT + al(SZ_TD4);
constexpr size_t WS_HID = WS_R;
#ifdef EMU
constexpr size_t WS_ACT = WS_HID + al((size_t)T * 2 * DFF * 2);
#else
constexpr size_t WS_ACT = WS_GOUT + al(SZ_TD4);
constexpr size_t WS_PP2 = (size_t)1952 * MiB;
#endif
constexpr size_t WS_HALO = WS_ACT + al((size_t)T * DFF * 2);
constexpr size_t WS_PROJ = WS_GOUT + al(SZ_TD4);
constexpr size_t WS_X1 = WS_PROJ + al((size_t)T * ABINP * 2);
constexpr size_t SZ_HD4 = al((size_t)T * NH * DH * 4);
#ifdef EMU
constexpr size_t WS_QN = WS_X1, WS_KN = WS_QN + SZ_HD4, WS_VV = WS_KN + SZ_HD4, WS_OF = WS_VV + SZ_HD4, WS_OB = WS_OF + SZ_HD4, WS_NASC = WS_OB + SZ_HD4;
constexpr size_t WS_END_AB = WS_NASC + SZ_HD4;
#else
constexpr size_t WS_OF = WS_GOUT, WS_OB = WS_OF + SZ_HD4;
constexpr size_t WS_QN = WS_X1, WS_KN = WS_X1, WS_VV = WS_X1, WS_NASC = WS_X1;
constexpr int NUD_ = NSEQ * NH * (S / 64) * 2;
constexpr size_t WS_DN_UT = WS_X1, WS_DN_WN = WS_DN_UT + al((size_t)NUD_ * 128 * 64 * 4), WS_DN_QE = WS_DN_WN + al((size_t)NUD_ * 16 * 512 * 2), WS_DN_IN = WS_DN_QE + al((size_t)NUD_ * 16 * 512 * 2),
    WS_DN_KD = WS_DN_IN + al((size_t)NUD_ * 8 * 512 * 2), WS_DN_EG = WS_DN_KD + al((size_t)NUD_ * 16 * 512 * 2);
constexpr size_t WS_END_AB = WS_DN_EG + MiB;
#endif
constexpr size_t WS_O0 = WS_X1, WS_O1 = WS_O0 + al((size_t)T * 2048 * 4);
constexpr size_t WS_END_C = WS_O1 + al((size_t)T * 2048 * 4);
constexpr size_t WS_END_F = WS_HALO + 32 * MiB;
constexpr size_t WS_END = (WS_END_AB > WS_END_C ? (WS_END_AB > WS_END_F ? WS_END_AB : WS_END_F) : (WS_END_C > WS_END_F ? WS_END_C : WS_END_F));
#ifndef EMU
static_assert(WS_END <= WS_PP2 && WS_PP2 + SZ_TD2 <= (size_t)2048 * MiB, "workspace map exceeds 2 GiB");
#endif

struct P {
    const float *x_prompt, *x_sample, *p_prompt, *p_sample, *ab_w_in, *ab_conv_w, *ab_a_log, *ab_dt_bias, *ab_out_norm, *ab_rpb, *ab_w_out,
        *c_w_in, *c_lambda, *c_subln, *c_w_out, *norms, *ffn_w_in, *ffn_conv_w, *ffn_conv_b, *ffn_w_out, *ple_w_proj, *ple_w_gate;
    float* h;
    unsigned char* ws;
};
#define WSP(type, off) ((type*)(p.ws + (off)))
#define PRM(off) (WSP(const float, WS_PRM) + (off))
constexpr long N_PRM = PR_END;
DEVFN void st_prm(const P& p, int, long g) {
    const int i = (int)g; float v;
    if (i < PR_ALOG) v = p.ab_conv_w[i - PR_ABCONV]; else if (i < PR_DTB) v = p.ab_a_log[i - PR_ALOG]; else if (i < PR_ONORM) v = p.ab_dt_bias[i - PR_DTB];
    else if (i < PR_RPB) v = p.ab_out_norm[i - PR_ONORM]; else if (i < PR_LAMBDA) v = p.ab_rpb[i - PR_RPB]; else if (i < PR_SUBLN) v = p.c_lambda[i - PR_LAMBDA];
    else if (i < PR_NORMS) v = p.c_subln[i - PR_SUBLN]; else if (i < PR_FCW) v = p.norms[i - PR_NORMS]; else if (i < PR_FCB) v = p.ffn_conv_w[i - PR_FCW]; else v = p.ffn_conv_b[i - PR_FCB];
    WSP(float, WS_PRM)[i] = v;
}
constexpr long N_INIT = (long)T * D / 4;
DEVFN void st_init(const P& p, int, long g) {
    const long i = g * 4, np = (long)NPROMPT * S * D;
    const float* src = i < np ? p.x_prompt + i : p.x_sample + (i - np);
    for (int k = 0; k < 4; ++k) p.h[i + k] = src[k];
}
constexpr long N_PB = (long)T * PLE;
DEVFN void st_pb(const P& p, int layer, long g) {
    const long np = (long)NPROMPT * S * PLE, ns = (long)(NSEQ - NPROMPT) * S * PLE;
    const float v = g < np ? p.p_prompt[(long)layer * np + g] : p.p_sample[(long)layer * ns + (g - np)];
    WSP(bf16, WS_PB + (size_t)layer * SZ_PB)[g] = f2bf(v);
}
struct WT { const float* W; bf16* O; int K, N, Npad; };
DEVFN void st_wt(const WT& w, long g) {
    const int n = (int)(g / w.K), k = (int)(g % w.K);
    w.O[g] = n < w.N ? f2bf(w.W[(size_t)k * w.N + n]) : (bf16)0;
}
constexpr long N_ROWS = T;
DEVFN void st_rowss(const P& p, const float* x, long g) {
    const float* r = x + (size_t)g * D; float s = 0.f;
    for (int c = 0; c < D; ++c) s += r[c] * r[c];
    WSP(float, WS_RSTD)[g] = 1.0f / sqrtf(s / (float)D + RMS_EPS);
}
constexpr long N_TD = (long)T * D;
DEVFN void st_norm_bf16(const P& p, const float* w, long g) {
    const long t = g / D; const int c = (int)(g % D);
    WSP(bf16, WS_HN)[g] = f2bf(p.h[g] * WSP(float, WS_RSTD)[t] * w[c]);
}
DEVFN void st_resid(const P& p, const float* y, const float* w, int write_hb, long g) {
    const long t = g / D; const int c = (int)(g % D);
    const float v = p.h[g] + y[g] * WSP(float, WS_RSTD)[t] * w[c];
    p.h[g] = v; if (write_hb) WSP(bf16, WS_HN)[g] = f2bf(v);
}
constexpr long N_TH = (long)T * NH;
DEVFN void st_dn_prep(const P& p, int layer, long g) {
    const int j = layer / 2; const long t = g / NH; const int hh = (int)(g % NH); const int tt = (int)(t % S); const long t0 = t - tt;
    const bf16* proj = WSP(bf16, WS_PROJ); const float* cw = PRM(PR_ABCONV) + (size_t)j * 5 * AQKV;
    for (int part = 0; part < 3; ++part) {
        float* o = (part == 0 ? WSP(float, WS_QN) : (part == 1 ? WSP(float, WS_KN) : WSP(float, WS_VV))) + (size_t)g * DH; float ss = 0.f;
        for (int d = 0; d < DH; ++d) {
            const int col = part * 1024 + hh * DH + d; float acc = 0.f;
            for (int i = 0; i < 5; ++i) { const int ts = tt + i - 2; if (ts >= 0 && ts < S) acc += bf2f(proj[(size_t)(t0 + ts) * ABINP + col]) * cw[i * AQKV + col]; }
            const float y = siluf(acc); ss += y * y; o[d] = y;
        }
        if (part < 2) { const float r = (1.0f / sqrtf(ss + 1e-6f)) * (part == 0 ? 0.08838834764831845f : 1.f); for (int d = 0; d < DH; ++d) o[d] *= r; }
    }
    for (int dir = 0; dir < 2; ++dir) {
        const float graw = bf2f(proj[(size_t)t * ABINP + COL_G + dir * NH + hh]), braw = bf2f(proj[(size_t)t * ABINP + COL_G + 16 + dir * NH + hh]);
        const float a = expf(PRM(PR_ALOG)[(j * 2 + dir) * NH + hh]), dtb = PRM(PR_DTB)[(j * 2 + dir) * NH + hh];
        WSP(float, WS_G)[(t * 2 + dir) * NH + hh] = -a * softplusf(graw + dtb);
        WSP(float, WS_BETA)[(t * 2 + dir) * NH + hh] = sigmoidf(braw);
    }
}
constexpr long N_SCAN = (long)NSEQ * NH * 2 * DH;
DEVFN void st_dn_scan(const P& p, int, long g) {
    const int vc = (int)(g % DH); const int dir = (int)((g / DH) % 2); const int hh = (int)((g / (2 * DH)) % NH); const int seq = (int)(g / (2 * DH * NH));
    const float *QN = WSP(float, WS_QN), *KN = WSP(float, WS_KN), *VV = WSP(float, WS_VV), *G = WSP(float, WS_G), *BT = WSP(float, WS_BETA);
    float* O = WSP(float, dir ? WS_OB : WS_OF);
    float Sx[DH];
#pragma unroll
    for (int d = 0; d < DH; ++d) Sx[d] = 0.f;
    for (int step = 0; step < S; ++step) {
        const int tt = dir ? S - 1 - step : step; const long t = (long)seq * S + tt;
        const float eg = expf(G[(t * 2 + dir) * NH + hh]), b = BT[(t * 2 + dir) * NH + hh];
        const float* kp = KN + ((size_t)t * NH + hh) * DH; const float* qp = QN + ((size_t)t * NH + hh) * DH; const float vv = VV[((size_t)t * NH + hh) * DH + vc];
        float dot = 0.f;
#pragma unroll
        for (int d0 = 0; d0 < DH; d0 += 16) { MEMFENCE();
#pragma unroll
            for (int d = d0; d < d0 + 16; ++d) { Sx[d] *= eg; dot += Sx[d] * kp[d]; } }
        const float delta = b * (vv - dot); float o = 0.f;
#pragma unroll
        for (int d0 = 0; d0 < DH; d0 += 16) { MEMFENCE();
#pragma unroll
            for (int d = d0; d < d0 + 16; ++d) { Sx[d] += kp[d] * delta; o += Sx[d] * qp[d]; } }
        MEMFENCE();
        O[((size_t)t * NH + hh) * DH + vc] = o;
    }
}
DEVFN void st_dn_out(const P& p, int layer, long g) {
    const int j = layer / 2; const long t = g / NH; const int hh = (int)(g % NH);
    const float *OF = WSP(float, WS_OF) + (size_t)g * DH, *OB = WSP(float, WS_OB) + (size_t)g * DH; const float* on = PRM(PR_ONORM) + j * DH;
    float ss = 0.f; for (int d = 0; d < DH; ++d) { const float o = OF[d] + OB[d]; ss += o * o; }
    const float r = 1.0f / sqrtf(ss / (float)DH + RMS_EPS);
    const bf16* z = WSP(bf16, WS_PROJ) + (size_t)t * ABINP + COL_Z + hh * DH; bf16* out = WSP(bf16, WS_MIXIN) + (size_t)t * ABMIX + hh * DH;
    for (int d = 0; d < DH; ++d) out[d] = f2bf((OF[d] + OB[d]) * r * on[d] * siluf(bf2f(z[d])));
}
constexpr long N_THD = (long)T * NH * DH;
DEVFN long na_key_token(long t, int jw, int& dr, int& dc) {
    const int tt = (int)(t % S); const long t0 = t - tt; const int r = tt / GW, c = tt % GW;
    const int rs = clampi(r - WR / 2, 0, ROWS - WR), cs = clampi(c - NAC / 2, 0, GW - NAC);
    const int rk = rs + jw / NAC, ck = cs + jw % NAC;
    dr = rk - r + NAR - 1; dc = clampi(ck - c + NAC - 1, 0, 2 * NAC - 2);
    return t0 + (long)rk * GW + ck;
}
DEVFN void st_na_scores(const P& p, int layer, long g) {
    const int j = layer / 2; const int jw = (int)(g % DH); const int hh = (int)((g / DH) % NH); const long t = g / (DH * NH);
    int dr, dc; const long tk = na_key_token(t, jw, dr, dc);
    const bf16* q = WSP(bf16, WS_PROJ) + (size_t)t * ABINP + COL_QB + hh * DH; const bf16* k = WSP(bf16, WS_PROJ) + (size_t)tk * ABINP + COL_KB + hh * DH;
    float dot = 0.f; for (int d = 0; d < DH; ++d) dot += bf2f(q[d]) * bf2f(k[d]);
    WSP(float, WS_NASC)[g] = dot * 0.08838834764831845f + PRM(PR_RPB)[(((size_t)j * NH + hh) * (2 * NAR - 1) + dr) * (2 * NAC - 1) + dc];
}
DEVFN void st_na_out(const P& p, int, long g) {
    const int d = (int)(g % DH); const int hh = (int)((g / DH) % NH); const long t = g / (DH * NH);
    const float* sc = WSP(float, WS_NASC) + ((size_t)t * NH + hh) * DH;
    float m = sc[0]; for (int jw = 1; jw < WR * NAC; ++jw) m = fmaxf(m, sc[jw]);
    float l = 0.f, o = 0.f;
    for (int jw = 0; jw < WR * NAC; ++jw) { int dr, dc; const long tk = na_key_token(t, jw, dr, dc); const float e = expf(sc[jw] - m); l += e;
        o += e * bf2f(WSP(bf16, WS_PROJ)[(size_t)tk * ABINP + COL_VB + hh * DH + d]); }
    WSP(bf16, WS_MIXIN)[(size_t)t * ABMIX + 1024 + hh * DH + d] = f2bf(o / l);
}
DEVFN float lambda_init_of(int layer) { return 0.8f - 0.6f * expf(-0.3f * (float)layer); }
DEVFN void st_lam(const P& p, int layer, long) {
    const float* lp = PRM(PR_LAMBDA) + (size_t)(layer / 2) * 4 * DH; float a = 0.f, b = 0.f;
    for (int d = 0; d < DH; ++d) { a += lp[d] * lp[DH + d]; b += lp[2 * DH + d] * lp[3 * DH + d]; }
    const float li = lambda_init_of(layer); WSP(float, WS_LAM)[0] = expf(a) - expf(b) + li; WSP(float, WS_LAM)[1] = li;
}
constexpr long N_ROPE = (long)T * 2 * 16 * 16;
DEVFN void st_rope(const P& p, int, long g) {
    const int i = (int)(g % 16); const int hj = (int)((g / 16) % 16); const int which = (int)((g / 256) % 2); const long t = g / 512;
    bf16* x = WSP(bf16, WS_PROJ) + (size_t)t * CIN + which * 2048 + hj * DH;
    const float inv = powf(500000.0f, -(float)(2 * i) / 32.0f); const float ang = (float)(t % S) * inv; const float cs = cosf(ang), sn = sinf(ang);
    const float x1 = bf2f(x[i]), x2 = bf2f(x[16 + i]);
    x[i] = f2bf(x1 * cs - x2 * sn); x[16 + i] = f2bf(x2 * cs + x1 * sn);
}
constexpr int DA_E = 64;
constexpr long N_DATT = (long)NSEQ * NH * 2 * (256 / DA_E) * S;
DEVFN void st_dattn(const P& p, int, long g) {
    const int qi = (int)(g % S); long r = g / S; const int es = (int)(r % (256 / DA_E)); r /= (256 / DA_E); const int jj = (int)(r % 2); r /= 2; const int hh = (int)(r % NH); const int seq = (int)(r / NH);
    const bf16* proj = WSP(bf16, WS_PROJ); const long t = (long)seq * S + qi;
    float q[DH];
#pragma unroll
    for (int d = 0; d < DH; ++d) q[d] = bf2f(proj[(size_t)t * CIN + hh * 256 + jj * DH + d]) * 0.08838834764831845f;
    float o[DA_E];
#pragma unroll
    for (int e = 0; e < DA_E; ++e) o[e] = 0.f;
    float m = -1e30f, l = 0.f;
    for (int kk = 0; kk < S; ++kk) {
        const bf16* kr = proj + (size_t)((long)seq * S + kk) * CIN + 2048 + hh * 256 + jj * DH; const bf16* vr = proj + (size_t)((long)seq * S + kk) * CIN + 4096 + hh * 256 + es * DA_E;
        float s = 0.f;
#pragma unroll
        for (int d0 = 0; d0 < DH; d0 += 32) { MEMFENCE();
#pragma unroll
            for (int d = d0; d < d0 + 32; ++d) s += q[d] * bf2f(kr[d]); }
        MEMFENCE();
        const float mn = fmaxf(m, s), al = expf(m - mn), pe = expf(s - mn); m = mn; l = l * al + pe;
#pragma unroll
        for (int e = 0; e < DA_E; ++e) o[e] = o[e] * al + pe * bf2f(vr[e]);
    }
    float* O = WSP(float, jj ? WS_O1 : WS_O0) + (size_t)t * 2048 + hh * 256 + es * DA_E; const float il = 1.0f / l;
#pragma unroll
    for (int e = 0; e < DA_E; ++e) O[e] = o[e] * il;
}
DEVFN void st_c_out(const P& p, int layer, long g) {
    const int j = layer / 2; const long t = g / NH; const int hh = (int)(g % NH); const float lam = WSP(float, WS_LAM)[0], li = WSP(float, WS_LAM)[1];
    const float *O0 = WSP(float, WS_O0) + (size_t)t * 2048 + hh * 256, *O1 = WSP(float, WS_O1) + (size_t)t * 2048 + hh * 256; const float* sw = PRM(PR_SUBLN) + j * 256;
    float ss = 0.f; for (int e = 0; e < 256; ++e) { const float o = O0[e] - lam * O1[e]; ss += o * o; }
    const float r = (1.0f / sqrtf(ss / 256.0f + RMS_EPS)) * (1.0f - li);
    bf16* out = WSP(bf16, WS_MIXIN) + (size_t)t * 2048 + hh * 256;
    for (int e = 0; e < 256; ++e) out[e] = f2bf((O0[e] - lam * O1[e]) * r * sw[e]);
}
constexpr long N_ACT = (long)T * DFF;
DEVFN float gelu_tanh(float x) { return 0.5f * x * (1.0f + tanhf(0.7978845608028654f * (x + 0.044715f * x * x * x))); }
DEVFN void st_ffn_act(const P& p, int layer, long g) {
    const long t = g / DFF; const int c = (int)(g % DFF); const int tt = (int)(t % S);
    const bf16* hid = WSP(bf16, WS_HID); const float* cw = PRM(PR_FCW) + (size_t)layer * 3 * 2 * DFF; const float* cb = PRM(PR_FCB) + (size_t)layer * 2 * DFF;
    float ga = cb[c], up = cb[DFF + c];
    for (int i = 0; i < 3; ++i) { const int ts = tt + i - 1; if (ts >= 0 && ts < S) { const bf16* r = hid + (size_t)(t - tt + ts) * (2 * DFF);
        ga += bf2f(r[c]) * cw[i * 2 * DFF + c]; up += bf2f(r[DFF + c]) * cw[i * 2 * DFF + DFF + c]; } }
    WSP(bf16, WS_ACT)[g] = f2bf(gelu_tanh(ga) * up);
}
DEVFN void st_ple(const P& p, int, long g) { p.h[g] += sigmoidf(WSP(float, WS_GOUT)[g]) * WSP(float, WS_GOUT2)[g]; }
#ifndef EMU
namespace pg8 {
#define PG8_LAS __attribute__((address_space(3)))
typedef unsigned short bf16_t;
typedef short bf16x8 __attribute__((ext_vector_type(8)));
typedef float f32x4 __attribute__((ext_vector_type(4)));
typedef unsigned u32x4 __attribute__((ext_vector_type(4)));
constexpr int BM = 256, BK = 64, HALF = 128, HTB = HALF * BK * 2  , STAGE_BYTES = 8 * HTB, NXCD = 8, WGM = 4;

__host__ __device__ __forceinline__ int lds_byte(int r, int c) { const int st = (r >> 4) * 2 + (c >> 5), rr = r & 15, cc = c & 31, ob = rr * 64 + cc * 2; return st * 1024 + (ob ^ (((ob >> 9) & 1) << 5)); }
__host__ __device__ __forceinline__ void stage_rc(int b, int& R, int& C) { const int st = b / 1024, sb = b % 1024, swz = sb ^ (((sb >> 9) & 1) << 5); R = (st >> 1) * 16 + swz / 64; C = (st & 1) * 32 + (swz % 64) / 2; }
__host__ __device__ __forceinline__ int perm32(int rho) { const int n = rho >> 4, i = rho & 15; return 8 * (i >> 2) + 4 * n + (i & 3); }

struct Unit { int pm, pn; };
struct Gemm { const bf16_t* A; const bf16_t* Bt; int M, N, K; };

struct StaticOrder {
    int nM, nN, nwg, G, c;
    __host__ __device__ void init(int M, int N, int G_, int c_) { nM = M / BM; nN = N / BM; nwg = nM * nN; G = G_; c = c_; }
    __host__ __device__ bool next(int i, Unit& u) const {
        const long L = (long)i * G + c; if (L >= nwg) return false;
        int wgid = (int)L; { const int q = nwg / NXCD, r = nwg % NXCD, xcd = wgid % NXCD, off = wgid / NXCD; wgid = (xcd < r ? xcd * (q + 1) : r * (q + 1) + (xcd - r) * q) + off; }
        const int nig = WGM * nN, gid = wgid / nig, fm = gid * WGM, gsz = (nM - fm) < WGM ? (nM - fm) : WGM;
        u.pm = fm + ((wgid % nig) % gsz); u.pn = (wgid % nig) / gsz; return true;
    }
    __device__ __forceinline__ void a_ready(const Unit&) const {}
    __device__ __forceinline__ void done(const Unit&) const {}
};

__device__ __forceinline__ unsigned cvt_pk_bf16(float lo, float hi) { unsigned r; asm volatile("v_cvt_pk_bf16_f32 %0, %1, %2" : "=v"(r) : "v"(lo), "v"(hi)); return r; }
struct EpiBf16 {
    static constexpr bool PERM = true, AFTER_DRAIN = false;
    bf16_t* O; int ldc;
    __device__ __forceinline__ void operator()(const f32x4 (&acc)[2][2][4][2], const Unit& u, int wr, int wc, int fr, int fq) const {
        const int row0 = u.pm * BM + wr * 64 + fr; const int col0 = u.pn * BM + wc * 32 + 8 * fq;
#pragma unroll
        for (int ai = 0; ai < 2; ++ai)
#pragma unroll
            for (int m = 0; m < 4; ++m) { bf16_t* rowp = O + (size_t)(row0 + ai * HALF + m * 16) * ldc + col0;
#pragma unroll
                for (int bj = 0; bj < 2; ++bj) { const f32x4 v0 = acc[ai][bj][m][0], v1 = acc[ai][bj][m][1];
                    u32x4 w; w.x = cvt_pk_bf16(v0[0], v0[1]); w.y = cvt_pk_bf16(v0[2], v0[3]); w.z = cvt_pk_bf16(v1[0], v1[1]); w.w = cvt_pk_bf16(v1[2], v1[3]);
                    *(u32x4*)(rowp + bj * HALF) = w; } }
    }
};
struct EpiBf16Ro {
    static constexpr bool PERM = true, AFTER_DRAIN = false;
    bf16_t* O; int ldc; const float* tab; int seqlen;
    __device__ __forceinline__ void operator()(const f32x4 (&acc)[2][2][4][2], const Unit& u, int wr, int wc, int fr, int fq) const {
        const int row0 = u.pm * BM + wr * 64 + fr; const int col0 = u.pn * BM + wc * 32 + 8 * fq;
        const bool rope = tab != nullptr && u.pn < 16 && wc == 0;
#pragma unroll
        for (int ai = 0; ai < 2; ++ai)
#pragma unroll
            for (int m = 0; m < 4; ++m) { const int row = row0 + ai * HALF + m * 16; bf16_t* rowp = O + (size_t)row * ldc + col0;
#pragma unroll
                for (int bj = 0; bj < 2; ++bj) { f32x4 v0 = acc[ai][bj][m][0], v1 = acc[ai][bj][m][1];
                    if (rope) { const float* cs = tab + ((size_t)(row % seqlen) * 16 + 8 * (fq & 1)) * 2; const float sgn = fq < 2 ? -1.f : 1.f;
                        const f32x4 c0 = *(const f32x4*)cs, c1 = *(const f32x4*)(cs + 4), c2 = *(const f32x4*)(cs + 8), c3 = *(const f32x4*)(cs + 12);
#pragma unroll
                        for (int e = 0; e < 4; ++e) { const float o0 = __shfl_xor(v0[e], 32), o1 = __shfl_xor(v1[e], 32);
                            const float cs0 = (e < 2 ? c0 : c1)[2 * (e & 1)], sn0 = (e < 2 ? c0 : c1)[2 * (e & 1) + 1], cs1 = (e < 2 ? c2 : c3)[2 * (e & 1)], sn1 = (e < 2 ? c2 : c3)[2 * (e & 1) + 1];
                            v0[e] = v0[e] * cs0 + sgn * o0 * sn0; v1[e] = v1[e] * cs1 + sgn * o1 * sn1; } }
                    u32x4 w; w.x = cvt_pk_bf16(v0[0], v0[1]); w.y = cvt_pk_bf16(v0[2], v0[3]); w.z = cvt_pk_bf16(v1[0], v1[1]); w.w = cvt_pk_bf16(v1[2], v1[3]);
                    *(u32x4*)(rowp + bj * HALF) = w; } }
    }
};
__device__ __forceinline__ float dpp_prev(float oldv, float x) { return __int_as_float(__builtin_amdgcn_update_dpp(__float_as_int(oldv), __float_as_int(x), 0x111, 0xf, 0xf, false)); }
__device__ __forceinline__ float dpp_next(float oldv, float x) { return __int_as_float(__builtin_amdgcn_update_dpp(__float_as_int(oldv), __float_as_int(x), 0x101, 0xf, 0xf, false)); }
__device__ __forceinline__ float dpp_ror1(float x) { return __int_as_float(__builtin_amdgcn_update_dpp(__float_as_int(x), __float_as_int(x), 0x121, 0xf, 0xf, false)); }
__device__ __forceinline__ float dpp_rol1(float x) { return __int_as_float(__builtin_amdgcn_update_dpp(__float_as_int(x), __float_as_int(x), 0x12F, 0xf, 0xf, false)); }
__device__ __forceinline__ void fmac_ror1(float& acc, float x, float w)  { asm("s_nop 1\n\tv_fmac_f32_dpp %0, %1, %2 row_ror:1 row_mask:0xf bank_mask:0xf" : "+v"(acc) : "v"(x), "v"(w)); }
__device__ __forceinline__ void fmac_ror15(float& acc, float x, float w) { asm("s_nop 1\n\tv_fmac_f32_dpp %0, %1, %2 row_ror:15 row_mask:0xf bank_mask:0xf" : "+v"(acc) : "v"(x), "v"(w)); }
__device__ __forceinline__ float gelu_t(float x) { const float u = 0.7978845608028654f * (x + 0.044715f * x * x * x); return x * __builtin_amdgcn_rcpf(1.0f + __builtin_amdgcn_exp2f(-2.885390081777927f * u)); }
struct EpiConvAct {
    static constexpr bool PERM = true, AFTER_DRAIN = false;
    bf16_t* ACT; float* HALO; float* HDUMP; const float* cw; const float* cb; PG8_LAS float* EX;
    __device__ __forceinline__ void operator()(const f32x4 (&acc)[2][2][4][2], const Unit& u, int wr, int wc, int fr, int fq) const {
        const int ch0 = u.pn * 128 + wc * 32 + 8 * fq;
#pragma unroll
        for (int ai = 0; ai < 2; ++ai) { const int sg = 2 * ai + wr;
            PG8_LAS float* d0 = EX + ((fr == 0) ? ((((sg * 2 + 0) * 4 + wc) * 4 + fq) * 16) : (2048 + wc * 64 + fq * 16));
            PG8_LAS float* d1 = EX + ((fr == 15) ? ((((sg * 2 + 1) * 4 + wc) * 4 + fq) * 16) : (2048 + wc * 64 + fq * 16));
#pragma unroll
            for (int bj = 0; bj < 2; ++bj)
#pragma unroll
                for (int n = 0; n < 2; ++n) { *(PG8_LAS f32x4*)(d0 + (bj * 2 + n) * 4) = acc[ai][bj][0][n]; *(PG8_LAS f32x4*)(d1 + (bj * 2 + n) * 4) = acc[ai][bj][3][n]; } }
        if (wr == 0) { float* hp = (fr < 2) ? HALO + (((size_t)u.pm * 4 + fr) * 2) * DFF + ch0 : HDUMP + (size_t)(wc * 4 + fq) * 16;
            const size_t bs = (fr < 2) ? (size_t)DFF : (size_t)8;
#pragma unroll
            for (int bj = 0; bj < 2; ++bj)
#pragma unroll
                for (int n = 0; n < 2; ++n) *(f32x4*)(hp + bj * bs + 4 * n) = acc[0][bj][0][n]; }
        else { float* hp = (fr >= 14) ? HALO + (((size_t)u.pm * 4 + 2 + (fr - 14)) * 2) * DFF + ch0 : HDUMP + (size_t)(wc * 4 + fq) * 16;
            const size_t bs = (fr >= 14) ? (size_t)DFF : (size_t)8;
#pragma unroll
            for (int bj = 0; bj < 2; ++bj)
#pragma unroll
                for (int n = 0; n < 2; ++n) *(f32x4*)(hp + bj * bs + 4 * n) = acc[1][bj][3][n]; }
        asm volatile("s_waitcnt lgkmcnt(0)" ::: "memory"); __builtin_amdgcn_s_barrier(); asm volatile("" ::: "memory");
        const bool is15 = fr == 15, is0 = fr == 0;
        unsigned W[2][4][4];
#pragma unroll
        for (int n = 0; n < 2; ++n)
#pragma unroll
            for (int e2 = 0; e2 < 4; e2 += 2) {
                float wg[3][2], wu[3][2], bg[2], bu[2];
#pragma unroll
                for (int k = 0; k < 2; ++k) { const int ch = ch0 + 4 * n + e2 + k;
#pragma unroll
                    for (int t = 0; t < 3; ++t) { wg[t][k] = cw[t * 2 * DFF + ch]; wu[t][k] = cw[t * 2 * DFF + DFF + ch]; }
                    bg[k] = cb[ch]; bu[k] = cb[DFF + ch]; }
#pragma unroll
                for (int ai = 0; ai < 2; ++ai) { const int sg = 2 * ai + wr;
                    float pg[2] = {0.f, 0.f}, pu[2] = {0.f, 0.f}, ng[2] = {0.f, 0.f}, nu[2] = {0.f, 0.f};
                    if (sg > 0) { const PG8_LAS float* d = EX + ((((sg - 1) * 2 + 1) * 4 + wc) * 4 + fq) * 16 + n * 4 + e2; pg[0] = d[0]; pg[1] = d[1]; pu[0] = d[8]; pu[1] = d[9]; }
                    if (sg < 3) { const PG8_LAS float* d = EX + ((((sg + 1) * 2 + 0) * 4 + wc) * 4 + fq) * 16 + n * 4 + e2; ng[0] = d[0]; ng[1] = d[1]; nu[0] = d[8]; nu[1] = d[9]; }
#pragma unroll
                    for (int m = 0; m < 4; ++m) { float o[2];
#pragma unroll
                        for (int k = 0; k < 2; ++k) { const int e = e2 + k;
                            const float xg = acc[ai][0][m][n][e], xu = acc[ai][1][m][n][e];
                            const float bg_p = is15 ? (m > 0 ? acc[ai][0][m - 1][n][e] : pg[k]) : xg, bu_p = is15 ? (m > 0 ? acc[ai][1][m - 1][n][e] : pu[k]) : xu;
                            const float bg_n = is0 ? (m < 3 ? acc[ai][0][m + 1][n][e] : ng[k]) : xg, bu_n = is0 ? (m < 3 ? acc[ai][1][m + 1][n][e] : nu[k]) : xu;
                            float cg = __builtin_fmaf(wg[1][k], xg, bg[k]), cu = __builtin_fmaf(wu[1][k], xu, bu[k]);
                            fmac_ror1(cg, bg_p, wg[0][k]); fmac_ror15(cg, bg_n, wg[2][k]); fmac_ror1(cu, bu_p, wu[0][k]); fmac_ror15(cu, bu_n, wu[2][k]);
                            o[k] = gelu_t(cg) * cu; }
                        W[ai][m][n * 2 + (e2 >> 1)] = cvt_pk_bf16(o[0], o[1]); } }
            }
        const int row0 = u.pm * BM + wr * 64 + fr;
#pragma unroll
        for (int ai = 0; ai < 2; ++ai)
#pragma unroll
            for (int m = 0; m < 4; ++m) { u32x4 w; w.x = W[ai][m][0]; w.y = W[ai][m][1]; w.z = W[ai][m][2]; w.w = W[ai][m][3];
                *(u32x4*)(ACT + (size_t)(row0 + ai * HALF + m * 16) * DFF + ch0) = w; }
    }
};
struct EpiF32 {
    static constexpr bool PERM = false, AFTER_DRAIN = false;
    float* C; int ldc;
    __device__ __forceinline__ void operator()(const f32x4 (&acc)[2][2][4][2], const Unit& u, int wr, int wc, int fr, int fq) const {
        const int row0 = u.pm * BM + wr * 64 + fr, col0 = u.pn * BM + wc * 32 + 4 * fq;
#pragma unroll
        for (int ai = 0; ai < 2; ++ai)
#pragma unroll
            for (int m = 0; m < 4; ++m) { float* rowp = C + (size_t)(row0 + ai * HALF + m * 16) * ldc + col0;
#pragma unroll
                for (int bj = 0; bj < 2; ++bj)
#pragma unroll
                    for (int n = 0; n < 2; ++n) *(f32x4*)(rowp + bj * HALF + n * 16) = acc[ai][bj][m][n]; }
    }
};
template <class Epi, class Sched, bool ALIGN_EPI = false, bool SP2 = false>
__device__ __forceinline__ void gemm_phase(PG8_LAS unsigned char* lds, const Gemm g, const Sched& S, const Epi& E, int tid_in) {
    int tid_ = tid_in; asm volatile("" : "+v"(tid_));
    const int tid = tid_, wid = __builtin_amdgcn_readfirstlane(tid >> 6), lane = tid & 63, wr = wid >> 2, wc = wid & 3, fr = lane & 15, fq = lane >> 4;
    const int K = g.K, nt = K / BK;
    unsigned voffA[2], voffB[2];
#pragma unroll
    for (int i = 0; i < 2; ++i) { int R, C; stage_rc(tid * 16 + i * 8192, R, C); const int Rb = Epi::PERM ? ((R & ~31) + perm32(R & 31)) : R;
        voffA[i] = (unsigned)(R * K + C) * 2u; voffB[i] = (unsigned)(Rb * K + C) * 2u; }
    const size_t kstep = (size_t)(BK * 2);
    const size_t hstep = (size_t)HALF * K * 2;
    const size_t tstep = 2 * hstep;
    const unsigned ldsw = (unsigned)wid * 1024u;
    const int aoff = lds_byte(wr * 64 + fr, fq * 8), boff = lds_byte(wc * 32 + fr, fq * 8);
#define PG8_SA(b, h) (((b) * 2 + (h)) * HTB)
#define PG8_SB(b, h) ((4 + (b) * 2 + (h)) * HTB)
#define PG8_STAGE(bufoff, gbase, voff) do { _Pragma("unroll") for (int _i = 0; _i < 2; ++_i) \
        __builtin_amdgcn_global_load_lds((const unsigned*)((const char*)(gbase) + (voff)[_i]), (PG8_LAS unsigned*)(lds + (bufoff) + ldsw + _i * 8192), 16, 0, 0); } while (0)
#define PG8_LDA(dst, b, h) do { _Pragma("unroll") for (int m = 0; m < 4; ++m) _Pragma("unroll") for (int k = 0; k < 2; ++k) dst[m][k] = *(const PG8_LAS bf16x8*)(lds + PG8_SA(b, h) + aoff + m * 2048 + k * 1024); } while (0)
#define PG8_LDB(dst, b, h) do { _Pragma("unroll") for (int n = 0; n < 2; ++n) _Pragma("unroll") for (int k = 0; k < 2; ++k) dst[n][k] = *(const PG8_LAS bf16x8*)(lds + PG8_SB(b, h) + boff + n * 2048 + k * 1024); } while (0)
#define PG8_MMA(ai, bj, At, Bt) do { __builtin_amdgcn_s_setprio(1); _Pragma("unroll") for (int m = 0; m < 4; ++m) _Pragma("unroll") for (int n = 0; n < 2; ++n) _Pragma("unroll") for (int k = 0; k < 2; ++k) \
        acc[ai][bj][m][n] = __builtin_amdgcn_mfma_f32_16x16x32_bf16(Bt[n][k], At[m][k], acc[ai][bj][m][n], 0, 0, 0); __builtin_amdgcn_s_setprio(0); } while (0)
#define PG8_WAIT_V(n) asm volatile("s_waitcnt vmcnt(" #n ")" ::: "memory")
#define PG8_WAIT_L(n) asm volatile("s_waitcnt lgkmcnt(" #n ")" ::: "memory")
#define PG8_BAR __builtin_amdgcn_s_barrier()
#define PG8_SCHED __builtin_amdgcn_sched_barrier(0)
    Unit cur, nxt; int ui = 0;
    if (!S.next(0, cur)) return;
    f32x4 acc[2][2][4][2];
#pragma unroll
    for (int a = 0; a < 2; ++a)
#pragma unroll
        for (int b = 0; b < 2; ++b)
#pragma unroll
            for (int m = 0; m < 4; ++m)
#pragma unroll
                for (int n = 0; n < 2; ++n) acc[a][b][m][n] = (f32x4){0.f, 0.f, 0.f, 0.f};
    bf16x8 At[4][2], B0[2][2], B1[2][2];
    const char* cA = (const char*)g.A + (size_t)cur.pm * tstep; const char* cB = (const char*)g.Bt + (size_t)cur.pn * tstep;
    S.a_ready(cur);
    if constexpr (SP2) {
        PG8_STAGE(PG8_SB(0, 0), cB, voffB); PG8_STAGE(PG8_SB(0, 1), cB + hstep, voffB); PG8_STAGE(PG8_SA(0, 0), cA, voffA); PG8_STAGE(PG8_SA(0, 1), cA + hstep, voffA);
        if (wr == 1) PG8_BAR;
        PG8_WAIT_V(2); PG8_BAR;
        PG8_STAGE(PG8_SB(1, 0), cB + kstep, voffB); PG8_STAGE(PG8_SA(1, 0), cA + kstep, voffA); PG8_STAGE(PG8_SB(1, 1), cB + hstep + kstep, voffB);
        PG8_WAIT_V(6); PG8_BAR;
    } else {
        PG8_STAGE(PG8_SB(0, 0), cB, voffB); PG8_STAGE(PG8_SA(0, 0), cA, voffA); PG8_STAGE(PG8_SB(0, 1), cB + hstep, voffB); PG8_STAGE(PG8_SA(0, 1), cA + hstep, voffA);
        if (wr == 1) PG8_BAR;
        PG8_WAIT_V(4); PG8_BAR;
        PG8_STAGE(PG8_SB(1, 0), cB + kstep, voffB); PG8_STAGE(PG8_SA(1, 0), cA + kstep, voffA); PG8_STAGE(PG8_SB(1, 1), cB + hstep + kstep, voffB);
        PG8_WAIT_V(6); PG8_BAR;
    }
    for (;;) {
        const bool has_next = S.next(ui + 1, nxt);
        const char* nA = has_next ? (const char*)g.A + (size_t)nxt.pm * tstep : cA; const char* nB = has_next ? (const char*)g.Bt + (size_t)nxt.pn * tstep : cB;
        for (int t = 0; t < nt; t += 2) {
            const bool last = (t == nt - 2);
            const char* a1 = cA + (size_t)(t + 1) * kstep;
            const char* a2 = last ? nA : cA + (size_t)(t + 2) * kstep; const char* b2 = last ? nB : cB + (size_t)(t + 2) * kstep;
            const char* a3 = a2 + kstep; const char* b3 = b2 + kstep;
            if (last && has_next) S.a_ready(nxt);
            if constexpr (SP2) {
            PG8_LDB(B0, 0, 0); PG8_LDB(B1, 0, 1); PG8_SCHED; PG8_LDA(At, 0, 0); PG8_STAGE(PG8_SA(1, 1), a1 + hstep, voffA);
            PG8_WAIT_V(8); PG8_WAIT_L(0); PG8_BAR; PG8_MMA(0, 0, At, B0); PG8_MMA(0, 1, At, B1); PG8_BAR; PG8_SCHED;
            PG8_LDA(At, 0, 1); PG8_STAGE(PG8_SB(0, 0), b2, voffB); PG8_STAGE(PG8_SB(0, 1), b2 + hstep, voffB); PG8_STAGE(PG8_SA(0, 0), a2, voffA);
            PG8_WAIT_V(8); PG8_WAIT_L(0); PG8_BAR; PG8_MMA(1, 0, At, B0); PG8_MMA(1, 1, At, B1); PG8_BAR; PG8_SCHED;
            PG8_LDB(B0, 1, 0); PG8_LDB(B1, 1, 1); PG8_SCHED; PG8_LDA(At, 1, 0); PG8_STAGE(PG8_SA(0, 1), a2 + hstep, voffA);
            PG8_WAIT_V(8); PG8_WAIT_L(0); PG8_BAR; PG8_MMA(0, 0, At, B0); PG8_MMA(0, 1, At, B1); PG8_BAR; PG8_SCHED;
            PG8_LDA(At, 1, 1); PG8_STAGE(PG8_SB(1, 0), b3, voffB); PG8_STAGE(PG8_SB(1, 1), b3 + hstep, voffB); PG8_STAGE(PG8_SA(1, 0), a3, voffA);
            PG8_WAIT_V(8); PG8_WAIT_L(0); PG8_BAR; PG8_MMA(1, 0, At, B0); PG8_MMA(1, 1, At, B1); PG8_BAR; PG8_SCHED;
            } else {
            PG8_LDB(B0, 0, 0); PG8_SCHED; PG8_LDA(At, 0, 0); PG8_STAGE(PG8_SA(1, 1), a1 + hstep, voffA);
            PG8_WAIT_L(8); PG8_BAR; PG8_WAIT_L(0); PG8_MMA(0, 0, At, B0); PG8_BAR; PG8_SCHED;
            PG8_LDB(B1, 0, 1); PG8_STAGE(PG8_SB(0, 0), b2, voffB);
            PG8_BAR; PG8_WAIT_L(0); PG8_MMA(0, 1, At, B1); PG8_BAR;
            PG8_LDA(At, 0, 1); PG8_STAGE(PG8_SA(0, 0), a2, voffA);
            PG8_BAR; PG8_WAIT_L(0); PG8_MMA(1, 0, At, B0); PG8_BAR; PG8_SCHED;
            PG8_STAGE(PG8_SB(0, 1), b2 + hstep, voffB);
            PG8_WAIT_V(6); PG8_BAR; PG8_MMA(1, 1, At, B1); PG8_BAR;
            PG8_LDB(B0, 1, 0); PG8_SCHED; PG8_LDA(At, 1, 0); PG8_STAGE(PG8_SA(0, 1), a2 + hstep, voffA);
            PG8_WAIT_L(8); PG8_BAR; PG8_WAIT_L(0); PG8_MMA(0, 0, At, B0); PG8_BAR; PG8_SCHED;
            PG8_LDB(B1, 1, 1); PG8_STAGE(PG8_SB(1, 0), b3, voffB);
            PG8_BAR; PG8_WAIT_L(0); PG8_MMA(0, 1, At, B1); PG8_BAR;
            PG8_LDA(At, 1, 1); PG8_STAGE(PG8_SA(1, 0), a3, voffA);
            PG8_BAR; PG8_WAIT_L(0); PG8_MMA(1, 0, At, B0); PG8_BAR; PG8_SCHED;
            PG8_STAGE(PG8_SB(1, 1), b3 + hstep, voffB);
            PG8_WAIT_V(6); PG8_BAR; PG8_MMA(1, 1, At, B1); PG8_BAR;
            }
        }
        if constexpr (ALIGN_EPI) { if (wr == 0) PG8_BAR; }
        if constexpr (!Epi::AFTER_DRAIN) { E(acc, cur, wr, wc, fr, fq); S.done(cur); }
        if (!has_next) break;
#pragma unroll
        for (int a = 0; a < 2; ++a)
#pragma unroll
            for (int b = 0; b < 2; ++b)
#pragma unroll
                for (int m = 0; m < 4; ++m)
#pragma unroll
                    for (int n = 0; n < 2; ++n) acc[a][b][m][n] = (f32x4){0.f, 0.f, 0.f, 0.f};
        cur = nxt; cA = nA; cB = nB; ++ui;
        if constexpr (ALIGN_EPI) { if (wr == 1) PG8_BAR; }
    }
    PG8_WAIT_V(0);
    if constexpr (!ALIGN_EPI) { if (wr == 0) PG8_BAR; }
    PG8_BAR;
    if constexpr (Epi::AFTER_DRAIN) { E.fused(acc, cur, wr, wc, fr, fq, lds, wid, lane); S.done(cur); }
#undef PG8_SA
#undef PG8_SB
#undef PG8_STAGE
#undef PG8_LDA
#undef PG8_LDB
#undef PG8_MMA
#undef PG8_WAIT_V
#undef PG8_WAIT_L
#undef PG8_BAR
#undef PG8_SCHED
}
}
#endif
enum { ST_PRM = 100, ST_INIT = 0, ST_PB, ST_WT, ST_ROWSS, ST_NORM, ST_RESID, ST_DNPREP, ST_DNSCAN, ST_DNOUT, ST_NASC, ST_NAOUT, ST_LAM, ST_ROPE, ST_DATTN, ST_COUT, ST_FFNACT, ST_PLE };
struct Job { P p; WT w; const float* a; const float* b; long n; int layer; int flag; };
template <int ST> DEVFN void run_item(const Job& j, long g) {
    if constexpr (ST == ST_PRM) st_prm(j.p, j.layer, g);
    else if constexpr (ST == ST_INIT) st_init(j.p, j.layer, g);
    else if constexpr (ST == ST_PB) st_pb(j.p, j.layer, g);
    else if constexpr (ST == ST_WT) st_wt(j.w, g);
    else if constexpr (ST == ST_ROWSS) st_rowss(j.p, j.a, g);
    else if constexpr (ST == ST_NORM) st_norm_bf16(j.p, j.a, g);
    else if constexpr (ST == ST_RESID) st_resid(j.p, j.a, j.b, j.flag, g);
    else if constexpr (ST == ST_DNPREP) st_dn_prep(j.p, j.layer, g);
    else if constexpr (ST == ST_DNSCAN) st_dn_scan(j.p, j.layer, g);
    else if constexpr (ST == ST_DNOUT) st_dn_out(j.p, j.layer, g);
    else if constexpr (ST == ST_NASC) st_na_scores(j.p, j.layer, g);
    else if constexpr (ST == ST_NAOUT) st_na_out(j.p, j.layer, g);
    else if constexpr (ST == ST_LAM) st_lam(j.p, j.layer, g);
    else if constexpr (ST == ST_ROPE) st_rope(j.p, j.layer, g);
    else if constexpr (ST == ST_DATTN) st_dattn(j.p, j.layer, g);
    else if constexpr (ST == ST_COUT) st_c_out(j.p, j.layer, g);
    else if constexpr (ST == ST_FFNACT) st_ffn_act(j.p, j.layer, g);
    else if constexpr (ST == ST_PLE) st_ple(j.p, j.layer, g);
}
#ifdef EMU
template <int ST> static void run_stage(Job j, long n) {
    j.n = n;
#pragma omp parallel for schedule(dynamic, 64)
    for (long g = 0; g < n; ++g) run_item<ST>(j, g);
}
static void emu_gemm(const bf16* A, const bf16* Bt, int M, int N, int K, bf16* Ob, float* Of, int ldc) {
    std::vector<float> Af((size_t)M * K), Bf((size_t)N * K);
    for (size_t i = 0; i < Af.size(); ++i) Af[i] = bf2f(A[i]);
    for (size_t i = 0; i < Bf.size(); ++i) Bf[i] = bf2f(Bt[i]);
#pragma omp parallel for schedule(dynamic, 8)
    for (int m = 0; m < M; ++m) for (int n = 0; n < N; ++n) { const float* a = &Af[(size_t)m * K]; const float* b = &Bf[(size_t)n * K]; float s = 0.f;
        for (int k = 0; k < K; ++k) s += a[k] * b[k];
        if (Ob) Ob[(size_t)m * ldc + n] = f2bf(s); else Of[(size_t)m * ldc + n] = s; }
}
static void gemm_bf16(const bf16* A, const bf16* Bt, int M, int N, int K, bf16* O, int ldc) { emu_gemm(A, Bt, M, N, K, O, nullptr, ldc); }
static void gemm_f32(const bf16* A, const bf16* Bt, int M, int N, int K, float* O, int ldc) { emu_gemm(A, Bt, M, N, K, nullptr, O, ldc); }

static void forward(const P& p) {
    Job j; memset(&j, 0, sizeof(j)); j.p = p;
    auto wt = [&](const float* W, size_t off, int K, int N, int Npad) { j.w.W = W; j.w.O = WSP(bf16, off); j.w.K = K; j.w.N = N; j.w.Npad = Npad; run_stage<ST_WT>(j, (long)Npad * K); };
    for (int i = 0; i < 2; ++i) {
        wt(p.ab_w_in + (size_t)i * D * ABIN, WS_WABIN + (size_t)i * ABINP * D * 2, D, ABIN, ABINP);
        wt(p.ab_w_out + (size_t)i * ABMIX * D, WS_WABOUT + (size_t)i * D * ABMIX * 2, ABMIX, D, D);
        wt(p.c_w_in + (size_t)i * D * CIN, WS_WCIN + (size_t)i * CIN * D * 2, D, CIN, CIN);
        wt(p.c_w_out + (size_t)i * CV * D, WS_WCOUT + (size_t)i * D * CV * 2, CV, D, D);
    }
    for (int l = 0; l < DEPTH; ++l) {
        wt(p.ffn_w_in + (size_t)l * D * 2 * DFF, WS_WFIN + (size_t)l * 2 * DFF * D * 2, D, 2 * DFF, 2 * DFF);
        wt(p.ffn_w_out + (size_t)l * DFF * D, WS_WFOUT + (size_t)l * D * DFF * 2, DFF, D, D);
        wt(p.ple_w_proj + (size_t)l * PLE * D, WS_WPP + (size_t)l * D * PLE * 2, PLE, D, D);
        wt(p.ple_w_gate + (size_t)l * D * D, WS_WPG + (size_t)l * D * D * 2, D, D, D);
    }
    run_stage<ST_PRM>(j, N_PRM);
    for (int l = 0; l < DEPTH; ++l) { j.layer = l; run_stage<ST_PB>(j, N_PB); }
    run_stage<ST_INIT>(j, N_INIT);
    for (int layer = 0; layer < DEPTH; ++layer) {
        j.layer = layer; const int jj = layer / 2; const float* nw = PRM(PR_NORMS) + (size_t)layer * 4 * D;
        j.a = p.h; run_stage<ST_ROWSS>(j, N_ROWS);
        j.a = nw; run_stage<ST_NORM>(j, N_TD);
        if (layer % 2 == 0) {
            gemm_bf16(WSP(bf16, WS_HN), WSP(bf16, WS_WABIN + (size_t)jj * ABINP * D * 2), T, ABINP, D, WSP(bf16, WS_PROJ), ABINP);
            run_stage<ST_DNPREP>(j, N_TH);
            run_stage<ST_DNSCAN>(j, N_SCAN);
            run_stage<ST_DNOUT>(j, N_TH);
            run_stage<ST_NASC>(j, N_THD);
            run_stage<ST_NAOUT>(j, N_THD);
            gemm_f32(WSP(bf16, WS_MIXIN), WSP(bf16, WS_WABOUT + (size_t)jj * D * ABMIX * 2), T, D, ABMIX, WSP(float, WS_GOUT), D);
        } else {
            gemm_bf16(WSP(bf16, WS_HN), WSP(bf16, WS_WCIN + (size_t)jj * CIN * D * 2), T, CIN, D, WSP(bf16, WS_PROJ), CIN);
            run_stage<ST_LAM>(j, 1);
            run_stage<ST_ROPE>(j, N_ROPE);
            run_stage<ST_DATTN>(j, N_DATT);
            run_stage<ST_COUT>(j, N_TH);
            gemm_f32(WSP(bf16, WS_MIXIN), WSP(bf16, WS_WCOUT + (size_t)jj * D * CV * 2), T, D, CV, WSP(float, WS_GOUT), D);
        }
        j.a = WSP(float, WS_GOUT); run_stage<ST_ROWSS>(j, N_ROWS);
        j.a = WSP(float, WS_GOUT); j.b = nw + D; j.flag = 0; run_stage<ST_RESID>(j, N_TD);
        j.a = p.h; run_stage<ST_ROWSS>(j, N_ROWS);
        j.a = nw + 2 * D; run_stage<ST_NORM>(j, N_TD);
        gemm_bf16(WSP(bf16, WS_HN), WSP(bf16, WS_WFIN + (size_t)layer * 2 * DFF * D * 2), T, 2 * DFF, D, WSP(bf16, WS_HID), 2 * DFF);
        run_stage<ST_FFNACT>(j, N_ACT);
        gemm_f32(WSP(bf16, WS_ACT), WSP(bf16, WS_WFOUT + (size_t)layer * D * DFF * 2), T, D, DFF, WSP(float, WS_GOUT), D);
        j.a = WSP(float, WS_GOUT); run_stage<ST_ROWSS>(j, N_ROWS);
        j.a = WSP(float, WS_GOUT); j.b = nw + 3 * D; j.flag = 1; run_stage<ST_RESID>(j, N_TD);
        gemm_f32(WSP(bf16, WS_HN), WSP(bf16, WS_WPG + (size_t)layer * D * D * 2), T, D, D, WSP(float, WS_GOUT), D);
        gemm_f32(WSP(bf16, WS_PB + (size_t)layer * SZ_PB), WSP(bf16, WS_WPP + (size_t)layer * D * PLE * 2), T, D, PLE, WSP(float, WS_GOUT2), D);
        run_stage<ST_PLE>(j, N_TD);
    }
}
#endif

#ifndef EMU
namespace att {
using bf16x8 = __attribute__((ext_vector_type(8))) short;
using s16x4  = __attribute__((ext_vector_type(4))) short;
using f32x16 = __attribute__((ext_vector_type(16))) float;
using u32x4  = __attribute__((ext_vector_type(4))) unsigned;
constexpr int DA = 128, NW = 8, QBLK = 32, KVBLK = 64;
constexpr float SCALE = 0.088388347648318440f;
constexpr float THR = 8.f;
constexpr size_t SHM_V = KVBLK * DA * 2, SHM_K = KVBLK * DA * 2, SHM_ATTN = 2 * SHM_V + 2 * SHM_K + NW * 64 * 4;
#define KSWZ(row, colB) ((row) * 256 + ((colB) ^ (((row) & 15) << 4)))
#define SBAR() __builtin_amdgcn_sched_barrier(0)
__device__ __forceinline__ int crow(int r, int hi) { return (r & 3) + 8 * (r >> 2) + 4 * hi; }
__device__ __forceinline__ unsigned cvtpk(float lo, float hi) { unsigned r; asm volatile("v_cvt_pk_bf16_f32 %0, %1, %2" : "=v"(r) : "v"(lo), "v"(hi)); return r; }
__device__ __forceinline__ bf16x8 ld8(const bf16* p) { return *reinterpret_cast<const bf16x8*>(p); }
__device__ __forceinline__ void partialSM(f32x16& p0, f32x16& p1, float& m_reg, float& mn, float& alpha) {
  constexpr float C = SCALE * 1.4426950408889634f;
  float pmax = p0[0]; for (int r = 1; r < 16; ++r) pmax = fmaxf(pmax, p0[r]); for (int r = 0; r < 16; ++r) pmax = fmaxf(pmax, p1[r]);
  { auto rr = __builtin_amdgcn_permlane32_swap(__float_as_uint(pmax), __float_as_uint(pmax), false, false);
    pmax = fmaxf(__uint_as_float(rr[0]), __uint_as_float(rr[1])); }
  if (__builtin_expect(__all(pmax - m_reg <= THR / SCALE), 1)) { mn = m_reg; alpha = 1.f; }
  else { mn = fmaxf(m_reg, pmax); alpha = __builtin_amdgcn_exp2f((m_reg - mn) * C); m_reg = mn; }
  float mnC = -mn * C;
  for (int r = 0; r < 16; ++r) p0[r] = fmaf(p0[r], C, mnC); for (int r = 0; r < 16; ++r) p1[r] = fmaf(p1[r], C, mnC);
  for (int r = 0; r < 16; ++r) p0[r] = __builtin_amdgcn_exp2f(p0[r]);
}
__device__ __forceinline__ void finishSM(f32x16& p0, f32x16& p1, float alpha, float& l_reg, bf16x8& pa0, bf16x8& pa1, bf16x8& pa2, bf16x8& pa3) {
  for (int r = 0; r < 16; ++r) p1[r] = __builtin_amdgcn_exp2f(p1[r]);
  float ps = 0; for (int r = 0; r < 16; ++r) ps += p0[r]; for (int r = 0; r < 16; ++r) ps += p1[r];
  { auto rr = __builtin_amdgcn_permlane32_swap(__float_as_uint(ps), __float_as_uint(ps), false, false);
    ps = __uint_as_float(rr[0]) + __uint_as_float(rr[1]); }
  l_reg = l_reg * alpha + ps;
#define PK4(P, BASE, OUT) do { unsigned a0 = cvtpk(P[BASE + 0], P[BASE + 1]), a1 = cvtpk(P[BASE + 2], P[BASE + 3]);   \
    unsigned b0 = cvtpk(P[BASE + 4], P[BASE + 5]), b1 = cvtpk(P[BASE + 6], P[BASE + 7]);                              \
    auto r0 = __builtin_amdgcn_permlane32_swap(a0, b0, false, false); auto r1 = __builtin_amdgcn_permlane32_swap(a1, b1, false, false); \
    u32x4 w = {r0[0], r1[0], r0[1], r1[1]}; OUT = *reinterpret_cast<bf16x8*>(&w); } while (0)
  PK4(p0, 0, pa0); PK4(p0, 8, pa1); PK4(p1, 0, pa2); PK4(p1, 8, pa3);
#undef PK4
}
__device__ __forceinline__ void qkt(f32x16& p0, f32x16& p1, const bf16* Ks, const bf16x8* qr, int r32, int hi) {
  p0 = f32x16{}; p1 = f32x16{};
  for (int d0 = 0; d0 < 8; ++d0) { int cb = (d0 * 16 + hi * 8) * 2;
    bf16x8 b0 = *reinterpret_cast<const bf16x8*>((const char*)Ks + KSWZ(r32, cb));
    bf16x8 b1 = *reinterpret_cast<const bf16x8*>((const char*)Ks + KSWZ(32 + r32, cb));
    p0 = __builtin_amdgcn_mfma_f32_32x32x16_bf16(b0, qr[d0], p0, 0, 0, 0);
    p1 = __builtin_amdgcn_mfma_f32_32x32x16_bf16(b1, qr[d0], p1, 0, 0, 0); }
}
__device__ __forceinline__ int v_st(int k, int c) { const int kk = (k & ~0xC) | ((k & 4) << 1) | ((k & 8) >> 1); return ((kk >> 3) * 4 + (c >> 5)) * 512 + ((kk & 7) * 32 + (c & 31)) * 2; }
__device__ __forceinline__ int v_rd_base(int lane) { return ((lane & 3) << 3) | (((lane >> 2) & 3) << 6) | (((lane >> 4) & 1) << 5) | (((lane >> 5) & 1) << 8); }
constexpr int v_rd_off(int d0, int ks, int half) { return d0 * 512 + ks * 4096 + half * 2048; }
template <int OFF> __device__ __forceinline__ s16x4 tr_read(int vb) {
  s16x4 r; asm volatile("ds_read_b64_tr_b16 %0, %1 offset:%2" : "=&v"(r) : "v"(vb), "i"(OFF) : "memory"); return r;
}
template <int D0> __device__ __forceinline__ void pv_one(f32x16& od, int vb, bf16x8 pa0, bf16x8 pa1, bf16x8 pa2, bf16x8 pa3) {
  const s16x4 l0 = tr_read<v_rd_off(D0, 0, 0)>(vb), h0 = tr_read<v_rd_off(D0, 0, 1)>(vb), l1 = tr_read<v_rd_off(D0, 1, 0)>(vb), h1 = tr_read<v_rd_off(D0, 1, 1)>(vb);
  const s16x4 l2 = tr_read<v_rd_off(D0, 2, 0)>(vb), h2 = tr_read<v_rd_off(D0, 2, 1)>(vb), l3 = tr_read<v_rd_off(D0, 3, 0)>(vb), h3 = tr_read<v_rd_off(D0, 3, 1)>(vb);
  asm volatile("s_waitcnt lgkmcnt(0)" ::: "memory"); SBAR();
#define PK(L, H) (bf16x8){L[0], L[1], L[2], L[3], H[0], H[1], H[2], H[3]}
  od = __builtin_amdgcn_mfma_f32_32x32x16_bf16(pa0, PK(l0, h0), od, 0, 0, 0);
  od = __builtin_amdgcn_mfma_f32_32x32x16_bf16(pa1, PK(l1, h1), od, 0, 0, 0);
  od = __builtin_amdgcn_mfma_f32_32x32x16_bf16(pa2, PK(l2, h2), od, 0, 0, 0);
  od = __builtin_amdgcn_mfma_f32_32x32x16_bf16(pa3, PK(l3, h3), od, 0, 0, 0);
#undef PK
}
__device__ __forceinline__ void pv_d0(f32x16* o, int vb, bf16x8 pa0, bf16x8 pa1, bf16x8 pa2, bf16x8 pa3) {
  pv_one<0>(o[0], vb, pa0, pa1, pa2, pa3); pv_one<1>(o[1], vb, pa0, pa1, pa2, pa3); pv_one<2>(o[2], vb, pa0, pa1, pa2, pa3); pv_one<3>(o[3], vb, pa0, pa1, pa2, pa3);
}
struct NaInfo { int rq0, kr0; const float* tab; };
__device__ __forceinline__ void na_mask(f32x16& p0, f32x16& p1, int rk, int rq, int rs, int cq, int cs, int hi, const float* tab) {
  const bool rowok = (rk >= rs) && (rk < rs + NAR);
  int dr = rk - rq + NAR - 1; dr = dr < 0 ? 0 : (dr > 2 * NAR - 2 ? 2 * NAR - 2 : dr);
  const float* trow = tab + dr * (2 * NAC - 1); const float ninf = -__builtin_inff();
#pragma unroll
  for (int r = 0; r < 16; ++r) { const int ck = crow(r, hi); int dc = ck - cq + NAC - 1; dc = dc < 0 ? 0 : (dc > 2 * NAC - 2 ? 2 * NAC - 2 : dc);
    const bool ok = rowok && ck >= cs && ck < cs + NAC; const float b = trow[dc]; p0[r] = ok ? p0[r] + b : ninf; }
#pragma unroll
  for (int r = 0; r < 16; ++r) { const int ck = 32 + crow(r, hi); int dc = ck - cq + NAC - 1; dc = dc < 0 ? 0 : (dc > 2 * NAC - 2 ? 2 * NAC - 2 : dc);
    const bool ok = rowok && ck >= cs && ck < cs + NAC; const float b = trow[dc]; p1[r] = ok ? p1[r] + b : ninf; }
}
template <int LDQ, int LDK, int LDO, int MODE>
__device__ __forceinline__ void attn_dense_body(const bf16* __restrict__ Qb, const bf16* __restrict__ Kh, const bf16* __restrict__ Vh, void* __restrict__ Ob_, int seq, char* lds, NaInfo na, int tid_in) {
  constexpr int SDEPTH = 2;
  int tid_ = tid_in; asm volatile("" : "+v"(tid_));
  const int tid = tid_, wid = tid >> 6, lane = tid & 63, r32 = lane & 31, hi = lane >> 5;
  const int na_rq = na.rq0 + (wid >> 1), na_cq = (wid & 1) * 32 + r32, na_rs = clampi(na_rq - WR / 2, 0, ROWS - WR), na_cs = clampi(na_cq - NAC / 2, 0, GW - NAC);
#define NAMASK(P0, P1, jt) do { if constexpr (MODE == 1) na_mask(P0, P1, na.kr0 + (jt), na_rq, na_rs, na_cq, na_cs, hi, na.tab); } while (0)
  bf16* V_lds = (bf16*)lds; bf16* K_lds = (bf16*)(lds + 2 * SHM_V);
  float* ws = (float*)(lds + 2 * SHM_V + 2 * SHM_K) + wid * 64; float* li_l = ws; float* al_l = ws + 32;
  float m_reg = -1e30f, l_reg = 0; f32x16 o[4] = {}; bf16x8 qr[8];
  const bf16* Qw = Qb + (long)(wid * QBLK + r32) * LDQ + hi * 8;
#pragma unroll
  for (int d0 = 0; d0 < 8; ++d0) qr[d0] = ld8(Qw + d0 * 16);
  const int sr = tid >> 4, sc = (tid & 15) * 8, vst0 = v_st(sr, sc), vst1 = v_st(32 + sr, sc);
  const int vb0 = (int)(uintptr_t)V_lds + v_rd_base(lane);
  struct { bf16x8 vs0, vs1, ks0, ks1; } sr_[SDEPTH];
#define SLOAD(i, k0) do { sr_[i].vs0 = ld8(&Vh[(long)((k0) + sr) * LDK + sc]); sr_[i].vs1 = ld8(&Vh[(long)((k0) + 32 + sr) * LDK + sc]); \
    sr_[i].ks0 = ld8(&Kh[(long)((k0) + sr) * LDK + sc]); sr_[i].ks1 = ld8(&Kh[(long)((k0) + 32 + sr) * LDK + sc]); } while (0)
#define SWRITE(b, i) do { *(bf16x8*)((char*)V_lds + (b) * SHM_V + vst0) = sr_[i].vs0;          \
    *(bf16x8*)((char*)V_lds + (b) * SHM_V + vst1) = sr_[i].vs1; int kc = sc * 2;               \
    *(bf16x8*)((char*)K_lds + (b) * SHM_K + KSWZ(sr, kc)) = sr_[i].ks0;                       \
    *(bf16x8*)((char*)K_lds + (b) * SHM_K + KSWZ(32 + sr, kc)) = sr_[i].ks1; } while (0)
#define SWAIT() asm volatile("s_waitcnt vmcnt(4)" ::: "memory")
#define RESC(a) do { if (__any((a) < 1.f)) { if (hi == 0) al_l[r32] = (a); asm volatile("s_waitcnt lgkmcnt(0)" ::: "memory"); \
    for (int d = 0; d < 4; ++d) for (int r = 0; r < 16; ++r) o[d][r] *= al_l[crow(r, hi)]; } } while (0)
  f32x16 pA0, pA1, pB0, pB1; float mnA, mnB, alA, alB; bf16x8 pa0, pa1, pa2, pa3; const int NT = seq / KVBLK;
  constexpr int SE = 0, SO = SDEPTH - 1;
  SLOAD(SE, 0); asm volatile("s_waitcnt vmcnt(0)" ::: "memory"); SWRITE(0, SE); __syncthreads();
  qkt(pA0, pA1, K_lds, qr, r32, hi); NAMASK(pA0, pA1, 0); partialSM(pA0, pA1, m_reg, mnA, alA);
  SLOAD(SO, KVBLK); if (2 < NT) SLOAD(SE, 2 * KVBLK);
  SWAIT(); SWRITE(1, SO); __syncthreads();
  for (int j = 1; j + 1 < NT; j += 2) {
    SBAR(); qkt(pB0, pB1, (bf16*)((char*)K_lds + SHM_K), qr, r32, hi); NAMASK(pB0, pB1, j);
    finishSM(pA0, pA1, alA, l_reg, pa0, pa1, pa2, pa3); SBAR();
    SLOAD(SO, (j + SDEPTH) * KVBLK); SBAR();
    pv_d0(o, vb0, pa0, pa1, pa2, pa3); partialSM(pB0, pB1, m_reg, mnB, alB);
    __syncthreads(); SWAIT(); SWRITE(0, SE);
    RESC(alB); __syncthreads();
    SBAR(); qkt(pA0, pA1, K_lds, qr, r32, hi); NAMASK(pA0, pA1, j + 1);
    finishSM(pB0, pB1, alB, l_reg, pa0, pa1, pa2, pa3); SBAR();
    if (j + 3 < NT) SLOAD(SE, (j + 1 + SDEPTH) * KVBLK); SBAR();
    pv_d0(o, vb0 + (int)SHM_V, pa0, pa1, pa2, pa3); partialSM(pA0, pA1, m_reg, mnA, alA);
    __syncthreads(); SWAIT(); SWRITE(1, SO);
    RESC(alA); __syncthreads();
  }
  SBAR(); qkt(pB0, pB1, (bf16*)((char*)K_lds + SHM_K), qr, r32, hi); NAMASK(pB0, pB1, NT - 1);
  finishSM(pA0, pA1, alA, l_reg, pa0, pa1, pa2, pa3); SBAR();
  pv_d0(o, vb0, pa0, pa1, pa2, pa3); partialSM(pB0, pB1, m_reg, mnB, alB);
  __syncthreads(); RESC(alB);
  finishSM(pB0, pB1, alB, l_reg, pa0, pa1, pa2, pa3); SBAR();
  pv_d0(o, vb0 + (int)SHM_V, pa0, pa1, pa2, pa3);
  if (hi == 0) li_l[r32] = l_reg; asm volatile("s_waitcnt lgkmcnt(0)" ::: "memory");
  float rli[16];
#pragma unroll
  for (int r = 0; r < 16; ++r) rli[r] = __builtin_amdgcn_rcpf(li_l[crow(r, hi)]);
  if constexpr (MODE == 2) { float* Ow = (float*)Ob_ + (long)(wid * QBLK) * LDO;
#pragma unroll
    for (int r = 0; r < 16; ++r) { int orow = crow(r, hi);
      for (int d0 = 0; d0 < 4; ++d0) Ow[(long)orow * LDO + d0 * 32 + r32] = o[d0][r] * rli[r]; }
  } else { bf16* Ow = (bf16*)Ob_ + (long)(wid * QBLK) * LDO;
#pragma unroll
    for (int r = 0; r < 16; ++r) { int orow = crow(r, hi);
      for (int d0 = 0; d0 < 4; ++d0) Ow[(long)orow * LDO + d0 * 32 + r32] = f2bf(o[d0][r] * rli[r]); } }
#undef NAMASK
#undef SLOAD
#undef SWRITE
#undef SWAIT
#undef RESC
}
template <int LDQ, int LDK, int LDO>
__device__ __forceinline__ void na_body(const bf16* __restrict__ Qb, const bf16* __restrict__ Kh, const bf16* __restrict__ Vh, bf16* __restrict__ Ob, int ntiles, char* lds, NaInfo na, int tid_in) {
  int tid_ = tid_in; asm volatile("" : "+v"(tid_));
  const int tid = tid_, wid = tid >> 6, lane = tid & 63, r32 = lane & 31, hi = lane >> 5;
  const int na_rq = na.rq0 + (wid >> 1), na_cq = (wid & 1) * 32 + r32, na_rs = clampi(na_rq - WR / 2, 0, ROWS - WR), na_cs = clampi(na_cq - NAC / 2, 0, GW - NAC);
  bf16* V_lds = (bf16*)lds; bf16* K_lds = (bf16*)(lds + 2 * SHM_V);
  float* ws = (float*)(lds + 2 * SHM_V + 2 * SHM_K) + wid * 64; float* li_l = ws; float* al_l = ws + 32;
  float m_reg = -1e30f, l_reg = 0; f32x16 o[4] = {}; bf16x8 qr[8];
  const bf16* Qw = Qb + (long)(wid * QBLK + r32) * LDQ + hi * 8;
#pragma unroll
  for (int d0 = 0; d0 < 8; ++d0) qr[d0] = ld8(Qw + d0 * 16);
  const int sr = tid >> 4, sc = (tid & 15) * 8, vst0 = v_st(sr, sc), vst1 = v_st(32 + sr, sc);
  const int vb0 = (int)(uintptr_t)V_lds + v_rd_base(lane);
  bf16x8 vs0 = ld8(&Vh[(long)sr * LDK + sc]), vs1 = ld8(&Vh[(long)(32 + sr) * LDK + sc]), ks0 = ld8(&Kh[(long)sr * LDK + sc]), ks1 = ld8(&Kh[(long)(32 + sr) * LDK + sc]);
  for (int jt = 0; jt < ntiles; ++jt) {
    __syncthreads();
    *(bf16x8*)((char*)V_lds + vst0) = vs0; *(bf16x8*)((char*)V_lds + vst1) = vs1;
    *(bf16x8*)((char*)K_lds + KSWZ(sr, sc * 2)) = ks0; *(bf16x8*)((char*)K_lds + KSWZ(32 + sr, sc * 2)) = ks1;
    __syncthreads();
    if (jt + 1 < ntiles) { const int k0 = (jt + 1) * KVBLK;
      vs0 = ld8(&Vh[(long)(k0 + sr) * LDK + sc]); vs1 = ld8(&Vh[(long)(k0 + 32 + sr) * LDK + sc]); ks0 = ld8(&Kh[(long)(k0 + sr) * LDK + sc]); ks1 = ld8(&Kh[(long)(k0 + 32 + sr) * LDK + sc]); }
    f32x16 p0, p1; float mn, al; bf16x8 pa0, pa1, pa2, pa3;
    qkt(p0, p1, K_lds, qr, r32, hi);
    na_mask(p0, p1, na.kr0 + jt, na_rq, na_rs, na_cq, na_cs, hi, na.tab);
    partialSM(p0, p1, m_reg, mn, al);
    if (__any(al < 1.f)) { if (hi == 0) al_l[r32] = al; asm volatile("s_waitcnt lgkmcnt(0)" ::: "memory");
      for (int d = 0; d < 4; ++d) for (int r = 0; r < 16; ++r) o[d][r] *= al_l[crow(r, hi)]; }
    finishSM(p0, p1, al, l_reg, pa0, pa1, pa2, pa3); SBAR();
    pv_d0(o, vb0, pa0, pa1, pa2, pa3);
  }
  if (hi == 0) li_l[r32] = l_reg; asm volatile("s_waitcnt lgkmcnt(0)" ::: "memory");
  float rli[16];
#pragma unroll
  for (int r = 0; r < 16; ++r) rli[r] = __builtin_amdgcn_rcpf(li_l[crow(r, hi)]);
  bf16* Ow = Ob + (long)(wid * QBLK) * LDO;
#pragma unroll
  for (int r = 0; r < 16; ++r) { int orow = crow(r, hi);
    for (int d0 = 0; d0 < 4; ++d0) Ow[(long)orow * LDO + d0 * 32 + r32] = f2bf(o[d0][r] * rli[r]); }
}
template <int LDQ, int LDK, int LDO>
__device__ __forceinline__ void dattn256_body(const bf16* __restrict__ Qb, const bf16* __restrict__ Kh, const bf16* __restrict__ Vh, bf16* Ob, int ntiles, char* lds, int tid_in,
                                              int mode = 0, bf16* Mx = nullptr, float lam = 0.f, float scale = 0.f, const float* sw = nullptr) {
  typedef __attribute__((address_space(3))) unsigned lds_u32;
  int tid_ = tid_in; asm volatile("" : "+v"(tid_));
  const int tid = tid_, wid = __builtin_amdgcn_readfirstlane(tid >> 6), lane = tid & 63, r32 = lane & 31, hi = lane >> 5;
  constexpr int VB = 2 * (int)SHM_V, KB = (int)SHM_K;
  char* V_lds = lds; char* K_lds = lds + 2 * VB;
  float* ws = (float*)(lds + 2 * VB + 2 * KB) + wid * 64; float* li_l = ws; float* al_l = ws + 32;
  float m_reg = -1e30f, l_reg = 0; f32x16 o[8] = {}; bf16x8 qr[8];
  const bf16* Qw = Qb + (long)(wid * QBLK + r32) * LDQ + hi * 8;
#pragma unroll
  for (int d0 = 0; d0 < 8; ++d0) qr[d0] = ld8(Qw + d0 * 16);
  unsigned koff[2], voff[2];
#pragma unroll
  for (int i = 0; i < 2; ++i) { const int kp = 2 * wid + i; const int row = 4 * kp + (lane >> 4), c = (lane & 15) ^ (row & 15); koff[i] = (unsigned)(row * LDK + c * 8);
    const int st = 2 * kp + (lane >> 5), within = lane & 31, kk = (st >> 2) * 8 + (within >> 2), k = (kk & ~0xC) | ((kk & 4) << 1) | ((kk & 8) >> 1); voff[i] = (unsigned)(k * LDK + (st & 3) * 32 + (within & 3) * 8); }
  const int vbase = (int)(uintptr_t)V_lds + v_rd_base(lane);
#define DA_DMA(t, b) do { const bf16* kt_ = Kh + (long)(t) * KVBLK * LDK; const bf16* vt_ = Vh + (long)(t) * KVBLK * LDK; \
      _Pragma("unroll") for (int i = 0; i < 2; ++i) { \
        __builtin_amdgcn_global_load_lds((const unsigned*)(kt_ + koff[i]), (lds_u32*)(K_lds + (b) * KB + (2 * wid + i) * 1024), 16, 0, 0); \
        __builtin_amdgcn_global_load_lds((const unsigned*)(vt_ + voff[i]), (lds_u32*)(V_lds + (b) * VB + (2 * wid + i) * 1024), 16, 0, 0); \
        __builtin_amdgcn_global_load_lds((const unsigned*)(vt_ + voff[i] + 128), (lds_u32*)(V_lds + (b) * VB + (int)SHM_V + (2 * wid + i) * 1024), 16, 0, 0); } } while (0)
  __syncthreads();
  DA_DMA(0, 0);
  for (int jt = 0; jt < ntiles; ++jt) {
    const int b = jt & 1;
    asm volatile("s_waitcnt vmcnt(0)" ::: "memory");
    __syncthreads();
    if (jt + 1 < ntiles) DA_DMA(jt + 1, b ^ 1);
    const char* Kb = K_lds + b * KB;
    f32x16 p0, p1; float mn, al; bf16x8 pa0, pa1, pa2, pa3;
    p0 = f32x16{}; p1 = f32x16{};
#pragma unroll
    for (int d0 = 0; d0 < 8; ++d0) { const int cb = (d0 * 16 + hi * 8) * 2;
      const bf16x8 b0 = *reinterpret_cast<const bf16x8*>(Kb + KSWZ(r32, cb)), b1 = *reinterpret_cast<const bf16x8*>(Kb + KSWZ(32 + r32, cb));
      p0 = __builtin_amdgcn_mfma_f32_32x32x16_bf16(b0, qr[d0], p0, 0, 0, 0); p1 = __builtin_amdgcn_mfma_f32_32x32x16_bf16(b1, qr[d0], p1, 0, 0, 0); }
    partialSM(p0, p1, m_reg, mn, al);
    if (__any(al < 1.f)) { if (hi == 0) al_l[r32] = al; asm volatile("s_waitcnt lgkmcnt(0)" ::: "memory");
      for (int d = 0; d < 8; ++d) for (int r = 0; r < 16; ++r) o[d][r] *= al_l[crow(r, hi)]; }
    finishSM(p0, p1, al, l_reg, pa0, pa1, pa2, pa3); SBAR();
    pv_d0(o, vbase + b * VB, pa0, pa1, pa2, pa3);
    pv_d0(o + 4, vbase + b * VB + (int)SHM_V, pa0, pa1, pa2, pa3);
  }
#undef DA_DMA
  if (hi == 0) li_l[r32] = l_reg; asm volatile("s_waitcnt lgkmcnt(0)" ::: "memory");
  float rli[16];
#pragma unroll
  for (int r = 0; r < 16; ++r) rli[r] = __builtin_amdgcn_rcpf(li_l[crow(r, hi)]);
  bf16* Ow = Ob + (long)(wid * QBLK) * LDO;
  if (mode == 0) {
#pragma unroll
    for (int r = 0; r < 16; ++r) { int orow = crow(r, hi);
      for (int d0 = 0; d0 < 8; ++d0) Ow[(long)orow * LDO + d0 * 32 + r32] = f2bf(o[d0][r] * rli[r]); }
  } else {
    bf16* Mw = Mx + (long)(wid * QBLK) * LDO;
    float swv[8];
#pragma unroll
    for (int d0 = 0; d0 < 8; ++d0) swv[d0] = sw[d0 * 32 + r32] * scale;
#pragma unroll
    for (int r = 0; r < 16; ++r) { const int orow = crow(r, hi); float ss = 0.f; const float nl = -lam * rli[r];
#pragma unroll
      for (int d0 = 0; d0 < 8; ++d0) { const float x = bf2f(Ow[(long)orow * LDO + d0 * 32 + r32]) + nl * o[d0][r]; o[d0][r] = x; ss += x * x; }
      ss += __shfl_xor(ss, 1); ss += __shfl_xor(ss, 2); ss += __shfl_xor(ss, 4); ss += __shfl_xor(ss, 8); ss += __shfl_xor(ss, 16);
      const float rs = 1.0f / sqrtf(ss * (1.0f / 256.0f) + RMS_EPS);
#pragma unroll
      for (int d0 = 0; d0 < 8; ++d0) Mw[(long)orow * LDO + d0 * 32 + r32] = f2bf(o[d0][r] * rs * swv[d0]); }
  }
}
}
namespace dn {
using bf16x8 = __attribute__((ext_vector_type(8))) short;
using f32x4v = __attribute__((ext_vector_type(4))) float;
using f32x2v = __attribute__((ext_vector_type(2))) float;
using bf16x2v = __attribute__((ext_vector_type(2))) __bf16;
using u32x4 = __attribute__((ext_vector_type(4))) unsigned;
constexpr int KP = 136;
constexpr int L_K = 0, L_Q = 17408, L_V = 34816, L_AKK = 67584, L_AQK = 84224, L_L0 = 100864, L_L1 = 117248, L_SM = 133632, L_DB = 135680, L_END = 143872;
__device__ __forceinline__ unsigned pk(float lo, float hi) { const f32x2v v = {lo, hi}; return __builtin_bit_cast(unsigned, __builtin_convertvector(v, bf16x2v)); }
__device__ __forceinline__ bf16x8 pack8(f32x4v a, f32x4v b) { u32x4 w = {pk(a[0], a[1]), pk(a[2], a[3]), pk(b[0], b[1]), pk(b[2], b[3])}; return __builtin_bit_cast(bf16x8, w); }
__device__ __forceinline__ int kperm(int s, int q, int j) { return 32 * s + 16 * (j >> 2) + 4 * q + (j & 3); }
#define MFMA16(a, b, c) __builtin_amdgcn_mfma_f32_16x16x32_bf16((a), (b), (c), 0, 0, 0)

__device__ __forceinline__ float fexp(float x) { return __builtin_amdgcn_exp2f(x * 1.4426950408889634f); }
__device__ __forceinline__ float fsilu(float x) { return x * __builtin_amdgcn_rcpf(1.0f + fexp(-x)); }
template <int C> __device__ __forceinline__ float dpp_bc(int v) { return __int_as_float(__builtin_amdgcn_update_dpp(0, v, C, 0xf, 0xf, false)); }
template <int I, int J> __device__ __forceinline__ void inv16_terms(float& r, int lk, const float (&x)[16]) {
    if constexpr (J < I) { r -= dpp_bc<0x150 + J>(lk) * x[J]; inv16_terms<I, J + 1>(r, lk, x); }
}
template <int I> __device__ __forceinline__ void inv16_rows(float (&x)[16], const float* Lbb, int c) {
    if constexpr (I < 16) { float r = (I == c) ? 1.f : 0.f; const int lk = __float_as_int(Lbb[I * 64 + c]); inv16_terms<I, 0>(r, lk, x); x[I] = r; inv16_rows<I + 1>(x, Lbb, c); }
}
__device__ __forceinline__ void dn1_unit(const P& p, int jl, int seq, int hh, int chunk, char* lds, int tid_in) {
    int tid_ = tid_in; asm volatile("" : "+v"(tid_));
    const int tid = tid_, lane = tid & 63, wave = tid >> 6;
    bf16* Kl = (bf16*)(lds + L_K); bf16* Ql = (bf16*)(lds + L_Q); float* Vl = (float*)(lds + L_V); float* AKK = (float*)(lds + L_AKK); float* AQK = (float*)(lds + L_AQK);
    float* L0 = (float*)(lds + L_L0); float* L1 = (float*)(lds + L_L1); float* g_l = (float*)(lds + L_SM); float* beta_l = g_l + 128; float* gc_l = g_l + 256; float* bk_l = g_l + 384;
    const int tt0 = chunk * 64; const long tb = (long)seq * S; const bf16* PROJ = WSP(bf16, WS_PROJ);
    const size_t unit = ((size_t)(seq * NH + hh) * (S / 64) + chunk);
    if (tid < 384) {
        const int cgi = tid & 15, part = (tid >> 4) % 3, oct = tid / 48, i0 = 8 * oct; const int coff = part * 1024 + hh * DH + 8 * cgi;
        bf16x8 x[12]; float w[5][8];
#pragma unroll
        for (int k = 0; k < 12; ++k) { const int ts = tt0 + i0 + k - 2; x[k] = (ts >= 0 && ts < S) ? *(const bf16x8*)(PROJ + (size_t)(tb + ts) * ABINP + coff) : (bf16x8){0, 0, 0, 0, 0, 0, 0, 0}; }
#pragma unroll
        for (int tap = 0; tap < 5; ++tap) { const float* cw = PRM(PR_ABCONV) + (size_t)(jl * 5 + tap) * AQKV + coff; const f32x4v a = *(const f32x4v*)cw, b = *(const f32x4v*)(cw + 4);
#pragma unroll
            for (int e = 0; e < 4; ++e) { w[tap][e] = a[e]; w[tap][4 + e] = b[e]; } }
#pragma unroll
        for (int kk = 0; kk < 8; ++kk) { float y[8]; float ss = 0.f;
#pragma unroll
            for (int c = 0; c < 8; ++c) { float acc = 0.f;
#pragma unroll
                for (int tap = 0; tap < 5; ++tap) acc += bf2f((bf16)x[kk + tap][c]) * w[tap][c];
                y[c] = fsilu(acc); ss += y[c] * y[c]; }
            ss += __shfl_xor(ss, 1); ss += __shfl_xor(ss, 2); ss += __shfl_xor(ss, 4); ss += __shfl_xor(ss, 8);
            const float rn = 1.0f / sqrtf(ss + 1e-6f); const float sc_ = part == 0 ? rn * 0.08838834764831845f : (part == 1 ? rn : 1.0f); const int i = i0 + kk;
            if (part < 2) { u32x4 wv; wv[0] = pk(y[0] * sc_, y[1] * sc_); wv[1] = pk(y[2] * sc_, y[3] * sc_); wv[2] = pk(y[4] * sc_, y[5] * sc_); wv[3] = pk(y[6] * sc_, y[7] * sc_);
                *(u32x4*)((part ? Kl : Ql) + i * KP + 8 * cgi) = wv; }
            else { *(f32x4v*)(Vl + i * 128 + 8 * cgi) = (f32x4v){y[0], y[1], y[2], y[3]}; *(f32x4v*)(Vl + i * 128 + 8 * cgi + 4) = (f32x4v){y[4], y[5], y[6], y[7]}; } }
    } else { const int gt = tid - 384; const int dir = gt >> 6, il = gt & 63, ti = dir ? 63 - il : il; const bf16* gr = PROJ + (size_t)(tb + tt0 + ti) * ABINP + COL_G;
        const float graw = bf2f(gr[dir * NH + hh]), braw = bf2f(gr[16 + dir * NH + hh]);
        const float a = expf(PRM(PR_ALOG)[(jl * 2 + dir) * NH + hh]), dtb = PRM(PR_DTB)[(jl * 2 + dir) * NH + hh];
        g_l[dir * 64 + il] = -a * softplusf(graw + dtb); beta_l[dir * 64 + il] = sigmoidf(braw); }
    __syncthreads();
    if (wave < 2) { const int dir = wave; float c = g_l[dir * 64 + lane];
#pragma unroll
        for (int o = 1; o < 64; o <<= 1) { const float t = __shfl_up(c, o); if (lane >= o) c += t; }
        gc_l[dir * 64 + lane] = c; bk_l[dir * 64 + lane] = beta_l[dir * 64 + lane] * fexp(c); }
    {
        const int r = lane & 15, q = lane >> 4;
#pragma unroll
        for (int tt = 0; tt < 2; ++tt) { const int tile = 2 * wave + tt, ti_ = tile >> 2, tj_ = tile & 3; f32x4v ck = {0.f, 0.f, 0.f, 0.f}, cq = {0.f, 0.f, 0.f, 0.f};
#pragma unroll
            for (int s = 0; s < 4; ++s) { const bf16x8 ak = *(const bf16x8*)(Kl + (16 * ti_ + r) * KP + 32 * s + 8 * q), aq = *(const bf16x8*)(Ql + (16 * ti_ + r) * KP + 32 * s + 8 * q), b = *(const bf16x8*)(Kl + (16 * tj_ + r) * KP + 32 * s + 8 * q);
                ck = MFMA16(ak, b, ck); cq = MFMA16(aq, b, cq); }
#pragma unroll
            for (int rr = 0; rr < 4; ++rr) { AKK[(16 * ti_ + 4 * q + rr) * 65 + 16 * tj_ + r] = ck[rr]; AQK[(16 * ti_ + 4 * q + rr) * 65 + 16 * tj_ + r] = cq[rr]; } }
    }
    __syncthreads();
    for (int e = tid; e < 8192; e += 512) { const int dir = e >> 12, i = (e >> 6) & 63, jx = e & 63; float v = 0.f;
        if (jx < i) { const int ti = dir ? 63 - i : i, tj = dir ? 63 - jx : jx; v = beta_l[dir * 64 + i] * AKK[ti * 65 + tj] * fexp(gc_l[dir * 64 + i] - gc_l[dir * 64 + jx]); }
        (dir ? L1 : L0)[i * 64 + jx] = v; }
#pragma unroll
    for (int dir = 0; dir < 2; ++dir) {
        const size_t ud = unit * 2 + dir; const float* gc = gc_l + dir * 64; const float glast = gc[63];
        {
            const int frag = tid >> 6, mt = frag >> 1, s = frag & 1, i = 16 * mt + (lane & 15), q = lane >> 4, ti = dir ? 63 - i : i; const float gi = gc[i]; float v[8];
#pragma unroll
            for (int jv = 0; jv < 8; ++jv) { const int jx = kperm(s, q, jv); v[jv] = (jx <= i) ? AQK[ti * 65 + (dir ? 63 - jx : jx)] * fexp(gi - gc[jx]) : 0.f; }
            u32x4 w = {pk(v[0], v[1]), pk(v[2], v[3]), pk(v[4], v[5]), pk(v[6], v[7])};
            *(u32x4*)(WSP(bf16, WS_DN_IN) + ((ud * 8 + frag) * 64 + lane) * 8) = w;
        }
#pragma unroll
        for (int rep = 0; rep < 2; ++rep) {
            const int fl = tid + 512 * rep, frag = fl >> 6, q = lane >> 4;
            { const int mt = frag >> 2, s = frag & 3, i = 16 * mt + (lane & 15), ti = dir ? 63 - i : i; const float eg = fexp(gc[i]); float v[8];
#pragma unroll
              for (int jv = 0; jv < 8; ++jv) v[jv] = bf2f(Ql[ti * KP + kperm(s, q, jv)]) * eg;
              u32x4 w = {pk(v[0], v[1]), pk(v[2], v[3]), pk(v[4], v[5]), pk(v[6], v[7])};
              *(u32x4*)(WSP(bf16, WS_DN_QE) + ((ud * 16 + frag) * 64 + lane) * 8) = w; }
            { const int mt = frag >> 1, s = frag & 1, d = 16 * mt + (lane & 15); float v[8];
#pragma unroll
              for (int jv = 0; jv < 8; ++jv) { const int jx = kperm(s, q, jv), tj = dir ? 63 - jx : jx; v[jv] = bf2f(Kl[tj * KP + d]) * fexp(glast - gc[jx]); }
              u32x4 w = {pk(v[0], v[1]), pk(v[2], v[3]), pk(v[4], v[5]), pk(v[6], v[7])};
              *(u32x4*)(WSP(bf16, WS_DN_KD) + ((ud * 16 + frag) * 64 + lane) * 8) = w; }
        }
        if (tid == 0) WSP(float, WS_DN_EG)[ud] = fexp(glast);
    }
    __syncthreads();
    {
        float* DB = (float*)(lds + L_DB);
        if (wave < 2) { const int b = lane >> 4, c = lane & 15; const float* Lbb = (wave ? L1 : L0) + (16 * b) * 64 + 16 * b; float x[16];
            inv16_rows<0>(x, Lbb, c);
#pragma unroll
            for (int i = 0; i < 16; ++i) DB[((wave * 4 + b) * 16 + i) * 16 + c] = x[i]; }
        __syncthreads();
        const int dir = __builtin_amdgcn_readfirstlane(tid >> 8), wq = __builtin_amdgcn_readfirstlane((tid >> 6) & 3); const float* L = dir ? L1 : L0; const size_t ud = unit * 2 + dir;
        const float* bv = beta_l + dir * 64; const float* bk = bk_l + dir * 64; const int m = lane & 15, q = lane >> 4;
        const f32x4v zero4 = {0.f, 0.f, 0.f, 0.f};
        bf16x8 A01[3], A23, Ad[4];
#pragma unroll
        for (int b = 1; b < 4; ++b) { const float* lr = L + (16 * b + m) * 64 + 4 * q; const f32x4v l0 = *(const f32x4v*)lr, l1 = (b >= 2) ? *(const f32x4v*)(lr + 16) : zero4; A01[b - 1] = pack8(-l0, -l1); }
        { const float* lr = L + (48 + m) * 64 + 32 + 4 * q; A23 = pack8(-*(const f32x4v*)lr, zero4); }
#pragma unroll
        for (int b = 0; b < 4; ++b) Ad[b] = pack8(*(const f32x4v*)(DB + ((dir * 4 + b) * 16 + m) * 16 + 4 * q), zero4);
#pragma unroll
        for (int nt4 = 0; nt4 < 4; ++nt4) { const int col = 64 * wq + 16 * nt4 + m; f32x4v X[4];
#pragma unroll
            for (int b = 0; b < 4; ++b) { f32x4v acc;
#pragma unroll
                for (int r = 0; r < 4; ++r) { const int i = 16 * b + 4 * q + r, ti = dir ? 63 - i : i; acc[r] = (wq < 2) ? bv[i] * Vl[ti * 128 + col] : bk[i] * bf2f(Kl[ti * KP + (col - 128)]); }
                if (b >= 1) acc = MFMA16(A01[b - 1], pack8(X[0], b >= 2 ? X[1] : zero4), acc);
                if (b == 3) acc = MFMA16(A23, pack8(X[2], zero4), acc);
                X[b] = MFMA16(Ad[b], pack8(acc, zero4), zero4); }
            if (wq < 2) { float* o = WSP(float, WS_DN_UT) + (ud * 128 + col) * 64 + 4 * q;
#pragma unroll
                for (int b = 0; b < 4; ++b) *(f32x4v*)(o + 16 * b) = X[b];
            } else { const int d = col - 128, s = d >> 5, qd = (d >> 2) & 3, jv = 4 * ((d >> 4) & 1) + (d & 3); bf16* o = (bf16*)(lds + L_AKK) + dir * 16 * 512;
#pragma unroll
                for (int b = 0; b < 4; ++b)
#pragma unroll
                    for (int r = 0; r < 4; ++r) o[((b * 4 + s) * 64 + (4 * q + r) + 16 * qd) * 8 + jv] = f2bf(-X[b][r]); }
        }
    }
    __syncthreads();
    {
        u32x4* dst = (u32x4*)(WSP(bf16, WS_DN_WN) + unit * 2 * 16 * 512); const u32x4* src = (const u32x4*)(lds + L_AKK);
#pragma unroll
        for (int e = 0; e < 4; ++e) dst[tid + 512 * e] = src[tid + 512 * e];
    }
}
constexpr int SC_WN = 0, SC_QE = 16384, SC_IN = 32768, SC_KD = 40960, SC_BUF = 57344;
__device__ __forceinline__ void dn_scan_chain(const P& p, int chain, char* lds, int tid_in) {
    int tid_ = tid_in; asm volatile("" : "+v"(tid_));
    const int tid = tid_, lane = tid & 63, wave = tid >> 6, n = lane & 15, q = lane >> 4, n0 = wave * 16;
    const int dir = chain & 1, sh = chain >> 1, hh = sh % NH, seq = sh / NH;
    f32x4v Sacc[8];
#pragma unroll
    for (int mt = 0; mt < 8; ++mt) Sacc[mt] = (f32x4v){0.f, 0.f, 0.f, 0.f};
    bf16* O = WSP(bf16, dir ? WS_OB : WS_OF);
    u32x4 st0[7], st1[7];
#define SC_UD(step) (((size_t)sh * (S / 64) + (dir ? S / 64 - 1 - (step) : (step))) * 2 + dir)
#define SC_LOAD(st, ud) do { const u32x4* a = (const u32x4*)WSP(bf16, WS_DN_WN) + (ud) * 1024 + tid; const u32x4* b = (const u32x4*)WSP(bf16, WS_DN_QE) + (ud) * 1024 + tid; \
        const u32x4* c = (const u32x4*)WSP(bf16, WS_DN_IN) + (ud) * 512 + tid; const u32x4* d = (const u32x4*)WSP(bf16, WS_DN_KD) + (ud) * 1024 + tid; \
        st[0] = a[0]; st[1] = a[512]; st[2] = b[0]; st[3] = b[512]; st[4] = c[0]; st[5] = d[0]; st[6] = d[512]; } while (0)
#define SC_WRITE(st, buf) do { char* b_ = lds + (buf) * SC_BUF + tid * 16; *(u32x4*)(b_ + SC_WN) = st[0]; *(u32x4*)(b_ + SC_WN + 8192) = st[1]; *(u32x4*)(b_ + SC_QE) = st[2]; *(u32x4*)(b_ + SC_QE + 8192) = st[3]; \
        *(u32x4*)(b_ + SC_IN) = st[4]; *(u32x4*)(b_ + SC_KD) = st[5]; *(u32x4*)(b_ + SC_KD + 8192) = st[6]; } while (0)
    f32x4v ut0[4], ut1[4]; float eg0, eg1;
#define SC_LOADU(ut, egv, ud) do { const float* u_ = WSP(float, WS_DN_UT) + ((ud) * 128 + n0 + n) * 64 + 4 * q; _Pragma("unroll") for (int mt = 0; mt < 4; ++mt) ut[mt] = *(const f32x4v*)(u_ + 16 * mt); egv = WSP(float, WS_DN_EG)[ud]; } while (0)
    { const size_t ud0 = SC_UD(0), ud1 = SC_UD(1), ud2 = SC_UD(2); SC_LOAD(st0, ud0); SC_LOADU(ut0, eg0, ud0); SC_LOAD(st1, ud1); SC_LOADU(ut1, eg1, ud1); SC_WRITE(st0, 0); SC_LOAD(st0, ud2); }
    __syncthreads();
#define SC_STEP(step, stY, utX, egX) do { \
        const int c = dir ? S / 64 - 1 - (step) : (step); \
        if ((step) + 1 < S / 64) SC_WRITE(stY, ((step) + 1) & 1);                                       \
        if ((step) + 3 < S / 64) { const size_t udn = SC_UD((step) + 3); SC_LOAD(stY, udn); } \
        f32x4v vn[4], o[4]; const float eg = egX; \
        _Pragma("unroll") for (int mt = 0; mt < 4; ++mt) { vn[mt] = utX[mt]; o[mt] = (f32x4v){0.f, 0.f, 0.f, 0.f}; } \
        if ((step) + 2 < S / 64) { const size_t udu = SC_UD((step) + 2); SC_LOADU(utX, egX, udu); } \
        const char* fb = lds + ((step) & 1) * SC_BUF + lane * 16; \
        bf16x8 Sb[4]; \
        _Pragma("unroll") for (int s = 0; s < 4; ++s) Sb[s] = pack8(Sacc[2 * s], Sacc[2 * s + 1]); \
        _Pragma("unroll") for (int mt = 0; mt < 4; ++mt) \
            _Pragma("unroll") for (int s = 0; s < 4; ++s) { vn[mt] = MFMA16(*(const bf16x8*)(fb + SC_WN + (mt * 4 + s) * 1024), Sb[s], vn[mt]); o[mt] = MFMA16(*(const bf16x8*)(fb + SC_QE + (mt * 4 + s) * 1024), Sb[s], o[mt]); } \
        bf16x8 Vb[2]; \
        _Pragma("unroll") for (int s = 0; s < 2; ++s) Vb[s] = pack8(vn[2 * s], vn[2 * s + 1]); \
        _Pragma("unroll") for (int mt = 0; mt < 4; ++mt) \
            _Pragma("unroll") for (int s = 0; s < 2; ++s) o[mt] = MFMA16(*(const bf16x8*)(fb + SC_IN + (mt * 2 + s) * 1024), Vb[s], o[mt]); \
        const long tbase = (long)seq * S + (long)c * 64; \
        _Pragma("unroll") for (int mt = 0; mt < 4; ++mt) \
            _Pragma("unroll") for (int r = 0; r < 4; ++r) { const int i = 16 * mt + 4 * q + r, ti = dir ? 63 - i : i; O[((size_t)(tbase + ti) * NH + hh) * DH + n0 + n] = f2bf(o[mt][r]); } \
        _Pragma("unroll") for (int mt = 0; mt < 8; ++mt) { f32x4v a = Sacc[mt] * eg; \
            _Pragma("unroll") for (int s = 0; s < 2; ++s) a = MFMA16(*(const bf16x8*)(fb + SC_KD + (mt * 2 + s) * 1024), Vb[s], a); \
            Sacc[mt] = a; } \
        __syncthreads(); } while (0)
#pragma unroll 1
    SC_STEP(0, st1, ut0, eg0); SC_STEP(1, st0, ut1, eg1);
#pragma unroll 1
    for (int step = 2; step < S / 64; step += 2) { SC_STEP(step, st1, ut0, eg0); SC_STEP(step + 1, st0, ut1, eg1); }
#undef SC_STEP
#undef SC_UD
#undef SC_LOAD
#undef SC_LOADU
#undef SC_WRITE
}
#undef MFMA16
}
constexpr int NWAVES = 8, NTHR = 512;
constexpr int RING_BYTES = 131072, LDSCTL_OFF = 158720, MISC_OFF = LDSCTL_OFF + 320, LDS_BYTES = 159744;
#define LAS __attribute__((address_space(3)))
#define GAS __attribute__((address_space(1)))
typedef unsigned v4u __attribute__((ext_vector_type(4)));
typedef float f32x4 __attribute__((ext_vector_type(4)));
#define LDS_WAIT() asm volatile("s_waitcnt lgkmcnt(0)" ::: "memory")
#define XB_TMO      128
#define XB_XCNT(j)  (256  + 64 * (j))
#define XB_XSUB(j)  (1280 + 64 * (j))
#define XB_XGEN(j)  (2304 + 64 * (j))
#define XB_TOP      3328
#define XB_TOPGEN   3392
#define XCD_BAR_WORDS 3456
#define XB_SPIN_CAP (1u << 22)
__device__ __forceinline__ unsigned xb_ld(unsigned* p)              { return __hip_atomic_load(p, __ATOMIC_RELAXED, __HIP_MEMORY_SCOPE_AGENT); }
__device__ __forceinline__ unsigned xb_add(unsigned* p, unsigned v) { return __hip_atomic_fetch_add(p, v, __ATOMIC_RELAXED, __HIP_MEMORY_SCOPE_AGENT); }
__device__ __forceinline__ unsigned xb_xcc_id() { return (unsigned)__builtin_amdgcn_s_getreg((3 << 11) | 20) & 0xFu; }
#define XB_SPIN(cond, bar) do { unsigned _sp = 0; while (cond) { __builtin_amdgcn_s_sleep(1); \
    if ((++_sp & 255u) == 0u) { if (xb_ld(&(bar)[XB_TMO])) break; if (_sp > XB_SPIN_CAP) { atomicAdd(&(bar)[XB_TMO], 1u); break; } } } } while (0)
struct XcdBarrier { unsigned* bar; unsigned x; volatile LAS unsigned* st; };
__device__ __forceinline__ XcdBarrier xcd_barrier_post(unsigned* bar, volatile LAS unsigned* st) {
    XcdBarrier b; b.bar = bar; b.x = xb_xcc_id(); b.st = st;
    if (threadIdx.x == 0) (void)xb_add(&bar[XB_XCNT(b.x)], 1u);
    return b;
}
__device__ __forceinline__ void xcd_barrier_complete(unsigned* bar, unsigned x, unsigned& nloc, unsigned& nx) {
    const unsigned G = gridDim.x * gridDim.y * gridDim.z;
    unsigned sum, cnt, mine, sp = 0u;
    for (;;) {
        sum = 0u; cnt = 0u; mine = 0u;
#pragma unroll
        for (unsigned j = 0; j < 16; ++j) { const unsigned c = xb_ld(&bar[XB_XCNT(j)]); sum += c; cnt += (c > 0u) ? 1u : 0u; mine = (j == x) ? c : mine; }
        if (sum == G) break;
        __builtin_amdgcn_s_sleep(1);
        if ((++sp & 255u) == 0u) { if (xb_ld(&bar[XB_TMO])) break; if (sp > XB_SPIN_CAP) { atomicAdd(&bar[XB_TMO], 1u); break; } }
    }
    nloc = mine > 0u ? mine : 1u; nx = cnt > 0u ? cnt : 1u;
}
__device__ __forceinline__ void xcd_barrier(const XcdBarrier& b, int tid_in) {
    asm volatile("s_waitcnt vmcnt(0)" ::: "memory");
    __syncthreads();
    if (tid_in == 0) {
        unsigned* bar = b.bar; const unsigned bx = xb_xcc_id();
        __builtin_amdgcn_s_waitcnt(0);
        unsigned nloc = b.st[0], nx = b.st[1];
        if (nloc == 0u) { xcd_barrier_complete(bar, bx, nloc, nx); b.st[0] = nloc; b.st[1] = nx; }
        const unsigned old = xb_add(&bar[XB_XSUB(bx)], 1u);
        const unsigned gen = old / nloc;
        if (old + 1u == (gen + 1u) * nloc) {
            __builtin_amdgcn_fence(__ATOMIC_RELEASE, "agent");
            asm volatile("s_waitcnt vmcnt(0)" ::: "memory");
            const unsigned og = xb_add(&bar[XB_TOP], 1u);
            const unsigned tg = og / nx;
            if (og + 1u == (tg + 1u) * nx) xb_add(&bar[XB_TOPGEN], 1u);
            else XB_SPIN(xb_ld(&bar[XB_TOPGEN]) == tg, bar);
            __builtin_amdgcn_fence(__ATOMIC_ACQUIRE, "agent");
            xb_add(&bar[XB_XGEN(bx)], 1u);
            asm volatile("s_waitcnt vmcnt(0)" ::: "memory");
        } else {
            XB_SPIN(xb_ld(&bar[XB_XGEN(bx)]) == gen, bar);
            __builtin_amdgcn_fence(__ATOMIC_ACQUIRE, "agent");
            asm volatile("s_waitcnt vmcnt(0)" ::: "memory");
        }
    }
    __syncthreads();
}
constexpr size_t CTL_ZERO_BYTES = 65536; constexpr int CW_BAR = 1024;

__device__ __forceinline__ float wave_sum(float v) {
#pragma unroll
    for (int o = 1; o < 64; o <<= 1) v += __shfl_xor(v, o);
    return v;
}
constexpr long N_SCAN4 = N_SCAN * 4;
__device__ __forceinline__ void st_dn_scan4(const P& p, long g) {
    const int part = (int)(g & 3); const long g1 = g >> 2;
    const int vc = (int)(g1 % DH); const int dir = (int)((g1 / DH) % 2); const int hh = (int)((g1 / (2 * DH)) % NH); const int seq = (int)(g1 / (2 * DH * NH));
    const float *QN = WSP(float, WS_QN), *KN = WSP(float, WS_KN), *VV = WSP(float, WS_VV), *G = WSP(float, WS_G), *BT = WSP(float, WS_BETA);
    float* O = WSP(float, dir ? WS_OB : WS_OF);
    float Sx[32];
#pragma unroll
    for (int d = 0; d < 32; ++d) Sx[d] = 0.f;
    for (int step = 0; step < S; ++step) {
        const int tt = dir ? S - 1 - step : step; const long t = (long)seq * S + tt;
        const float eg = expf(G[(t * 2 + dir) * NH + hh]), b = BT[(t * 2 + dir) * NH + hh];
        const float* kp = KN + ((size_t)t * NH + hh) * DH + part * 32; const float* qp = QN + ((size_t)t * NH + hh) * DH + part * 32; const float vv = VV[((size_t)t * NH + hh) * DH + vc];
        float dot = 0.f;
#pragma unroll
        for (int d = 0; d < 32; ++d) { Sx[d] *= eg; dot += Sx[d] * kp[d]; }
        dot += __shfl_xor(dot, 1); dot += __shfl_xor(dot, 2);
        const float delta = b * (vv - dot); float o = 0.f;
#pragma unroll
        for (int d = 0; d < 32; ++d) { Sx[d] += kp[d] * delta; o += Sx[d] * qp[d]; }
        o += __shfl_xor(o, 1); o += __shfl_xor(o, 2);
        if (part == 0) O[((size_t)t * NH + hh) * DH + vc] = o;
    }
}
__device__ __forceinline__ unsigned pk2(float lo, float hi) { return (unsigned)f2bf(lo) | ((unsigned)f2bf(hi) << 16); }
template <int ST> __device__ __forceinline__ void grid_items(const Job& j, long n, int tid_in) {
    int t_ = tid_in; asm volatile("" : "+v"(t_));
    for (long g = (long)blockIdx.x * NTHR + t_; g < n; g += (long)gridDim.x * NTHR) run_item<ST>(j, g);
}
__device__ __forceinline__ void transpose_item(const float* W, int K, int N, bf16* WT, LAS float* scr, int item, int lane, int GU = 0) {
    const int nblk_src = (N + 63) / 64; const int kblks = K / 64; const int KBL = kblks < 16 ? kblks : 16, NBL = 64 / KBL, kbb = kblks / KBL;
    const int blk = item >> 6, within = item & 63; const int kb = (blk % kbb) * KBL + (within % KBL), nb = (blk / kbb) * NBL + (within / KBL), k0 = 64 * kb, n0 = 64 * nb;
    const int n0s = GU ? (((n0 >> 7) & 1) * DFF + (n0 >> 8) * 128 + (n0 & 127)) : n0;
    const int c = lane & 7;
    if (nb >= nblk_src) {
#pragma unroll
        for (int jj = 0; jj < 8; ++jj) { const int n = (lane >> 3) + 8 * jj; *(GAS v4u*)(WT + (size_t)(n0 + n) * K + k0 + 8 * c) = (v4u){0u, 0u, 0u, 0u}; }
        return;
    }
    {
        f32x4 v[16]; const int kq = lane >> 4, nn = (lane & 15) * 4;
#pragma unroll
        for (int i = 0; i < 16; ++i) v[i] = (n0s + nn < N) ? *(const f32x4*)(W + (size_t)(k0 + 4 * i + kq) * N + n0s + nn) : (f32x4){0.f, 0.f, 0.f, 0.f};
#pragma unroll
        for (int i = 0; i < 16; ++i) { LAS float* d = scr + (4 * i + kq) * 65 + nn; d[0] = v[i].x; d[1] = v[i].y; d[2] = v[i].z; d[3] = v[i].w; }
    }
    LDS_WAIT(); asm volatile("" ::: "memory");
#pragma unroll
    for (int jj = 0; jj < 8; ++jj) { const int n = (lane >> 3) + 8 * jj; const LAS float* s_ = scr + (8 * c) * 65 + n;
        v4u o; o.x = pk2(s_[0 * 65], s_[1 * 65]); o.y = pk2(s_[2 * 65], s_[3 * 65]); o.z = pk2(s_[4 * 65], s_[5 * 65]); o.w = pk2(s_[6 * 65], s_[7 * 65]);
        *(GAS v4u*)(WT + (size_t)(n0 + n) * K + k0 + 8 * c) = o; }
    LDS_WAIT(); asm volatile("" ::: "memory");
}
__device__ __forceinline__ void pb_phase(const P& p, int tid_in) {
    int t_ = tid_in; asm volatile("" : "+v"(t_));
    constexpr long np8 = (long)NPROMPT * S * PLE / 8, ns8 = (long)(NSEQ - NPROMPT) * S * PLE / 8, n8 = np8 + ns8;
    for (int layer = 0; layer < DEPTH; ++layer) {
        const float* pp = p.p_prompt + (size_t)layer * np8 * 8; const float* ps = p.p_sample + (size_t)layer * ns8 * 8; bf16* o = WSP(bf16, WS_PB + (size_t)layer * SZ_PB);
#pragma unroll 2
        for (long g = (long)blockIdx.x * NTHR + t_; g < n8; g += (long)gridDim.x * NTHR) { const float* src = g < np8 ? pp + g * 8 : ps + (g - np8) * 8;
            const f32x4 a = *(const f32x4*)src, b = *(const f32x4*)(src + 4); v4u w; w.x = pk2(a.x, a.y); w.y = pk2(a.z, a.w); w.z = pk2(b.x, b.y); w.w = pk2(b.z, b.w); *(v4u*)(o + g * 8) = w; }
    }
}
__device__ __forceinline__ float fast_sigmoid(float x) { return __builtin_amdgcn_rcpf(1.0f + __builtin_amdgcn_exp2f(-1.4426950408889634f * x)); }
template <int MODE> __device__ __forceinline__ void row_phase(const P& p, const float* wa, const float* wn, int gw, int ngw, int lane) {
    constexpr int NV = D / 256;
    asm volatile("" : "+v"(lane));
    f32x4 hN[NV]; unsigned long long hB[NV], yN[NV], pN[NV];
#define ROW_LOAD(t_) do { const long tt_ = (t_); \
        if (MODE == 0) { const long np = (long)NPROMPT * S * D; const float* src = (tt_ * D < np) ? p.x_prompt + (size_t)tt_ * D : p.x_sample + ((size_t)tt_ * D - np); \
            _Pragma("unroll") for (int i = 0; i < NV; ++i) hN[i] = *(const f32x4*)(src + (i * 64 + lane) * 4); } \
        else { const bf16* hr_ = WSP(bf16, WS_H16) + (size_t)tt_ * D; const bf16* yr_ = WSP(bf16, WS_GOUT) + (size_t)tt_ * D; \
            _Pragma("unroll") for (int i = 0; i < NV; ++i) { hB[i] = *(const unsigned long long*)(hr_ + (i * 64 + lane) * 4); yN[i] = *(const unsigned long long*)(yr_ + (i * 64 + lane) * 4); } \
            if (MODE == 3) { const bf16* pr_ = WSP(bf16, WS_PP2) + (size_t)tt_ * D; _Pragma("unroll") for (int i = 0; i < NV; ++i) pN[i] = *(const unsigned long long*)(pr_ + (i * 64 + lane) * 4); } } } while (0)
#define UNPK(q_) (f32x4){bf2f((bf16)((q_) & 0xffff)), bf2f((bf16)(((q_) >> 16) & 0xffff)), bf2f((bf16)(((q_) >> 32) & 0xffff)), bf2f((bf16)((q_) >> 48))}
    if (gw < T) ROW_LOAD(gw);
    for (int t = gw; t < T; t += ngw) {
        f32x4 h[NV], y[NV], pp[NV];
#pragma unroll
        for (int i = 0; i < NV; ++i) { if (MODE == 0) h[i] = hN[i]; else { h[i] = UNPK(hB[i]); y[i] = UNPK(yN[i]); } if (MODE == 3) pp[i] = UNPK(pN[i]); }
        if (t + ngw < T) ROW_LOAD(t + ngw);
        if (MODE == 1 || MODE == 2) {
            float ss = 0.f;
#pragma unroll
            for (int i = 0; i < NV; ++i) ss += (y[i].x * y[i].x + y[i].y * y[i].y) + (y[i].z * y[i].z + y[i].w * y[i].w);
            const float r = 1.0f / sqrtf(wave_sum(ss) * (1.0f / D) + RMS_EPS);
#pragma unroll
            for (int i = 0; i < NV; ++i) { const f32x4 w = *(const f32x4*)(wa + (i * 64 + lane) * 4); h[i] = h[i] + y[i] * r * w; }
        } else if (MODE == 3) {
#pragma unroll
            for (int i = 0; i < NV; ++i) { h[i].x += fast_sigmoid(y[i].x) * pp[i].x; h[i].y += fast_sigmoid(y[i].y) * pp[i].y; h[i].z += fast_sigmoid(y[i].z) * pp[i].z; h[i].w += fast_sigmoid(y[i].w) * pp[i].w; }
        }
        if (MODE == 3 && wn == nullptr) { float* hr = p.h + (size_t)t * D;
#pragma unroll
            for (int i = 0; i < NV; ++i) *(f32x4*)(hr + (i * 64 + lane) * 4) = h[i];
            continue; }
        { bf16* hw = WSP(bf16, WS_H16) + (size_t)t * D;
#pragma unroll
            for (int i = 0; i < NV; ++i) *(unsigned long long*)(hw + (i * 64 + lane) * 4) = (unsigned long long)pk2(h[i].x, h[i].y) | ((unsigned long long)pk2(h[i].z, h[i].w) << 32); }
        if (MODE == 2) continue;
        float r2 = 1.f;
        if (MODE != 2) { float ss = 0.f;
#pragma unroll
            for (int i = 0; i < NV; ++i) ss += (h[i].x * h[i].x + h[i].y * h[i].y) + (h[i].z * h[i].z + h[i].w * h[i].w);
            r2 = 1.0f / sqrtf(wave_sum(ss) * (1.0f / D) + RMS_EPS); }
        bf16* o = WSP(bf16, WS_HN) + (size_t)t * D;
#pragma unroll
        for (int i = 0; i < NV; ++i) { f32x4 v = h[i] * r2; if (MODE != 2) { const f32x4 w = *(const f32x4*)(wn + (i * 64 + lane) * 4); v = v * w; }
            *(unsigned long long*)(o + (i * 64 + lane) * 4) = (unsigned long long)pk2(v.x, v.y) | ((unsigned long long)pk2(v.z, v.w) << 32); }
    }
#undef ROW_LOAD
#undef UNPK
}

typedef short bf16x8_t __attribute__((ext_vector_type(8)));
__device__ __forceinline__ float gelu_fast(float x) { const float u = 0.7978845608028654f * (x + 0.044715f * x * x * x); return x * __builtin_amdgcn_rcpf(1.0f + __builtin_amdgcn_exp2f(-2.885390081777927f * u)); }
__device__ __forceinline__ void ffn_act_phase(const P& p, int layer, int gw, int ngw, int lane) {
    asm volatile("" : "+v"(lane));
    constexpr int TT = 32, NCB = DFF / 512, NIT = (T / TT) * NCB;
    const bf16* hid = WSP(bf16, WS_HID); bf16* act = WSP(bf16, WS_ACT);
    const float* cw = PRM(PR_FCW) + (size_t)layer * 3 * 2 * DFF; const float* cb = PRM(PR_FCB) + (size_t)layer * 2 * DFF;
    for (int it = gw; it < NIT; it += ngw) {
        const int cblk = it % NCB, tile = it / NCB; const int c0 = cblk * 512 + lane * 8; const long t0 = (long)tile * TT; const int tt0 = (int)(t0 % S);
        float wg[3][8], wu[3][8], bg[8], bu[8];
#pragma unroll
        for (int i = 0; i < 3; ++i)
#pragma unroll
            for (int e = 0; e < 8; ++e) { wg[i][e] = cw[i * 2 * DFF + c0 + e]; wu[i][e] = cw[i * 2 * DFF + DFF + c0 + e]; }
#pragma unroll
        for (int e = 0; e < 8; ++e) { bg[e] = cb[c0 + e]; bu[e] = cb[DFF + c0 + e]; }
        const bf16x8_t zero8 = {0, 0, 0, 0, 0, 0, 0, 0};
        bf16x8_t g0 = zero8, u0 = zero8, g1, u1, g2, u2;
        if (tt0 > 0) { g0 = *(const bf16x8_t*)(hid + (size_t)(t0 - 1) * (2 * DFF) + c0); u0 = *(const bf16x8_t*)(hid + (size_t)(t0 - 1) * (2 * DFF) + DFF + c0); }
        g1 = *(const bf16x8_t*)(hid + (size_t)t0 * (2 * DFF) + c0); u1 = *(const bf16x8_t*)(hid + (size_t)t0 * (2 * DFF) + DFF + c0);
        for (int k = 0; k < TT; ++k) {
            const long t = t0 + k;
            if (tt0 + k + 1 < S) { g2 = *(const bf16x8_t*)(hid + (size_t)(t + 1) * (2 * DFF) + c0); u2 = *(const bf16x8_t*)(hid + (size_t)(t + 1) * (2 * DFF) + DFF + c0); } else { g2 = zero8; u2 = zero8; }
            float o[8];
#pragma unroll
            for (int e = 0; e < 8; ++e) {
                const float ga = bg[e] + bf2f((bf16)g0[e]) * wg[0][e] + bf2f((bf16)g1[e]) * wg[1][e] + bf2f((bf16)g2[e]) * wg[2][e];
                const float up = bu[e] + bf2f((bf16)u0[e]) * wu[0][e] + bf2f((bf16)u1[e]) * wu[1][e] + bf2f((bf16)u2[e]) * wu[2][e];
                o[e] = gelu_fast(ga) * up; }
            v4u w; w.x = pk2(o[0], o[1]); w.y = pk2(o[2], o[3]); w.z = pk2(o[4], o[5]); w.w = pk2(o[6], o[7]);
            *(v4u*)(act + (size_t)t * DFF + c0) = w;
            g0 = g1; u0 = u1; g1 = g2; u1 = u2;
        }
    }
}
__device__ __forceinline__ void dn_out_phase(const P& p, int jl, int gw, int ngw, int lane) {
    asm volatile("" : "+v"(lane));
    const int hh = lane >> 3, d0 = (lane & 7) * 16; const float* on = PRM(PR_ONORM) + jl * DH + d0;
    bf16x8_t aN[2], bN[2], zN0, zN1;
#define DNO_LOAD(t_) do { const bf16* of_ = WSP(bf16, WS_OF) + ((size_t)(t_) * NH + hh) * DH + d0; const bf16* ob_ = WSP(bf16, WS_OB) + ((size_t)(t_) * NH + hh) * DH + d0; \
        const bf16* z_ = WSP(bf16, WS_PROJ) + (size_t)(t_) * ABINP + COL_Z + hh * DH + d0; \
        aN[0] = *(const bf16x8_t*)of_; aN[1] = *(const bf16x8_t*)(of_ + 8); bN[0] = *(const bf16x8_t*)ob_; bN[1] = *(const bf16x8_t*)(ob_ + 8); zN0 = *(const bf16x8_t*)z_; zN1 = *(const bf16x8_t*)(z_ + 8); } while (0)
    if (gw < T) DNO_LOAD(gw);
    for (int t = gw; t < T; t += ngw) {
        float o[16]; float ss = 0.f; const bf16x8_t z0 = zN0, z1 = zN1;
#pragma unroll
        for (int c8 = 0; c8 < 2; ++c8)
#pragma unroll
            for (int e = 0; e < 8; ++e) { o[8 * c8 + e] = bf2f((bf16)aN[c8][e]) + bf2f((bf16)bN[c8][e]); ss += o[8 * c8 + e] * o[8 * c8 + e]; }
        if (t + ngw < T) DNO_LOAD(t + ngw);
        ss += __shfl_xor(ss, 1); ss += __shfl_xor(ss, 2); ss += __shfl_xor(ss, 4);
        const float r = 1.0f / sqrtf(ss * (1.0f / DH) + RMS_EPS); float v[16];
#pragma unroll
        for (int e = 0; e < 16; ++e) { const float zz = bf2f((bf16)(e < 8 ? z0[e] : z1[e - 8])); v[e] = o[e] * r * on[e] * zz * fast_sigmoid(zz); }
        bf16* out = WSP(bf16, WS_MIXIN) + (size_t)t * ABMIX + hh * DH + d0;
        v4u w0, w1; w0.x = pk2(v[0], v[1]); w0.y = pk2(v[2], v[3]); w0.z = pk2(v[4], v[5]); w0.w = pk2(v[6], v[7]); w1.x = pk2(v[8], v[9]); w1.y = pk2(v[10], v[11]); w1.z = pk2(v[12], v[13]); w1.w = pk2(v[14], v[15]);
        *(v4u*)out = w0; *(v4u*)(out + 8) = w1;
    }
#undef DNO_LOAD
}
__device__ __forceinline__ void c_out_phase(const P& p, int jl, int gw, int ngw, int lane) {
    asm volatile("" : "+v"(lane));
    const int hh = lane >> 3, e0 = (lane & 7) * 32; const float lam = WSP(float, WS_LAM)[0], li = WSP(float, WS_LAM)[1]; const float* sw = PRM(PR_SUBLN) + jl * 256 + e0;
    bf16x8_t aN[4], bN[4];
#define CO_LOAD(t_) do { const bf16* o0_ = WSP(bf16, WS_O0) + (size_t)(t_) * 2048 + hh * 256 + e0; const bf16* o1_ = WSP(bf16, WS_O1) + (size_t)(t_) * 2048 + hh * 256 + e0; \
        _Pragma("unroll") for (int c8 = 0; c8 < 4; ++c8) { aN[c8] = *(const bf16x8_t*)(o0_ + 8 * c8); bN[c8] = *(const bf16x8_t*)(o1_ + 8 * c8); } } while (0)
    if (gw < T) CO_LOAD(gw);
    for (int t = gw; t < T; t += ngw) {
        float o[32]; float ss = 0.f;
#pragma unroll
        for (int c8 = 0; c8 < 4; ++c8)
#pragma unroll
            for (int e = 0; e < 8; ++e) { o[8 * c8 + e] = bf2f((bf16)aN[c8][e]) - lam * bf2f((bf16)bN[c8][e]); ss += o[8 * c8 + e] * o[8 * c8 + e]; }
        if (t + ngw < T) CO_LOAD(t + ngw);
        ss += __shfl_xor(ss, 1); ss += __shfl_xor(ss, 2); ss += __shfl_xor(ss, 4);
        const float r = (1.0f / sqrtf(ss * (1.0f / 256.0f) + RMS_EPS)) * (1.0f - li);
        bf16* out = WSP(bf16, WS_MIXIN) + (size_t)t * 2048 + hh * 256 + e0;
#pragma unroll
        for (int c8 = 0; c8 < 4; ++c8) { v4u w; w.x = pk2(o[8 * c8] * r * sw[8 * c8], o[8 * c8 + 1] * r * sw[8 * c8 + 1]); w.y = pk2(o[8 * c8 + 2] * r * sw[8 * c8 + 2], o[8 * c8 + 3] * r * sw[8 * c8 + 3]);
            w.z = pk2(o[8 * c8 + 4] * r * sw[8 * c8 + 4], o[8 * c8 + 5] * r * sw[8 * c8 + 5]); w.w = pk2(o[8 * c8 + 6] * r * sw[8 * c8 + 6], o[8 * c8 + 7] * r * sw[8 * c8 + 7]); *(v4u*)(out + 8 * c8) = w; }
    }
#undef CO_LOAD
}
__device__ __forceinline__ void rope_table_phase(const P& p, int tid_in) {
    int t_ = tid_in; asm volatile("" : "+v"(t_));
    float* tab = WSP(float, WS_LAM) + 16;
    for (int g = (int)blockIdx.x * NTHR + t_; g < S * 16; g += (int)gridDim.x * NTHR) { const int i = g & 15, pos = g >> 4;
        const float inv = powf(500000.0f, -(float)(2 * i) / 32.0f); const float ang = (float)pos * inv; tab[2 * g] = cosf(ang); tab[2 * g + 1] = sinf(ang); }
}
__device__ __forceinline__ void rope_phase(const P& p, int tid_in) {
    int t_ = tid_in; asm volatile("" : "+v"(t_));
    const float* tab = WSP(const float, WS_LAM) + 16;
    for (long g = (long)blockIdx.x * NTHR + t_; g < (long)T * 32; g += (long)gridDim.x * NTHR) {
        const int hj = (int)(g & 15), which = (int)((g >> 4) & 1); const long t = g >> 5; const float* cs_ = tab + (size_t)(t % S) * 32;
        bf16* x = WSP(bf16, WS_PROJ) + (size_t)t * CIN + which * 2048 + hj * DH;
        bf16x8_t a0 = *(const bf16x8_t*)x, a1 = *(const bf16x8_t*)(x + 8), b0 = *(const bf16x8_t*)(x + 16), b1 = *(const bf16x8_t*)(x + 24); float r1[16], r2[16];
#pragma unroll
        for (int i = 0; i < 16; ++i) { const float cs = cs_[2 * i], sn = cs_[2 * i + 1];
            const float x1 = bf2f((bf16)(i < 8 ? a0[i] : a1[i - 8])), x2 = bf2f((bf16)(i < 8 ? b0[i] : b1[i - 8])); r1[i] = x1 * cs - x2 * sn; r2[i] = x2 * cs + x1 * sn; }
        v4u w;
        w.x = pk2(r1[0], r1[1]); w.y = pk2(r1[2], r1[3]); w.z = pk2(r1[4], r1[5]); w.w = pk2(r1[6], r1[7]); *(v4u*)x = w;
        w.x = pk2(r1[8], r1[9]); w.y = pk2(r1[10], r1[11]); w.z = pk2(r1[12], r1[13]); w.w = pk2(r1[14], r1[15]); *(v4u*)(x + 8) = w;
        w.x = pk2(r2[0], r2[1]); w.y = pk2(r2[2], r2[3]); w.z = pk2(r2[4], r2[5]); w.w = pk2(r2[6], r2[7]); *(v4u*)(x + 16) = w;
        w.x = pk2(r2[8], r2[9]); w.y = pk2(r2[10], r2[11]); w.z = pk2(r2[12], r2[13]); w.w = pk2(r2[14], r2[15]); *(v4u*)(x + 24) = w;
    }
}
__device__ __forceinline__ void ffn_fix_phase(const P& p, int layer, int tid_in) {
    int t_ = tid_in; asm volatile("" : "+v"(t_));
    const int ln = t_ & 63, gwv = (int)blockIdx.x * NWAVES + __builtin_amdgcn_readfirstlane(t_ >> 6), ngwv = (int)gridDim.x * NWAVES;
    const float* cw = PRM(PR_FCW) + (size_t)layer * 3 * 2 * DFF; const float* cb = PRM(PR_FCB) + (size_t)layer * 2 * DFF; const float* HALO = WSP(float, WS_HALO);
    constexpr int NP = T / 256, PPS = S / 256, NCB = DFF / 256;
    for (int g = gwv; g < NP * 2 * NCB; g += ngwv) {
        const int c0 = (g % NCB) * 256 + ln * 4; const int edge = (g / NCB) & 1; const int pm = g / (2 * NCB);
        const bool has_prev = edge ? true : (pm % PPS != 0), has_next = edge ? (pm % PPS != PPS - 1) : true;
        const float* rp = HALO + (((size_t)(edge ? pm : pm - 1) * 4 + (edge ? 2 : 3)) * 2) * DFF + c0;
        const float* rc = HALO + (((size_t)pm * 4 + (edge ? 3 : 0)) * 2) * DFF + c0;
        const float* rn = HALO + (((size_t)(edge ? pm + 1 : pm) * 4 + (edge ? 0 : 1)) * 2) * DFF + c0;
        const f32x4 z4 = {0.f, 0.f, 0.f, 0.f};
        f32x4 gp = z4, up = z4, gn = z4, un = z4;
        if (has_prev) { gp = *(const f32x4*)rp; up = *(const f32x4*)(rp + DFF); }
        if (has_next) { gn = *(const f32x4*)rn; un = *(const f32x4*)(rn + DFF); }
        const f32x4 gc = *(const f32x4*)rc, uc = *(const f32x4*)(rc + DFF);
        const f32x4 bg = *(const f32x4*)(cb + c0), bu = *(const f32x4*)(cb + DFF + c0);
        const f32x4 wg0 = *(const f32x4*)(cw + c0), wu0 = *(const f32x4*)(cw + DFF + c0), wg1 = *(const f32x4*)(cw + 2 * DFF + c0), wu1 = *(const f32x4*)(cw + 3 * DFF + c0),
                    wg2 = *(const f32x4*)(cw + 4 * DFF + c0), wu2 = *(const f32x4*)(cw + 5 * DFF + c0);
        float o[4];
#pragma unroll
        for (int e = 0; e < 4; ++e) {
            const float cg = bg[e] + wg0[e] * gp[e] + wg1[e] * gc[e] + wg2[e] * gn[e];
            const float cu = bu[e] + wu0[e] * up[e] + wu1[e] * uc[e] + wu2[e] * un[e];
            o[e] = pg8::gelu_t(cg) * cu; }
        *(unsigned long long*)(WSP(bf16, WS_ACT) + ((size_t)pm * 256 + (edge ? 255 : 0)) * DFF + c0) = (unsigned long long)pk2(o[0], o[1]) | ((unsigned long long)pk2(o[2], o[3]) << 32);
    }
}
__device__ __forceinline__ int hw_lane() { int l; asm volatile("v_mbcnt_lo_u32_b32 %0, -1, 0\n\tv_mbcnt_hi_u32_b32 %0, -1, %0" : "=v"(l)); return l; }
struct Args { P p; };
__global__ void __launch_bounds__(NTHR, 2) mega_fwd(Args args) {
    extern __shared__ __attribute__((aligned(16))) unsigned char lds_raw[];
    LAS unsigned char* lds = (LAS unsigned char*)lds_raw;
    const P& p = args.p;
    const int tid = threadIdx.x, wave = __builtin_amdgcn_readfirstlane(tid >> 6);
#define HWLANE hw_lane()
#define HWTID ((wave << 6) | HWLANE)
#define lane HWLANE
    const int G = gridDim.x; const int gw = blockIdx.x * NWAVES + wave, ngw = G * NWAVES;
    volatile LAS unsigned* MISC = (volatile LAS unsigned*)(lds + MISC_OFF);
    for (int u = tid; u < (LDS_BYTES - LDSCTL_OFF) / 4; u += NTHR) ((LAS unsigned*)(lds + LDSCTL_OFF))[u] = 0u;
    __syncthreads();
    XcdBarrier bar = xcd_barrier_post(WSP(unsigned, WS_CTL) + CW_BAR, MISC + 8);
    Job j; j.p = p; j.w.W = nullptr; j.w.O = nullptr; j.w.K = 0; j.w.N = 0; j.w.Npad = 0; j.a = nullptr; j.b = nullptr; j.n = 0; j.layer = 0; j.flag = 0;

    {
        LAS float* scr = (LAS float*)(lds + wave * 16640);
        for (int m = 0; m < 24; ++m) {
            const float* W; bf16* O; int K, N, Npad; const int i = m & 1, l = m & 3;
            if (m < 2)       { W = p.ab_w_in + (size_t)i * D * ABIN;  O = WSP(bf16, WS_WABIN + (size_t)i * ABINP * D * 2); K = D; N = ABIN; Npad = ABINP; }
            else if (m < 4)  { W = p.ab_w_out + (size_t)i * ABMIX * D; O = WSP(bf16, WS_WABOUT + (size_t)i * D * ABMIX * 2); K = ABMIX; N = D; Npad = D; }
            else if (m < 6)  { W = p.c_w_in + (size_t)i * D * CIN;    O = WSP(bf16, WS_WCIN + (size_t)i * CIN * D * 2); K = D; N = CIN; Npad = CIN; }
            else if (m < 8)  { W = p.c_w_out + (size_t)i * CV * D;    O = WSP(bf16, WS_WCOUT + (size_t)i * D * CV * 2); K = CV; N = D; Npad = D; }
            else if (m < 12) { W = p.ffn_w_in + (size_t)l * D * 2 * DFF; O = WSP(bf16, WS_WFIN + (size_t)l * 2 * DFF * D * 2); K = D; N = 2 * DFF; Npad = 2 * DFF; }
            else if (m < 16) { W = p.ffn_w_out + (size_t)l * DFF * D;  O = WSP(bf16, WS_WFOUT + (size_t)l * D * DFF * 2); K = DFF; N = D; Npad = D; }
            else if (m < 20) { W = p.ple_w_proj + (size_t)l * PLE * D; O = WSP(bf16, WS_WPP + (size_t)l * D * PLE * 2); K = PLE; N = D; Npad = D; }
            else             { W = p.ple_w_gate + (size_t)l * D * D;   O = WSP(bf16, WS_WPG + (size_t)l * D * D * 2); K = D; N = D; Npad = D; }
            const int nitems = (K / 64) * (Npad / 64);
            for (int it = gw; it < nitems; it += ngw) transpose_item(W, K, N, O, scr, it, lane, (m >= 8 && m < 12) ? 1 : 0);
        }
        rope_table_phase(p, HWTID);
        {
            int t_ = HWTID; asm volatile("" : "+v"(t_));
            if (blockIdx.x == 0 && t_ < 2) { const float* lp = p.c_lambda + (size_t)t_ * 4 * DH; float a = 0.f, b = 0.f;
                for (int d = 0; d < DH; ++d) { a += lp[d] * lp[DH + d]; b += lp[2 * DH + d] * lp[3 * DH + d]; }
                const float li = lambda_init_of(2 * t_ + 1); WSP(float, WS_LAM)[2 * t_] = expf(a) - expf(b) + li; WSP(float, WS_LAM)[2 * t_ + 1] = li; }
        }
        grid_items<ST_PRM>(j, N_PRM, HWTID);
        pb_phase(p, HWTID);
        row_phase<0>(p, nullptr, p.norms, gw, ngw, lane);
    }
    xcd_barrier(bar, HWTID);

    for (int layer = 0; layer < DEPTH; ++layer) {
        j.layer = layer; const int jj = layer >> 1; const float* nw = PRM(PR_NORMS) + (size_t)layer * 4 * D;
        {
            const bool ab = (layer & 1) == 0; const int N = ab ? ABINP : CIN;
            const bf16* Bt = ab ? WSP(bf16, WS_WABIN + (size_t)jj * ABINP * D * 2) : WSP(bf16, WS_WCIN + (size_t)jj * CIN * D * 2);
            pg8::Gemm g{WSP(bf16, WS_HN), Bt, T, N, D}; pg8::StaticOrder S_; S_.init(T, N, G, (int)blockIdx.x);
            pg8::EpiBf16Ro E{WSP(bf16, WS_PROJ), N, ab ? nullptr : WSP(const float, WS_LAM) + 16, S};
            pg8::gemm_phase<pg8::EpiBf16Ro, pg8::StaticOrder, true, true>(lds, g, S_, E, HWTID);
        }
        xcd_barrier(bar, HWTID);
        int pp_first = (int)blockIdx.x, pp_stride = G; bool pp_run = true;
        if ((layer & 1) == 0) {
            {
                constexpr int NU = NSEQ * NH * (S / 64);
                for (int u = (int)blockIdx.x; u < NU; u += G) dn::dn1_unit(p, jj, u / (NH * (S / 64)), (u / (S / 64)) % NH, u % (S / 64), (char*)lds_raw, HWTID);
            }
            xcd_barrier(bar, HWTID);
            constexpr int NSC = NSEQ * NH * 2; const bool split = G >= 2 * NSC; const int na_first = split ? (int)blockIdx.x - NSC : (int)blockIdx.x, na_stride = split ? G - NSC : G;
            if (!split || (int)blockIdx.x < NSC) { for (int ch = (int)blockIdx.x; ch < NSC; ch += G) dn::dn_scan_chain(p, ch, (char*)lds_raw, HWTID); }
            if (!split || (int)blockIdx.x >= NSC)
            {
                constexpr int NU = NSEQ * NH * (ROWS / 4);
                float* tab = (float*)((char*)lds_raw + att::SHM_ATTN);
                for (int u = na_first; u < NU; u += na_stride) {
                    const int rg = u % (ROWS / 4); const int hh = (u / (ROWS / 4)) % NH, seq = u / ((ROWS / 4) * NH); const int r0 = rg * 4;
                    const int kr0 = clampi(r0 - WR / 2, 0, ROWS - WR), krl = clampi(r0 + 3 - WR / 2, 0, ROWS - WR) + WR - 1; const int nt = krl - kr0 + 1;
                    { int t_ = HWTID; asm volatile("" : "+v"(t_)); if (t_ < 15 * 31) tab[t_] = PRM(PR_RPB)[((size_t)jj * NH + hh) * 15 * 31 + t_] * 11.313708498984761f; }
                    const bf16* base = WSP(bf16, WS_PROJ) + (size_t)seq * S * ABINP;
                    att::na_body<ABINP, ABINP, ABMIX>(base + (size_t)r0 * GW * ABINP + COL_QB + hh * DH, base + (size_t)kr0 * GW * ABINP + COL_KB + hh * DH, base + (size_t)kr0 * GW * ABINP + COL_VB + hh * DH,
                        WSP(bf16, WS_MIXIN) + ((size_t)seq * S + (size_t)r0 * GW) * ABMIX + 1024 + hh * DH, nt, (char*)lds_raw, att::NaInfo{r0, kr0, tab}, HWTID);
                    __syncthreads();
                }
            }
            pp_first = na_first; pp_stride = na_stride; pp_run = !split || (int)blockIdx.x >= NSC;
        } else {
            {
                constexpr int NU = NSEQ * NH * (S / 256);
                const int vcu = (G % 8 == 0) ? ((int)blockIdx.x % 8) * (G / 8) + (int)blockIdx.x / 8 : (int)blockIdx.x;
                const float lam = WSP(float, WS_LAM)[2 * jj], li = WSP(float, WS_LAM)[2 * jj + 1];
                for (int u = vcu; u < NU; u += G) {
                    const int qb = u % (S / 256); const int r_ = u / (S / 256); const int hh = r_ % NH, seq = r_ / NH;
                    const bf16* base = WSP(bf16, WS_PROJ) + (size_t)seq * S * CIN; const size_t oo = ((size_t)seq * S + (size_t)qb * 256) * 2048 + hh * 256;
#pragma unroll 1
                    for (int jj2 = 0; jj2 < 2; ++jj2) {
                        att::dattn256_body<CIN, CIN, 2048>(base + (size_t)qb * 256 * CIN + hh * 256 + jj2 * DH, base + 2048 + hh * 256 + jj2 * DH, base + 4096 + hh * 256,
                            WSP(bf16, WS_O0) + oo, S / 64, (char*)lds_raw, HWTID, jj2, WSP(bf16, WS_MIXIN) + oo, lam, 1.0f - li, PRM(PR_SUBLN) + jj * 256);
                        __syncthreads();
                    }
                }
            }
        }
        if (pp_run) {
            pg8::Gemm g{WSP(bf16, WS_PB + (size_t)layer * SZ_PB), WSP(bf16, WS_WPP + (size_t)layer * D * PLE * 2), T, D, PLE}; pg8::StaticOrder S_; S_.init(T, D, pp_stride, pp_first);
            pg8::EpiBf16 E{WSP(bf16, WS_PP2), D};
            pg8::gemm_phase<pg8::EpiBf16, pg8::StaticOrder, true, true>(lds, g, S_, E, HWTID);
        }
        xcd_barrier(bar, HWTID);
        if ((layer & 1) == 0) { dn_out_phase(p, jj, gw, ngw, lane); xcd_barrier(bar, HWTID); }
        {
            const bf16* Bt = (layer & 1) == 0 ? WSP(bf16, WS_WABOUT + (size_t)jj * D * ABMIX * 2) : WSP(bf16, WS_WCOUT + (size_t)jj * D * CV * 2);
            pg8::Gemm g{WSP(bf16, WS_MIXIN), Bt, T, D, 2048}; pg8::StaticOrder S_; S_.init(T, D, G, (int)blockIdx.x);
            pg8::EpiBf16 E{WSP(bf16, WS_GOUT), D};
            pg8::gemm_phase<pg8::EpiBf16, pg8::StaticOrder, true, true>(lds, g, S_, E, HWTID);
        }
        xcd_barrier(bar, HWTID);
        row_phase<1>(p, nw + D, nw + 2 * D, gw, ngw, lane);
        xcd_barrier(bar, HWTID);
        {
            pg8::Gemm g{WSP(bf16, WS_HN), WSP(bf16, WS_WFIN + (size_t)layer * 2 * DFF * D * 2), T, 2 * DFF, D}; pg8::StaticOrder S_; S_.init(T, 2 * DFF, G, (int)blockIdx.x);
            pg8::EpiConvAct E{WSP(bf16, WS_ACT), WSP(float, WS_HALO), WSP(float, WS_HALO) + (size_t)(T / 256) * 4 * 2 * DFF + 4096 * (int)blockIdx.x, PRM(PR_FCW) + (size_t)layer * 3 * 2 * DFF, PRM(PR_FCB) + (size_t)layer * 2 * DFF, (PG8_LAS float*)(lds + RING_BYTES)};
            pg8::gemm_phase<pg8::EpiConvAct, pg8::StaticOrder, true, true>(lds, g, S_, E, HWTID);
        }
        xcd_barrier(bar, HWTID);
        ffn_fix_phase(p, layer, HWTID);
        xcd_barrier(bar, HWTID);
        {
            pg8::Gemm g{WSP(bf16, WS_ACT), WSP(bf16, WS_WFOUT + (size_t)layer * D * DFF * 2), T, D, DFF}; pg8::StaticOrder S_; S_.init(T, D, G, (int)blockIdx.x);
            pg8::EpiBf16 E{WSP(bf16, WS_GOUT), D};
            pg8::gemm_phase<pg8::EpiBf16, pg8::StaticOrder, true, true>(lds, g, S_, E, HWTID);
        }
        xcd_barrier(bar, HWTID);
        row_phase<2>(p, nw + 3 * D, nullptr, gw, ngw, lane);
        xcd_barrier(bar, HWTID);
        {
            pg8::Gemm g{WSP(bf16, WS_H16), WSP(bf16, WS_WPG + (size_t)layer * D * D * 2), T, D, D}; pg8::StaticOrder S_; S_.init(T, D, G, (int)blockIdx.x);
            pg8::EpiBf16 E{WSP(bf16, WS_GOUT), D};
            pg8::gemm_phase<pg8::EpiBf16, pg8::StaticOrder, true, true>(lds, g, S_, E, HWTID);
        }
        xcd_barrier(bar, HWTID);
        row_phase<3>(p, nullptr, layer + 1 < DEPTH ? PRM(PR_NORMS) + (size_t)(layer + 1) * 4 * D : nullptr, gw, ngw, lane);
        if (layer + 1 < DEPTH) xcd_barrier(bar, HWTID);
    }
}

#undef lane
#undef HWTID
#undef HWLANE
extern "C" void kernel_launch(void* const* d_in, const int* in_sizes, int n_in, void* d_out, int out_size, void* d_ws, size_t ws_size, hipStream_t stream) {
    static int grid = 0;
    if (grid == 0) {
        if (n_in != 22 || out_size != T * D || ws_size < WS_END) { fprintf(stderr, "kernel_launch: unexpected shapes n_in %d out %d ws %zu (need %zu)\n", n_in, out_size, ws_size, (size_t)WS_END); grid = -1; return; }
        int dev = 0, cus = 0, per_cu = 0;
        if (hipGetDevice(&dev) != hipSuccess || hipDeviceGetAttribute(&cus, hipDeviceAttributeMultiprocessorCount, dev) != hipSuccess) { grid = -1; return; }
        if (hipFuncSetAttribute((const void*)mega_fwd, hipFuncAttributeMaxDynamicSharedMemorySize, LDS_BYTES) != hipSuccess) { fprintf(stderr, "kernel_launch: hipFuncSetAttribute failed\n"); grid = -1; return; }
        if (hipOccupancyMaxActiveBlocksPerMultiprocessor(&per_cu, (const void*)mega_fwd, NTHR, LDS_BYTES) != hipSuccess || per_cu < 1) fprintf(stderr, "kernel_launch: occupancy query reports %d blocks per CU\n", per_cu);
        (void)hipGetLastError();
        grid = cus;
    }
    if (grid < 0) return;
    if (hipMemsetAsync((char*)d_ws + WS_CTL, 0, CTL_ZERO_BYTES, stream) != hipSuccess) { fprintf(stderr, "kernel_launch: memset failed\n"); return; }
    Args a; memset(&a, 0, sizeof(a));
    const float** f = (const float**)&a.p;
    for (int i = 0; i < 22; ++i) f[i] = (const float*)d_in[i];
    a.p.h = (float*)d_out; a.p.ws = (unsigned char*)d_ws;
    hipLaunchKernelGGL(mega_fwd, dim3(grid), dim3(NTHR), LDS_BYTES, stream, a);
    const hipError_t le = hipPeekAtLastError();
    if (le != hipSuccess) fprintf(stderr, "kernel_launch: launch failed: %s\n", hipGetErrorName(le));
}
#else
int main(int argc, char** argv) {
    FILE* fs = fopen("sizes.txt", "r"); std::vector<long> sizes(22); for (int i = 0; i < 22; ++i) if (fscanf(fs, "%ld", &sizes[i]) != 1) return 1; fclose(fs);
    FILE* fi = fopen("inputs.bin", "rb"); std::vector<std::vector<float>> in(22);
    for (int i = 0; i < 22; ++i) { in[i].resize(sizes[i]); if (fread(in[i].data(), 4, sizes[i], fi) != (size_t)sizes[i]) return 2; } fclose(fi);
    std::vector<float> out((size_t)T * D); std::vector<unsigned char> ws(WS_END, 0xAA);
    printf("T %d D %d WS_END %zu MiB\n", T, D, (size_t)(WS_END / MiB));
    P p; memset(&p, 0, sizeof(p)); const float** f = (const float**)&p; for (int i = 0; i < 22; ++i) f[i] = in[i].data();
    p.h = out.data(); p.ws = ws.data();
    forward(p);
    FILE* fo = fopen("emu_out.bin", "wb"); fwrite(out.data(), 4, out.size(), fo); fclose(fo);
    return 0;
}
#endif
```

```cpp
#ifndef EMU
#include <hip/hip_runtime.h>
#include <cstdio>
#include <cstdint>
#include <cstring>
#define DEVFN __device__ __forceinline__
#define MEMFENCE() asm volatile("" ::: "memory")
#else
#include <cstdio>
#include <cstdint>
#include <cstdlib>
#include <cstring>
#include <cmath>
#include <vector>
#define DEVFN static inline
#define MEMFENCE() do {} while (0)
#endif
#include <cmath>

#ifndef EMU
constexpr int D = 2048, NSEQ = 6, NPROMPT = 2, S = 4096, PLE = 256, DFF = 8192;
#else
constexpr int D = 256, NSEQ = 2, NPROMPT = 1, S = 1024, PLE = 64, DFF = 512;
#endif
constexpr int T = NSEQ * S, DEPTH = 4, NH = 8, DH = 128;
constexpr int AQKV = 3072, ABIN = 7200, ABINP = 7424, ABMIX = 2048, CIN = 6144, CV = 2048;
constexpr int COL_Z = 3072, COL_G = 4096, COL_QB = 4128, COL_KB = 4128 + 1024, COL_VB = 4128 + 2048;
constexpr int GW = 64, ROWS = S / GW, NAR = 8, NAC = 16, WR = (NAR < ROWS ? NAR : ROWS);
constexpr float RMS_EPS = 1e-6f;

typedef unsigned short bf16;
DEVFN float bf2f(bf16 b) { unsigned u = ((unsigned)b) << 16; float f; memcpy(&f, &u, 4); return f; }
DEVFN bf16 f2bf(float f) { unsigned u; memcpy(&u, &f, 4); u += 0x7fffu + ((u >> 16) & 1u); return (bf16)(u >> 16); }
DEVFN float siluf(float x) { return x / (1.f + expf(-x)); }
DEVFN float sigmoidf(float x) { return 1.f / (1.f + expf(-x)); }
DEVFN float softplusf(float x) { if (x > 20.f) return x; const float y = expf(x); return y < 0.01f ? y * (1.f - y * (0.5f - y * 0.33333333f)) : logf(1.f + y); }
DEVFN int clampi(int v, int lo, int hi) { return v < lo ? lo : (v > hi ? hi : v); }

constexpr size_t MiB = 1u << 20;
constexpr size_t SZ_TD2 = (size_t)T * D * 2, SZ_TD4 = (size_t)T * D * 4;
constexpr size_t al(size_t x) { return (x + MiB - 1) / MiB * MiB; }
constexpr size_t WS_CTL = 0;
constexpr size_t WS_PRM = 1 * MiB;
constexpr int PR_ABCONV = 0, PR_ALOG = PR_ABCONV + 2 * 5 * AQKV, PR_DTB = PR_ALOG + 32, PR_ONORM = PR_DTB + 32, PR_RPB = PR_ONORM + 2 * DH, PR_LAMBDA = PR_RPB + 2 * NH * 15 * 31,
    PR_SUBLN = PR_LAMBDA + 2 * 4 * DH, PR_NORMS = PR_SUBLN + 2 * 256, PR_FCW = PR_NORMS + DEPTH * 4 * D, PR_FCB = PR_FCW + DEPTH * 3 * 2 * DFF, PR_END = PR_FCB + DEPTH * 2 * DFF;
static_assert((size_t)PR_END * 4 <= 2 * MiB, "param region");
constexpr size_t WS_WABIN = 3 * MiB;
constexpr size_t WS_WABOUT = WS_WABIN + al((size_t)2 * ABINP * D * 2);
constexpr size_t WS_WCIN = WS_WABOUT + al((size_t)2 * D * ABMIX * 2);
constexpr size_t WS_WCOUT = WS_WCIN + al((size_t)2 * CIN * D * 2);
constexpr size_t WS_WFIN = WS_WCOUT + al((size_t)2 * D * CV * 2);
constexpr size_t WS_WFOUT = WS_WFIN + al((size_t)4 * 2 * DFF * D * 2);
constexpr size_t WS_WPP = WS_WFOUT + al((size_t)4 * D * DFF * 2);
constexpr size_t WS_WPG = WS_WPP + al((size_t)4 * D * PLE * 2);
constexpr size_t WS_HN = WS_WPG + al((size_t)4 * D * D * 2);
#ifdef EMU
constexpr size_t WS_MIXIN = WS_HN + al(SZ_TD2);
#else
constexpr size_t WS_MIXIN = WS_HN;
constexpr size_t WS_H16 = WS_HN + al(SZ_TD2);
#endif
constexpr size_t WS_PB = WS_HN + 2 * al(SZ_TD2);
constexpr size_t SZ_PB = al((size_t)T * PLE * 2);
constexpr size_t WS_SMALL = WS_PB + DEPTH * SZ_PB;
constexpr size_t WS_RSTD = WS_SMALL, WS_G = WS_SMALL + al((size_t)T * 4), WS_BETA = WS_G + al((size_t)T * 16 * 4), WS_LAM = WS_BETA + al((size_t)T * 16 * 4);
constexpr size_t WS_R = WS_LAM + MiB;
constexpr size_t WS_GOUT = WS_R;
constexpr size_t WS_GOUT2 = WS_GOUT + al(SZ_TD4);
constexpr size_t WS_HID = WS_R;
#ifdef EMU
constexpr size_t WS_ACT = WS_HID + al((size_t)T * 2 * DFF * 2);
#else
constexpr size_t WS_ACT = WS_GOUT + al(SZ_TD4);
constexpr size_t WS_PP2 = (size_t)1952 * MiB;
#endif
constexpr size_t WS_HALO = WS_ACT + al((size_t)T * DFF * 2);
constexpr size_t WS_PROJ = WS_GOUT + al(SZ_TD4);
constexpr size_t WS_X1 = WS_PROJ + al((size_t)T * ABINP * 2);
constexpr size_t SZ_HD4 = al((size_t)T * NH * DH * 4);
#ifdef EMU
constexpr size_t WS_QN = WS_X1, WS_KN = WS_QN + SZ_HD4, WS_VV = WS_KN + SZ_HD4, WS_OF = WS_VV + SZ_HD4, WS_OB = WS_OF + SZ_HD4, WS_NASC = WS_OB + SZ_HD4;
constexpr size_t WS_END_AB = WS_NASC + SZ_HD4;
#else
constexpr size_t WS_OF = WS_GOUT, WS_OB = WS_OF + SZ_HD4;
constexpr size_t WS_QN = WS_X1, WS_KN = WS_X1, WS_VV = WS_X1, WS_NASC = WS_X1;
constexpr int NUD_ = NSEQ * NH * (S / 64) * 2;
constexpr size_t WS_DN_UT = WS_X1, WS_DN_WN = WS_DN_UT + al((size_t)NUD_ * 128 * 64 * 4), WS_DN_QE = WS_DN_WN + al((size_t)NUD_ * 16 * 512 * 2), WS_DN_IN = WS_DN_QE + al((size_t)NUD_ * 16 * 512 * 2),
    WS_DN_KD = WS_DN_IN + al((size_t)NUD_ * 8 * 512 * 2), WS_DN_EG = WS_DN_KD + al((size_t)NUD_ * 16 * 512 * 2);
constexpr size_t WS_END_AB = WS_DN_EG + MiB;
#endif
constexpr size_t WS_O0 = WS_X1, WS_O1 = WS_O0 + al((size_t)T * 2048 * 4);
constexpr size_t WS_END_C = WS_O1 + al((size_t)T * 2048 * 4);
constexpr size_t WS_END_F = WS_HALO + 32 * MiB;
constexpr size_t WS_END = (WS_END_AB > WS_END_C ? (WS_END_AB > WS_END_F ? WS_END_AB : WS_END_F) : (WS_END_C > WS_END_F ? WS_END_C : WS_END_F));
#ifndef EMU
static_assert(WS_END <= WS_PP2 && WS_PP2 + SZ_TD2 <= (size_t)2048 * MiB, "workspace map exceeds 2 GiB");
#endif

struct P {
    const float *x_prompt, *x_sample, *p_prompt, *p_sample, *ab_w_in, *ab_conv_w, *ab_a_log, *ab_dt_bias, *ab_out_norm, *ab_rpb, *ab_w_out,
        *c_w_in, *c_lambda, *c_subln, *c_w_out, *norms, *ffn_w_in, *ffn_conv_w, *ffn_conv_b, *ffn_w_out, *ple_w_proj, *ple_w_gate;
    float* h;
    unsigned char* ws;
};
#define WSP(type, off) ((type*)(p.ws + (off)))
#define PRM(off) (WSP(const float, WS_PRM) + (off))
constexpr long N_PRM = PR_END;
DEVFN void st_prm(const P& p, int, long g) {
    const int i = (int)g; float v;
    if (i < PR_ALOG) v = p.ab_conv_w[i - PR_ABCONV]; else if (i < PR_DTB) v = p.ab_a_log[i - PR_ALOG]; else if (i < PR_ONORM) v = p.ab_dt_bias[i - PR_DTB];
    else if (i < PR_RPB) v = p.ab_out_norm[i - PR_ONORM]; else if (i < PR_LAMBDA) v = p.ab_rpb[i - PR_RPB]; else if (i < PR_SUBLN) v = p.c_lambda[i - PR_LAMBDA];
    else if (i < PR_NORMS) v = p.c_subln[i - PR_SUBLN]; else if (i < PR_FCW) v = p.norms[i - PR_NORMS]; else if (i < PR_FCB) v = p.ffn_conv_w[i - PR_FCW]; else v = p.ffn_conv_b[i - PR_FCB];
    WSP(float, WS_PRM)[i] = v;
}
constexpr long N_INIT = (long)T * D / 4;
DEVFN void st_init(const P& p, int, long g) {
    const long i = g * 4, np = (long)NPROMPT * S * D;
    const float* src = i < np ? p.x_prompt + i : p.x_sample + (i - np);
    for (int k = 0; k < 4; ++k) p.h[i + k] = src[k];
}
constexpr long N_PB = (long)T * PLE;
DEVFN void st_pb(const P& p, int layer, long g) {
    const long np = (long)NPROMPT * S * PLE, ns = (long)(NSEQ - NPROMPT) * S * PLE;
    const float v = g < np ? p.p_prompt[(long)layer * np + g] : p.p_sample[(long)layer * ns + (g - np)];
    WSP(bf16, WS_PB + (size_t)layer * SZ_PB)[g] = f2bf(v);
}
struct WT { const float* W; bf16* O; int K, N, Npad; };
DEVFN void st_wt(const WT& w, long g) {
    const int n = (int)(g / w.K), k = (int)(g % w.K);
    w.O[g] = n < w.N ? f2bf(w.W[(size_t)k * w.N + n]) : (bf16)0;
}
constexpr long N_ROWS = T;
DEVFN void st_rowss(const P& p, const float* x, long g) {
    const float* r = x + (size_t)g * D; float s = 0.f;
    for (int c = 0; c < D; ++c) s += r[c] * r[c];
    WSP(float, WS_RSTD)[g] = 1.0f / sqrtf(s / (float)D + RMS_EPS);
}
constexpr long N_TD = (long)T * D;
DEVFN void st_norm_bf16(const P& p, const float* w, long g) {
    const long t = g / D; const int c = (int)(g % D);
    WSP(bf16, WS_HN)[g] = f2bf(p.h[g] * WSP(float, WS_RSTD)[t] * w[c]);
}
DEVFN void st_resid(const P& p, const float* y, const float* w, int write_hb, long g) {
    const long t = g / D; const int c = (int)(g % D);
    const float v = p.h[g] + y[g] * WSP(float, WS_RSTD)[t] * w[c];
    p.h[g] = v; if (write_hb) WSP(bf16, WS_HN)[g] = f2bf(v);
}
constexpr long N_TH = (long)T * NH;
DEVFN void st_dn_prep(const P& p, int layer, long g) {
    const int j = layer / 2; const long t = g / NH; const int hh = (int)(g % NH); const int tt = (int)(t % S); const long t0 = t - tt;
    const bf16* proj = WSP(bf16, WS_PROJ); const float* cw = PRM(PR_ABCONV) + (size_t)j * 5 * AQKV;
    for (int part = 0; part < 3; ++part) {
        float* o = (part == 0 ? WSP(float, WS_QN) : (part == 1 ? WSP(float, WS_KN) : WSP(float, WS_VV))) + (size_t)g * DH; float ss = 0.f;
        for (int d = 0; d < DH; ++d) {
            const int col = part * 1024 + hh * DH + d; float acc = 0.f;
            for (int i = 0; i < 5; ++i) { const int ts = tt + i - 2; if (ts >= 0 && ts < S) acc += bf2f(proj[(size_t)(t0 + ts) * ABINP + col]) * cw[i * AQKV + col]; }
            const float y = siluf(acc); ss += y * y; o[d] = y;
        }
        if (part < 2) { const float r = (1.0f / sqrtf(ss + 1e-6f)) * (part == 0 ? 0.08838834764831845f : 1.f); for (int d = 0; d < DH; ++d) o[d] *= r; }
    }
    for (int dir = 0; dir < 2; ++dir) {
        const float graw = bf2f(proj[(size_t)t * ABINP + COL_G + dir * NH + hh]), braw = bf2f(proj[(size_t)t * ABINP + COL_G + 16 + dir * NH + hh]);
        const float a = expf(PRM(PR_ALOG)[(j * 2 + dir) * NH + hh]), dtb = PRM(PR_DTB)[(j * 2 + dir) * NH + hh];
        WSP(float, WS_G)[(t * 2 + dir) * NH + hh] = -a * softplusf(graw + dtb);
        WSP(float, WS_BETA)[(t * 2 + dir) * NH + hh] = sigmoidf(braw);
    }
}
constexpr long N_SCAN = (long)NSEQ * NH * 2 * DH;
DEVFN void st_dn_scan(const P& p, int, long g) {
    const int vc = (int)(g % DH); const int dir = (int)((g / DH) % 2); const int hh = (int)((g / (2 * DH)) % NH); const int seq = (int)(g / (2 * DH * NH));
    const float *QN = WSP(float, WS_QN), *KN = WSP(float, WS_KN), *VV = WSP(float, WS_VV), *G = WSP(float, WS_G), *BT = WSP(float, WS_BETA);
    float* O = WSP(float, dir ? WS_OB : WS_OF);
    float Sx[DH];
#pragma unroll
    for (int d = 0; d < DH; ++d) Sx[d] = 0.f;
    for (int step = 0; step < S; ++step) {
        const int tt = dir ? S - 1 - step : step; const long t = (long)seq * S + tt;
        const float eg = expf(G[(t * 2 + dir) * NH + hh]), b = BT[(t * 2 + dir) * NH + hh];
        const float* kp = KN + ((size_t)t * NH + hh) * DH; const float* qp = QN + ((size_t)t * NH + hh) * DH; const float vv = VV[((size_t)t * NH + hh) * DH + vc];
        float dot = 0.f;
#pragma unroll
        for (int d0 = 0; d0 < DH; d0 += 16) { MEMFENCE();
#pragma unroll
            for (int d = d0; d < d0 + 16; ++d) { Sx[d] *= eg; dot += Sx[d] * kp[d]; } }
        const float delta = b * (vv - dot); float o = 0.f;
#pragma unroll
        for (int d0 = 0; d0 < DH; d0 += 16) { MEMFENCE();
#pragma unroll
            for (int d = d0; d < d0 + 16; ++d) { Sx[d] += kp[d] * delta; o += Sx[d] * qp[d]; } }
        MEMFENCE();
        O[((size_t)t * NH + hh) * DH + vc] = o;
    }
}
DEVFN void st_dn_out(const P& p, int layer, long g) {
    const int j = layer / 2; const long t = g / NH; const int hh = (int)(g % NH);
    const float *OF = WSP(float, WS_OF) + (size_t)g * DH, *OB = WSP(float, WS_OB) + (size_t)g * DH; const float* on = PRM(PR_ONORM) + j * DH;
    float ss = 0.f; for (int d = 0; d < DH; ++d) { const float o = OF[d] + OB[d]; ss += o * o; }
    const float r = 1.0f / sqrtf(ss / (float)DH + RMS_EPS);
    const bf16* z = WSP(bf16, WS_PROJ) + (size_t)t * ABINP + COL_Z + hh * DH; bf16* out = WSP(bf16, WS_MIXIN) + (size_t)t * ABMIX + hh * DH;
    for (int d = 0; d < DH; ++d) out[d] = f2bf((OF[d] + OB[d]) * r * on[d] * siluf(bf2f(z[d])));
}
constexpr long N_THD = (long)T * NH * DH;
DEVFN long na_key_token(long t, int jw, int& dr, int& dc) {
    const int tt = (int)(t % S); const long t0 = t - tt; const int r = tt / GW, c = tt % GW;
    const int rs = clampi(r - WR / 2, 0, ROWS - WR), cs = clampi(c - NAC / 2, 0, GW - NAC);
    const int rk = rs + jw / NAC, ck = cs + jw % NAC;
    dr = rk - r + NAR - 1; dc = clampi(ck - c + NAC - 1, 0, 2 * NAC - 2);
    return t0 + (long)rk * GW + ck;
}
DEVFN void st_na_scores(const P& p, int layer, long g) {
    const int j = layer / 2; const int jw = (int)(g % DH); const int hh = (int)((g / DH) % NH); const long t = g / (DH * NH);
    int dr, dc; const long tk = na_key_token(t, jw, dr, dc);
    const bf16* q = WSP(bf16, WS_PROJ) + (size_t)t * ABINP + COL_QB + hh * DH; const bf16* k = WSP(bf16, WS_PROJ) + (size_t)tk * ABINP + COL_KB + hh * DH;
    float dot = 0.f; for (int d = 0; d < DH; ++d) dot += bf2f(q[d]) * bf2f(k[d]);
    WSP(float, WS_NASC)[g] = dot * 0.08838834764831845f + PRM(PR_RPB)[(((size_t)j * NH + hh) * (2 * NAR - 1) + dr) * (2 * NAC - 1) + dc];
}
DEVFN void st_na_out(const P& p, int, long g) {
    const int d = (int)(g % DH); const int hh = (int)((g / DH) % NH); const long t = g / (DH * NH);
    const float* sc = WSP(float, WS_NASC) + ((size_t)t * NH + hh) * DH;
    float m = sc[0]; for (int jw = 1; jw < WR * NAC; ++jw) m = fmaxf(m, sc[jw]);
    float l = 0.f, o = 0.f;
    for (int jw = 0; jw < WR * NAC; ++jw) { int dr, dc; const long tk = na_key_token(t, jw, dr, dc); const float e = expf(sc[jw] - m); l += e;
        o += e * bf2f(WSP(bf16, WS_PROJ)[(size_t)tk * ABINP + COL_VB + hh * DH + d]); }
    WSP(bf16, WS_MIXIN)[(size_t)t * ABMIX + 1024 + hh * DH + d] = f2bf(o / l);
}
DEVFN float lambda_init_of(int layer) { return 0.8f - 0.6f * expf(-0.3f * (float)layer); }
DEVFN void st_lam(const P& p, int layer, long) {
    const float* lp = PRM(PR_LAMBDA) + (size_t)(layer / 2) * 4 * DH; float a = 0.f, b = 0.f;
    for (int d = 0; d < DH; ++d) { a += lp[d] * lp[DH + d]; b += lp[2 * DH + d] * lp[3 * DH + d]; }
    const float li = lambda_init_of(layer); WSP(float, WS_LAM)[0] = expf(a) - expf(b) + li; WSP(float, WS_LAM)[1] = li;
}
constexpr long N_ROPE = (long)T * 2 * 16 * 16;
DEVFN void st_rope(const P& p, int, long g) {
    const int i = (int)(g % 16); const int hj = (int)((g / 16) % 16); const int which = (int)((g / 256) % 2); const long t = g / 512;
    bf16* x = WSP(bf16, WS_PROJ) + (size_t)t * CIN + which * 2048 + hj * DH;
    const float inv = powf(500000.0f, -(float)(2 * i) / 32.0f); const float ang = (float)(t % S) * inv; const float cs = cosf(ang), sn = sinf(ang);
    const float x1 = bf2f(x[i]), x2 = bf2f(x[16 + i]);
    x[i] = f2bf(x1 * cs - x2 * sn); x[16 + i] = f2bf(x2 * cs + x1 * sn);
}
constexpr int DA_E = 64;
constexpr long N_DATT = (long)NSEQ * NH * 2 * (256 / DA_E) * S;
DEVFN void st_dattn(const P& p, int, long g) {
    const int qi = (int)(g % S); long r = g / S; const int es = (int)(r % (256 / DA_E)); r /= (256 / DA_E); const int jj = (int)(r % 2); r /= 2; const int hh = (int)(r % NH); const int seq = (int)(r / NH);
    const bf16* proj = WSP(bf16, WS_PROJ); const long t = (long)seq * S + qi;
    float q[DH];
#pragma unroll
    for (int d = 0; d < DH; ++d) q[d] = bf2f(proj[(size_t)t * CIN + hh * 256 + jj * DH + d]) * 0.08838834764831845f;
    float o[DA_E];
#pragma unroll
    for (int e = 0; e < DA_E; ++e) o[e] = 0.f;
    float m = -1e30f, l = 0.f;
    for (int kk = 0; kk < S; ++kk) {
        const bf16* kr = proj + (size_t)((long)seq * S + kk) * CIN + 2048 + hh * 256 + jj * DH; const bf16* vr = proj + (size_t)((long)seq * S + kk) * CIN + 4096 + hh * 256 + es * DA_E;
        float s = 0.f;
#pragma unroll
        for (int d0 = 0; d0 < DH; d0 += 32) { MEMFENCE();
#pragma unroll
            for (int d = d0; d < d0 + 32; ++d) s += q[d] * bf2f(kr[d]); }
        MEMFENCE();
        const float mn = fmaxf(m, s), al = expf(m - mn), pe = expf(s - mn); m = mn; l = l * al + pe;
#pragma unroll
        for (int e = 0; e < DA_E; ++e) o[e] = o[e] * al + pe * bf2f(vr[e]);
    }
    float* O = WSP(float, jj ? WS_O1 : WS_O0) + (size_t)t * 2048 + hh * 256 + es * DA_E; const float il = 1.0f / l;
#pragma unroll
    for (int e = 0; e < DA_E; ++e) O[e] = o[e] * il;
}
DEVFN void st_c_out(const P& p, int layer, long g) {
    const int j = layer / 2; const long t = g / NH; const int hh = (int)(g % NH); const float lam = WSP(float, WS_LAM)[0], li = WSP(float, WS_LAM)[1];
    const float *O0 = WSP(float, WS_O0) + (size_t)t * 2048 + hh * 256, *O1 = WSP(float, WS_O1) + (size_t)t * 2048 + hh * 256; const float* sw = PRM(PR_SUBLN) + j * 256;
    float ss = 0.f; for (int e = 0; e < 256; ++e) { const float o = O0[e] - lam * O1[e]; ss += o * o; }
    const float r = (1.0f / sqrtf(ss / 256.0f + RMS_EPS)) * (1.0f - li);
    bf16* out = WSP(bf16, WS_MIXIN) + (size_t)t * 2048 + hh * 256;
    for (int e = 0; e < 256; ++e) out[e] = f2bf((O0[e] - lam * O1[e]) * r * sw[e]);
}
constexpr long N_ACT = (long)T * DFF;
DEVFN float gelu_tanh(float x) { return 0.5f * x * (1.0f + tanhf(0.7978845608028654f * (x + 0.044715f * x * x * x))); }
DEVFN void st_ffn_act(const P& p, int layer, long g) {
    const long t = g / DFF; const int c = (int)(g % DFF); const int tt = (int)(t % S);
    const bf16* hid = WSP(bf16, WS_HID); const float* cw = PRM(PR_FCW) + (size_t)layer * 3 * 2 * DFF; const float* cb = PRM(PR_FCB) + (size_t)layer * 2 * DFF;
    float ga = cb[c], up = cb[DFF + c];
    for (int i = 0; i < 3; ++i) { const int ts = tt + i - 1; if (ts >= 0 && ts < S) { const bf16* r = hid + (size_t)(t - tt + ts) * (2 * DFF);
        ga += bf2f(r[c]) * cw[i * 2 * DFF + c]; up += bf2f(r[DFF + c]) * cw[i * 2 * DFF + DFF + c]; } }
    WSP(bf16, WS_ACT)[g] = f2bf(gelu_tanh(ga) * up);
}
DEVFN void st_ple(const P& p, int, long g) { p.h[g] += sigmoidf(WSP(float, WS_GOUT)[g]) * WSP(float, WS_GOUT2)[g]; }
#ifndef EMU
namespace pg8 {
#define PG8_LAS __attribute__((address_space(3)))
typedef unsigned short bf16_t;
typedef short bf16x8 __attribute__((ext_vector_type(8)));
typedef float f32x4 __attribute__((ext_vector_type(4)));
typedef unsigned u32x4 __attribute__((ext_vector_type(4)));
constexpr int BM = 256, BK = 64, HALF = 128, HTB = HALF * BK * 2  , STAGE_BYTES = 8 * HTB, NXCD = 8, WGM = 4;

__host__ __device__ __forceinline__ int lds_byte(int r, int c) { const int st = (r >> 4) * 2 + (c >> 5), rr = r & 15, cc = c & 31, ob = rr * 64 + cc * 2; return st * 1024 + (ob ^ (((ob >> 9) & 1) << 5)); }
__host__ __device__ __forceinline__ void stage_rc(int b, int& R, int& C) { const int st = b / 1024, sb = b % 1024, swz = sb ^ (((sb >> 9) & 1) << 5); R = (st >> 1) * 16 + swz / 64; C = (st & 1) * 32 + (swz % 64) / 2; }
__host__ __device__ __forceinline__ int perm32(int rho) { const int n = rho >> 4, i = rho & 15; return 8 * (i >> 2) + 4 * n + (i & 3); }

struct Unit { int pm, pn; };
struct Gemm { const bf16_t* A; const bf16_t* Bt; int M, N, K; };

struct StaticOrder {
    int nM, nN, nwg, G, c;
    __host__ __device__ void init(int M, int N, int G_, int c_) { nM = M / BM; nN = N / BM; nwg = nM * nN; G = G_; c = c_; }
    __host__ __device__ bool next(int i, Unit& u) const {
        const long L = (long)i * G + c; if (L >= nwg) return false;
        int wgid = (int)L; { const int q = nwg / NXCD, r = nwg % NXCD, xcd = wgid % NXCD, off = wgid / NXCD; wgid = (xcd < r ? xcd * (q + 1) : r * (q + 1) + (xcd - r) * q) + off; }
        const int nig = WGM * nN, gid = wgid / nig, fm = gid * WGM, gsz = (nM - fm) < WGM ? (nM - fm) : WGM;
        u.pm = fm + ((wgid % nig) % gsz); u.pn = (wgid % nig) / gsz; return true;
    }
    __device__ __forceinline__ void a_ready(const Unit&) const {}
    __device__ __forceinline__ void done(const Unit&) const {}
};

__device__ __forceinline__ unsigned cvt_pk_bf16(float lo, float hi) { unsigned r; asm volatile("v_cvt_pk_bf16_f32 %0, %1, %2" : "=v"(r) : "v"(lo), "v"(hi)); return r; }
struct EpiBf16 {
    static constexpr bool PERM = true, AFTER_DRAIN = false;
    bf16_t* O; int ldc;
    __device__ __forceinline__ void operator()(const f32x4 (&acc)[2][2][4][2], const Unit& u, int wr, int wc, int fr, int fq) const {
        const int row0 = u.pm * BM + wr * 64 + fr; const int col0 = u.pn * BM + wc * 32 + 8 * fq;
#pragma unroll
        for (int ai = 0; ai < 2; ++ai)
#pragma unroll
            for (int m = 0; m < 4; ++m) { bf16_t* rowp = O + (size_t)(row0 + ai * HALF + m * 16) * ldc + col0;
#pragma unroll
                for (int bj = 0; bj < 2; ++bj) { const f32x4 v0 = acc[ai][bj][m][0], v1 = acc[ai][bj][m][1];
                    u32x4 w; w.x = cvt_pk_bf16(v0[0], v0[1]); w.y = cvt_pk_bf16(v0[2], v0[3]); w.z = cvt_pk_bf16(v1[0], v1[1]); w.w = cvt_pk_bf16(v1[2], v1[3]);
                    *(u32x4*)(rowp + bj * HALF) = w; } }
    }
};
struct EpiBf16Ro {
    static constexpr bool PERM = true, AFTER_DRAIN = false;
    bf16_t* O; int ldc; const float* tab; int seqlen;
    __device__ __forceinline__ void operator()(const f32x4 (&acc)[2][2][4][2], const Unit& u, int wr, int wc, int fr, int fq) const {
        const int row0 = u.pm * BM + wr * 64 + fr; const int col0 = u.pn * BM + wc * 32 + 8 * fq;
        const bool rope = tab != nullptr && u.pn < 16 && wc == 0;
#pragma unroll
        for (int ai = 0; ai < 2; ++ai)
#pragma unroll
            for (int m = 0; m < 4; ++m) { const int row = row0 + ai * HALF + m * 16; bf16_t* rowp = O + (size_t)row * ldc + col0;
#pragma unroll
                for (int bj = 0; bj < 2; ++bj) { f32x4 v0 = acc[ai][bj][m][0], v1 = acc[ai][bj][m][1];
                    if (rope) { const float* cs = tab + ((size_t)(row % seqlen) * 16 + 8 * (fq & 1)) * 2; const float sgn = fq < 2 ? -1.f : 1.f;
                        const f32x4 c0 = *(const f32x4*)cs, c1 = *(const f32x4*)(cs + 4), c2 = *(const f32x4*)(cs + 8), c3 = *(const f32x4*)(cs + 12);
#pragma unroll
                        for (int e = 0; e < 4; ++e) { const float o0 = __shfl_xor(v0[e], 32), o1 = __shfl_xor(v1[e], 32);
                            const float cs0 = (e < 2 ? c0 : c1)[2 * (e & 1)], sn0 = (e < 2 ? c0 : c1)[2 * (e & 1) + 1], cs1 = (e < 2 ? c2 : c3)[2 * (e & 1)], sn1 = (e < 2 ? c2 : c3)[2 * (e & 1) + 1];
                            v0[e] = v0[e] * cs0 + sgn * o0 * sn0; v1[e] = v1[e] * cs1 + sgn * o1 * sn1; } }
                    u32x4 w; w.x = cvt_pk_bf16(v0[0], v0[1]); w.y = cvt_pk_bf16(v0[2], v0[3]); w.z = cvt_pk_bf16(v1[0], v1[1]); w.w = cvt_pk_bf16(v1[2], v1[3]);
                    *(u32x4*)(rowp + bj * HALF) = w; } }
    }
};
__device__ __forceinline__ float dpp_prev(float oldv, float x) { return __int_as_float(__builtin_amdgcn_update_dpp(__float_as_int(oldv), __float_as_int(x), 0x111, 0xf, 0xf, false)); }
__device__ __forceinline__ float dpp_next(float oldv, float x) { return __int_as_float(__builtin_amdgcn_update_dpp(__float_as_int(oldv), __float_as_int(x), 0x101, 0xf, 0xf, false)); }
__device__ __forceinline__ float dpp_ror1(float x) { return __int_as_float(__builtin_amdgcn_update_dpp(__float_as_int(x), __float_as_int(x), 0x121, 0xf, 0xf, false)); }
__device__ __forceinline__ float dpp_rol1(float x) { return __int_as_float(__builtin_amdgcn_update_dpp(__float_as_int(x), __float_as_int(x), 0x12F, 0xf, 0xf, false)); }
__device__ __forceinline__ void conv3_pair(float& cg, float& cu, float xg, float xu, float egp, float egn, float eup, float eun,
                                           float wg0, float wg1, float wg2, float wu0, float wu1, float wu2, float bg, float bu, unsigned long long m15, unsigned long long m0) {
    float t0, t1, t2, t3;
    asm("v_cndmask_b32_e64 %[t0], %[xg], %[egp], %[m15]\n\t"
        "v_cndmask_b32_e64 %[t1], %[xg], %[egn], %[m0]\n\t"
        "v_cndmask_b32_e64 %[t2], %[xu], %[eup], %[m15]\n\t"
        "v_cndmask_b32_e64 %[t3], %[xu], %[eun], %[m0]\n\t"
        "v_fma_f32 %[cg], %[wg1], %[xg], %[bg]\n\t"
        "v_fma_f32 %[cu], %[wu1], %[xu], %[bu]\n\t"
        "v_fmac_f32_dpp %[cg], %[t0], %[wg0] row_ror:1 row_mask:0xf bank_mask:0xf\n\t"
        "v_fmac_f32_dpp %[cg], %[t1], %[wg2] row_ror:15 row_mask:0xf bank_mask:0xf\n\t"
        "v_fmac_f32_dpp %[cu], %[t2], %[wu0] row_ror:1 row_mask:0xf bank_mask:0xf\n\t"
        "v_fmac_f32_dpp %[cu], %[t3], %[wu2] row_ror:15 row_mask:0xf bank_mask:0xf"
        : [cg] "=&v"(cg), [cu] "=&v"(cu), [t0] "=&v"(t0), [t1] "=&v"(t1), [t2] "=&v"(t2), [t3] "=&v"(t3)
        : [xg] "v"(xg), [xu] "v"(xu), [egp] "v"(egp), [egn] "v"(egn), [eup] "v"(eup), [eun] "v"(eun), [wg0] "v"(wg0), [wg1] "v"(wg1), [wg2] "v"(wg2), [wu0] "v"(wu0), [wu1] "v"(wu1), [wu2] "v"(wu2),
          [bg] "v"(bg), [bu] "v"(bu), [m15] "s"(m15), [m0] "s"(m0));
}
__device__ __forceinline__ float gelu_t(float x) { const float u = 0.7978845608028654f * (x + 0.044715f * x * x * x); return x * __builtin_amdgcn_rcpf(1.0f + __builtin_amdgcn_exp2f(-2.885390081777927f * u)); }
struct EpiConvAct {
    static constexpr bool PERM = true, AFTER_DRAIN = false;
    bf16_t* ACT; float* HALO; float* HDUMP; const float* cw; const float* cb; PG8_LAS float* EX;
    __device__ __forceinline__ void operator()(const f32x4 (&acc)[2][2][4][2], const Unit& u, int wr, int wc, int fr, int fq) const {
        const int ch0 = u.pn * 128 + wc * 32 + 8 * fq;
        PG8_LAS float* WL = EX + 2560; const int t_ = ((wr * 4 + wc) << 6) | (fq * 16 + fr); float wv[2];
#pragma unroll
        for (int j = 0; j < 2; ++j) { const int idx = t_ + 512 * j, r = idx >> 7, c = idx & 127; const float* src = r < 6 ? cw + (size_t)(r >> 1) * 2 * DFF + (r & 1) * DFF : cb + (r & 1) * DFF; wv[j] = src[u.pn * 128 + c]; }
#pragma unroll
        for (int ai = 0; ai < 2; ++ai) { const int sg = 2 * ai + wr;
            PG8_LAS float* d0 = EX + ((fr == 0) ? ((((sg * 2 + 0) * 4 + wc) * 4 + fq) * 16) : (2048 + wc * 64 + fq * 16));
            PG8_LAS float* d1 = EX + ((fr == 15) ? ((((sg * 2 + 1) * 4 + wc) * 4 + fq) * 16) : (2048 + wc * 64 + fq * 16));
#pragma unroll
            for (int bj = 0; bj < 2; ++bj)
#pragma unroll
                for (int n = 0; n < 2; ++n) { *(PG8_LAS f32x4*)(d0 + (bj * 2 + n) * 4) = acc[ai][bj][0][n]; *(PG8_LAS f32x4*)(d1 + (bj * 2 + n) * 4) = acc[ai][bj][3][n]; } }
        if (wr == 0) { float* hp = (fr < 2) ? HALO + (((size_t)u.pm * 4 + fr) * 2) * DFF + ch0 : HDUMP + (size_t)(wc * 4 + fq) * 16;
            const size_t bs = (fr < 2) ? (size_t)DFF : (size_t)8;
#pragma unroll
            for (int bj = 0; bj < 2; ++bj)
#pragma unroll
                for (int n = 0; n < 2; ++n) *(f32x4*)(hp + bj * bs + 4 * n) = acc[0][bj][0][n]; }
        else { float* hp = (fr >= 14) ? HALO + (((size_t)u.pm * 4 + 2 + (fr - 14)) * 2) * DFF + ch0 : HDUMP + (size_t)(wc * 4 + fq) * 16;
            const size_t bs = (fr >= 14) ? (size_t)DFF : (size_t)8;
#pragma unroll
            for (int bj = 0; bj < 2; ++bj)
#pragma unroll
                for (int n = 0; n < 2; ++n) *(f32x4*)(hp + bj * bs + 4 * n) = acc[1][bj][3][n]; }
        WL[t_] = wv[0]; WL[t_ + 512] = wv[1];
        asm volatile("s_waitcnt lgkmcnt(0)" ::: "memory"); __builtin_amdgcn_s_barrier(); asm volatile("" ::: "memory");
        const unsigned long long m15 = __ballot(fr == 15), m0 = __ballot(fr == 0);
        unsigned W[2][4][4];
#pragma unroll
        for (int n = 0; n < 2; ++n)
#pragma unroll
            for (int e2 = 0; e2 < 4; e2 += 2) {
                float wg[3][2], wu[3][2], bg[2], bu[2];
#pragma unroll
                for (int k = 0; k < 2; ++k) { const int cl = wc * 32 + 8 * fq + 4 * n + e2 + k;
#pragma unroll
                    for (int t = 0; t < 3; ++t) { wg[t][k] = WL[(2 * t) * 128 + cl]; wu[t][k] = WL[(2 * t + 1) * 128 + cl]; }
                    bg[k] = WL[6 * 128 + cl]; bu[k] = WL[7 * 128 + cl]; }
#pragma unroll
                for (int ai = 0; ai < 2; ++ai) { const int sg = 2 * ai + wr;
                    float pg[2] = {0.f, 0.f}, pu[2] = {0.f, 0.f}, ng[2] = {0.f, 0.f}, nu[2] = {0.f, 0.f};
                    if (sg > 0) { const PG8_LAS float* d = EX + ((((sg - 1) * 2 + 1) * 4 + wc) * 4 + fq) * 16 + n * 4 + e2; pg[0] = d[0]; pg[1] = d[1]; pu[0] = d[8]; pu[1] = d[9]; }
                    if (sg < 3) { const PG8_LAS float* d = EX + ((((sg + 1) * 2 + 0) * 4 + wc) * 4 + fq) * 16 + n * 4 + e2; ng[0] = d[0]; ng[1] = d[1]; nu[0] = d[8]; nu[1] = d[9]; }
#pragma unroll
                    for (int m = 0; m < 4; ++m) { float o[2];
#pragma unroll
                        for (int k = 0; k < 2; ++k) { const int e = e2 + k;
                            const float xg = acc[ai][0][m][n][e], xu = acc[ai][1][m][n][e];
                            const float bg_p = m > 0 ? acc[ai][0][m - 1][n][e] : pg[k], bu_p = m > 0 ? acc[ai][1][m - 1][n][e] : pu[k];
                            const float bg_n = m < 3 ? acc[ai][0][m + 1][n][e] : ng[k], bu_n = m < 3 ? acc[ai][1][m + 1][n][e] : nu[k];
                            float cg, cu; conv3_pair(cg, cu, xg, xu, bg_p, bg_n, bu_p, bu_n, wg[0][k], wg[1][k], wg[2][k], wu[0][k], wu[1][k], wu[2][k], bg[k], bu[k], m15, m0);
                            o[k] = gelu_t(cg) * cu; }
                        W[ai][m][n * 2 + (e2 >> 1)] = cvt_pk_bf16(o[0], o[1]); } }
            }
        const int row0 = u.pm * BM + wr * 64 + fr;
#pragma unroll
        for (int ai = 0; ai < 2; ++ai)
#pragma unroll
            for (int m = 0; m < 4; ++m) { u32x4 w; w.x = W[ai][m][0]; w.y = W[ai][m][1]; w.z = W[ai][m][2]; w.w = W[ai][m][3];
                *(u32x4*)(ACT + (size_t)(row0 + ai * HALF + m * 16) * DFF + ch0) = w; }
    }
};
struct EpiF32 {
    static constexpr bool PERM = false, AFTER_DRAIN = false;
    float* C; int ldc;
    __device__ __forceinline__ void operator()(const f32x4 (&acc)[2][2][4][2], const Unit& u, int wr, int wc, int fr, int fq) const {
        const int row0 = u.pm * BM + wr * 64 + fr, col0 = u.pn * BM + wc * 32 + 4 * fq;
#pragma unroll
        for (int ai = 0; ai < 2; ++ai)
#pragma unroll
            for (int m = 0; m < 4; ++m) { float* rowp = C + (size_t)(row0 + ai * HALF + m * 16) * ldc + col0;
#pragma unroll
                for (int bj = 0; bj < 2; ++bj)
#pragma unroll
                    for (int n = 0; n < 2; ++n) *(f32x4*)(rowp + bj * HALF + n * 16) = acc[ai][bj][m][n]; }
    }
};
template <class Epi, class Sched, bool ALIGN_EPI = false, bool SP2 = false>
__device__ __forceinline__ void gemm_phase(PG8_LAS unsigned char* lds, const Gemm g, const Sched& S, const Epi& E, int tid_in) {
    int tid_ = tid_in; asm volatile("" : "+v"(tid_));
    const int tid = tid_, wid = __builtin_amdgcn_readfirstlane(tid >> 6), lane = tid & 63, wr = wid >> 2, wc = wid & 3, fr = lane & 15, fq = lane >> 4;
    const int K = g.K, nt = K / BK;
    unsigned voffA[2], voffB[2];
#pragma unroll
    for (int i = 0; i < 2; ++i) { int R, C; stage_rc(tid * 16 + i * 8192, R, C); const int Rb = Epi::PERM ? ((R & ~31) + perm32(R & 31)) : R;
        voffA[i] = (unsigned)(R * K + C) * 2u; voffB[i] = (unsigned)(Rb * K + C) * 2u; }
    const size_t kstep = (size_t)(BK * 2);
    const size_t hstep = (size_t)HALF * K * 2;
    const size_t tstep = 2 * hstep;
    const unsigned ldsw = (unsigned)wid * 1024u;
    const int aoff = lds_byte(wr * 64 + fr, fq * 8), boff = lds_byte(wc * 32 + fr, fq * 8);
#define PG8_SA(b, h) (((b) * 2 + (h)) * HTB)
#define PG8_SB(b, h) ((4 + (b) * 2 + (h)) * HTB)
#define PG8_STAGE(bufoff, gbase, voff) do { _Pragma("unroll") for (int _i = 0; _i < 2; ++_i) \
        __builtin_amdgcn_global_load_lds((const unsigned*)((const char*)(gbase) + (voff)[_i]), (PG8_LAS unsigned*)(lds + (bufoff) + ldsw + _i * 8192), 16, 0, 0); } while (0)
#define PG8_LDA(dst, b, h) do { _Pragma("unroll") for (int m = 0; m < 4; ++m) _Pragma("unroll") for (int k = 0; k < 2; ++k) dst[m][k] = *(const PG8_LAS bf16x8*)(lds + PG8_SA(b, h) + aoff + m * 2048 + k * 1024); } while (0)
#define PG8_LDB(dst, b, h) do { _Pragma("unroll") for (int n = 0; n < 2; ++n) _Pragma("unroll") for (int k = 0; k < 2; ++k) dst[n][k] = *(const PG8_LAS bf16x8*)(lds + PG8_SB(b, h) + boff + n * 2048 + k * 1024); } while (0)
#define PG8_MMA(ai, bj, At, Bt) do { __builtin_amdgcn_s_setprio(1); _Pragma("unroll") for (int m = 0; m < 4; ++m) _Pragma("unroll") for (int n = 0; n < 2; ++n) _Pragma("unroll") for (int k = 0; k < 2; ++k) \
        acc[ai][bj][m][n] = __builtin_amdgcn_mfma_f32_16x16x32_bf16(Bt[n][k], At[m][k], acc[ai][bj][m][n], 0, 0, 0); __builtin_amdgcn_s_setprio(0); } while (0)
#define PG8_WAIT_V(n) asm volatile("s_waitcnt vmcnt(" #n ")" ::: "memory")
#define PG8_WAIT_L(n) asm volatile("s_waitcnt lgkmcnt(" #n ")" ::: "memory")
#define PG8_BAR __builtin_amdgcn_s_barrier()
#define PG8_SCHED __builtin_amdgcn_sched_barrier(0)
    Unit cur, nxt; int ui = 0;
    if (!S.next(0, cur)) return;
    f32x4 acc[2][2][4][2];
#pragma unroll
    for (int a = 0; a < 2; ++a)
#pragma unroll
        for (int b = 0; b < 2; ++b)
#pragma unroll
            for (int m = 0; m < 4; ++m)
#pragma unroll
                for (int n = 0; n < 2; ++n) acc[a][b][m][n] = (f32x4){0.f, 0.f, 0.f, 0.f};
    bf16x8 At[4][2], B0[2][2], B1[2][2];
    const char* cA = (const char*)g.A + (size_t)cur.pm * tstep; const char* cB = (const char*)g.Bt + (size_t)cur.pn * tstep;
    S.a_ready(cur);
    if constexpr (SP2) {
        PG8_STAGE(PG8_SB(0, 0), cB, voffB); PG8_STAGE(PG8_SB(0, 1), cB + hstep, voffB); PG8_STAGE(PG8_SA(0, 0), cA, voffA); PG8_STAGE(PG8_SA(0, 1), cA + hstep, voffA);
        if (wr == 1) PG8_BAR;
        PG8_WAIT_V(2); PG8_BAR;
        PG8_STAGE(PG8_SB(1, 0), cB + kstep, voffB); PG8_STAGE(PG8_SA(1, 0), cA + kstep, voffA); PG8_STAGE(PG8_SB(1, 1), cB + hstep + kstep, voffB);
        PG8_WAIT_V(6); PG8_BAR;
    } else {
        PG8_STAGE(PG8_SB(0, 0), cB, voffB); PG8_STAGE(PG8_SA(0, 0), cA, voffA); PG8_STAGE(PG8_SB(0, 1), cB + hstep, voffB); PG8_STAGE(PG8_SA(0, 1), cA + hstep, voffA);
        if (wr == 1) PG8_BAR;
        PG8_WAIT_V(4); PG8_BAR;
        PG8_STAGE(PG8_SB(1, 0), cB + kstep, voffB); PG8_STAGE(PG8_SA(1, 0), cA + kstep, voffA); PG8_STAGE(PG8_SB(1, 1), cB + hstep + kstep, voffB);
        PG8_WAIT_V(6); PG8_BAR;
    }
    for (;;) {
        const bool has_next = S.next(ui + 1, nxt);
        const char* nA = has_next ? (const char*)g.A + (size_t)nxt.pm * tstep : cA; const char* nB = has_next ? (const char*)g.Bt + (size_t)nxt.pn * tstep : cB;
        for (int t = 0; t < nt; t += 2) {
            const bool last = (t == nt - 2);
            const char* a1 = cA + (size_t)(t + 1) * kstep;
            const char* a2 = last ? nA : cA + (size_t)(t + 2) * kstep; const char* b2 = last ? nB : cB + (size_t)(t + 2) * kstep;
            const char* a3 = a2 + kstep; const char* b3 = b2 + kstep;
            if (last && has_next) S.a_ready(nxt);
            if constexpr (SP2) {
            PG8_LDB(B0, 0, 0); PG8_LDB(B1, 0, 1); PG8_SCHED; PG8_LDA(At, 0, 0); PG8_STAGE(PG8_SA(1, 1), a1 + hstep, voffA);
            PG8_WAIT_V(8); PG8_WAIT_L(0); PG8_BAR; PG8_MMA(0, 0, At, B0); PG8_MMA(0, 1, At, B1); PG8_BAR; PG8_SCHED;
            PG8_LDA(At, 0, 1); PG8_STAGE(PG8_SB(0, 0), b2, voffB); PG8_STAGE(PG8_SB(0, 1), b2 + hstep, voffB); PG8_STAGE(PG8_SA(0, 0), a2, voffA);
            PG8_WAIT_V(8); PG8_WAIT_L(0); PG8_BAR; PG8_MMA(1, 0, At, B0); PG8_MMA(1, 1, At, B1); PG8_BAR; PG8_SCHED;
            PG8_LDB(B0, 1, 0); PG8_LDB(B1, 1, 1); PG8_SCHED; PG8_LDA(At, 1, 0); PG8_STAGE(PG8_SA(0, 1), a2 + hstep, voffA);
            PG8_WAIT_V(8); PG8_WAIT_L(0); PG8_BAR; PG8_MMA(0, 0, At, B0); PG8_MMA(0, 1, At, B1); PG8_BAR; PG8_SCHED;
            PG8_LDA(At, 1, 1); PG8_STAGE(PG8_SB(1, 0), b3, voffB); PG8_STAGE(PG8_SB(1, 1), b3 + hstep, voffB); PG8_STAGE(PG8_SA(1, 0), a3, voffA);
            PG8_WAIT_V(8); PG8_WAIT_L(0); PG8_BAR; PG8_MMA(1, 0, At, B0); PG8_MMA(1, 1, At, B1); PG8_BAR; PG8_SCHED;
            } else {
            PG8_LDB(B0, 0, 0); PG8_SCHED; PG8_LDA(At, 0, 0); PG8_STAGE(PG8_SA(1, 1), a1 + hstep, voffA);
            PG8_WAIT_L(8); PG8_BAR; PG8_WAIT_L(0); PG8_MMA(0, 0, At, B0); PG8_BAR; PG8_SCHED;
            PG8_LDB(B1, 0, 1); PG8_STAGE(PG8_SB(0, 0), b2, voffB);
            PG8_BAR; PG8_WAIT_L(0); PG8_MMA(0, 1, At, B1); PG8_BAR;
            PG8_LDA(At, 0, 1); PG8_STAGE(PG8_SA(0, 0), a2, voffA);
            PG8_BAR; PG8_WAIT_L(0); PG8_MMA(1, 0, At, B0); PG8_BAR; PG8_SCHED;
            PG8_STAGE(PG8_SB(0, 1), b2 + hstep, voffB);
            PG8_WAIT_V(6); PG8_BAR; PG8_MMA(1, 1, At, B1); PG8_BAR;
            PG8_LDB(B0, 1, 0); PG8_SCHED; PG8_LDA(At, 1, 0); PG8_STAGE(PG8_SA(0, 1), a2 + hstep, voffA);
            PG8_WAIT_L(8); PG8_BAR; PG8_WAIT_L(0); PG8_MMA(0, 0, At, B0); PG8_BAR; PG8_SCHED;
            PG8_LDB(B1, 1, 1); PG8_STAGE(PG8_SB(1, 0), b3, voffB);
            PG8_BAR; PG8_WAIT_L(0); PG8_MMA(0, 1, At, B1); PG8_BAR;
            PG8_LDA(At, 1, 1); PG8_STAGE(PG8_SA(1, 0), a3, voffA);
            PG8_BAR; PG8_WAIT_L(0); PG8_MMA(1, 0, At, B0); PG8_BAR; PG8_SCHED;
            PG8_STAGE(PG8_SB(1, 1), b3 + hstep, voffB);
            PG8_WAIT_V(6); PG8_BAR; PG8_MMA(1, 1, At, B1); PG8_BAR;
            }
        }
        if constexpr (ALIGN_EPI) { if (wr == 0) PG8_BAR; }
        if constexpr (!Epi::AFTER_DRAIN) { E(acc, cur, wr, wc, fr, fq); S.done(cur); }
        if (!has_next) break;
#pragma unroll
        for (int a = 0; a < 2; ++a)
#pragma unroll
            for (int b = 0; b < 2; ++b)
#pragma unroll
                for (int m = 0; m < 4; ++m)
#pragma unroll
                    for (int n = 0; n < 2; ++n) acc[a][b][m][n] = (f32x4){0.f, 0.f, 0.f, 0.f};
        cur = nxt; cA = nA; cB = nB; ++ui;
        if constexpr (ALIGN_EPI) { if (wr == 1) PG8_BAR; }
    }
    PG8_WAIT_V(0);
    if constexpr (!ALIGN_EPI) { if (wr == 0) PG8_BAR; }
    PG8_BAR;
    if constexpr (Epi::AFTER_DRAIN) { E.fused(acc, cur, wr, wc, fr, fq, lds, wid, lane); S.done(cur); }
#undef PG8_SA
#undef PG8_SB
#undef PG8_STAGE
#undef PG8_LDA
#undef PG8_LDB
#undef PG8_MMA
#undef PG8_WAIT_V
#undef PG8_WAIT_L
#undef PG8_BAR
#undef PG8_SCHED
}
}
#endif
enum { ST_PRM = 100, ST_INIT = 0, ST_PB, ST_WT, ST_ROWSS, ST_NORM, ST_RESID, ST_DNPREP, ST_DNSCAN, ST_DNOUT, ST_NASC, ST_NAOUT, ST_LAM, ST_ROPE, ST_DATTN, ST_COUT, ST_FFNACT, ST_PLE };
struct Job { P p; WT w; const float* a; const float* b; long n; int layer; int flag; };
template <int ST> DEVFN void run_item(const Job& j, long g) {
    if constexpr (ST == ST_PRM) st_prm(j.p, j.layer, g);
    else if constexpr (ST == ST_INIT) st_init(j.p, j.layer, g);
    else if constexpr (ST == ST_PB) st_pb(j.p, j.layer, g);
    else if constexpr (ST == ST_WT) st_wt(j.w, g);
    else if constexpr (ST == ST_ROWSS) st_rowss(j.p, j.a, g);
    else if constexpr (ST == ST_NORM) st_norm_bf16(j.p, j.a, g);
    else if constexpr (ST == ST_RESID) st_resid(j.p, j.a, j.b, j.flag, g);
    else if constexpr (ST == ST_DNPREP) st_dn_prep(j.p, j.layer, g);
    else if constexpr (ST == ST_DNSCAN) st_dn_scan(j.p, j.layer, g);
    else if constexpr (ST == ST_DNOUT) st_dn_out(j.p, j.layer, g);
    else if constexpr (ST == ST_NASC) st_na_scores(j.p, j.layer, g);
    else if constexpr (ST == ST_NAOUT) st_na_out(j.p, j.layer, g);
    else if constexpr (ST == ST_LAM) st_lam(j.p, j.layer, g);
    else if constexpr (ST == ST_ROPE) st_rope(j.p, j.layer, g);
    else if constexpr (ST == ST_DATTN) st_dattn(j.p, j.layer, g);
    else if constexpr (ST == ST_COUT) st_c_out(j.p, j.layer, g);
    else if constexpr (ST == ST_FFNACT) st_ffn_act(j.p, j.layer, g);
    else if constexpr (ST == ST_PLE) st_ple(j.p, j.layer, g);
}
#ifdef EMU
template <int ST> static void run_stage(Job j, long n) {
    j.n = n;
#pragma omp parallel for schedule(dynamic, 64)
    for (long g = 0; g < n; ++g) run_item<ST>(j, g);
}
static void emu_gemm(const bf16* A, const bf16* Bt, int M, int N, int K, bf16* Ob, float* Of, int ldc) {
    std::vector<float> Af((size_t)M * K), Bf((size_t)N * K);
    for (size_t i = 0; i < Af.size(); ++i) Af[i] = bf2f(A[i]);
    for (size_t i = 0; i < Bf.size(); ++i) Bf[i] = bf2f(Bt[i]);
#pragma omp parallel for schedule(dynamic, 8)
    for (int m = 0; m < M; ++m) for (int n = 0; n < N; ++n) { const float* a = &Af[(size_t)m * K]; const float* b = &Bf[(size_t)n * K]; float s = 0.f;
        for (int k = 0; k < K; ++k) s += a[k] * b[k];
        if (Ob) Ob[(size_t)m * ldc + n] = f2bf(s); else Of[(size_t)m * ldc + n] = s; }
}
static void gemm_bf16(const bf16* A, const bf16* Bt, int M, int N, int K, bf16* O, int ldc) { emu_gemm(A, Bt, M, N, K, O, nullptr, ldc); }
static void gemm_f32(const bf16* A, const bf16* Bt, int M, int N, int K, float* O, int ldc) { emu_gemm(A, Bt, M, N, K, nullptr, O, ldc); }

static void forward(const P& p) {
    Job j; memset(&j, 0, sizeof(j)); j.p = p;
    auto wt = [&](const float* W, size_t off, int K, int N, int Npad) { j.w.W = W; j.w.O = WSP(bf16, off); j.w.K = K; j.w.N = N; j.w.Npad = Npad; run_stage<ST_WT>(j, (long)Npad * K); };
    for (int i = 0; i < 2; ++i) {
        wt(p.ab_w_in + (size_t)i * D * ABIN, WS_WABIN + (size_t)i * ABINP * D * 2, D, ABIN, ABINP);
        wt(p.ab_w_out + (size_t)i * ABMIX * D, WS_WABOUT + (size_t)i * D * ABMIX * 2, ABMIX, D, D);
        wt(p.c_w_in + (size_t)i * D * CIN, WS_WCIN + (size_t)i * CIN * D * 2, D, CIN, CIN);
        wt(p.c_w_out + (size_t)i * CV * D, WS_WCOUT + (size_t)i * D * CV * 2, CV, D, D);
    }
    for (int l = 0; l < DEPTH; ++l) {
        wt(p.ffn_w_in + (size_t)l * D * 2 * DFF, WS_WFIN + (size_t)l * 2 * DFF * D * 2, D, 2 * DFF, 2 * DFF);
        wt(p.ffn_w_out + (size_t)l * DFF * D, WS_WFOUT + (size_t)l * D * DFF * 2, DFF, D, D);
        wt(p.ple_w_proj + (size_t)l * PLE * D, WS_WPP + (size_t)l * D * PLE * 2, PLE, D, D);
        wt(p.ple_w_gate + (size_t)l * D * D, WS_WPG + (size_t)l * D * D * 2, D, D, D);
    }
    run_stage<ST_PRM>(j, N_PRM);
    for (int l = 0; l < DEPTH; ++l) { j.layer = l; run_stage<ST_PB>(j, N_PB); }
    run_stage<ST_INIT>(j, N_INIT);
    for (int layer = 0; layer < DEPTH; ++layer) {
        j.layer = layer; const int jj = layer / 2; const float* nw = PRM(PR_NORMS) + (size_t)layer * 4 * D;
        j.a = p.h; run_stage<ST_ROWSS>(j, N_ROWS);
        j.a = nw; run_stage<ST_NORM>(j, N_TD);
        if (layer % 2 == 0) {
            gemm_bf16(WSP(bf16, WS_HN), WSP(bf16, WS_WABIN + (size_t)jj * ABINP * D * 2), T, ABINP, D, WSP(bf16, WS_PROJ), ABINP);
            run_stage<ST_DNPREP>(j, N_TH);
            run_stage<ST_DNSCAN>(j, N_SCAN);
            run_stage<ST_DNOUT>(j, N_TH);
            run_stage<ST_NASC>(j, N_THD);
            run_stage<ST_NAOUT>(j, N_THD);
            gemm_f32(WSP(bf16, WS_MIXIN), WSP(bf16, WS_WABOUT + (size_t)jj * D * ABMIX * 2), T, D, ABMIX, WSP(float, WS_GOUT), D);
        } else {
            gemm_bf16(WSP(bf16, WS_HN), WSP(bf16, WS_WCIN + (size_t)jj * CIN * D * 2), T, CIN, D, WSP(bf16, WS_PROJ), CIN);
            run_stage<ST_LAM>(j, 1);
            run_stage<ST_ROPE>(j, N_ROPE);
            run_stage<ST_DATTN>(j, N_DATT);
            run_stage<ST_COUT>(j, N_TH);
            gemm_f32(WSP(bf16, WS_MIXIN), WSP(bf16, WS_WCOUT + (size_t)jj * D * CV * 2), T, D, CV, WSP(float, WS_GOUT), D);
        }
        j.a = WSP(float, WS_GOUT); run_stage<ST_ROWSS>(j, N_ROWS);
        j.a = WSP(float, WS_GOUT); j.b = nw + D; j.flag = 0; run_stage<ST_RESID>(j, N_TD);
        j.a = p.h; run_stage<ST_ROWSS>(j, N_ROWS);
        j.a = nw + 2 * D; run_stage<ST_NORM>(j, N_TD);
        gemm_bf16(WSP(bf16, WS_HN), WSP(bf16, WS_WFIN + (size_t)layer * 2 * DFF * D * 2), T, 2 * DFF, D, WSP(bf16, WS_HID), 2 * DFF);
        run_stage<ST_FFNACT>(j, N_ACT);
        gemm_f32(WSP(bf16, WS_ACT), WSP(bf16, WS_WFOUT + (size_t)layer * D * DFF * 2), T, D, DFF, WSP(float, WS_GOUT), D);
        j.a = WSP(float, WS_GOUT); run_stage<ST_ROWSS>(j, N_ROWS);
        j.a = WSP(float, WS_GOUT); j.b = nw + 3 * D; j.flag = 1; run_stage<ST_RESID>(j, N_TD);
        gemm_f32(WSP(bf16, WS_HN), WSP(bf16, WS_WPG + (size_t)layer * D * D * 2), T, D, D, WSP(float, WS_GOUT), D);
        gemm_f32(WSP(bf16, WS_PB + (size_t)layer * SZ_PB), WSP(bf16, WS_WPP + (size_t)layer * D * PLE * 2), T, D, PLE, WSP(float, WS_GOUT2), D);
        run_stage<ST_PLE>(j, N_TD);
    }
}
#endif

#ifndef EMU
namespace att {
using bf16x8 = __attribute__((ext_vector_type(8))) short;
using s16x4  = __attribute__((ext_vector_type(4))) short;
using f32x16 = __attribute__((ext_vector_type(16))) float;
using u32x4  = __attribute__((ext_vector_type(4))) unsigned;
constexpr int DA = 128, NW = 8, QBLK = 32, KVBLK = 64;
constexpr float SCALE = 0.088388347648318440f;
constexpr float THR = 8.f;
constexpr size_t SHM_V = KVBLK * DA * 2, SHM_K = KVBLK * DA * 2, SHM_ATTN = 2 * SHM_V + 2 * SHM_K + NW * 64 * 4;
#define KSWZ(row, colB) ((row) * 256 + ((colB) ^ (((row) & 15) << 4)))
#define SBAR() __builtin_amdgcn_sched_barrier(0)
__device__ __forceinline__ int crow(int r, int hi) { return (r & 3) + 8 * (r >> 2) + 4 * hi; }
__device__ __forceinline__ unsigned cvtpk(float lo, float hi) { unsigned r; asm volatile("v_cvt_pk_bf16_f32 %0, %1, %2" : "=v"(r) : "v"(lo), "v"(hi)); return r; }
__device__ __forceinline__ bf16x8 ld8(const bf16* p) { return *reinterpret_cast<const bf16x8*>(p); }
__device__ __forceinline__ void partialSM(f32x16& p0, f32x16& p1, float& m_reg, float& mn, float& alpha) {
  constexpr float C = SCALE * 1.4426950408889634f;
  float pmax = p0[0]; for (int r = 1; r < 16; ++r) pmax = fmaxf(pmax, p0[r]); for (int r = 0; r < 16; ++r) pmax = fmaxf(pmax, p1[r]);
  { auto rr = __builtin_amdgcn_permlane32_swap(__float_as_uint(pmax), __float_as_uint(pmax), false, false);
    pmax = fmaxf(__uint_as_float(rr[0]), __uint_as_float(rr[1])); }
  if (__builtin_expect(__all(pmax - m_reg <= THR / SCALE), 1)) { mn = m_reg; alpha = 1.f; }
  else { mn = fmaxf(m_reg, pmax); alpha = __builtin_amdgcn_exp2f((m_reg - mn) * C); m_reg = mn; }
  float mnC = -mn * C;
  for (int r = 0; r < 16; ++r) p0[r] = fmaf(p0[r], C, mnC); for (int r = 0; r < 16; ++r) p1[r] = fmaf(p1[r], C, mnC);
  for (int r = 0; r < 16; ++r) p0[r] = __builtin_amdgcn_exp2f(p0[r]);
}
__device__ __forceinline__ void finishSM(f32x16& p0, f32x16& p1, float alpha, float& l_reg, bf16x8& pa0, bf16x8& pa1, bf16x8& pa2, bf16x8& pa3) {
  for (int r = 0; r < 16; ++r) p1[r] = __builtin_amdgcn_exp2f(p1[r]);
  float ps = 0; for (int r = 0; r < 16; ++r) ps += p0[r]; for (int r = 0; r < 16; ++r) ps += p1[r];
  { auto rr = __builtin_amdgcn_permlane32_swap(__float_as_uint(ps), __float_as_uint(ps), false, false);
    ps = __uint_as_float(rr[0]) + __uint_as_float(rr[1]); }
  l_reg = l_reg * alpha + ps;
#define PK4(P, BASE, OUT) do { unsigned a0 = cvtpk(P[BASE + 0], P[BASE + 1]), a1 = cvtpk(P[BASE + 2], P[BASE + 3]);   \
    unsigned b0 = cvtpk(P[BASE + 4], P[BASE + 5]), b1 = cvtpk(P[BASE + 6], P[BASE + 7]);                              \
    auto r0 = __builtin_amdgcn_permlane32_swap(a0, b0, false, false); auto r1 = __builtin_amdgcn_permlane32_swap(a1, b1, false, false); \
    u32x4 w = {r0[0], r1[0], r0[1], r1[1]}; OUT = *reinterpret_cast<bf16x8*>(&w); } while (0)
  PK4(p0, 0, pa0); PK4(p0, 8, pa1); PK4(p1, 0, pa2); PK4(p1, 8, pa3);
#undef PK4
}
__device__ __forceinline__ void qkt(f32x16& p0, f32x16& p1, const bf16* Ks, const bf16x8* qr, int r32, int hi) {
  p0 = f32x16{}; p1 = f32x16{};
  for (int d0 = 0; d0 < 8; ++d0) { int cb = (d0 * 16 + hi * 8) * 2;
    bf16x8 b0 = *reinterpret_cast<const bf16x8*>((const char*)Ks + KSWZ(r32, cb));
    bf16x8 b1 = *reinterpret_cast<const bf16x8*>((const char*)Ks + KSWZ(32 + r32, cb));
    p0 = __builtin_amdgcn_mfma_f32_32x32x16_bf16(b0, qr[d0], p0, 0, 0, 0);
    p1 = __builtin_amdgcn_mfma_f32_32x32x16_bf16(b1, qr[d0], p1, 0, 0, 0); }
}
__device__ __forceinline__ int v_st(int k, int c) { const int kk = (k & ~0xC) | ((k & 4) << 1) | ((k & 8) >> 1); return ((kk >> 3) * 4 + (c >> 5)) * 512 + ((kk & 7) * 32 + (c & 31)) * 2; }
__device__ __forceinline__ int v_rd_base(int lane) { return ((lane & 3) << 3) | (((lane >> 2) & 3) << 6) | (((lane >> 4) & 1) << 5) | (((lane >> 5) & 1) << 8); }
constexpr int v_rd_off(int d0, int ks, int half) { return d0 * 512 + ks * 4096 + half * 2048; }
template <int OFF> __device__ __forceinline__ s16x4 tr_read(int vb) {
  s16x4 r; asm volatile("ds_read_b64_tr_b16 %0, %1 offset:%2" : "=&v"(r) : "v"(vb), "i"(OFF) : "memory"); return r;
}
template <int D0> __device__ __forceinline__ void pv_one(f32x16& od, int vb, bf16x8 pa0, bf16x8 pa1, bf16x8 pa2, bf16x8 pa3) {
  const s16x4 l0 = tr_read<v_rd_off(D0, 0, 0)>(vb), h0 = tr_read<v_rd_off(D0, 0, 1)>(vb), l1 = tr_read<v_rd_off(D0, 1, 0)>(vb), h1 = tr_read<v_rd_off(D0, 1, 1)>(vb);
  const s16x4 l2 = tr_read<v_rd_off(D0, 2, 0)>(vb), h2 = tr_read<v_rd_off(D0, 2, 1)>(vb), l3 = tr_read<v_rd_off(D0, 3, 0)>(vb), h3 = tr_read<v_rd_off(D0, 3, 1)>(vb);
  asm volatile("s_waitcnt lgkmcnt(0)" ::: "memory"); SBAR();
#define PK(L, H) (bf16x8){L[0], L[1], L[2], L[3], H[0], H[1], H[2], H[3]}
  od = __builtin_amdgcn_mfma_f32_32x32x16_bf16(pa0, PK(l0, h0), od, 0, 0, 0);
  od = __builtin_amdgcn_mfma_f32_32x32x16_bf16(pa1, PK(l1, h1), od, 0, 0, 0);
  od = __builtin_amdgcn_mfma_f32_32x32x16_bf16(pa2, PK(l2, h2), od, 0, 0, 0);
  od = __builtin_amdgcn_mfma_f32_32x32x16_bf16(pa3, PK(l3, h3), od, 0, 0, 0);
#undef PK
}
__device__ __forceinline__ void pv_d0(f32x16* o, int vb, bf16x8 pa0, bf16x8 pa1, bf16x8 pa2, bf16x8 pa3) {
  pv_one<0>(o[0], vb, pa0, pa1, pa2, pa3); pv_one<1>(o[1], vb, pa0, pa1, pa2, pa3); pv_one<2>(o[2], vb, pa0, pa1, pa2, pa3); pv_one<3>(o[3], vb, pa0, pa1, pa2, pa3);
}
struct NaInfo { int rq0, kr0; const float* tab; };
__device__ __forceinline__ void na_mask(f32x16& p0, f32x16& p1, int rk, int rq, int rs, int cq, int cs, int hi, const float* tab) {
  const bool rowok = (rk >= rs) && (rk < rs + NAR);
  int dr = rk - rq + NAR - 1; dr = dr < 0 ? 0 : (dr > 2 * NAR - 2 ? 2 * NAR - 2 : dr);
  const float* trow = tab + dr * (2 * NAC - 1); const float ninf = -__builtin_inff();
#pragma unroll
  for (int r = 0; r < 16; ++r) { const int ck = crow(r, hi); int dc = ck - cq + NAC - 1; dc = dc < 0 ? 0 : (dc > 2 * NAC - 2 ? 2 * NAC - 2 : dc);
    const bool ok = rowok && ck >= cs && ck < cs + NAC; const float b = trow[dc]; p0[r] = ok ? p0[r] + b : ninf; }
#pragma unroll
  for (int r = 0; r < 16; ++r) { const int ck = 32 + crow(r, hi); int dc = ck - cq + NAC - 1; dc = dc < 0 ? 0 : (dc > 2 * NAC - 2 ? 2 * NAC - 2 : dc);
    const bool ok = rowok && ck >= cs && ck < cs + NAC; const float b = trow[dc]; p1[r] = ok ? p1[r] + b : ninf; }
}
template <int LDQ, int LDK, int LDO, int MODE>
__device__ __forceinline__ void attn_dense_body(const bf16* __restrict__ Qb, const bf16* __restrict__ Kh, const bf16* __restrict__ Vh, void* __restrict__ Ob_, int seq, char* lds, NaInfo na, int tid_in) {
  constexpr int SDEPTH = 2;
  int tid_ = tid_in; asm volatile("" : "+v"(tid_));
  const int tid = tid_, wid = tid >> 6, lane = tid & 63, r32 = lane & 31, hi = lane >> 5;
  const int na_rq = na.rq0 + (wid >> 1), na_cq = (wid & 1) * 32 + r32, na_rs = clampi(na_rq - WR / 2, 0, ROWS - WR), na_cs = clampi(na_cq - NAC / 2, 0, GW - NAC);
#define NAMASK(P0, P1, jt) do { if constexpr (MODE == 1) na_mask(P0, P1, na.kr0 + (jt), na_rq, na_rs, na_cq, na_cs, hi, na.tab); } while (0)
  bf16* V_lds = (bf16*)lds; bf16* K_lds = (bf16*)(lds + 2 * SHM_V);
  float* ws = (float*)(lds + 2 * SHM_V + 2 * SHM_K) + wid * 64; float* li_l = ws; float* al_l = ws + 32;
  float m_reg = -1e30f, l_reg = 0; f32x16 o[4] = {}; bf16x8 qr[8];
  const bf16* Qw = Qb + (long)(wid * QBLK + r32) * LDQ + hi * 8;
#pragma unroll
  for (int d0 = 0; d0 < 8; ++d0) qr[d0] = ld8(Qw + d0 * 16);
  const int sr = tid >> 4, sc = (tid & 15) * 8, vst0 = v_st(sr, sc), vst1 = v_st(32 + sr, sc);
  const int vb0 = (int)(uintptr_t)V_lds + v_rd_base(lane);
  struct { bf16x8 vs0, vs1, ks0, ks1; } sr_[SDEPTH];
#define SLOAD(i, k0) do { sr_[i].vs0 = ld8(&Vh[(long)((k0) + sr) * LDK + sc]); sr_[i].vs1 = ld8(&Vh[(long)((k0) + 32 + sr) * LDK + sc]); \
    sr_[i].ks0 = ld8(&Kh[(long)((k0) + sr) * LDK + sc]); sr_[i].ks1 = ld8(&Kh[(long)((k0) + 32 + sr) * LDK + sc]); } while (0)
#define SWRITE(b, i) do { *(bf16x8*)((char*)V_lds + (b) * SHM_V + vst0) = sr_[i].vs0;          \
    *(bf16x8*)((char*)V_lds + (b) * SHM_V + vst1) = sr_[i].vs1; int kc = sc * 2;               \
    *(bf16x8*)((char*)K_lds + (b) * SHM_K + KSWZ(sr, kc)) = sr_[i].ks0;                       \
    *(bf16x8*)((char*)K_lds + (b) * SHM_K + KSWZ(32 + sr, kc)) = sr_[i].ks1; } while (0)
#define SWAIT() asm volatile("s_waitcnt vmcnt(4)" ::: "memory")
#define RESC(a) do { if (__any((a) < 1.f)) { if (hi == 0) al_l[r32] = (a); asm volatile("s_waitcnt lgkmcnt(0)" ::: "memory"); \
    for (int d = 0; d < 4; ++d) for (int r = 0; r < 16; ++r) o[d][r] *= al_l[crow(r, hi)]; } } while (0)
  f32x16 pA0, pA1, pB0, pB1; float mnA, mnB, alA, alB; bf16x8 pa0, pa1, pa2, pa3; const int NT = seq / KVBLK;
  constexpr int SE = 0, SO = SDEPTH - 1;
  SLOAD(SE, 0); asm volatile("s_waitcnt vmcnt(0)" ::: "memory"); SWRITE(0, SE); __syncthreads();
  qkt(pA0, pA1, K_lds, qr, r32, hi); NAMASK(pA0, pA1, 0); partialSM(pA0, pA1, m_reg, mnA, alA);
  SLOAD(SO, KVBLK); if (2 < NT) SLOAD(SE, 2 * KVBLK);
  SWAIT(); SWRITE(1, SO); __syncthreads();
  for (int j = 1; j + 1 < NT; j += 2) {
    SBAR(); qkt(pB0, pB1, (bf16*)((char*)K_lds + SHM_K), qr, r32, hi); NAMASK(pB0, pB1, j);
    finishSM(pA0, pA1, alA, l_reg, pa0, pa1, pa2, pa3); SBAR();
    SLOAD(SO, (j + SDEPTH) * KVBLK); SBAR();
    pv_d0(o, vb0, pa0, pa1, pa2, pa3); partialSM(pB0, pB1, m_reg, mnB, alB);
    __syncthreads(); SWAIT(); SWRITE(0, SE);
    RESC(alB); __syncthreads();
    SBAR(); qkt(pA0, pA1, K_lds, qr, r32, hi); NAMASK(pA0, pA1, j + 1);
    finishSM(pB0, pB1, alB, l_reg, pa0, pa1, pa2, pa3); SBAR();
    if (j + 3 < NT) SLOAD(SE, (j + 1 + SDEPTH) * KVBLK); SBAR();
    pv_d0(o, vb0 + (int)SHM_V, pa0, pa1, pa2, pa3); partialSM(pA0, pA1, m_reg, mnA, alA);
    __syncthreads(); SWAIT(); SWRITE(1, SO);
    RESC(alA); __syncthreads();
  }
  SBAR(); qkt(pB0, pB1, (bf16*)((char*)K_lds + SHM_K), qr, r32, hi); NAMASK(pB0, pB1, NT - 1);
  finishSM(pA0, pA1, alA, l_reg, pa0, pa1, pa2, pa3); SBAR();
  pv_d0(o, vb0, pa0, pa1, pa2, pa3); partialSM(pB0, pB1, m_reg, mnB, alB);
  __syncthreads(); RESC(alB);
  finishSM(pB0, pB1, alB, l_reg, pa0, pa1, pa2, pa3); SBAR();
  pv_d0(o, vb0 + (int)SHM_V, pa0, pa1, pa2, pa3);
  if (hi == 0) li_l[r32] = l_reg; asm volatile("s_waitcnt lgkmcnt(0)" ::: "memory");
  float rli[16];
#pragma unroll
  for (int r = 0; r < 16; ++r) rli[r] = __builtin_amdgcn_rcpf(li_l[crow(r, hi)]);
  if constexpr (MODE == 2) { float* Ow = (float*)Ob_ + (long)(wid * QBLK) * LDO;
#pragma unroll
    for (int r = 0; r < 16; ++r) { int orow = crow(r, hi);
      for (int d0 = 0; d0 < 4; ++d0) Ow[(long)orow * LDO + d0 * 32 + r32] = o[d0][r] * rli[r]; }
  } else { bf16* Ow = (bf16*)Ob_ + (long)(wid * QBLK) * LDO;
#pragma unroll
    for (int r = 0; r < 16; ++r) { int orow = crow(r, hi);
      for (int d0 = 0; d0 < 4; ++d0) Ow[(long)orow * LDO + d0 * 32 + r32] = f2bf(o[d0][r] * rli[r]); } }
#undef NAMASK
#undef SLOAD
#undef SWRITE
#undef SWAIT
#undef RESC
}
template <int LDQ, int LDK, int LDO>
__device__ __forceinline__ void na_body(const bf16* __restrict__ Qb, const bf16* __restrict__ Kh, const bf16* __restrict__ Vh, bf16* __restrict__ Ob, int ntiles, char* lds, NaInfo na, int tid_in) {
  int tid_ = tid_in; asm volatile("" : "+v"(tid_));
  const int tid = tid_, wid = tid >> 6, lane = tid & 63, r32 = lane & 31, hi = lane >> 5;
  const int na_rq = na.rq0 + (wid >> 1), na_cq = (wid & 1) * 32 + r32, na_rs = clampi(na_rq - WR / 2, 0, ROWS - WR), na_cs = clampi(na_cq - NAC / 2, 0, GW - NAC);
  bf16* V_lds = (bf16*)lds; bf16* K_lds = (bf16*)(lds + 2 * SHM_V);
  float* ws = (float*)(lds + 2 * SHM_V + 2 * SHM_K) + wid * 64; float* li_l = ws; float* al_l = ws + 32;
  float m_reg = -1e30f, l_reg = 0; f32x16 o[4] = {}; bf16x8 qr[8];
  const bf16* Qw = Qb + (long)(wid * QBLK + r32) * LDQ + hi * 8;
#pragma unroll
  for (int d0 = 0; d0 < 8; ++d0) qr[d0] = ld8(Qw + d0 * 16);
  const int sr = tid >> 4, sc = (tid & 15) * 8, vst0 = v_st(sr, sc), vst1 = v_st(32 + sr, sc);
  const int vb0 = (int)(uintptr_t)V_lds + v_rd_base(lane);
  bf16x8 vs0 = ld8(&Vh[(long)sr * LDK + sc]), vs1 = ld8(&Vh[(long)(32 + sr) * LDK + sc]), ks0 = ld8(&Kh[(long)sr * LDK + sc]), ks1 = ld8(&Kh[(long)(32 + sr) * LDK + sc]);
  for (int jt = 0; jt < ntiles; ++jt) {
    __syncthreads();
    *(bf16x8*)((char*)V_lds + vst0) = vs0; *(bf16x8*)((char*)V_lds + vst1) = vs1;
    *(bf16x8*)((char*)K_lds + KSWZ(sr, sc * 2)) = ks0; *(bf16x8*)((char*)K_lds + KSWZ(32 + sr, sc * 2)) = ks1;
    __syncthreads();
    if (jt + 1 < ntiles) { const int k0 = (jt + 1) * KVBLK;
      vs0 = ld8(&Vh[(long)(k0 + sr) * LDK + sc]); vs1 = ld8(&Vh[(long)(k0 + 32 + sr) * LDK + sc]); ks0 = ld8(&Kh[(long)(k0 + sr) * LDK + sc]); ks1 = ld8(&Kh[(long)(k0 + 32 + sr) * LDK + sc]); }
    f32x16 p0, p1; float mn, al; bf16x8 pa0, pa1, pa2, pa3;
    qkt(p0, p1, K_lds, qr, r32, hi);
    na_mask(p0, p1, na.kr0 + jt, na_rq, na_rs, na_cq, na_cs, hi, na.tab);
    partialSM(p0, p1, m_reg, mn, al);
    if (__any(al < 1.f)) { if (hi == 0) al_l[r32] = al; asm volatile("s_waitcnt lgkmcnt(0)" ::: "memory");
      for (int d = 0; d < 4; ++d) for (int r = 0; r < 16; ++r) o[d][r] *= al_l[crow(r, hi)]; }
    finishSM(p0, p1, al, l_reg, pa0, pa1, pa2, pa3); SBAR();
    pv_d0(o, vb0, pa0, pa1, pa2, pa3);
  }
  if (hi == 0) li_l[r32] = l_reg; asm volatile("s_waitcnt lgkmcnt(0)" ::: "memory");
  float rli[16];
#pragma unroll
  for (int r = 0; r < 16; ++r) rli[r] = __builtin_amdgcn_rcpf(li_l[crow(r, hi)]);
  bf16* Ow = Ob + (long)(wid * QBLK) * LDO;
#pragma unroll
  for (int r = 0; r < 16; ++r) { int orow = crow(r, hi);
    for (int d0 = 0; d0 < 4; ++d0) Ow[(long)orow * LDO + d0 * 32 + r32] = f2bf(o[d0][r] * rli[r]); }
}
template <int LDQ, int LDK, int LDO>
__device__ __forceinline__ void dattn256_body(const bf16* __restrict__ Qb, const bf16* __restrict__ Kh, const bf16* __restrict__ Vh, bf16* Ob, int ntiles, char* lds, int tid_in,
                                              int mode = 0, bf16* Mx = nullptr, float lam = 0.f, float scale = 0.f, const float* sw = nullptr) {
  typedef __attribute__((address_space(3))) unsigned lds_u32;
  int tid_ = tid_in; asm volatile("" : "+v"(tid_));
  const int tid = tid_, wid = __builtin_amdgcn_readfirstlane(tid >> 6), lane = tid & 63, r32 = lane & 31, hi = lane >> 5;
  constexpr int VB = 2 * (int)SHM_V, KB = (int)SHM_K;
  char* V_lds = lds; char* K_lds = lds + 2 * VB;
  float* ws = (float*)(lds + 2 * VB + 2 * KB) + wid * 64; float* li_l = ws; float* al_l = ws + 32;
  float m_reg = -1e30f, l_reg = 0; f32x16 o[8] = {}; bf16x8 qr[8];
  const bf16* Qw = Qb + (long)(wid * QBLK + r32) * LDQ + hi * 8;
#pragma unroll
  for (int d0 = 0; d0 < 8; ++d0) qr[d0] = ld8(Qw + d0 * 16);
  unsigned koff[2], voff[2];
#pragma unroll
  for (int i = 0; i < 2; ++i) { const int kp = 2 * wid + i; const int row = 4 * kp + (lane >> 4), c = (lane & 15) ^ (row & 15); koff[i] = (unsigned)(row * LDK + c * 8);
    const int st = 2 * kp + (lane >> 5), within = lane & 31, kk = (st >> 2) * 8 + (within >> 2), k = (kk & ~0xC) | ((kk & 4) << 1) | ((kk & 8) >> 1); voff[i] = (unsigned)(k * LDK + (st & 3) * 32 + (within & 3) * 8); }
  const int vbase = (int)(uintptr_t)V_lds + v_rd_base(lane);
#define DA_DMA(t, b) do { const bf16* kt_ = Kh + (long)(t) * KVBLK * LDK; const bf16* vt_ = Vh + (long)(t) * KVBLK * LDK; \
      _Pragma("unroll") for (int i = 0; i < 2; ++i) { \
        __builtin_amdgcn_global_load_lds((const unsigned*)(kt_ + koff[i]), (lds_u32*)(K_lds + (b) * KB + (2 * wid + i) * 1024), 16, 0, 0); \
        __builtin_amdgcn_global_load_lds((const unsigned*)(vt_ + voff[i]), (lds_u32*)(V_lds + (b) * VB + (2 * wid + i) * 1024), 16, 0, 0); \
        __builtin_amdgcn_global_load_lds((const unsigned*)(vt_ + voff[i] + 128), (lds_u32*)(V_lds + (b) * VB + (int)SHM_V + (2 * wid + i) * 1024), 16, 0, 0); } } while (0)
  __syncthreads();
  DA_DMA(0, 0);
  for (int jt = 0; jt < ntiles; ++jt) {
    const int b = jt & 1;
    asm volatile("s_waitcnt vmcnt(0)" ::: "memory");
    __syncthreads();
    if (jt + 1 < ntiles) DA_DMA(jt + 1, b ^ 1);
    const char* Kb = K_lds + b * KB;
    f32x16 p0, p1; float mn, al; bf16x8 pa0, pa1, pa2, pa3;
    p0 = f32x16{}; p1 = f32x16{};
#pragma unroll
    for (int d0 = 0; d0 < 8; ++d0) { const int cb = (d0 * 16 + hi * 8) * 2;
      const bf16x8 b0 = *reinterpret_cast<const bf16x8*>(Kb + KSWZ(r32, cb)), b1 = *reinterpret_cast<const bf16x8*>(Kb + KSWZ(32 + r32, cb));
      p0 = __builtin_amdgcn_mfma_f32_32x32x16_bf16(b0, qr[d0], p0, 0, 0, 0); p1 = __builtin_amdgcn_mfma_f32_32x32x16_bf16(b1, qr[d0], p1, 0, 0, 0); }
    partialSM(p0, p1, m_reg, mn, al);
    if (__any(al < 1.f)) { if (hi == 0) al_l[r32] = al; asm volatile("s_waitcnt lgkmcnt(0)" ::: "memory");
      for (int d = 0; d < 8; ++d) for (int r = 0; r < 16; ++r) o[d][r] *= al_l[crow(r, hi)]; }
    finishSM(p0, p1, al, l_reg, pa0, pa1, pa2, pa3); SBAR();
    pv_d0(o, vbase + b * VB, pa0, pa1, pa2, pa3);
    pv_d0(o + 4, vbase + b * VB + (int)SHM_V, pa0, pa1, pa2, pa3);
  }
#undef DA_DMA
  if (hi == 0) li_l[r32] = l_reg; asm volatile("s_waitcnt lgkmcnt(0)" ::: "memory");
  float rli[16];
#pragma unroll
  for (int r = 0; r < 16; ++r) rli[r] = __builtin_amdgcn_rcpf(li_l[crow(r, hi)]);
  bf16* Ow = Ob + (long)(wid * QBLK) * LDO;
  if (mode == 0) {
#pragma unroll
    for (int r = 0; r < 16; ++r) { int orow = crow(r, hi);
      for (int d0 = 0; d0 < 8; ++d0) Ow[(long)orow * LDO + d0 * 32 + r32] = f2bf(o[d0][r] * rli[r]); }
  } else {
    bf16* Mw = Mx + (long)(wid * QBLK) * LDO;
    float swv[8];
#pragma unroll
    for (int d0 = 0; d0 < 8; ++d0) swv[d0] = sw[d0 * 32 + r32] * scale;
#pragma unroll
    for (int r = 0; r < 16; ++r) { const int orow = crow(r, hi); float ss = 0.f; const float nl = -lam * rli[r];
#pragma unroll
      for (int d0 = 0; d0 < 8; ++d0) { const float x = bf2f(Ow[(long)orow * LDO + d0 * 32 + r32]) + nl * o[d0][r]; o[d0][r] = x; ss += x * x; }
      ss += __shfl_xor(ss, 1); ss += __shfl_xor(ss, 2); ss += __shfl_xor(ss, 4); ss += __shfl_xor(ss, 8); ss += __shfl_xor(ss, 16);
      const float rs = 1.0f / sqrtf(ss * (1.0f / 256.0f) + RMS_EPS);
#pragma unroll
      for (int d0 = 0; d0 < 8; ++d0) Mw[(long)orow * LDO + d0 * 32 + r32] = f2bf(o[d0][r] * rs * swv[d0]); }
  }
}
}
namespace dn {
using bf16x8 = __attribute__((ext_vector_type(8))) short;
using f32x4v = __attribute__((ext_vector_type(4))) float;
using f32x2v = __attribute__((ext_vector_type(2))) float;
using bf16x2v = __attribute__((ext_vector_type(2))) __bf16;
using u32x4 = __attribute__((ext_vector_type(4))) unsigned;
constexpr int KP = 136;
constexpr int L_K = 0, L_Q = 17408, L_V = 34816, L_AKK = 67584, L_AQK = 84224, L_L0 = 100864, L_L1 = 117248, L_SM = 133632, L_DB = 135680, L_END = 143872;
__device__ __forceinline__ unsigned pk(float lo, float hi) { const f32x2v v = {lo, hi}; return __builtin_bit_cast(unsigned, __builtin_convertvector(v, bf16x2v)); }
__device__ __forceinline__ bf16x8 pack8(f32x4v a, f32x4v b) { u32x4 w = {pk(a[0], a[1]), pk(a[2], a[3]), pk(b[0], b[1]), pk(b[2], b[3])}; return __builtin_bit_cast(bf16x8, w); }
__device__ __forceinline__ int kperm(int s, int q, int j) { return 32 * s + 16 * (j >> 2) + 4 * q + (j & 3); }
#define MFMA16(a, b, c) __builtin_amdgcn_mfma_f32_16x16x32_bf16((a), (b), (c), 0, 0, 0)

__device__ __forceinline__ float fexp(float x) { return __builtin_amdgcn_exp2f(x * 1.4426950408889634f); }
__device__ __forceinline__ float fsilu(float x) { return x * __builtin_amdgcn_rcpf(1.0f + fexp(-x)); }
template <int C> __device__ __forceinline__ float dpp_bc(int v) { return __int_as_float(__builtin_amdgcn_update_dpp(0, v, C, 0xf, 0xf, false)); }
template <int I, int J> __device__ __forceinline__ void inv16_terms(float& r, int lk, const float (&x)[16]) {
    if constexpr (J < I) { r -= dpp_bc<0x150 + J>(lk) * x[J]; inv16_terms<I, J + 1>(r, lk, x); }
}
template <int I> __device__ __forceinline__ void inv16_rows(float (&x)[16], const float* Lbb, int c) {
    if constexpr (I < 16) { float r = (I == c) ? 1.f : 0.f; const int lk = __float_as_int(Lbb[I * 64 + c]); inv16_terms<I, 0>(r, lk, x); x[I] = r; inv16_rows<I + 1>(x, Lbb, c); }
}
__device__ __forceinline__ void dn1_unit(const P& p, int jl, int seq, int hh, int chunk, char* lds, int tid_in) {
    int tid_ = tid_in; asm volatile("" : "+v"(tid_));
    const int tid = tid_, lane = tid & 63, wave = tid >> 6;
    bf16* Kl = (bf16*)(lds + L_K); bf16* Ql = (bf16*)(lds + L_Q); float* Vl = (float*)(lds + L_V); float* AKK = (float*)(lds + L_AKK); float* AQK = (float*)(lds + L_AQK);
    float* L0 = (float*)(lds + L_L0); float* L1 = (float*)(lds + L_L1); float* g_l = (float*)(lds + L_SM); float* beta_l = g_l + 128; float* gc_l = g_l + 256; float* bk_l = g_l + 384;
    const int tt0 = chunk * 64; const long tb = (long)seq * S; const bf16* PROJ = WSP(bf16, WS_PROJ);
    const size_t unit = ((size_t)(seq * NH + hh) * (S / 64) + chunk);
    if (tid < 384) {
        const int cgi = tid & 15, part = (tid >> 4) % 3, oct = tid / 48, i0 = 8 * oct; const int coff = part * 1024 + hh * DH + 8 * cgi;
        bf16x8 x[12]; float w[5][8];
#pragma unroll
        for (int k = 0; k < 12; ++k) { const int ts = tt0 + i0 + k - 2; x[k] = (ts >= 0 && ts < S) ? *(const bf16x8*)(PROJ + (size_t)(tb + ts) * ABINP + coff) : (bf16x8){0, 0, 0, 0, 0, 0, 0, 0}; }
#pragma unroll
        for (int tap = 0; tap < 5; ++tap) { const float* cw = PRM(PR_ABCONV) + (size_t)(jl * 5 + tap) * AQKV + coff; const f32x4v a = *(const f32x4v*)cw, b = *(const f32x4v*)(cw + 4);
#pragma unroll
            for (int e = 0; e < 4; ++e) { w[tap][e] = a[e]; w[tap][4 + e] = b[e]; } }
#pragma unroll
        for (int kk = 0; kk < 8; ++kk) { float y[8]; float ss = 0.f;
#pragma unroll
            for (int c = 0; c < 8; ++c) { float acc = 0.f;
#pragma unroll
                for (int tap = 0; tap < 5; ++tap) acc += bf2f((bf16)x[kk + tap][c]) * w[tap][c];
                y[c] = fsilu(acc); ss += y[c] * y[c]; }
            ss += __shfl_xor(ss, 1); ss += __shfl_xor(ss, 2); ss += __shfl_xor(ss, 4); ss += __shfl_xor(ss, 8);
            const float rn = 1.0f / sqrtf(ss + 1e-6f); const float sc_ = part == 0 ? rn * 0.08838834764831845f : (part == 1 ? rn : 1.0f); const int i = i0 + kk;
            if (part < 2) { u32x4 wv; wv[0] = pk(y[0] * sc_, y[1] * sc_); wv[1] = pk(y[2] * sc_, y[3] * sc_); wv[2] = pk(y[4] * sc_, y[5] * sc_); wv[3] = pk(y[6] * sc_, y[7] * sc_);
                *(u32x4*)((part ? Kl : Ql) + i * KP + 8 * cgi) = wv; }
            else { *(f32x4v*)(Vl + i * 128 + 8 * cgi) = (f32x4v){y[0], y[1], y[2], y[3]}; *(f32x4v*)(Vl + i * 128 + 8 * cgi + 4) = (f32x4v){y[4], y[5], y[6], y[7]}; } }
    } else { const int gt = tid - 384; const int dir = gt >> 6, il = gt & 63, ti = dir ? 63 - il : il; const bf16* gr = PROJ + (size_t)(tb + tt0 + ti) * ABINP + COL_G;
        const float graw = bf2f(gr[dir * NH + hh]), braw = bf2f(gr[16 + dir * NH + hh]);
        const float a = expf(PRM(PR_ALOG)[(jl * 2 + dir) * NH + hh]), dtb = PRM(PR_DTB)[(jl * 2 + dir) * NH + hh];
        g_l[dir * 64 + il] = -a * softplusf(graw + dtb); beta_l[dir * 64 + il] = sigmoidf(braw); }
    __syncthreads();
    if (wave < 2) { const int dir = wave; float c = g_l[dir * 64 + lane];
#pragma unroll
        for (int o = 1; o < 64; o <<= 1) { const float t = __shfl_up(c, o); if (lane >= o) c += t; }
        gc_l[dir * 64 + lane] = c; bk_l[dir * 64 + lane] = beta_l[dir * 64 + lane] * fexp(c); }
    {
        const int r = lane & 15, q = lane >> 4;
#pragma unroll
        for (int tt = 0; tt < 2; ++tt) { const int tile = 2 * wave + tt, ti_ = tile >> 2, tj_ = tile & 3; f32x4v ck = {0.f, 0.f, 0.f, 0.f}, cq = {0.f, 0.f, 0.f, 0.f};
#pragma unroll
            for (int s = 0; s < 4; ++s) { const bf16x8 ak = *(const bf16x8*)(Kl + (16 * ti_ + r) * KP + 32 * s + 8 * q), aq = *(const bf16x8*)(Ql + (16 * ti_ + r) * KP + 32 * s + 8 * q), b = *(const bf16x8*)(Kl + (16 * tj_ + r) * KP + 32 * s + 8 * q);
                ck = MFMA16(ak, b, ck); cq = MFMA16(aq, b, cq); }
#pragma unroll
            for (int rr = 0; rr < 4; ++rr) { AKK[(16 * ti_ + 4 * q + rr) * 65 + 16 * tj_ + r] = ck[rr]; AQK[(16 * ti_ + 4 * q + rr) * 65 + 16 * tj_ + r] = cq[rr]; } }
    }
    __syncthreads();
    for (int e = tid; e < 8192; e += 512) { const int dir = e >> 12, i = (e >> 6) & 63, jx = e & 63; float v = 0.f;
        if (jx < i) { const int ti = dir ? 63 - i : i, tj = dir ? 63 - jx : jx; v = beta_l[dir * 64 + i] * AKK[ti * 65 + tj] * fexp(gc_l[dir * 64 + i] - gc_l[dir * 64 + jx]); }
        (dir ? L1 : L0)[i * 64 + jx] = v; }
#pragma unroll
    for (int dir = 0; dir < 2; ++dir) {
        const size_t ud = unit * 2 + dir; const float* gc = gc_l + dir * 64; const float glast = gc[63];
        {
            const int frag = tid >> 6, mt = frag >> 1, s = frag & 1, i = 16 * mt + (lane & 15), q = lane >> 4, ti = dir ? 63 - i : i; const float gi = gc[i]; float v[8];
#pragma unroll
            for (int jv = 0; jv < 8; ++jv) { const int jx = kperm(s, q, jv); v[jv] = (jx <= i) ? AQK[ti * 65 + (dir ? 63 - jx : jx)] * fexp(gi - gc[jx]) : 0.f; }
            u32x4 w = {pk(v[0], v[1]), pk(v[2], v[3]), pk(v[4], v[5]), pk(v[6], v[7])};
            *(u32x4*)(WSP(bf16, WS_DN_IN) + ((ud * 8 + frag) * 64 + lane) * 8) = w;
        }
#pragma unroll
        for (int rep = 0; rep < 2; ++rep) {
            const int fl = tid + 512 * rep, frag = fl >> 6, q = lane >> 4;
            { const int mt = frag >> 2, s = frag & 3, i = 16 * mt + (lane & 15), ti = dir ? 63 - i : i; const float eg = fexp(gc[i]); float v[8];
#pragma unroll
              for (int jv = 0; jv < 8; ++jv) v[jv] = bf2f(Ql[ti * KP + kperm(s, q, jv)]) * eg;
              u32x4 w = {pk(v[0], v[1]), pk(v[2], v[3]), pk(v[4], v[5]), pk(v[6], v[7])};
              *(u32x4*)(WSP(bf16, WS_DN_QE) + ((ud * 16 + frag) * 64 + lane) * 8) = w; }
            { const int mt = frag >> 1, s = frag & 1, d = 16 * mt + (lane & 15); float v[8];
#pragma unroll
              for (int jv = 0; jv < 8; ++jv) { const int jx = kperm(s, q, jv), tj = dir ? 63 - jx : jx; v[jv] = bf2f(Kl[tj * KP + d]) * fexp(glast - gc[jx]); }
              u32x4 w = {pk(v[0], v[1]), pk(v[2], v[3]), pk(v[4], v[5]), pk(v[6], v[7])};
              *(u32x4*)(WSP(bf16, WS_DN_KD) + ((ud * 16 + frag) * 64 + lane) * 8) = w; }
        }
        if (tid == 0) WSP(float, WS_DN_EG)[ud] = fexp(glast);
    }
    __syncthreads();
    {
        float* DB = (float*)(lds + L_DB);
        if (wave < 2) { const int b = lane >> 4, c = lane & 15; const float* Lbb = (wave ? L1 : L0) + (16 * b) * 64 + 16 * b; float x[16];
            inv16_rows<0>(x, Lbb, c);
#pragma unroll
            for (int i = 0; i < 16; ++i) DB[((wave * 4 + b) * 16 + i) * 16 + c] = x[i]; }
        __syncthreads();
        const int dir = __builtin_amdgcn_readfirstlane(tid >> 8), wq = __builtin_amdgcn_readfirstlane((tid >> 6) & 3); const float* L = dir ? L1 : L0; const size_t ud = unit * 2 + dir;
        const float* bv = beta_l + dir * 64; const float* bk = bk_l + dir * 64; const int m = lane & 15, q = lane >> 4;
        const f32x4v zero4 = {0.f, 0.f, 0.f, 0.f};
        bf16x8 A01[3], A23, Ad[4];
#pragma unroll
        for (int b = 1; b < 4; ++b) { const float* lr = L + (16 * b + m) * 64 + 4 * q; const f32x4v l0 = *(const f32x4v*)lr, l1 = (b >= 2) ? *(const f32x4v*)(lr + 16) : zero4; A01[b - 1] = pack8(-l0, -l1); }
        { const float* lr = L + (48 + m) * 64 + 32 + 4 * q; A23 = pack8(-*(const f32x4v*)lr, zero4); }
#pragma unroll
        for (int b = 0; b < 4; ++b) Ad[b] = pack8(*(const f32x4v*)(DB + ((dir * 4 + b) * 16 + m) * 16 + 4 * q), zero4);
#pragma unroll
        for (int nt4 = 0; nt4 < 4; ++nt4) { const int col = 64 * wq + 16 * nt4 + m; f32x4v X[4];
#pragma unroll
            for (int b = 0; b < 4; ++b) { f32x4v acc;
#pragma unroll
                for (int r = 0; r < 4; ++r) { const int i = 16 * b + 4 * q + r, ti = dir ? 63 - i : i; acc[r] = (wq < 2) ? bv[i] * Vl[ti * 128 + col] : bk[i] * bf2f(Kl[ti * KP + (col - 128)]); }
                if (b >= 1) acc = MFMA16(A01[b - 1], pack8(X[0], b >= 2 ? X[1] : zero4), acc);
                if (b == 3) acc = MFMA16(A23, pack8(X[2], zero4), acc);
                X[b] = MFMA16(Ad[b], pack8(acc, zero4), zero4); }
            if (wq < 2) { float* o = WSP(float, WS_DN_UT) + (ud * 128 + col) * 64 + 4 * q;
#pragma unroll
                for (int b = 0; b < 4; ++b) *(f32x4v*)(o + 16 * b) = X[b];
            } else { const int d = col - 128, s = d >> 5, qd = (d >> 2) & 3, jv = 4 * ((d >> 4) & 1) + (d & 3); bf16* o = (bf16*)(lds + L_AKK) + dir * 16 * 512;
#pragma unroll
                for (int b = 0; b < 4; ++b)
#pragma unroll
                    for (int r = 0; r < 4; ++r) o[((b * 4 + s) * 64 + (4 * q + r) + 16 * qd) * 8 + jv] = f2bf(-X[b][r]); }
        }
    }
    __syncthreads();
    {
        u32x4* dst = (u32x4*)(WSP(bf16, WS_DN_WN) + unit * 2 * 16 * 512); const u32x4* src = (const u32x4*)(lds + L_AKK);
#pragma unroll
        for (int e = 0; e < 4; ++e) dst[tid + 512 * e] = src[tid + 512 * e];
    }
}
constexpr int SC_WN = 0, SC_QE = 16384, SC_IN = 32768, SC_KD = 40960, SC_BUF = 57344;
__device__ __forceinline__ void dn_scan_chain(const P& p, int chain, char* lds, int tid_in) {
    int tid_ = tid_in; asm volatile("" : "+v"(tid_));
    const int tid = tid_, lane = tid & 63, wave = tid >> 6, n = lane & 15, q = lane >> 4, n0 = wave * 16;
    const int dir = chain & 1, sh = chain >> 1, hh = sh % NH, seq = sh / NH;
    f32x4v Sacc[8];
#pragma unroll
    for (int mt = 0; mt < 8; ++mt) Sacc[mt] = (f32x4v){0.f, 0.f, 0.f, 0.f};
    bf16* O = WSP(bf16, dir ? WS_OB : WS_OF);
    u32x4 st0[7], st1[7];
#define SC_UD(step) (((size_t)sh * (S / 64) + (dir ? S / 64 - 1 - (step) : (step))) * 2 + dir)
#define SC_LOAD(st, ud) do { const u32x4* a = (const u32x4*)WSP(bf16, WS_DN_WN) + (ud) * 1024 + tid; const u32x4* b = (const u32x4*)WSP(bf16, WS_DN_QE) + (ud) * 1024 + tid; \
        const u32x4* c = (const u32x4*)WSP(bf16, WS_DN_IN) + (ud) * 512 + tid; const u32x4* d = (const u32x4*)WSP(bf16, WS_DN_KD) + (ud) * 1024 + tid; \
        st[0] = a[0]; st[1] = a[512]; st[2] = b[0]; st[3] = b[512]; st[4] = c[0]; st[5] = d[0]; st[6] = d[512]; } while (0)
#define SC_WRITE(st, buf) do { char* b_ = lds + (buf) * SC_BUF + tid * 16; *(u32x4*)(b_ + SC_WN) = st[0]; *(u32x4*)(b_ + SC_WN + 8192) = st[1]; *(u32x4*)(b_ + SC_QE) = st[2]; *(u32x4*)(b_ + SC_QE + 8192) = st[3]; \
        *(u32x4*)(b_ + SC_IN) = st[4]; *(u32x4*)(b_ + SC_KD) = st[5]; *(u32x4*)(b_ + SC_KD + 8192) = st[6]; } while (0)
    f32x4v ut0[4], ut1[4]; float eg0, eg1;
#define SC_LOADU(ut, egv, ud) do { const float* u_ = WSP(float, WS_DN_UT) + ((ud) * 128 + n0 + n) * 64 + 4 * q; _Pragma("unroll") for (int mt = 0; mt < 4; ++mt) ut[mt] = *(const f32x4v*)(u_ + 16 * mt); egv = WSP(float, WS_DN_EG)[ud]; } while (0)
    { const size_t ud0 = SC_UD(0), ud1 = SC_UD(1), ud2 = SC_UD(2); SC_LOAD(st0, ud0); SC_LOADU(ut0, eg0, ud0); SC_LOAD(st1, ud1); SC_LOADU(ut1, eg1, ud1); SC_WRITE(st0, 0); SC_LOAD(st0, ud2); }
    __syncthreads();
#define SC_STEP(step, stY, utX, egX) do { \
        const int c = dir ? S / 64 - 1 - (step) : (step); \
        if ((step) + 1 < S / 64) SC_WRITE(stY, ((step) + 1) & 1);                                       \
        if ((step) + 3 < S / 64) { const size_t udn = SC_UD((step) + 3); SC_LOAD(stY, udn); } \
        f32x4v vn[4], o[4]; const float eg = egX; \
        _Pragma("unroll") for (int mt = 0; mt < 4; ++mt) { vn[mt] = utX[mt]; o[mt] = (f32x4v){0.f, 0.f, 0.f, 0.f}; } \
        if ((step) + 2 < S / 64) { const size_t udu = SC_UD((step) + 2); SC_LOADU(utX, egX, udu); } \
        const char* fb = lds + ((step) & 1) * SC_BUF + lane * 16; \
        bf16x8 Sb[4]; \
        _Pragma("unroll") for (int s = 0; s < 4; ++s) Sb[s] = pack8(Sacc[2 * s], Sacc[2 * s + 1]); \
        _Pragma("unroll") for (int mt = 0; mt < 4; ++mt) \
            _Pragma("unroll") for (int s = 0; s < 4; ++s) { vn[mt] = MFMA16(*(const bf16x8*)(fb + SC_WN + (mt * 4 + s) * 1024), Sb[s], vn[mt]); o[mt] = MFMA16(*(const bf16x8*)(fb + SC_QE + (mt * 4 + s) * 1024), Sb[s], o[mt]); } \
        bf16x8 Vb[2]; \
        _Pragma("unroll") for (int s = 0; s < 2; ++s) Vb[s] = pack8(vn[2 * s], vn[2 * s + 1]); \
        _Pragma("unroll") for (int mt = 0; mt < 4; ++mt) \
            _Pragma("unroll") for (int s = 0; s < 2; ++s) o[mt] = MFMA16(*(const bf16x8*)(fb + SC_IN + (mt * 2 + s) * 1024), Vb[s], o[mt]); \
        const long tbase = (long)seq * S + (long)c * 64; \
        _Pragma("unroll") for (int mt = 0; mt < 4; ++mt) \
            _Pragma("unroll") for (int r = 0; r < 4; ++r) { const int i = 16 * mt + 4 * q + r, ti = dir ? 63 - i : i; O[((size_t)(tbase + ti) * NH + hh) * DH + n0 + n] = f2bf(o[mt][r]); } \
        _Pragma("unroll") for (int mt = 0; mt < 8; ++mt) { f32x4v a = Sacc[mt] * eg; \
            _Pragma("unroll") for (int s = 0; s < 2; ++s) a = MFMA16(*(const bf16x8*)(fb + SC_KD + (mt * 2 + s) * 1024), Vb[s], a); \
            Sacc[mt] = a; } \
        __syncthreads(); } while (0)
#pragma unroll 1
    SC_STEP(0, st1, ut0, eg0); SC_STEP(1, st0, ut1, eg1);
#pragma unroll 1
    for (int step = 2; step < S / 64; step += 2) { SC_STEP(step, st1, ut0, eg0); SC_STEP(step + 1, st0, ut1, eg1); }
#undef SC_STEP
#undef SC_UD
#undef SC_LOAD
#undef SC_LOADU
#undef SC_WRITE
}
#undef MFMA16
}
constexpr int NWAVES = 8, NTHR = 512;
constexpr int RING_BYTES = 131072, LDSCTL_OFF = 158720, MISC_OFF = LDSCTL_OFF + 320, LDS_BYTES = 159744;
#define LAS __attribute__((address_space(3)))
#define GAS __attribute__((address_space(1)))
typedef unsigned v4u __attribute__((ext_vector_type(4)));
typedef float f32x4 __attribute__((ext_vector_type(4)));
#define LDS_WAIT() asm volatile("s_waitcnt lgkmcnt(0)" ::: "memory")
#define XB_TMO      128
#define XB_XCNT(j)  (256  + 64 * (j))
#define XB_XSUB(j)  (1280 + 64 * (j))
#define XB_XGEN(j)  (2304 + 64 * (j))
#define XB_TOP      3328
#define XB_TOPGEN   3392
#define XCD_BAR_WORDS 3456
#define XB_SPIN_CAP (1u << 22)
__device__ __forceinline__ unsigned xb_ld(unsigned* p)              { return __hip_atomic_load(p, __ATOMIC_RELAXED, __HIP_MEMORY_SCOPE_AGENT); }
__device__ __forceinline__ unsigned xb_add(unsigned* p, unsigned v) { return __hip_atomic_fetch_add(p, v, __ATOMIC_RELAXED, __HIP_MEMORY_SCOPE_AGENT); }
__device__ __forceinline__ unsigned xb_xcc_id() { return (unsigned)__builtin_amdgcn_s_getreg((3 << 11) | 20) & 0xFu; }
#define XB_SPIN(cond, bar) do { unsigned _sp = 0; while (cond) { __builtin_amdgcn_s_sleep(1); \
    if ((++_sp & 255u) == 0u) { if (xb_ld(&(bar)[XB_TMO])) break; if (_sp > XB_SPIN_CAP) { atomicAdd(&(bar)[XB_TMO], 1u); break; } } } } while (0)
struct XcdBarrier { unsigned* bar; unsigned x; volatile LAS unsigned* st; };
__device__ __forceinline__ XcdBarrier xcd_barrier_post(unsigned* bar, volatile LAS unsigned* st) {
    XcdBarrier b; b.bar = bar; b.x = xb_xcc_id(); b.st = st;
    if (threadIdx.x == 0) (void)xb_add(&bar[XB_XCNT(b.x)], 1u);
    return b;
}
__device__ __forceinline__ void xcd_barrier_complete(unsigned* bar, unsigned x, unsigned& nloc, unsigned& nx) {
    const unsigned G = gridDim.x * gridDim.y * gridDim.z;
    unsigned sum, cnt, mine, sp = 0u;
    for (;;) {
        sum = 0u; cnt = 0u; mine = 0u;
#pragma unroll
        for (unsigned j = 0; j < 16; ++j) { const unsigned c = xb_ld(&bar[XB_XCNT(j)]); sum += c; cnt += (c > 0u) ? 1u : 0u; mine = (j == x) ? c : mine; }
        if (sum == G) break;
        __builtin_amdgcn_s_sleep(1);
        if ((++sp & 255u) == 0u) { if (xb_ld(&bar[XB_TMO])) break; if (sp > XB_SPIN_CAP) { atomicAdd(&bar[XB_TMO], 1u); break; } }
    }
    nloc = mine > 0u ? mine : 1u; nx = cnt > 0u ? cnt : 1u;
}
__device__ __forceinline__ void xcd_barrier(const XcdBarrier& b, int tid_in) {
    asm volatile("s_waitcnt vmcnt(0)" ::: "memory");
    __syncthreads();
    if (tid_in == 0) {
        unsigned* bar = b.bar; const unsigned bx = xb_xcc_id();
        __builtin_amdgcn_s_waitcnt(0);
        unsigned nloc = b.st[0], nx = b.st[1];
        if (nloc == 0u) { xcd_barrier_complete(bar, bx, nloc, nx); b.st[0] = nloc; b.st[1] = nx; }
        const unsigned old = xb_add(&bar[XB_XSUB(bx)], 1u);
        const unsigned gen = old / nloc;
        if (old + 1u == (gen + 1u) * nloc) {
            __builtin_amdgcn_fence(__ATOMIC_RELEASE, "agent");
            asm volatile("s_waitcnt vmcnt(0)" ::: "memory");
            const unsigned og = xb_add(&bar[XB_TOP], 1u);
            const unsigned tg = og / nx;
            if (og + 1u == (tg + 1u) * nx) xb_add(&bar[XB_TOPGEN], 1u);
            else XB_SPIN(xb_ld(&bar[XB_TOPGEN]) == tg, bar);
            __builtin_amdgcn_fence(__ATOMIC_ACQUIRE, "agent");
            xb_add(&bar[XB_XGEN(bx)], 1u);
            asm volatile("s_waitcnt vmcnt(0)" ::: "memory");
        } else {
            XB_SPIN(xb_ld(&bar[XB_XGEN(bx)]) == gen, bar);
            __builtin_amdgcn_fence(__ATOMIC_ACQUIRE, "agent");
            asm volatile("s_waitcnt vmcnt(0)" ::: "memory");
        }
    }
    __syncthreads();
}
constexpr size_t CTL_ZERO_BYTES = 65536; constexpr int CW_BAR = 1024;

__device__ __forceinline__ float wave_sum(float v) {
#pragma unroll
    for (int o = 1; o < 64; o <<= 1) v += __shfl_xor(v, o);
    return v;
}
constexpr long N_SCAN4 = N_SCAN * 4;
__device__ __forceinline__ void st_dn_scan4(const P& p, long g) {
    const int part = (int)(g & 3); const long g1 = g >> 2;
    const int vc = (int)(g1 % DH); const int dir = (int)((g1 / DH) % 2); const int hh = (int)((g1 / (2 * DH)) % NH); const int seq = (int)(g1 / (2 * DH * NH));
    const float *QN = WSP(float, WS_QN), *KN = WSP(float, WS_KN), *VV = WSP(float, WS_VV), *G = WSP(float, WS_G), *BT = WSP(float, WS_BETA);
    float* O = WSP(float, dir ? WS_OB : WS_OF);
    float Sx[32];
#pragma unroll
    for (int d = 0; d < 32; ++d) Sx[d] = 0.f;
    for (int step = 0; step < S; ++step) {
        const int tt = dir ? S - 1 - step : step; const long t = (long)seq * S + tt;
        const float eg = expf(G[(t * 2 + dir) * NH + hh]), b = BT[(t * 2 + dir) * NH + hh];
        const float* kp = KN + ((size_t)t * NH + hh) * DH + part * 32; const float* qp = QN + ((size_t)t * NH + hh) * DH + part * 32; const float vv = VV[((size_t)t * NH + hh) * DH + vc];
        float dot = 0.f;
#pragma unroll
        for (int d = 0; d < 32; ++d) { Sx[d] *= eg; dot += Sx[d] * kp[d]; }
        dot += __shfl_xor(dot, 1); dot += __shfl_xor(dot, 2);
        const float delta = b * (vv - dot); float o = 0.f;
#pragma unroll
        for (int d = 0; d < 32; ++d) { Sx[d] += kp[d] * delta; o += Sx[d] * qp[d]; }
        o += __shfl_xor(o, 1); o += __shfl_xor(o, 2);
        if (part == 0) O[((size_t)t * NH + hh) * DH + vc] = o;
    }
}
__device__ __forceinline__ unsigned pk2(float lo, float hi) { return (unsigned)f2bf(lo) | ((unsigned)f2bf(hi) << 16); }
template <int ST> __device__ __forceinline__ void grid_items(const Job& j, long n, int tid_in) {
    int t_ = tid_in; asm volatile("" : "+v"(t_));
    for (long g = (long)blockIdx.x * NTHR + t_; g < n; g += (long)gridDim.x * NTHR) run_item<ST>(j, g);
}
__device__ __forceinline__ void transpose_item(const float* W, int K, int N, bf16* WT, LAS float* scr, int item, int lane, int GU = 0) {
    const int nblk_src = (N + 63) / 64; const int kblks = K / 64; const int KBL = kblks < 16 ? kblks : 16, NBL = 64 / KBL, kbb = kblks / KBL;
    const int blk = item >> 6, within = item & 63; const int kb = (blk % kbb) * KBL + (within % KBL), nb = (blk / kbb) * NBL + (within / KBL), k0 = 64 * kb, n0 = 64 * nb;
    const int n0s = GU ? (((n0 >> 7) & 1) * DFF + (n0 >> 8) * 128 + (n0 & 127)) : n0;
    const int c = lane & 7;
    if (nb >= nblk_src) {
#pragma unroll
        for (int jj = 0; jj < 8; ++jj) { const int n = (lane >> 3) + 8 * jj; *(GAS v4u*)(WT + (size_t)(n0 + n) * K + k0 + 8 * c) = (v4u){0u, 0u, 0u, 0u}; }
        return;
    }
    {
        f32x4 v[16]; const int kq = lane >> 4, nn = (lane & 15) * 4;
#pragma unroll
        for (int i = 0; i < 16; ++i) v[i] = (n0s + nn < N) ? *(const f32x4*)(W + (size_t)(k0 + 4 * i + kq) * N + n0s + nn) : (f32x4){0.f, 0.f, 0.f, 0.f};
#pragma unroll
        for (int i = 0; i < 16; ++i) { LAS float* d = scr + (4 * i + kq) * 65 + nn; d[0] = v[i].x; d[1] = v[i].y; d[2] = v[i].z; d[3] = v[i].w; }
    }
    LDS_WAIT(); asm volatile("" ::: "memory");
#pragma unroll
    for (int jj = 0; jj < 8; ++jj) { const int n = (lane >> 3) + 8 * jj; const LAS float* s_ = scr + (8 * c) * 65 + n;
        v4u o; o.x = pk2(s_[0 * 65], s_[1 * 65]); o.y = pk2(s_[2 * 65], s_[3 * 65]); o.z = pk2(s_[4 * 65], s_[5 * 65]); o.w = pk2(s_[6 * 65], s_[7 * 65]);
        *(GAS v4u*)(WT + (size_t)(n0 + n) * K + k0 + 8 * c) = o; }
    LDS_WAIT(); asm volatile("" ::: "memory");
}
__device__ __forceinline__ void pb_phase(const P& p, int tid_in) {
    int t_ = tid_in; asm volatile("" : "+v"(t_));
    constexpr long np8 = (long)NPROMPT * S * PLE / 8, ns8 = (long)(NSEQ - NPROMPT) * S * PLE / 8, n8 = np8 + ns8;
    for (int layer = 0; layer < DEPTH; ++layer) {
        const float* pp = p.p_prompt + (size_t)layer * np8 * 8; const float* ps = p.p_sample + (size_t)layer * ns8 * 8; bf16* o = WSP(bf16, WS_PB + (size_t)layer * SZ_PB);
#pragma unroll 2
        for (long g = (long)blockIdx.x * NTHR + t_; g < n8; g += (long)gridDim.x * NTHR) { const float* src = g < np8 ? pp + g * 8 : ps + (g - np8) * 8;
            const f32x4 a = *(const f32x4*)src, b = *(const f32x4*)(src + 4); v4u w; w.x = pk2(a.x, a.y); w.y = pk2(a.z, a.w); w.z = pk2(b.x, b.y); w.w = pk2(b.z, b.w); *(v4u*)(o + g * 8) = w; }
    }
}
__device__ __forceinline__ float fast_sigmoid(float x) { return __builtin_amdgcn_rcpf(1.0f + __builtin_amdgcn_exp2f(-1.4426950408889634f * x)); }
template <int MODE> __device__ __forceinline__ void row_phase(const P& p, const float* wa, const float* wn, int gw, int ngw, int lane) {
    constexpr int NV = D / 256;
    asm volatile("" : "+v"(lane));
    f32x4 hN[NV]; unsigned long long hB[NV], yN[NV], pN[NV];
#define ROW_LOAD(t_) do { const long tt_ = (t_); \
        if (MODE == 0) { const long np = (long)NPROMPT * S * D; const float* src = (tt_ * D < np) ? p.x_prompt + (size_t)tt_ * D : p.x_sample + ((size_t)tt_ * D - np); \
            _Pragma("unroll") for (int i = 0; i < NV; ++i) hN[i] = *(const f32x4*)(src + (i * 64 + lane) * 4); } \
        else { const bf16* hr_ = WSP(bf16, WS_H16) + (size_t)tt_ * D; const bf16* yr_ = WSP(bf16, WS_GOUT) + (size_t)tt_ * D; \
            _Pragma("unroll") for (int i = 0; i < NV; ++i) { hB[i] = *(const unsigned long long*)(hr_ + (i * 64 + lane) * 4); yN[i] = *(const unsigned long long*)(yr_ + (i * 64 + lane) * 4); } \
            if (MODE == 3) { const bf16* pr_ = WSP(bf16, WS_PP2) + (size_t)tt_ * D; _Pragma("unroll") for (int i = 0; i < NV; ++i) pN[i] = *(const unsigned long long*)(pr_ + (i * 64 + lane) * 4); } } } while (0)
#define UNPK(q_) (f32x4){bf2f((bf16)((q_) & 0xffff)), bf2f((bf16)(((q_) >> 16) & 0xffff)), bf2f((bf16)(((q_) >> 32) & 0xffff)), bf2f((bf16)((q_) >> 48))}
    if (gw < T) ROW_LOAD(gw);
    for (int t = gw; t < T; t += ngw) {
        f32x4 h[NV], y[NV], pp[NV];
#pragma unroll
        for (int i = 0; i < NV; ++i) { if (MODE == 0) h[i] = hN[i]; else { h[i] = UNPK(hB[i]); y[i] = UNPK(yN[i]); } if (MODE == 3) pp[i] = UNPK(pN[i]); }
        if (t + ngw < T) ROW_LOAD(t + ngw);
        if (MODE == 1 || MODE == 2) {
            float ss = 0.f;
#pragma unroll
            for (int i = 0; i < NV; ++i) ss += (y[i].x * y[i].x + y[i].y * y[i].y) + (y[i].z * y[i].z + y[i].w * y[i].w);
            const float r = 1.0f / sqrtf(wave_sum(ss) * (1.0f / D) + RMS_EPS);
#pragma unroll
            for (int i = 0; i < NV; ++i) { const f32x4 w = *(const f32x4*)(wa + (i * 64 + lane) * 4); h[i] = h[i] + y[i] * r * w; }
        } else if (MODE == 3) {
#pragma unroll
            for (int i = 0; i < NV; ++i) { h[i].x += fast_sigmoid(y[i].x) * pp[i].x; h[i].y += fast_sigmoid(y[i].y) * pp[i].y; h[i].z += fast_sigmoid(y[i].z) * pp[i].z; h[i].w += fast_sigmoid(y[i].w) * pp[i].w; }
        }
        if (MODE == 3 && wn == nullptr) { float* hr = p.h + (size_t)t * D;
#pragma unroll
            for (int i = 0; i < NV; ++i) *(f32x4*)(hr + (i * 64 + lane) * 4) = h[i];
            continue; }
        { bf16* hw = WSP(bf16, WS_H16) + (size_t)t * D;
#pragma unroll
            for (int i = 0; i < NV; ++i) *(unsigned long long*)(hw + (i * 64 + lane) * 4) = (unsigned long long)pk2(h[i].x, h[i].y) | ((unsigned long long)pk2(h[i].z, h[i].w) << 32); }
        if (MODE == 2) continue;
        float r2 = 1.f;
        if (MODE != 2) { float ss = 0.f;
#pragma unroll
            for (int i = 0; i < NV; ++i) ss += (h[i].x * h[i].x + h[i].y * h[i].y) + (h[i].z * h[i].z + h[i].w * h[i].w);
            r2 = 1.0f / sqrtf(wave_sum(ss) * (1.0f / D) + RMS_EPS); }
        bf16* o = WSP(bf16, WS_HN) + (size_t)t * D;
#pragma unroll
        for (int i = 0; i < NV; ++i) { f32x4 v = h[i] * r2; if (MODE != 2) { const f32x4 w = *(const f32x4*)(wn + (i * 64 + lane) * 4); v = v * w; }
            *(unsigned long long*)(o + (i * 64 + lane) * 4) = (unsigned long long)pk2(v.x, v.y) | ((unsigned long long)pk2(v.z, v.w) << 32); }
    }
#undef ROW_LOAD
#undef UNPK
}

typedef short bf16x8_t __attribute__((ext_vector_type(8)));
__device__ __forceinline__ float gelu_fast(float x) { const float u = 0.7978845608028654f * (x + 0.044715f * x * x * x); return x * __builtin_amdgcn_rcpf(1.0f + __builtin_amdgcn_exp2f(-2.885390081777927f * u)); }
__device__ __forceinline__ void ffn_act_phase(const P& p, int layer, int gw, int ngw, int lane) {
    asm volatile("" : "+v"(lane));
    constexpr int TT = 32, NCB = DFF / 512, NIT = (T / TT) * NCB;
    const bf16* hid = WSP(bf16, WS_HID); bf16* act = WSP(bf16, WS_ACT);
    const float* cw = PRM(PR_FCW) + (size_t)layer * 3 * 2 * DFF; const float* cb = PRM(PR_FCB) + (size_t)layer * 2 * DFF;
    for (int it = gw; it < NIT; it += ngw) {
        const int cblk = it % NCB, tile = it / NCB; const int c0 = cblk * 512 + lane * 8; const long t0 = (long)tile * TT; const int tt0 = (int)(t0 % S);
        float wg[3][8], wu[3][8], bg[8], bu[8];
#pragma unroll
        for (int i = 0; i < 3; ++i)
#pragma unroll
            for (int e = 0; e < 8; ++e) { wg[i][e] = cw[i * 2 * DFF + c0 + e]; wu[i][e] = cw[i * 2 * DFF + DFF + c0 + e]; }
#pragma unroll
        for (int e = 0; e < 8; ++e) { bg[e] = cb[c0 + e]; bu[e] = cb[DFF + c0 + e]; }
        const bf16x8_t zero8 = {0, 0, 0, 0, 0, 0, 0, 0};
        bf16x8_t g0 = zero8, u0 = zero8, g1, u1, g2, u2;
        if (tt0 > 0) { g0 = *(const bf16x8_t*)(hid + (size_t)(t0 - 1) * (2 * DFF) + c0); u0 = *(const bf16x8_t*)(hid + (size_t)(t0 - 1) * (2 * DFF) + DFF + c0); }
        g1 = *(const bf16x8_t*)(hid + (size_t)t0 * (2 * DFF) + c0); u1 = *(const bf16x8_t*)(hid + (size_t)t0 * (2 * DFF) + DFF + c0);
        for (int k = 0; k < TT; ++k) {
            const long t = t0 + k;
            if (tt0 + k + 1 < S) { g2 = *(const bf16x8_t*)(hid + (size_t)(t + 1) * (2 * DFF) + c0); u2 = *(const bf16x8_t*)(hid + (size_t)(t + 1) * (2 * DFF) + DFF + c0); } else { g2 = zero8; u2 = zero8; }
            float o[8];
#pragma unroll
            for (int e = 0; e < 8; ++e) {
                const float ga = bg[e] + bf2f((bf16)g0[e]) * wg[0][e] + bf2f((bf16)g1[e]) * wg[1][e] + bf2f((bf16)g2[e]) * wg[2][e];
                const float up = bu[e] + bf2f((bf16)u0[e]) * wu[0][e] + bf2f((bf16)u1[e]) * wu[1][e] + bf2f((bf16)u2[e]) * wu[2][e];
                o[e] = gelu_fast(ga) * up; }
            v4u w; w.x = pk2(o[0], o[1]); w.y = pk2(o[2], o[3]); w.z = pk2(o[4], o[5]); w.w = pk2(o[6], o[7]);
            *(v4u*)(act + (size_t)t * DFF + c0) = w;
            g0 = g1; u0 = u1; g1 = g2; u1 = u2;
        }
    }
}
__device__ __forceinline__ void dn_out_phase(const P& p, int jl, int gw, int ngw, int lane) {
    asm volatile("" : "+v"(lane));
    const int hh = lane >> 3, d0 = (lane & 7) * 16; const float* on = PRM(PR_ONORM) + jl * DH + d0;
    bf16x8_t aN[2], bN[2], zN0, zN1;
#define DNO_LOAD(t_) do { const bf16* of_ = WSP(bf16, WS_OF) + ((size_t)(t_) * NH + hh) * DH + d0; const bf16* ob_ = WSP(bf16, WS_OB) + ((size_t)(t_) * NH + hh) * DH + d0; \
        const bf16* z_ = WSP(bf16, WS_PROJ) + (size_t)(t_) * ABINP + COL_Z + hh * DH + d0; \
        aN[0] = *(const bf16x8_t*)of_; aN[1] = *(const bf16x8_t*)(of_ + 8); bN[0] = *(const bf16x8_t*)ob_; bN[1] = *(const bf16x8_t*)(ob_ + 8); zN0 = *(const bf16x8_t*)z_; zN1 = *(const bf16x8_t*)(z_ + 8); } while (0)
    if (gw < T) DNO_LOAD(gw);
    for (int t = gw; t < T; t += ngw) {
        float o[16]; float ss = 0.f; const bf16x8_t z0 = zN0, z1 = zN1;
#pragma unroll
        for (int c8 = 0; c8 < 2; ++c8)
#pragma unroll
            for (int e = 0; e < 8; ++e) { o[8 * c8 + e] = bf2f((bf16)aN[c8][e]) + bf2f((bf16)bN[c8][e]); ss += o[8 * c8 + e] * o[8 * c8 + e]; }
        if (t + ngw < T) DNO_LOAD(t + ngw);
        ss += __shfl_xor(ss, 1); ss += __shfl_xor(ss, 2); ss += __shfl_xor(ss, 4);
        const float r = 1.0f / sqrtf(ss * (1.0f / DH) + RMS_EPS); float v[16];
#pragma unroll
        for (int e = 0; e < 16; ++e) { const float zz = bf2f((bf16)(e < 8 ? z0[e] : z1[e - 8])); v[e] = o[e] * r * on[e] * zz * fast_sigmoid(zz); }
        bf16* out = WSP(bf16, WS_MIXIN) + (size_t)t * ABMIX + hh * DH + d0;
        v4u w0, w1; w0.x = pk2(v[0], v[1]); w0.y = pk2(v[2], v[3]); w0.z = pk2(v[4], v[5]); w0.w = pk2(v[6], v[7]); w1.x = pk2(v[8], v[9]); w1.y = pk2(v[10], v[11]); w1.z = pk2(v[12], v[13]); w1.w = pk2(v[14], v[15]);
        *(v4u*)out = w0; *(v4u*)(out + 8) = w1;
    }
#undef DNO_LOAD
}
__device__ __forceinline__ void c_out_phase(const P& p, int jl, int gw, int ngw, int lane) {
    asm volatile("" : "+v"(lane));
    const int hh = lane >> 3, e0 = (lane & 7) * 32; const float lam = WSP(float, WS_LAM)[0], li = WSP(float, WS_LAM)[1]; const float* sw = PRM(PR_SUBLN) + jl * 256 + e0;
    bf16x8_t aN[4], bN[4];
#define CO_LOAD(t_) do { const bf16* o0_ = WSP(bf16, WS_O0) + (size_t)(t_) * 2048 + hh * 256 + e0; const bf16* o1_ = WSP(bf16, WS_O1) + (size_t)(t_) * 2048 + hh * 256 + e0; \
        _Pragma("unroll") for (int c8 = 0; c8 < 4; ++c8) { aN[c8] = *(const bf16x8_t*)(o0_ + 8 * c8); bN[c8] = *(const bf16x8_t*)(o1_ + 8 * c8); } } while (0)
    if (gw < T) CO_LOAD(gw);
    for (int t = gw; t < T; t += ngw) {
        float o[32]; float ss = 0.f;
#pragma unroll
        for (int c8 = 0; c8 < 4; ++c8)
#pragma unroll
            for (int e = 0; e < 8; ++e) { o[8 * c8 + e] = bf2f((bf16)aN[c8][e]) - lam * bf2f((bf16)bN[c8][e]); ss += o[8 * c8 + e] * o[8 * c8 + e]; }
        if (t + ngw < T) CO_LOAD(t + ngw);
        ss += __shfl_xor(ss, 1); ss += __shfl_xor(ss, 2); ss += __shfl_xor(ss, 4);
        const float r = (1.0f / sqrtf(ss * (1.0f / 256.0f) + RMS_EPS)) * (1.0f - li);
        bf16* out = WSP(bf16, WS_MIXIN) + (size_t)t * 2048 + hh * 256 + e0;
#pragma unroll
        for (int c8 = 0; c8 < 4; ++c8) { v4u w; w.x = pk2(o[8 * c8] * r * sw[8 * c8], o[8 * c8 + 1] * r * sw[8 * c8 + 1]); w.y = pk2(o[8 * c8 + 2] * r * sw[8 * c8 + 2], o[8 * c8 + 3] * r * sw[8 * c8 + 3]);
            w.z = pk2(o[8 * c8 + 4] * r * sw[8 * c8 + 4], o[8 * c8 + 5] * r * sw[8 * c8 + 5]); w.w = pk2(o[8 * c8 + 6] * r * sw[8 * c8 + 6], o[8 * c8 + 7] * r * sw[8 * c8 + 7]); *(v4u*)(out + 8 * c8) = w; }
    }
#undef CO_LOAD
}
__device__ __forceinline__ void rope_table_phase(const P& p, int tid_in) {
    int t_ = tid_in; asm volatile("" : "+v"(t_));
    float* tab = WSP(float, WS_LAM) + 16;
    for (int g = (int)blockIdx.x * NTHR + t_; g < S * 16; g += (int)gridDim.x * NTHR) { const int i = g & 15, pos = g >> 4;
        const float inv = powf(500000.0f, -(float)(2 * i) / 32.0f); const float ang = (float)pos * inv; tab[2 * g] = cosf(ang); tab[2 * g + 1] = sinf(ang); }
}
__device__ __forceinline__ void rope_phase(const P& p, int tid_in) {
    int t_ = tid_in; asm volatile("" : "+v"(t_));
    const float* tab = WSP(const float, WS_LAM) + 16;
    for (long g = (long)blockIdx.x * NTHR + t_; g < (long)T * 32; g += (long)gridDim.x * NTHR) {
        const int hj = (int)(g & 15), which = (int)((g >> 4) & 1); const long t = g >> 5; const float* cs_ = tab + (size_t)(t % S) * 32;
        bf16* x = WSP(bf16, WS_PROJ) + (size_t)t * CIN + which * 2048 + hj * DH;
        bf16x8_t a0 = *(const bf16x8_t*)x, a1 = *(const bf16x8_t*)(x + 8), b0 = *(const bf16x8_t*)(x + 16), b1 = *(const bf16x8_t*)(x + 24); float r1[16], r2[16];
#pragma unroll
        for (int i = 0; i < 16; ++i) { const float cs = cs_[2 * i], sn = cs_[2 * i + 1];
            const float x1 = bf2f((bf16)(i < 8 ? a0[i] : a1[i - 8])), x2 = bf2f((bf16)(i < 8 ? b0[i] : b1[i - 8])); r1[i] = x1 * cs - x2 * sn; r2[i] = x2 * cs + x1 * sn; }
        v4u w;
        w.x = pk2(r1[0], r1[1]); w.y = pk2(r1[2], r1[3]); w.z = pk2(r1[4], r1[5]); w.w = pk2(r1[6], r1[7]); *(v4u*)x = w;
        w.x = pk2(r1[8], r1[9]); w.y = pk2(r1[10], r1[11]); w.z = pk2(r1[12], r1[13]); w.w = pk2(r1[14], r1[15]); *(v4u*)(x + 8) = w;
        w.x = pk2(r2[0], r2[1]); w.y = pk2(r2[2], r2[3]); w.z = pk2(r2[4], r2[5]); w.w = pk2(r2[6], r2[7]); *(v4u*)(x + 16) = w;
        w.x = pk2(r2[8], r2[9]); w.y = pk2(r2[10], r2[11]); w.z = pk2(r2[12], r2[13]); w.w = pk2(r2[14], r2[15]); *(v4u*)(x + 24) = w;
    }
}
__device__ __forceinline__ void ffn_fix_phase(const P& p, int layer, int tid_in) {
    int t_ = tid_in; asm volatile("" : "+v"(t_));
    const int ln = t_ & 63, gwv = (int)blockIdx.x * NWAVES + __builtin_amdgcn_readfirstlane(t_ >> 6), ngwv = (int)gridDim.x * NWAVES;
    const float* cw = PRM(PR_FCW) + (size_t)layer * 3 * 2 * DFF; const float* cb = PRM(PR_FCB) + (size_t)layer * 2 * DFF; const float* HALO = WSP(float, WS_HALO);
    constexpr int NP = T / 256, PPS = S / 256, NCB = DFF / 256;
    for (int g = gwv; g < NP * 2 * NCB; g += ngwv) {
        const int c0 = (g % NCB) * 256 + ln * 4; const int edge = (g / NCB) & 1; const int pm = g / (2 * NCB);
        const bool has_prev = edge ? true : (pm % PPS != 0), has_next = edge ? (pm % PPS != PPS - 1) : true;
        const float* rp = HALO + (((size_t)(edge ? pm : pm - 1) * 4 + (edge ? 2 : 3)) * 2) * DFF + c0;
        const float* rc = HALO + (((size_t)pm * 4 + (edge ? 3 : 0)) * 2) * DFF + c0;
        const float* rn = HALO + (((size_t)(edge ? pm + 1 : pm) * 4 + (edge ? 0 : 1)) * 2) * DFF + c0;
        const f32x4 z4 = {0.f, 0.f, 0.f, 0.f};
        f32x4 gp = z4, up = z4, gn = z4, un = z4;
        if (has_prev) { gp = *(const f32x4*)rp; up = *(const f32x4*)(rp + DFF); }
        if (has_next) { gn = *(const f32x4*)rn; un = *(const f32x4*)(rn + DFF); }
        const f32x4 gc = *(const f32x4*)rc, uc = *(const f32x4*)(rc + DFF);
        const f32x4 bg = *(const f32x4*)(cb + c0), bu = *(const f32x4*)(cb + DFF + c0);
        const f32x4 wg0 = *(const f32x4*)(cw + c0), wu0 = *(const f32x4*)(cw + DFF + c0), wg1 = *(const f32x4*)(cw + 2 * DFF + c0), wu1 = *(const f32x4*)(cw + 3 * DFF + c0),
                    wg2 = *(const f32x4*)(cw + 4 * DFF + c0), wu2 = *(const f32x4*)(cw + 5 * DFF + c0);
        float o[4];
#pragma unroll
        for (int e = 0; e < 4; ++e) {
            const float cg = bg[e] + wg0[e] * gp[e] + wg1[e] * gc[e] + wg2[e] * gn[e];
            const float cu = bu[e] + wu0[e] * up[e] + wu1[e] * uc[e] + wu2[e] * un[e];
            o[e] = pg8::gelu_t(cg) * cu; }
        *(unsigned long long*)(WSP(bf16, WS_ACT) + ((size_t)pm * 256 + (edge ? 255 : 0)) * DFF + c0) = (unsigned long long)pk2(o[0], o[1]) | ((unsigned long long)pk2(o[2], o[3]) << 32);
    }
}
__device__ __forceinline__ int hw_lane() { int l; asm volatile("v_mbcnt_lo_u32_b32 %0, -1, 0\n\tv_mbcnt_hi_u32_b32 %0, -1, %0" : "=v"(l)); return l; }
struct Args { P p; };
__global__ void __launch_bounds__(NTHR, 2) mega_fwd(Args args) {
    extern __shared__ __attribute__((aligned(16))) unsigned char lds_raw[];
    LAS unsigned char* lds = (LAS unsigned char*)lds_raw;
    const P& p = args.p;
    const int tid = threadIdx.x, wave = __builtin_amdgcn_readfirstlane(tid >> 6);
#define HWLANE hw_lane()
#define HWTID ((wave << 6) | HWLANE)
#define lane HWLANE
    const int G = gridDim.x; const int gw = blockIdx.x * NWAVES + wave, ngw = G * NWAVES;
    volatile LAS unsigned* MISC = (volatile LAS unsigned*)(lds + MISC_OFF);
    for (int u = tid; u < (LDS_BYTES - LDSCTL_OFF) / 4; u += NTHR) ((LAS unsigned*)(lds + LDSCTL_OFF))[u] = 0u;
    __syncthreads();
    XcdBarrier bar = xcd_barrier_post(WSP(unsigned, WS_CTL) + CW_BAR, MISC + 8);
    Job j; j.p = p; j.w.W = nullptr; j.w.O = nullptr; j.w.K = 0; j.w.N = 0; j.w.Npad = 0; j.a = nullptr; j.b = nullptr; j.n = 0; j.layer = 0; j.flag = 0;

    {
        LAS float* scr = (LAS float*)(lds + wave * 16640);
        for (int m = 0; m < 24; ++m) {
            const float* W; bf16* O; int K, N, Npad; const int i = m & 1, l = m & 3;
            if (m < 2)       { W = p.ab_w_in + (size_t)i * D * ABIN;  O = WSP(bf16, WS_WABIN + (size_t)i * ABINP * D * 2); K = D; N = ABIN; Npad = ABINP; }
            else if (m < 4)  { W = p.ab_w_out + (size_t)i * ABMIX * D; O = WSP(bf16, WS_WABOUT + (size_t)i * D * ABMIX * 2); K = ABMIX; N = D; Npad = D; }
            else if (m < 6)  { W = p.c_w_in + (size_t)i * D * CIN;    O = WSP(bf16, WS_WCIN + (size_t)i * CIN * D * 2); K = D; N = CIN; Npad = CIN; }
            else if (m < 8)  { W = p.c_w_out + (size_t)i * CV * D;    O = WSP(bf16, WS_WCOUT + (size_t)i * D * CV * 2); K = CV; N = D; Npad = D; }
            else if (m < 12) { W = p.ffn_w_in + (size_t)l * D * 2 * DFF; O = WSP(bf16, WS_WFIN + (size_t)l * 2 * DFF * D * 2); K = D; N = 2 * DFF; Npad = 2 * DFF; }
            else if (m < 16) { W = p.ffn_w_out + (size_t)l * DFF * D;  O = WSP(bf16, WS_WFOUT + (size_t)l * D * DFF * 2); K = DFF; N = D; Npad = D; }
            else if (m < 20) { W = p.ple_w_proj + (size_t)l * PLE * D; O = WSP(bf16, WS_WPP + (size_t)l * D * PLE * 2); K = PLE; N = D; Npad = D; }
            else             { W = p.ple_w_gate + (size_t)l * D * D;   O = WSP(bf16, WS_WPG + (size_t)l * D * D * 2); K = D; N = D; Npad = D; }
            const int nitems = (K / 64) * (Npad / 64);
            for (int it = gw; it < nitems; it += ngw) transpose_item(W, K, N, O, scr, it, lane, (m >= 8 && m < 12) ? 1 : 0);
        }
        rope_table_phase(p, HWTID);
        {
            int t_ = HWTID; asm volatile("" : "+v"(t_));
            if (blockIdx.x == 0 && t_ < 2) { const float* lp = p.c_lambda + (size_t)t_ * 4 * DH; float a = 0.f, b = 0.f;
                for (int d = 0; d < DH; ++d) { a += lp[d] * lp[DH + d]; b += lp[2 * DH + d] * lp[3 * DH + d]; }
                const float li = lambda_init_of(2 * t_ + 1); WSP(float, WS_LAM)[2 * t_] = expf(a) - expf(b) + li; WSP(float, WS_LAM)[2 * t_ + 1] = li; }
        }
        grid_items<ST_PRM>(j, N_PRM, HWTID);
        pb_phase(p, HWTID);
        row_phase<0>(p, nullptr, p.norms, gw, ngw, lane);
    }
    xcd_barrier(bar, HWTID);

    for (int layer = 0; layer < DEPTH; ++layer) {
        j.layer = layer; const int jj = layer >> 1; const float* nw = PRM(PR_NORMS) + (size_t)layer * 4 * D;
        {
            const bool ab = (layer & 1) == 0; const int N = ab ? ABINP : CIN;
            const bf16* Bt = ab ? WSP(bf16, WS_WABIN + (size_t)jj * ABINP * D * 2) : WSP(bf16, WS_WCIN + (size_t)jj * CIN * D * 2);
            pg8::Gemm g{WSP(bf16, WS_HN), Bt, T, N, D}; pg8::StaticOrder S_; S_.init(T, N, G, (int)blockIdx.x);
            pg8::EpiBf16Ro E{WSP(bf16, WS_PROJ), N, ab ? nullptr : WSP(const float, WS_LAM) + 16, S};
            pg8::gemm_phase<pg8::EpiBf16Ro, pg8::StaticOrder, true, true>(lds, g, S_, E, HWTID);
        }
        xcd_barrier(bar, HWTID);
        int pp_first = (int)blockIdx.x, pp_stride = G; bool pp_run = true;
        if ((layer & 1) == 0) {
            {
                constexpr int NU = NSEQ * NH * (S / 64);
                for (int u = (int)blockIdx.x; u < NU; u += G) dn::dn1_unit(p, jj, u / (NH * (S / 64)), (u / (S / 64)) % NH, u % (S / 64), (char*)lds_raw, HWTID);
            }
            xcd_barrier(bar, HWTID);
            constexpr int NSC = NSEQ * NH * 2; const bool split = G >= 2 * NSC; const int na_first = split ? (int)blockIdx.x - NSC : (int)blockIdx.x, na_stride = split ? G - NSC : G;
            if (!split || (int)blockIdx.x < NSC) { for (int ch = (int)blockIdx.x; ch < NSC; ch += G) dn::dn_scan_chain(p, ch, (char*)lds_raw, HWTID); }
            if (!split || (int)blockIdx.x >= NSC)
            {
                constexpr int NU = NSEQ * NH * (ROWS / 4);
                float* tab = (float*)((char*)lds_raw + att::SHM_ATTN);
                for (int u = na_first; u < NU; u += na_stride) {
                    const int rg = u % (ROWS / 4); const int hh = (u / (ROWS / 4)) % NH, seq = u / ((ROWS / 4) * NH); const int r0 = rg * 4;
                    const int kr0 = clampi(r0 - WR / 2, 0, ROWS - WR), krl = clampi(r0 + 3 - WR / 2, 0, ROWS - WR) + WR - 1; const int nt = krl - kr0 + 1;
                    { int t_ = HWTID; asm volatile("" : "+v"(t_)); if (t_ < 15 * 31) tab[t_] = PRM(PR_RPB)[((size_t)jj * NH + hh) * 15 * 31 + t_] * 11.313708498984761f; }
                    const bf16* base = WSP(bf16, WS_PROJ) + (size_t)seq * S * ABINP;
                    att::na_body<ABINP, ABINP, ABMIX>(base + (size_t)r0 * GW * ABINP + COL_QB + hh * DH, base + (size_t)kr0 * GW * ABINP + COL_KB + hh * DH, base + (size_t)kr0 * GW * ABINP + COL_VB + hh * DH,
                        WSP(bf16, WS_MIXIN) + ((size_t)seq * S + (size_t)r0 * GW) * ABMIX + 1024 + hh * DH, nt, (char*)lds_raw, att::NaInfo{r0, kr0, tab}, HWTID);
                    __syncthreads();
                }
            }
            pp_first = na_first; pp_stride = na_stride; pp_run = !split || (int)blockIdx.x >= NSC;
        } else {
            {
                constexpr int NU = NSEQ * NH * (S / 256);
                const int vcu = (G % 8 == 0) ? ((int)blockIdx.x % 8) * (G / 8) + (int)blockIdx.x / 8 : (int)blockIdx.x;
                const float lam = WSP(float, WS_LAM)[2 * jj], li = WSP(float, WS_LAM)[2 * jj + 1];
                for (int u = vcu; u < NU; u += G) {
                    const int qb = u % (S / 256); const int r_ = u / (S / 256); const int hh = r_ % NH, seq = r_ / NH;
                    const bf16* base = WSP(bf16, WS_PROJ) + (size_t)seq * S * CIN; const size_t oo = ((size_t)seq * S + (size_t)qb * 256) * 2048 + hh * 256;
#pragma unroll 1
                    for (int jj2 = 0; jj2 < 2; ++jj2) {
                        att::dattn256_body<CIN, CIN, 2048>(base + (size_t)qb * 256 * CIN + hh * 256 + jj2 * DH, base + 2048 + hh * 256 + jj2 * DH, base + 4096 + hh * 256,
                            WSP(bf16, WS_O0) + oo, S / 64, (char*)lds_raw, HWTID, jj2, WSP(bf16, WS_MIXIN) + oo, lam, 1.0f - li, PRM(PR_SUBLN) + jj * 256);
                        __syncthreads();
                    }
                }
            }
        }
        if (pp_run) {
            pg8::Gemm g{WSP(bf16, WS_PB + (size_t)layer * SZ_PB), WSP(bf16, WS_WPP + (size_t)layer * D * PLE * 2), T, D, PLE}; pg8::StaticOrder S_; S_.init(T, D, pp_stride, pp_first);
            pg8::EpiBf16 E{WSP(bf16, WS_PP2), D};
            pg8::gemm_phase<pg8::EpiBf16, pg8::StaticOrder, true, true>(lds, g, S_, E, HWTID);
        }
        xcd_barrier(bar, HWTID);
        if ((layer & 1) == 0) { dn_out_phase(p, jj, gw, ngw, lane); xcd_barrier(bar, HWTID); }
        {
            const bf16* Bt = (layer & 1) == 0 ? WSP(bf16, WS_WABOUT + (size_t)jj * D * ABMIX * 2) : WSP(bf16, WS_WCOUT + (size_t)jj * D * CV * 2);
            pg8::Gemm g{WSP(bf16, WS_MIXIN), Bt, T, D, 2048}; pg8::StaticOrder S_; S_.init(T, D, G, (int)blockIdx.x);
            pg8::EpiBf16 E{WSP(bf16, WS_GOUT), D};
            pg8::gemm_phase<pg8::EpiBf16, pg8::StaticOrder, true, true>(lds, g, S_, E, HWTID);
        }
        xcd_barrier(bar, HWTID);
        row_phase<1>(p, nw + D, nw + 2 * D, gw, ngw, lane);
        xcd_barrier(bar, HWTID);
        {
            pg8::Gemm g{WSP(bf16, WS_HN), WSP(bf16, WS_WFIN + (size_t)layer * 2 * DFF * D * 2), T, 2 * DFF, D}; pg8::StaticOrder S_; S_.init(T, 2 * DFF, G, (int)blockIdx.x);
            pg8::EpiConvAct E{WSP(bf16, WS_ACT), WSP(float, WS_HALO), WSP(float, WS_HALO) + (size_t)(T / 256) * 4 * 2 * DFF + 4096 * (int)blockIdx.x, PRM(PR_FCW) + (size_t)layer * 3 * 2 * DFF, PRM(PR_FCB) + (size_t)layer * 2 * DFF, (PG8_LAS float*)(lds + RING_BYTES)};
            pg8::gemm_phase<pg8::EpiConvAct, pg8::StaticOrder, true, true>(lds, g, S_, E, HWTID);
        }
        xcd_barrier(bar, HWTID);
        ffn_fix_phase(p, layer, HWTID);
        xcd_barrier(bar, HWTID);
        {
            pg8::Gemm g{WSP(bf16, WS_ACT), WSP(bf16, WS_WFOUT + (size_t)layer * D * DFF * 2), T, D, DFF}; pg8::StaticOrder S_; S_.init(T, D, G, (int)blockIdx.x);
            pg8::EpiBf16 E{WSP(bf16, WS_GOUT), D};
            pg8::gemm_phase<pg8::EpiBf16, pg8::StaticOrder, true, true>(lds, g, S_, E, HWTID);
        }
        xcd_barrier(bar, HWTID);
        row_phase<2>(p, nw + 3 * D, nullptr, gw, ngw, lane);
        xcd_barrier(bar, HWTID);
        {
            pg8::Gemm g{WSP(bf16, WS_H16), WSP(bf16, WS_WPG + (size_t)layer * D * D * 2), T, D, D}; pg8::StaticOrder S_; S_.init(T, D, G, (int)blockIdx.x);
            pg8::EpiBf16 E{WSP(bf16, WS_GOUT), D};
            pg8::gemm_phase<pg8::EpiBf16, pg8::StaticOrder, true, true>(lds, g, S_, E, HWTID);
        }
        xcd_barrier(bar, HWTID);
        row_phase<3>(p, nullptr, layer + 1 < DEPTH ? PRM(PR_NORMS) + (size_t)(layer + 1) * 4 * D : nullptr, gw, ngw, lane);
        if (layer + 1 < DEPTH) xcd_barrier(bar, HWTID);
    }
}

#undef lane
#undef HWTID
#undef HWLANE
extern "C" void kernel_launch(void* const* d_in, const int* in_sizes, int n_in, void* d_out, int out_size, void* d_ws, size_t ws_size, hipStream_t stream) {
    static int grid = 0;
    if (grid == 0) {
        if (n_in != 22 || out_size != T * D || ws_size < WS_END) { fprintf(stderr, "kernel_launch: unexpected shapes n_in %d out %d ws %zu (need %zu)\n", n_in, out_size, ws_size, (size_t)WS_END); grid = -1; return; }
        int dev = 0, cus = 0, per_cu = 0;
        if (hipGetDevice(&dev) != hipSuccess || hipDeviceGetAttribute(&cus, hipDeviceAttributeMultiprocessorCount, dev) != hipSuccess) { grid = -1; return; }
        if (hipFuncSetAttribute((const void*)mega_fwd, hipFuncAttributeMaxDynamicSharedMemorySize, LDS_BYTES) != hipSuccess) { fprintf(stderr, "kernel_launch: hipFuncSetAttribute failed\n"); grid = -1; return; }
        if (hipOccupancyMaxActiveBlocksPerMultiprocessor(&per_cu, (const void*)mega_fwd, NTHR, LDS_BYTES) != hipSuccess || per_cu < 1) fprintf(stderr, "kernel_launch: occupancy query reports %d blocks per CU\n", per_cu);
        (void)hipGetLastError();
        grid = cus;
    }
    if (grid < 0) return;
    if (hipMemsetAsync((char*)d_ws + WS_CTL, 0, CTL_ZERO_BYTES, stream) != hipSuccess) { fprintf(stderr, "kernel_launch: memset failed\n"); return; }
    Args a; memset(&a, 0, sizeof(a));
    const float** f = (const float**)&a.p;
    for (int i = 0; i < 22; ++i) f[i] = (const float*)d_in[i];
    a.p.h = (float*)d_out; a.p.ws = (unsigned char*)d_ws;
    hipLaunchKernelGGL(mega_fwd, dim3(grid), dim3(NTHR), LDS_BYTES, stream, a);
    const hipError_t le = hipPeekAtLastError();
    if (le != hipSuccess) fprintf(stderr, "kernel_launch: launch failed: %s\n", hipGetErrorName(le));
}
#else
int main(int argc, char** argv) {
    FILE* fs = fopen("sizes.txt", "r"); std::vector<long> sizes(22); for (int i = 0; i < 22; ++i) if (fscanf(fs, "%ld", &sizes[i]) != 1) return 1; fclose(fs);
    FILE* fi = fopen("inputs.bin", "rb"); std::vector<std::vector<float>> in(22);
    for (int i = 0; i < 22; ++i) { in[i].resize(sizes[i]); if (fread(in[i].data(), 4, sizes[i], fi) != (size_t)sizes[i]) return 2; } fclose(fi);
    std::vector<float> out((size_t)T * D); std::vector<unsigned char> ws(WS_END, 0xAA);
    printf("T %d D %d WS_END %zu MiB\n", T, D, (size_t)(WS_END / MiB));
    P p; memset(&p, 0, sizeof(p)); const float** f = (const float**)&p; for (int i = 0; i < 22; ++i) f[i] = in[i].data();
    p.h = out.data(); p.ws = ws.data();
    forward(p);
    FILE* fo = fopen("emu_out.bin", "wb"); fwrite(out.data(), 4, out.size(), fo); fclose(fo);
    return 0;
}
#endif
```

```cpp
#ifndef EMU
#include <hip/hip_runtime.h>
#include <cstdio>
#include <cstdint>
#include <cstring>
#define DEVFN __device__ __forceinline__
#define MEMFENCE() asm volatile("" ::: "memory")
#else
#include <cstdio>
#include <cstdint>
#include <cstdlib>
#include <cstring>
#include <cmath>
#include <vector>
#define DEVFN static inline
#define MEMFENCE() do {} while (0)
#endif
#include <cmath>

#ifndef EMU
constexpr int D = 2048, NSEQ = 6, NPROMPT = 2, S = 4096, PLE = 256, DFF = 8192;
#else
constexpr int D = 256, NSEQ = 2, NPROMPT = 1, S = 1024, PLE = 64, DFF = 512;
#endif
constexpr int T = NSEQ * S, DEPTH = 4, NH = 8, DH = 128;
constexpr int AQKV = 3072, ABIN = 7200, ABINP = 7424, ABMIX = 2048, CIN = 6144, CV = 2048;
constexpr int COL_Z = 3072, COL_G = 4096, COL_QB = 4128, COL_KB = 4128 + 1024, COL_VB = 4128 + 2048;
constexpr int GW = 64, ROWS = S / GW, NAR = 8, NAC = 16, WR = (NAR < ROWS ? NAR : ROWS);
constexpr float RMS_EPS = 1e-6f;

typedef unsigned short bf16;
DEVFN float bf2f(bf16 b) { unsigned u = ((unsigned)b) << 16; float f; memcpy(&f, &u, 4); return f; }
DEVFN bf16 f2bf(float f) { unsigned u; memcpy(&u, &f, 4); u += 0x7fffu + ((u >> 16) & 1u); return (bf16)(u >> 16); }
DEVFN float siluf(float x) { return x / (1.f + expf(-x)); }
DEVFN float sigmoidf(float x) { return 1.f / (1.f + expf(-x)); }
DEVFN float softplusf(float x) { if (x > 20.f) return x; const float y = expf(x); return y < 0.01f ? y * (1.f - y * (0.5f - y * 0.33333333f)) : logf(1.f + y); }
DEVFN int clampi(int v, int lo, int hi) { return v < lo ? lo : (v > hi ? hi : v); }

constexpr size_t MiB = 1u << 20;
constexpr size_t SZ_TD2 = (size_t)T * D * 2, SZ_TD4 = (size_t)T * D * 4;
constexpr size_t al(size_t x) { return (x + MiB - 1) / MiB * MiB; }
constexpr size_t WS_CTL = 0;
constexpr size_t WS_PRM = 1 * MiB;
constexpr int PR_ABCONV = 0, PR_ALOG = PR_ABCONV + 2 * 5 * AQKV, PR_DTB = PR_ALOG + 32, PR_ONORM = PR_DTB + 32, PR_RPB = PR_ONORM + 2 * DH, PR_LAMBDA = PR_RPB + 2 * NH * 15 * 31,
    PR_SUBLN = PR_LAMBDA + 2 * 4 * DH, PR_NORMS = PR_SUBLN + 2 * 256, PR_FCW = PR_NORMS + DEPTH * 4 * D, PR_FCB = PR_FCW + DEPTH * 3 * 2 * DFF, PR_END = PR_FCB + DEPTH * 2 * DFF;
static_assert((size_t)PR_END * 4 <= 2 * MiB, "param region");
constexpr size_t WS_WABIN = 3 * MiB;
constexpr size_t WS_WABOUT = WS_WABIN + al((size_t)2 * ABINP * D * 2);
constexpr size_t WS_WCIN = WS_WABOUT + al((size_t)2 * D * ABMIX * 2);
constexpr size_t WS_WCOUT = WS_WCIN + al((size_t)2 * CIN * D * 2);
constexpr size_t WS_WFIN = WS_WCOUT + al((size_t)2 * D * CV * 2);
constexpr size_t WS_WFOUT = WS_WFIN + al((size_t)4 * 2 * DFF * D * 2);
constexpr size_t WS_WPP = WS_WFOUT + al((size_t)4 * D * DFF * 2);
constexpr size_t WS_WPG = WS_WPP + al((size_t)4 * D * PLE * 2);
constexpr size_t WS_HN = WS_WPG + al((size_t)4 * D * D * 2);
#ifdef EMU
constexpr size_t WS_MIXIN = WS_HN + al(SZ_TD2);
#else
constexpr size_t WS_MIXIN = WS_HN;
constexpr size_t WS_H16 = WS_HN + al(SZ_TD2);
#endif
constexpr size_t WS_PB = WS_HN + 2 * al(SZ_TD2);
constexpr size_t SZ_PB = al((size_t)T * PLE * 2);
constexpr size_t WS_SMALL = WS_PB + DEPTH * SZ_PB;
constexpr size_t WS_RSTD = WS_SMALL, WS_G = WS_SMALL + al((size_t)T * 4), WS_BETA = WS_G + al((size_t)T * 16 * 4), WS_LAM = WS_BETA + al((size_t)T * 16 * 4);
constexpr size_t WS_R = WS_LAM + MiB;
constexpr size_t WS_GOUT = WS_R;
constexpr size_t WS_GOUT2 = WS_GOUT + al(SZ_TD4);
constexpr size_t WS_HID = WS_R;
#ifdef EMU
constexpr size_t WS_ACT = WS_HID + al((size_t)T * 2 * DFF * 2);
#else
constexpr size_t WS_ACT = WS_GOUT + al(SZ_TD4);
constexpr size_t WS_PP2 = (size_t)1952 * MiB;
#endif
constexpr size_t WS_HALO = WS_ACT + al((size_t)T * DFF * 2);
constexpr size_t WS_PROJ = WS_GOUT + al(SZ_TD4);
constexpr size_t WS_X1 = WS_PROJ + al((size_t)T * ABINP * 2);
constexpr size_t SZ_HD4 = al((size_t)T * NH * DH * 4);
#ifdef EMU
constexpr size_t WS_QN = WS_X1, WS_KN = WS_QN + SZ_HD4, WS_VV = WS_KN + SZ_HD4, WS_OF = WS_VV + SZ_HD4, WS_OB = WS_OF + SZ_HD4, WS_NASC = WS_OB + SZ_HD4;
constexpr size_t WS_END_AB = WS_NASC + SZ_HD4;
#else
constexpr size_t WS_OF = WS_GOUT, WS_OB = WS_OF + SZ_HD4;
constexpr size_t WS_QN = WS_X1, WS_KN = WS_X1, WS_VV = WS_X1, WS_NASC = WS_X1;
constexpr int NUD_ = NSEQ * NH * (S / 64) * 2;
constexpr size_t WS_DN_UT = WS_X1, WS_DN_WN = WS_DN_UT + al((size_t)NUD_ * 128 * 64 * 4), WS_DN_QE = WS_DN_WN + al((size_t)NUD_ * 16 * 512 * 2), WS_DN_IN = WS_DN_QE + al((size_t)NUD_ * 16 * 512 * 2),
    WS_DN_KD = WS_DN_IN + al((size_t)NUD_ * 8 * 512 * 2), WS_DN_EG = WS_DN_KD + al((size_t)NUD_ * 16 * 512 * 2);
constexpr size_t WS_END_AB = WS_DN_EG + MiB;
#endif
constexpr size_t WS_O0 = WS_X1, WS_O1 = WS_O0 + al((size_t)T * 2048 * 4);
constexpr size_t WS_END_C = WS_O1 + al((size_t)T * 2048 * 4);
constexpr size_t WS_END_F = WS_HALO + 32 * MiB;
constexpr size_t WS_END = (WS_END_AB > WS_END_C ? (WS_END_AB > WS_END_F ? WS_END_AB : WS_END_F) : (WS_END_C > WS_END_F ? WS_END_C : WS_END_F));
#ifndef EMU
static_assert(WS_END <= WS_PP2 && WS_PP2 + SZ_TD2 <= (size_t)2048 * MiB, "workspace map exceeds 2 GiB");
#endif

struct P {
    const float *x_prompt, *x_sample, *p_prompt, *p_sample, *ab_w_in, *ab_conv_w, *ab_a_log, *ab_dt_bias, *ab_out_norm, *ab_rpb, *ab_w_out,
        *c_w_in, *c_lambda, *c_subln, *c_w_out, *norms, *ffn_w_in, *ffn_conv_w, *ffn_conv_b, *ffn_w_out, *ple_w_proj, *ple_w_gate;
    float* h;
    unsigned char* ws;
};
#define WSP(type, off) ((type*)(p.ws + (off)))
#define PRM(off) (WSP(const float, WS_PRM) + (off))
constexpr long N_PRM = PR_END;
DEVFN void st_prm(const P& p, int, long g) {
    const int i = (int)g; float v;
    if (i < PR_ALOG) v = p.ab_conv_w[i - PR_ABCONV]; else if (i < PR_DTB) v = p.ab_a_log[i - PR_ALOG]; else if (i < PR_ONORM) v = p.ab_dt_bias[i - PR_DTB];
    else if (i < PR_RPB) v = p.ab_out_norm[i - PR_ONORM]; else if (i < PR_LAMBDA) v = p.ab_rpb[i - PR_RPB]; else if (i < PR_SUBLN) v = p.c_lambda[i - PR_LAMBDA];
    else if (i < PR_NORMS) v = p.c_subln[i - PR_SUBLN]; else if (i < PR_FCW) v = p.norms[i - PR_NORMS]; else if (i < PR_FCB) v = p.ffn_conv_w[i - PR_FCW]; else v = p.ffn_conv_b[i - PR_FCB];
    WSP(float, WS_PRM)[i] = v;
}
constexpr long N_INIT = (long)T * D / 4;
DEVFN void st_init(const P& p, int, long g) {
    const long i = g * 4, np = (long)NPROMPT * S * D;
    const float* src = i < np ? p.x_prompt + i : p.x_sample + (i - np);
    for (int k = 0; k < 4; ++k) p.h[i + k] = src[k];
}
constexpr long N_PB = (long)T * PLE;
DEVFN void st_pb(const P& p, int layer, long g) {
    const long np = (long)NPROMPT * S * PLE, ns = (long)(NSEQ - NPROMPT) * S * PLE;
    const float v = g < np ? p.p_prompt[(long)layer * np + g] : p.p_sample[(long)layer * ns + (g - np)];
    WSP(bf16, WS_PB + (size_t)layer * SZ_PB)[g] = f2bf(v);
}
struct WT { const float* W; bf16* O; int K, N, Npad; };
DEVFN void st_wt(const WT& w, long g) {
    const int n = (int)(g / w.K), k = (int)(g % w.K);
    w.O[g] = n < w.N ? f2bf(w.W[(size_t)k * w.N + n]) : (bf16)0;
}
constexpr long N_ROWS = T;
DEVFN void st_rowss(const P& p, const float* x, long g) {
    const float* r = x + (size_t)g * D; float s = 0.f;
    for (int c = 0; c < D; ++c) s += r[c] * r[c];
    WSP(float, WS_RSTD)[g] = 1.0f / sqrtf(s / (float)D + RMS_EPS);
}
constexpr long N_TD = (long)T * D;
DEVFN void st_norm_bf16(const P& p, const float* w, long g) {
    const long t = g / D; const int c = (int)(g % D);
    WSP(bf16, WS_HN)[g] = f2bf(p.h[g] * WSP(float, WS_RSTD)[t] * w[c]);
}
DEVFN void st_resid(const P& p, const float* y, const float* w, int write_hb, long g) {
    const long t = g / D; const int c = (int)(g % D);
    const float v = p.h[g] + y[g] * WSP(float, WS_RSTD)[t] * w[c];
    p.h[g] = v; if (write_hb) WSP(bf16, WS_HN)[g] = f2bf(v);
}
constexpr long N_TH = (long)T * NH;
DEVFN void st_dn_prep(const P& p, int layer, long g) {
    const int j = layer / 2; const long t = g / NH; const int hh = (int)(g % NH); const int tt = (int)(t % S); const long t0 = t - tt;
    const bf16* proj = WSP(bf16, WS_PROJ); const float* cw = PRM(PR_ABCONV) + (size_t)j * 5 * AQKV;
    for (int part = 0; part < 3; ++part) {
        float* o = (part == 0 ? WSP(float, WS_QN) : (part == 1 ? WSP(float, WS_KN) : WSP(float, WS_VV))) + (size_t)g * DH; float ss = 0.f;
        for (int d = 0; d < DH; ++d) {
            const int col = part * 1024 + hh * DH + d; float acc = 0.f;
            for (int i = 0; i < 5; ++i) { const int ts = tt + i - 2; if (ts >= 0 && ts < S) acc += bf2f(proj[(size_t)(t0 + ts) * ABINP + col]) * cw[i * AQKV + col]; }
            const float y = siluf(acc); ss += y * y; o[d] = y;
        }
        if (part < 2) { const float r = (1.0f / sqrtf(ss + 1e-6f)) * (part == 0 ? 0.08838834764831845f : 1.f); for (int d = 0; d < DH; ++d) o[d] *= r; }
    }
    for (int dir = 0; dir < 2; ++dir) {
        const float graw = bf2f(proj[(size_t)t * ABINP + COL_G + dir * NH + hh]), braw = bf2f(proj[(size_t)t * ABINP + COL_G + 16 + dir * NH + hh]);
        const float a = expf(PRM(PR_ALOG)[(j * 2 + dir) * NH + hh]), dtb = PRM(PR_DTB)[(j * 2 + dir) * NH + hh];
        WSP(float, WS_G)[(t * 2 + dir) * NH + hh] = -a * softplusf(graw + dtb);
        WSP(float, WS_BETA)[(t * 2 + dir) * NH + hh] = sigmoidf(braw);
    }
}
constexpr long N_SCAN = (long)NSEQ * NH * 2 * DH;
DEVFN void st_dn_scan(const P& p, int, long g) {
    const int vc = (int)(g % DH); const int dir = (int)((g / DH) % 2); const int hh = (int)((g / (2 * DH)) % NH); const int seq = (int)(g / (2 * DH * NH));
    const float *QN = WSP(float, WS_QN), *KN = WSP(float, WS_KN), *VV = WSP(float, WS_VV), *G = WSP(float, WS_G), *BT = WSP(float, WS_BETA);
    float* O = WSP(float, dir ? WS_OB : WS_OF);
    float Sx[DH];
#pragma unroll
    for (int d = 0; d < DH; ++d) Sx[d] = 0.f;
    for (int step = 0; step < S; ++step) {
        const int tt = dir ? S - 1 - step : step; const long t = (long)seq * S + tt;
        const float eg = expf(G[(t * 2 + dir) * NH + hh]), b = BT[(t * 2 + dir) * NH + hh];
        const float* kp = KN + ((size_t)t * NH + hh) * DH; const float* qp = QN + ((size_t)t * NH + hh) * DH; const float vv = VV[((size_t)t * NH + hh) * DH + vc];
        float dot = 0.f;
#pragma unroll
        for (int d0 = 0; d0 < DH; d0 += 16) { MEMFENCE();
#pragma unroll
            for (int d = d0; d < d0 + 16; ++d) { Sx[d] *= eg; dot += Sx[d] * kp[d]; } }
        const float delta = b * (vv - dot); float o = 0.f;
#pragma unroll
        for (int d0 = 0; d0 < DH; d0 += 16) { MEMFENCE();
#pragma unroll
            for (int d = d0; d < d0 + 16; ++d) { Sx[d] += kp[d] * delta; o += Sx[d] * qp[d]; } }
        MEMFENCE();
        O[((size_t)t * NH + hh) * DH + vc] = o;
    }
}
DEVFN void st_dn_out(const P& p, int layer, long g) {
    const int j = layer / 2; const long t = g / NH; const int hh = (int)(g % NH);
    const float *OF = WSP(float, WS_OF) + (size_t)g * DH, *OB = WSP(float, WS_OB) + (size_t)g * DH; const float* on = PRM(PR_ONORM) + j * DH;
    float ss = 0.f; for (int d = 0; d < DH; ++d) { const float o = OF[d] + OB[d]; ss += o * o; }
    const float r = 1.0f / sqrtf(ss / (float)DH + RMS_EPS);
    const bf16* z = WSP(bf16, WS_PROJ) + (size_t)t * ABINP + COL_Z + hh * DH; bf16* out = WSP(bf16, WS_MIXIN) + (size_t)t * ABMIX + hh * DH;
    for (int d = 0; d < DH; ++d) out[d] = f2bf((OF[d] + OB[d]) * r * on[d] * siluf(bf2f(z[d])));
}
constexpr long N_THD = (long)T * NH * DH;
DEVFN long na_key_token(long t, int jw, int& dr, int& dc) {
    const int tt = (int)(t % S); const long t0 = t - tt; const int r = tt / GW, c = tt % GW;
    const int rs = clampi(r - WR / 2, 0, ROWS - WR), cs = clampi(c - NAC / 2, 0, GW - NAC);
    const int rk = rs + jw / NAC, ck = cs + jw % NAC;
    dr = rk - r + NAR - 1; dc = clampi(ck - c + NAC - 1, 0, 2 * NAC - 2);
    return t0 + (long)rk * GW + ck;
}
DEVFN void st_na_scores(const P& p, int layer, long g) {
    const int j = layer / 2; const int jw = (int)(g % DH); const int hh = (int)((g / DH) % NH); const long t = g / (DH * NH);
    int dr, dc; const long tk = na_key_token(t, jw, dr, dc);
    const bf16* q = WSP(bf16, WS_PROJ) + (size_t)t * ABINP + COL_QB + hh * DH; const bf16* k = WSP(bf16, WS_PROJ) + (size_t)tk * ABINP + COL_KB + hh * DH;
    float dot = 0.f; for (int d = 0; d < DH; ++d) dot += bf2f(q[d]) * bf2f(k[d]);
    WSP(float, WS_NASC)[g] = dot * 0.08838834764831845f + PRM(PR_RPB)[(((size_t)j * NH + hh) * (2 * NAR - 1) + dr) * (2 * NAC - 1) + dc];
}
DEVFN void st_na_out(const P& p, int, long g) {
    const int d = (int)(g % DH); const int hh = (int)((g / DH) % NH); const long t = g / (DH * NH);
    const float* sc = WSP(float, WS_NASC) + ((size_t)t * NH + hh) * DH;
    float m = sc[0]; for (int jw = 1; jw < WR * NAC; ++jw) m = fmaxf(m, sc[jw]);
    float l = 0.f, o = 0.f;
    for (int jw = 0; jw < WR * NAC; ++jw) { int dr, dc; const long tk = na_key_token(t, jw, dr, dc); const float e = expf(sc[jw] - m); l += e;
        o += e * bf2f(WSP(bf16, WS_PROJ)[(size_t)tk * ABINP + COL_VB + hh * DH + d]); }
    WSP(bf16, WS_MIXIN)[(size_t)t * ABMIX + 1024 + hh * DH + d] = f2bf(o / l);
}
DEVFN float lambda_init_of(int layer) { return 0.8f - 0.6f * expf(-0.3f * (float)layer); }
DEVFN void st_lam(const P& p, int layer, long) {
    const float* lp = PRM(PR_LAMBDA) + (size_t)(layer / 2) * 4 * DH; float a = 0.f, b = 0.f;
    for (int d = 0; d < DH; ++d) { a += lp[d] * lp[DH + d]; b += lp[2 * DH + d] * lp[3 * DH + d]; }
    const float li = lambda_init_of(layer); WSP(float, WS_LAM)[0] = expf(a) - expf(b) + li; WSP(float, WS_LAM)[1] = li;
}
constexpr long N_ROPE = (long)T * 2 * 16 * 16;
DEVFN void st_rope(const P& p, int, long g) {
    const int i = (int)(g % 16); const int hj = (int)((g / 16) % 16); const int which = (int)((g / 256) % 2); const long t = g / 512;
    bf16* x = WSP(bf16, WS_PROJ) + (size_t)t * CIN + which * 2048 + hj * DH;
    const float inv = powf(500000.0f, -(float)(2 * i) / 32.0f); const float ang = (float)(t % S) * inv; const float cs = cosf(ang), sn = sinf(ang);
    const float x1 = bf2f(x[i]), x2 = bf2f(x[16 + i]);
    x[i] = f2bf(x1 * cs - x2 * sn); x[16 + i] = f2bf(x2 * cs + x1 * sn);
}
constexpr int DA_E = 64;
constexpr long N_DATT = (long)NSEQ * NH * 2 * (256 / DA_E) * S;
DEVFN void st_dattn(const P& p, int, long g) {
    const int qi = (int)(g % S); long r = g / S; const int es = (int)(r % (256 / DA_E)); r /= (256 / DA_E); const int jj = (int)(r % 2); r /= 2; const int hh = (int)(r % NH); const int seq = (int)(r / NH);
    const bf16* proj = WSP(bf16, WS_PROJ); const long t = (long)seq * S + qi;
    float q[DH];
#pragma unroll
    for (int d = 0; d < DH; ++d) q[d] = bf2f(proj[(size_t)t * CIN + hh * 256 + jj * DH + d]) * 0.08838834764831845f;
    float o[DA_E];
#pragma unroll
    for (int e = 0; e < DA_E; ++e) o[e] = 0.f;
    float m = -1e30f, l = 0.f;
    for (int kk = 0; kk < S; ++kk) {
        const bf16* kr = proj + (size_t)((long)seq * S + kk) * CIN + 2048 + hh * 256 + jj * DH; const bf16* vr = proj + (size_t)((long)seq * S + kk) * CIN + 4096 + hh * 256 + es * DA_E;
        float s = 0.f;
#pragma unroll
        for (int d0 = 0; d0 < DH; d0 += 32) { MEMFENCE();
#pragma unroll
            for (int d = d0; d < d0 + 32; ++d) s += q[d] * bf2f(kr[d]); }
        MEMFENCE();
        const float mn = fmaxf(m, s), al = expf(m - mn), pe = expf(s - mn); m = mn; l = l * al + pe;
#pragma unroll
        for (int e = 0; e < DA_E; ++e) o[e] = o[e] * al + pe * bf2f(vr[e]);
    }
    float* O = WSP(float, jj ? WS_O1 : WS_O0) + (size_t)t * 2048 + hh * 256 + es * DA_E; const float il = 1.0f / l;
#pragma unroll
    for (int e = 0; e < DA_E; ++e) O[e] = o[e] * il;
}
DEVFN void st_c_out(const P& p, int layer, long g) {
    const int j = layer / 2; const long t = g / NH; const int hh = (int)(g % NH); const float lam = WSP(float, WS_LAM)[0], li = WSP(float, WS_LAM)[1];
    const float *O0 = WSP(float, WS_O0) + (size_t)t * 2048 + hh * 256, *O1 = WSP(float, WS_O1) + (size_t)t * 2048 + hh * 256; const float* sw = PRM(PR_SUBLN) + j * 256;
    float ss = 0.f; for (int e = 0; e < 256; ++e) { const float o = O0[e] - lam * O1[e]; ss += o * o; }
    const float r = (1.0f / sqrtf(ss / 256.0f + RMS_EPS)) * (1.0f - li);
    bf16* out = WSP(bf16, WS_MIXIN) + (size_t)t * 2048 + hh * 256;
    for (int e = 0; e < 256; ++e) out[e] = f2bf((O0[e] - lam * O1[e]) * r * sw[e]);
}
constexpr long N_ACT = (long)T * DFF;
DEVFN float gelu_tanh(float x) { return 0.5f * x * (1.0f + tanhf(0.7978845608028654f * (x + 0.044715f * x * x * x))); }
DEVFN void st_ffn_act(const P& p, int layer, long g) {
    const long t = g / DFF; const int c = (int)(g % DFF); const int tt = (int)(t % S);
    const bf16* hid = WSP(bf16, WS_HID); const float* cw = PRM(PR_FCW) + (size_t)layer * 3 * 2 * DFF; const float* cb = PRM(PR_FCB) + (size_t)layer * 2 * DFF;
    float ga = cb[c], up = cb[DFF + c];
    for (int i = 0; i < 3; ++i) { const int ts = tt + i - 1; if (ts >= 0 && ts < S) { const bf16* r = hid + (size_t)(t - tt + ts) * (2 * DFF);
        ga += bf2f(r[c]) * cw[i * 2 * DFF + c]; up += bf2f(r[DFF + c]) * cw[i * 2 * DFF + DFF + c]; } }
    WSP(bf16, WS_ACT)[g] = f2bf(gelu_tanh(ga) * up);
}
DEVFN void st_ple(const P& p, int, long g) { p.h[g] += sigmoidf(WSP(float, WS_GOUT)[g]) * WSP(float, WS_GOUT2)[g]; }
#ifndef EMU
namespace pg8 {
#define PG8_LAS __attribute__((address_space(3)))
typedef unsigned short bf16_t;
typedef short bf16x8 __attribute__((ext_vector_type(8)));
typedef float f32x4 __attribute__((ext_vector_type(4)));
typedef unsigned u32x4 __attribute__((ext_vector_type(4)));
constexpr int BM = 256, BK = 64, HALF = 128, HTB = HALF * BK * 2  , STAGE_BYTES = 8 * HTB, NXCD = 8, WGM = 4;

__host__ __device__ __forceinline__ int lds_byte(int r, int c) { const int st = (r >> 4) * 2 + (c >> 5), rr = r & 15, cc = c & 31, ob = rr * 64 + cc * 2; return st * 1024 + (ob ^ (((ob >> 9) & 1) << 5)); }
__host__ __device__ __forceinline__ void stage_rc(int b, int& R, int& C) { const int st = b / 1024, sb = b % 1024, swz = sb ^ (((sb >> 9) & 1) << 5); R = (st >> 1) * 16 + swz / 64; C = (st & 1) * 32 + (swz % 64) / 2; }
__host__ __device__ __forceinline__ int perm32(int rho) { const int n = rho >> 4, i = rho & 15; return 8 * (i >> 2) + 4 * n + (i & 3); }

struct Unit { int pm, pn; };
struct Gemm { const bf16_t* A; const bf16_t* Bt; int M, N, K; };

struct StaticOrder {
    int nM, nN, nwg, G, c;
    __host__ __device__ void init(int M, int N, int G_, int c_) { nM = M / BM; nN = N / BM; nwg = nM * nN; G = G_; c = c_; }
    __host__ __device__ bool next(int i, Unit& u) const {
        const long L = (long)i * G + c; if (L >= nwg) return false;
        int wgid = (int)L; { const int q = nwg / NXCD, r = nwg % NXCD, xcd = wgid % NXCD, off = wgid / NXCD; wgid = (xcd < r ? xcd * (q + 1) : r * (q + 1) + (xcd - r) * q) + off; }
        const int nig = WGM * nN, gid = wgid / nig, fm = gid * WGM, gsz = (nM - fm) < WGM ? (nM - fm) : WGM;
        u.pm = fm + ((wgid % nig) % gsz); u.pn = (wgid % nig) / gsz; return true;
    }
    __device__ __forceinline__ void a_ready(const Unit&) const {}
    __device__ __forceinline__ void done(const Unit&) const {}
};

__device__ __forceinline__ unsigned cvt_pk_bf16(float lo, float hi) { unsigned r; asm volatile("v_cvt_pk_bf16_f32 %0, %1, %2" : "=v"(r) : "v"(lo), "v"(hi)); return r; }
struct EpiBf16 {
    static constexpr bool PERM = true, AFTER_DRAIN = false;
    bf16_t* O; int ldc;
    __device__ __forceinline__ void operator()(const f32x4 (&acc)[2][2][4][2], const Unit& u, int wr, int wc, int fr, int fq) const {
        const int row0 = u.pm * BM + wr * 64 + fr; const int col0 = u.pn * BM + wc * 32 + 8 * fq;
#pragma unroll
        for (int ai = 0; ai < 2; ++ai)
#pragma unroll
            for (int m = 0; m < 4; ++m) { bf16_t* rowp = O + (size_t)(row0 + ai * HALF + m * 16) * ldc + col0;
#pragma unroll
                for (int bj = 0; bj < 2; ++bj) { const f32x4 v0 = acc[ai][bj][m][0], v1 = acc[ai][bj][m][1];
                    u32x4 w; w.x = cvt_pk_bf16(v0[0], v0[1]); w.y = cvt_pk_bf16(v0[2], v0[3]); w.z = cvt_pk_bf16(v1[0], v1[1]); w.w = cvt_pk_bf16(v1[2], v1[3]);
                    *(u32x4*)(rowp + bj * HALF) = w; } }
    }
};
struct EpiBf16Ro {
    static constexpr bool PERM = true, AFTER_DRAIN = false;
    bf16_t* O; int ldc; const float* tab; int seqlen;
    __device__ __forceinline__ void operator()(const f32x4 (&acc)[2][2][4][2], const Unit& u, int wr, int wc, int fr, int fq) const {
        const int row0 = u.pm * BM + wr * 64 + fr; const int col0 = u.pn * BM + wc * 32 + 8 * fq;
        const bool rope = tab != nullptr && u.pn < 16 && wc == 0;
        f32x4 cN[4] = {};
#define RO_LOAD(r_) do { const float* cs_ = tab + ((size_t)((r_) % seqlen) * 16 + 8 * (fq & 1)) * 2; cN[0] = *(const f32x4*)cs_; cN[1] = *(const f32x4*)(cs_ + 4); cN[2] = *(const f32x4*)(cs_ + 8); cN[3] = *(const f32x4*)(cs_ + 12); } while (0)
        if (rope) RO_LOAD(row0);
#pragma unroll
        for (int ai = 0; ai < 2; ++ai)
#pragma unroll
            for (int m = 0; m < 4; ++m) { const int row = row0 + ai * HALF + m * 16; bf16_t* rowp = O + (size_t)row * ldc + col0;
                const f32x4 c0 = cN[0], c1 = cN[1], c2 = cN[2], c3 = cN[3];
                if (rope && (ai * 4 + m) < 7) RO_LOAD(row0 + (m == 3 ? HALF : ai * HALF + (m + 1) * 16));
#pragma unroll
                for (int bj = 0; bj < 2; ++bj) { f32x4 v0 = acc[ai][bj][m][0], v1 = acc[ai][bj][m][1];
                    if (rope) { const float sgn = fq < 2 ? -1.f : 1.f;
#pragma unroll
                        for (int e = 0; e < 4; ++e) { const float o0 = __shfl_xor(v0[e], 32), o1 = __shfl_xor(v1[e], 32);
                            const float cs0 = (e < 2 ? c0 : c1)[2 * (e & 1)], sn0 = (e < 2 ? c0 : c1)[2 * (e & 1) + 1], cs1 = (e < 2 ? c2 : c3)[2 * (e & 1)], sn1 = (e < 2 ? c2 : c3)[2 * (e & 1) + 1];
                            v0[e] = v0[e] * cs0 + sgn * o0 * sn0; v1[e] = v1[e] * cs1 + sgn * o1 * sn1; } }
                    u32x4 w; w.x = cvt_pk_bf16(v0[0], v0[1]); w.y = cvt_pk_bf16(v0[2], v0[3]); w.z = cvt_pk_bf16(v1[0], v1[1]); w.w = cvt_pk_bf16(v1[2], v1[3]);
                    *(u32x4*)(rowp + bj * HALF) = w; } }
    }
};
#undef RO_LOAD
__device__ __forceinline__ float dpp_prev(float oldv, float x) { return __int_as_float(__builtin_amdgcn_update_dpp(__float_as_int(oldv), __float_as_int(x), 0x111, 0xf, 0xf, false)); }
__device__ __forceinline__ float dpp_next(float oldv, float x) { return __int_as_float(__builtin_amdgcn_update_dpp(__float_as_int(oldv), __float_as_int(x), 0x101, 0xf, 0xf, false)); }
__device__ __forceinline__ float dpp_ror1(float x) { return __int_as_float(__builtin_amdgcn_update_dpp(__float_as_int(x), __float_as_int(x), 0x121, 0xf, 0xf, false)); }
__device__ __forceinline__ float dpp_rol1(float x) { return __int_as_float(__builtin_amdgcn_update_dpp(__float_as_int(x), __float_as_int(x), 0x12F, 0xf, 0xf, false)); }
__device__ __forceinline__ void conv3_pair(float& cg, float& cu, float xg, float xu, float egp, float egn, float eup, float eun,
                                           float wg0, float wg1, float wg2, float wu0, float wu1, float wu2, float bg, float bu, unsigned long long m15, unsigned long long m0) {
    float t0, t1, t2, t3;
    asm("v_cndmask_b32_e64 %[t0], %[xg], %[egp], %[m15]\n\t"
        "v_cndmask_b32_e64 %[t1], %[xg], %[egn], %[m0]\n\t"
        "v_cndmask_b32_e64 %[t2], %[xu], %[eup], %[m15]\n\t"
        "v_cndmask_b32_e64 %[t3], %[xu], %[eun], %[m0]\n\t"
        "v_fma_f32 %[cg], %[wg1], %[xg], %[bg]\n\t"
        "v_fma_f32 %[cu], %[wu1], %[xu], %[bu]\n\t"
        "v_fmac_f32_dpp %[cg], %[t0], %[wg0] row_ror:1 row_mask:0xf bank_mask:0xf\n\t"
        "v_fmac_f32_dpp %[cg], %[t1], %[wg2] row_ror:15 row_mask:0xf bank_mask:0xf\n\t"
        "v_fmac_f32_dpp %[cu], %[t2], %[wu0] row_ror:1 row_mask:0xf bank_mask:0xf\n\t"
        "v_fmac_f32_dpp %[cu], %[t3], %[wu2] row_ror:15 row_mask:0xf bank_mask:0xf"
        : [cg] "=&v"(cg), [cu] "=&v"(cu), [t0] "=&v"(t0), [t1] "=&v"(t1), [t2] "=&v"(t2), [t3] "=&v"(t3)
        : [xg] "v"(xg), [xu] "v"(xu), [egp] "v"(egp), [egn] "v"(egn), [eup] "v"(eup), [eun] "v"(eun), [wg0] "v"(wg0), [wg1] "v"(wg1), [wg2] "v"(wg2), [wu0] "v"(wu0), [wu1] "v"(wu1), [wu2] "v"(wu2),
          [bg] "v"(bg), [bu] "v"(bu), [m15] "s"(m15), [m0] "s"(m0));
}
__device__ __forceinline__ float gelu_t(float x) { const float u = 0.7978845608028654f * (x + 0.044715f * x * x * x); return x * __builtin_amdgcn_rcpf(1.0f + __builtin_amdgcn_exp2f(-2.885390081777927f * u)); }
struct EpiConvAct {
    static constexpr bool PERM = true, AFTER_DRAIN = false;
    bf16_t* ACT; float* HALO; float* HDUMP; const float* cw; const float* cb; PG8_LAS float* EX;
    __device__ __forceinline__ void operator()(const f32x4 (&acc)[2][2][4][2], const Unit& u, int wr, int wc, int fr, int fq) const {
        const int ch0 = u.pn * 128 + wc * 32 + 8 * fq;
        PG8_LAS float* WL = EX + 2560; const int t_ = ((wr * 4 + wc) << 6) | (fq * 16 + fr); float wv[2];
#pragma unroll
        for (int j = 0; j < 2; ++j) { const int idx = t_ + 512 * j, r = idx >> 7, c = idx & 127; const float* src = r < 6 ? cw + (size_t)(r >> 1) * 2 * DFF + (r & 1) * DFF : cb + (r & 1) * DFF; wv[j] = src[u.pn * 128 + c]; }
#pragma unroll
        for (int ai = 0; ai < 2; ++ai) { const int sg = 2 * ai + wr;
            PG8_LAS float* d0 = EX + ((fr == 0) ? ((((sg * 2 + 0) * 4 + wc) * 4 + fq) * 16) : (2048 + wc * 64 + fq * 16));
            PG8_LAS float* d1 = EX + ((fr == 15) ? ((((sg * 2 + 1) * 4 + wc) * 4 + fq) * 16) : (2048 + wc * 64 + fq * 16));
#pragma unroll
            for (int bj = 0; bj < 2; ++bj)
#pragma unroll
                for (int n = 0; n < 2; ++n) { *(PG8_LAS f32x4*)(d0 + (bj * 2 + n) * 4) = acc[ai][bj][0][n]; *(PG8_LAS f32x4*)(d1 + (bj * 2 + n) * 4) = acc[ai][bj][3][n]; } }
        if (wr == 0) { float* hp = (fr < 2) ? HALO + (((size_t)u.pm * 4 + fr) * 2) * DFF + ch0 : HDUMP + (size_t)(wc * 4 + fq) * 16;
            const size_t bs = (fr < 2) ? (size_t)DFF : (size_t)8;
#pragma unroll
            for (int bj = 0; bj < 2; ++bj)
#pragma unroll
                for (int n = 0; n < 2; ++n) *(f32x4*)(hp + bj * bs + 4 * n) = acc[0][bj][0][n]; }
        else { float* hp = (fr >= 14) ? HALO + (((size_t)u.pm * 4 + 2 + (fr - 14)) * 2) * DFF + ch0 : HDUMP + (size_t)(wc * 4 + fq) * 16;
            const size_t bs = (fr >= 14) ? (size_t)DFF : (size_t)8;
#pragma unroll
            for (int bj = 0; bj < 2; ++bj)
#pragma unroll
                for (int n = 0; n < 2; ++n) *(f32x4*)(hp + bj * bs + 4 * n) = acc[1][bj][3][n]; }
        WL[t_] = wv[0]; WL[t_ + 512] = wv[1];
        asm volatile("s_waitcnt lgkmcnt(0)" ::: "memory"); __builtin_amdgcn_s_barrier(); asm volatile("" ::: "memory");
        const unsigned long long m15 = __ballot(fr == 15), m0 = __ballot(fr == 0);
        unsigned W[2][4][4];
#pragma unroll
        for (int n = 0; n < 2; ++n)
#pragma unroll
            for (int e2 = 0; e2 < 4; e2 += 2) {
                float wg[3][2], wu[3][2], bg[2], bu[2];
#pragma unroll
                for (int k = 0; k < 2; ++k) { const int cl = wc * 32 + 8 * fq + 4 * n + e2 + k;
#pragma unroll
                    for (int t = 0; t < 3; ++t) { wg[t][k] = WL[(2 * t) * 128 + cl]; wu[t][k] = WL[(2 * t + 1) * 128 + cl]; }
                    bg[k] = WL[6 * 128 + cl]; bu[k] = WL[7 * 128 + cl]; }
#pragma unroll
                for (int ai = 0; ai < 2; ++ai) { const int sg = 2 * ai + wr;
                    float pg[2] = {0.f, 0.f}, pu[2] = {0.f, 0.f}, ng[2] = {0.f, 0.f}, nu[2] = {0.f, 0.f};
                    if (sg > 0) { const PG8_LAS float* d = EX + ((((sg - 1) * 2 + 1) * 4 + wc) * 4 + fq) * 16 + n * 4 + e2; pg[0] = d[0]; pg[1] = d[1]; pu[0] = d[8]; pu[1] = d[9]; }
                    if (sg < 3) { const PG8_LAS float* d = EX + ((((sg + 1) * 2 + 0) * 4 + wc) * 4 + fq) * 16 + n * 4 + e2; ng[0] = d[0]; ng[1] = d[1]; nu[0] = d[8]; nu[1] = d[9]; }
#pragma unroll
                    for (int m = 0; m < 4; ++m) { float o[2];
#pragma unroll
                        for (int k = 0; k < 2; ++k) { const int e = e2 + k;
                            const float xg = acc[ai][0][m][n][e], xu = acc[ai][1][m][n][e];
                            const float bg_p = m > 0 ? acc[ai][0][m - 1][n][e] : pg[k], bu_p = m > 0 ? acc[ai][1][m - 1][n][e] : pu[k];
                            const float bg_n = m < 3 ? acc[ai][0][m + 1][n][e] : ng[k], bu_n = m < 3 ? acc[ai][1][m + 1][n][e] : nu[k];
                            float cg, cu; conv3_pair(cg, cu, xg, xu, bg_p, bg_n, bu_p, bu_n, wg[0][k], wg[1][k], wg[2][k], wu[0][k], wu[1][k], wu[2][k], bg[k], bu[k], m15, m0);
                            o[k] = gelu_t(cg) * cu; }
                        W[ai][m][n * 2 + (e2 >> 1)] = cvt_pk_bf16(o[0], o[1]); } }
            }
        const int row0 = u.pm * BM + wr * 64 + fr;
#pragma unroll
        for (int ai = 0; ai < 2; ++ai)
#pragma unroll
            for (int m = 0; m < 4; ++m) { u32x4 w; w.x = W[ai][m][0]; w.y = W[ai][m][1]; w.z = W[ai][m][2]; w.w = W[ai][m][3];
                *(u32x4*)(ACT + (size_t)(row0 + ai * HALF + m * 16) * DFF + ch0) = w; }
    }
};
struct EpiF32 {
    static constexpr bool PERM = false, AFTER_DRAIN = false;
    float* C; int ldc;
    __device__ __forceinline__ void operator()(const f32x4 (&acc)[2][2][4][2], const Unit& u, int wr, int wc, int fr, int fq) const {
        const int row0 = u.pm * BM + wr * 64 + fr, col0 = u.pn * BM + wc * 32 + 4 * fq;
#pragma unroll
        for (int ai = 0; ai < 2; ++ai)
#pragma unroll
            for (int m = 0; m < 4; ++m) { float* rowp = C + (size_t)(row0 + ai * HALF + m * 16) * ldc + col0;
#pragma unroll
                for (int bj = 0; bj < 2; ++bj)
#pragma unroll
                    for (int n = 0; n < 2; ++n) *(f32x4*)(rowp + bj * HALF + n * 16) = acc[ai][bj][m][n]; }
    }
};
template <class Epi, class Sched, bool ALIGN_EPI = false, bool SP2 = false>
__device__ __forceinline__ void gemm_phase(PG8_LAS unsigned char* lds, const Gemm g, const Sched& S, const Epi& E, int tid_in) {
    int tid_ = tid_in; asm volatile("" : "+v"(tid_));
    const int tid = tid_, wid = __builtin_amdgcn_readfirstlane(tid >> 6), lane = tid & 63, wr = wid >> 2, wc = wid & 3, fr = lane & 15, fq = lane >> 4;
    const int K = g.K, nt = K / BK;
    unsigned voffA[2], voffB[2];
#pragma unroll
    for (int i = 0; i < 2; ++i) { int R, C; stage_rc(tid * 16 + i * 8192, R, C); const int Rb = Epi::PERM ? ((R & ~31) + perm32(R & 31)) : R;
        voffA[i] = (unsigned)(R * K + C) * 2u; voffB[i] = (unsigned)(Rb * K + C) * 2u; }
    const size_t kstep = (size_t)(BK * 2);
    const size_t hstep = (size_t)HALF * K * 2;
    const size_t tstep = 2 * hstep;
    const unsigned ldsw = (unsigned)wid * 1024u;
    const int aoff = lds_byte(wr * 64 + fr, fq * 8), boff = lds_byte(wc * 32 + fr, fq * 8);
#define PG8_SA(b, h) (((b) * 2 + (h)) * HTB)
#define PG8_SB(b, h) ((4 + (b) * 2 + (h)) * HTB)
#define PG8_STAGE(bufoff, gbase, voff) do { _Pragma("unroll") for (int _i = 0; _i < 2; ++_i) \
        __builtin_amdgcn_global_load_lds((const unsigned*)((const char*)(gbase) + (voff)[_i]), (PG8_LAS unsigned*)(lds + (bufoff) + ldsw + _i * 8192), 16, 0, 0); } while (0)
#define PG8_LDA(dst, b, h) do { _Pragma("unroll") for (int m = 0; m < 4; ++m) _Pragma("unroll") for (int k = 0; k < 2; ++k) dst[m][k] = *(const PG8_LAS bf16x8*)(lds + PG8_SA(b, h) + aoff + m * 2048 + k * 1024); } while (0)
#define PG8_LDB(dst, b, h) do { _Pragma("unroll") for (int n = 0; n < 2; ++n) _Pragma("unroll") for (int k = 0; k < 2; ++k) dst[n][k] = *(const PG8_LAS bf16x8*)(lds + PG8_SB(b, h) + boff + n * 2048 + k * 1024); } while (0)
#define PG8_MMA(ai, bj, At, Bt) do { __builtin_amdgcn_s_setprio(1); _Pragma("unroll") for (int m = 0; m < 4; ++m) _Pragma("unroll") for (int n = 0; n < 2; ++n) _Pragma("unroll") for (int k = 0; k < 2; ++k) \
        acc[ai][bj][m][n] = __builtin_amdgcn_mfma_f32_16x16x32_bf16(Bt[n][k], At[m][k], acc[ai][bj][m][n], 0, 0, 0); __builtin_amdgcn_s_setprio(0); } while (0)
#define PG8_WAIT_V(n) asm volatile("s_waitcnt vmcnt(" #n ")" ::: "memory")
#define PG8_WAIT_L(n) asm volatile("s_waitcnt lgkmcnt(" #n ")" ::: "memory")
#define PG8_BAR __builtin_amdgcn_s_barrier()
#define PG8_SCHED __builtin_amdgcn_sched_barrier(0)
    Unit cur, nxt; int ui = 0;
    if (!S.next(0, cur)) return;
    f32x4 acc[2][2][4][2];
#pragma unroll
    for (int a = 0; a < 2; ++a)
#pragma unroll
        for (int b = 0; b < 2; ++b)
#pragma unroll
            for (int m = 0; m < 4; ++m)
#pragma unroll
                for (int n = 0; n < 2; ++n) acc[a][b][m][n] = (f32x4){0.f, 0.f, 0.f, 0.f};
    bf16x8 At[4][2], B0[2][2], B1[2][2];
    const char* cA = (const char*)g.A + (size_t)cur.pm * tstep; const char* cB = (const char*)g.Bt + (size_t)cur.pn * tstep;
    S.a_ready(cur);
    if constexpr (SP2) {
        PG8_STAGE(PG8_SB(0, 0), cB, voffB); PG8_STAGE(PG8_SB(0, 1), cB + hstep, voffB); PG8_STAGE(PG8_SA(0, 0), cA, voffA); PG8_STAGE(PG8_SA(0, 1), cA + hstep, voffA);
        if (wr == 1) PG8_BAR;
        PG8_WAIT_V(2); PG8_BAR;
        PG8_STAGE(PG8_SB(1, 0), cB + kstep, voffB); PG8_STAGE(PG8_SA(1, 0), cA + kstep, voffA); PG8_STAGE(PG8_SB(1, 1), cB + hstep + kstep, voffB);
        PG8_WAIT_V(6); PG8_BAR;
    } else {
        PG8_STAGE(PG8_SB(0, 0), cB, voffB); PG8_STAGE(PG8_SA(0, 0), cA, voffA); PG8_STAGE(PG8_SB(0, 1), cB + hstep, voffB); PG8_STAGE(PG8_SA(0, 1), cA + hstep, voffA);
        if (wr == 1) PG8_BAR;
        PG8_WAIT_V(4); PG8_BAR;
        PG8_STAGE(PG8_SB(1, 0), cB + kstep, voffB); PG8_STAGE(PG8_SA(1, 0), cA + kstep, voffA); PG8_STAGE(PG8_SB(1, 1), cB + hstep + kstep, voffB);
        PG8_WAIT_V(6); PG8_BAR;
    }
    for (;;) {
        const bool has_next = S.next(ui + 1, nxt);
        const char* nA = has_next ? (const char*)g.A + (size_t)nxt.pm * tstep : cA; const char* nB = has_next ? (const char*)g.Bt + (size_t)nxt.pn * tstep : cB;
        for (int t = 0; t < nt; t += 2) {
            const bool last = (t == nt - 2);
            const char* a1 = cA + (size_t)(t + 1) * kstep;
            const char* a2 = last ? nA : cA + (size_t)(t + 2) * kstep; const char* b2 = last ? nB : cB + (size_t)(t + 2) * kstep;
            const char* a3 = a2 + kstep; const char* b3 = b2 + kstep;
            if (last && has_next) S.a_ready(nxt);
            if constexpr (SP2) {
            PG8_LDB(B0, 0, 0); PG8_LDB(B1, 0, 1); PG8_SCHED; PG8_LDA(At, 0, 0); PG8_STAGE(PG8_SA(1, 1), a1 + hstep, voffA);
            PG8_WAIT_V(8); PG8_WAIT_L(0); PG8_BAR; PG8_MMA(0, 0, At, B0); PG8_MMA(0, 1, At, B1); PG8_BAR; PG8_SCHED;
            PG8_LDA(At, 0, 1); PG8_STAGE(PG8_SB(0, 0), b2, voffB); PG8_STAGE(PG8_SB(0, 1), b2 + hstep, voffB); PG8_STAGE(PG8_SA(0, 0), a2, voffA);
            PG8_WAIT_V(8); PG8_WAIT_L(0); PG8_BAR; PG8_MMA(1, 0, At, B0); PG8_MMA(1, 1, At, B1); PG8_BAR; PG8_SCHED;
            PG8_LDB(B0, 1, 0); PG8_LDB(B1, 1, 1); PG8_SCHED; PG8_LDA(At, 1, 0); PG8_STAGE(PG8_SA(0, 1), a2 + hstep, voffA);
            PG8_WAIT_V(8); PG8_WAIT_L(0); PG8_BAR; PG8_MMA(0, 0, At, B0); PG8_MMA(0, 1, At, B1); PG8_BAR; PG8_SCHED;
            PG8_LDA(At, 1, 1); PG8_STAGE(PG8_SB(1, 0), b3, voffB); PG8_STAGE(PG8_SB(1, 1), b3 + hstep, voffB); PG8_STAGE(PG8_SA(1, 0), a3, voffA);
            PG8_WAIT_V(8); PG8_WAIT_L(0); PG8_BAR; PG8_MMA(1, 0, At, B0); PG8_MMA(1, 1, At, B1); PG8_BAR; PG8_SCHED;
            } else {
            PG8_LDB(B0, 0, 0); PG8_SCHED; PG8_LDA(At, 0, 0); PG8_STAGE(PG8_SA(1, 1), a1 + hstep, voffA);
            PG8_WAIT_L(8); PG8_BAR; PG8_WAIT_L(0); PG8_MMA(0, 0, At, B0); PG8_BAR; PG8_SCHED;
            PG8_LDB(B1, 0, 1); PG8_STAGE(PG8_SB(0, 0), b2, voffB);
            PG8_BAR; PG8_WAIT_L(0); PG8_MMA(0, 1, At, B1); PG8_BAR;
            PG8_LDA(At, 0, 1); PG8_STAGE(PG8_SA(0, 0), a2, voffA);
            PG8_BAR; PG8_WAIT_L(0); PG8_MMA(1, 0, At, B0); PG8_BAR; PG8_SCHED;
            PG8_STAGE(PG8_SB(0, 1), b2 + hstep, voffB);
            PG8_WAIT_V(6); PG8_BAR; PG8_MMA(1, 1, At, B1); PG8_BAR;
            PG8_LDB(B0, 1, 0); PG8_SCHED; PG8_LDA(At, 1, 0); PG8_STAGE(PG8_SA(0, 1), a2 + hstep, voffA);
            PG8_WAIT_L(8); PG8_BAR; PG8_WAIT_L(0); PG8_MMA(0, 0, At, B0); PG8_BAR; PG8_SCHED;
            PG8_LDB(B1, 1, 1); PG8_STAGE(PG8_SB(1, 0), b3, voffB);
            PG8_BAR; PG8_WAIT_L(0); PG8_MMA(0, 1, At, B1); PG8_BAR;
            PG8_LDA(At, 1, 1); PG8_STAGE(PG8_SA(1, 0), a3, voffA);
            PG8_BAR; PG8_WAIT_L(0); PG8_MMA(1, 0, At, B0); PG8_BAR; PG8_SCHED;
            PG8_STAGE(PG8_SB(1, 1), b3 + hstep, voffB);
            PG8_WAIT_V(6); PG8_BAR; PG8_MMA(1, 1, At, B1); PG8_BAR;
            }
        }
        if constexpr (ALIGN_EPI) { if (wr == 0) PG8_BAR; }
        if constexpr (!Epi::AFTER_DRAIN) { E(acc, cur, wr, wc, fr, fq); S.done(cur); }
        if (!has_next) break;
#pragma unroll
        for (int a = 0; a < 2; ++a)
#pragma unroll
            for (int b = 0; b < 2; ++b)
#pragma unroll
                for (int m = 0; m < 4; ++m)
#pragma unroll
                    for (int n = 0; n < 2; ++n) acc[a][b][m][n] = (f32x4){0.f, 0.f, 0.f, 0.f};
        cur = nxt; cA = nA; cB = nB; ++ui;
        if constexpr (ALIGN_EPI) { if (wr == 1) PG8_BAR; }
    }
    PG8_WAIT_V(0);
    if constexpr (!ALIGN_EPI) { if (wr == 0) PG8_BAR; }
    PG8_BAR;
    if constexpr (Epi::AFTER_DRAIN) { E.fused(acc, cur, wr, wc, fr, fq, lds, wid, lane); S.done(cur); }
#undef PG8_SA
#undef PG8_SB
#undef PG8_STAGE
#undef PG8_LDA
#undef PG8_LDB
#undef PG8_MMA
#undef PG8_WAIT_V
#undef PG8_WAIT_L
#undef PG8_BAR
#undef PG8_SCHED
}
}
#endif
enum { ST_PRM = 100, ST_INIT = 0, ST_PB, ST_WT, ST_ROWSS, ST_NORM, ST_RESID, ST_DNPREP, ST_DNSCAN, ST_DNOUT, ST_NASC, ST_NAOUT, ST_LAM, ST_ROPE, ST_DATTN, ST_COUT, ST_FFNACT, ST_PLE };
struct Job { P p; WT w; const float* a; const float* b; long n; int layer; int flag; };
template <int ST> DEVFN void run_item(const Job& j, long g) {
    if constexpr (ST == ST_PRM) st_prm(j.p, j.layer, g);
    else if constexpr (ST == ST_INIT) st_init(j.p, j.layer, g);
    else if constexpr (ST == ST_PB) st_pb(j.p, j.layer, g);
    else if constexpr (ST == ST_WT) st_wt(j.w, g);
    else if constexpr (ST == ST_ROWSS) st_rowss(j.p, j.a, g);
    else if constexpr (ST == ST_NORM) st_norm_bf16(j.p, j.a, g);
    else if constexpr (ST == ST_RESID) st_resid(j.p, j.a, j.b, j.flag, g);
    else if constexpr (ST == ST_DNPREP) st_dn_prep(j.p, j.layer, g);
    else if constexpr (ST == ST_DNSCAN) st_dn_scan(j.p, j.layer, g);
    else if constexpr (ST == ST_DNOUT) st_dn_out(j.p, j.layer, g);
    else if constexpr (ST == ST_NASC) st_na_scores(j.p, j.layer, g);
    else if constexpr (ST == ST_NAOUT) st_na_out(j.p, j.layer, g);
    else if constexpr (ST == ST_LAM) st_lam(j.p, j.layer, g);
    else if constexpr (ST == ST_ROPE) st_rope(j.p, j.layer, g);
    else if constexpr (ST == ST_DATTN) st_dattn(j.p, j.layer, g);
    else if constexpr (ST == ST_COUT) st_c_out(j.p, j.layer, g);
    else if constexpr (ST == ST_FFNACT) st_ffn_act(j.p, j.layer, g);
    else if constexpr (ST == ST_PLE) st_ple(j.p, j.layer, g);
}
#ifdef EMU
template <int ST> static void run_stage(Job j, long n) {
    j.n = n;
#pragma omp parallel for schedule(dynamic, 64)
    for (long g = 0; g < n; ++g) run_item<ST>(j, g);
}
static void emu_gemm(const bf16* A, const bf16* Bt, int M, int N, int K, bf16* Ob, float* Of, int ldc) {
    std::vector<float> Af((size_t)M * K), Bf((size_t)N * K);
    for (size_t i = 0; i < Af.size(); ++i) Af[i] = bf2f(A[i]);
    for (size_t i = 0; i < Bf.size(); ++i) Bf[i] = bf2f(Bt[i]);
#pragma omp parallel for schedule(dynamic, 8)
    for (int m = 0; m < M; ++m) for (int n = 0; n < N; ++n) { const float* a = &Af[(size_t)m * K]; const float* b = &Bf[(size_t)n * K]; float s = 0.f;
        for (int k = 0; k < K; ++k) s += a[k] * b[k];
        if (Ob) Ob[(size_t)m * ldc + n] = f2bf(s); else Of[(size_t)m * ldc + n] = s; }
}
static void gemm_bf16(const bf16* A, const bf16* Bt, int M, int N, int K, bf16* O, int ldc) { emu_gemm(A, Bt, M, N, K, O, nullptr, ldc); }
static void gemm_f32(const bf16* A, const bf16* Bt, int M, int N, int K, float* O, int ldc) { emu_gemm(A, Bt, M, N, K, nullptr, O, ldc); }

static void forward(const P& p) {
    Job j; memset(&j, 0, sizeof(j)); j.p = p;
    auto wt = [&](const float* W, size_t off, int K, int N, int Npad) { j.w.W = W; j.w.O = WSP(bf16, off); j.w.K = K; j.w.N = N; j.w.Npad = Npad; run_stage<ST_WT>(j, (long)Npad * K); };
    for (int i = 0; i < 2; ++i) {
        wt(p.ab_w_in + (size_t)i * D * ABIN, WS_WABIN + (size_t)i * ABINP * D * 2, D, ABIN, ABINP);
        wt(p.ab_w_out + (size_t)i * ABMIX * D, WS_WABOUT + (size_t)i * D * ABMIX * 2, ABMIX, D, D);
        wt(p.c_w_in + (size_t)i * D * CIN, WS_WCIN + (size_t)i * CIN * D * 2, D, CIN, CIN);
        wt(p.c_w_out + (size_t)i * CV * D, WS_WCOUT + (size_t)i * D * CV * 2, CV, D, D);
    }
    for (int l = 0; l < DEPTH; ++l) {
        wt(p.ffn_w_in + (size_t)l * D * 2 * DFF, WS_WFIN + (size_t)l * 2 * DFF * D * 2, D, 2 * DFF, 2 * DFF);
        wt(p.ffn_w_out + (size_t)l * DFF * D, WS_WFOUT + (size_t)l * D * DFF * 2, DFF, D, D);
        wt(p.ple_w_proj + (size_t)l * PLE * D, WS_WPP + (size_t)l * D * PLE * 2, PLE, D, D);
        wt(p.ple_w_gate + (size_t)l * D * D, WS_WPG + (size_t)l * D * D * 2, D, D, D);
    }
    run_stage<ST_PRM>(j, N_PRM);
    for (int l = 0; l < DEPTH; ++l) { j.layer = l; run_stage<ST_PB>(j, N_PB); }
    run_stage<ST_INIT>(j, N_INIT);
    for (int layer = 0; layer < DEPTH; ++layer) {
        j.layer = layer; const int jj = layer / 2; const float* nw = PRM(PR_NORMS) + (size_t)layer * 4 * D;
        j.a = p.h; run_stage<ST_ROWSS>(j, N_ROWS);
        j.a = nw; run_stage<ST_NORM>(j, N_TD);
        if (layer % 2 == 0) {
            gemm_bf16(WSP(bf16, WS_HN), WSP(bf16, WS_WABIN + (size_t)jj * ABINP * D * 2), T, ABINP, D, WSP(bf16, WS_PROJ), ABINP);
            run_stage<ST_DNPREP>(j, N_TH);
            run_stage<ST_DNSCAN>(j, N_SCAN);
            run_stage<ST_DNOUT>(j, N_TH);
            run_stage<ST_NASC>(j, N_THD);
            run_stage<ST_NAOUT>(j, N_THD);
            gemm_f32(WSP(bf16, WS_MIXIN), WSP(bf16, WS_WABOUT + (size_t)jj * D * ABMIX * 2), T, D, ABMIX, WSP(float, WS_GOUT), D);
        } else {
            gemm_bf16(WSP(bf16, WS_HN), WSP(bf16, WS_WCIN + (size_t)jj * CIN * D * 2), T, CIN, D, WSP(bf16, WS_PROJ), CIN);
            run_stage<ST_LAM>(j, 1);
            run_stage<ST_ROPE>(j, N_ROPE);
            run_stage<ST_DATTN>(j, N_DATT);
            run_stage<ST_COUT>(j, N_TH);
            gemm_f32(WSP(bf16, WS_MIXIN), WSP(bf16, WS_WCOUT + (size_t)jj * D * CV * 2), T, D, CV, WSP(float, WS_GOUT), D);
        }
        j.a = WSP(float, WS_GOUT); run_stage<ST_ROWSS>(j, N_ROWS);
        j.a = WSP(float, WS_GOUT); j.b = nw + D; j.flag = 0; run_stage<ST_RESID>(j, N_TD);
        j.a = p.h; run_stage<ST_ROWSS>(j, N_ROWS);
        j.a = nw + 2 * D; run_stage<ST_NORM>(j, N_TD);
        gemm_bf16(WSP(bf16, WS_HN), WSP(bf16, WS_WFIN + (size_t)layer * 2 * DFF * D * 2), T, 2 * DFF, D, WSP(bf16, WS_HID), 2 * DFF);
        run_stage<ST_FFNACT>(j, N_ACT);
        gemm_f32(WSP(bf16, WS_ACT), WSP(bf16, WS_WFOUT + (size_t)layer * D * DFF * 2), T, D, DFF, WSP(float, WS_GOUT), D);
        j.a = WSP(float, WS_GOUT); run_stage<ST_ROWSS>(j, N_ROWS);
        j.a = WSP(float, WS_GOUT); j.b = nw + 3 * D; j.flag = 1; run_stage<ST_RESID>(j, N_TD);
        gemm_f32(WSP(bf16, WS_HN), WSP(bf16, WS_WPG + (size_t)layer * D * D * 2), T, D, D, WSP(float, WS_GOUT), D);
        gemm_f32(WSP(bf16, WS_PB + (size_t)layer * SZ_PB), WSP(bf16, WS_WPP + (size_t)layer * D * PLE * 2), T, D, PLE, WSP(float, WS_GOUT2), D);
        run_stage<ST_PLE>(j, N_TD);
    }
}
#endif

#ifndef EMU
namespace att {
using bf16x8 = __attribute__((ext_vector_type(8))) short;
using s16x4  = __attribute__((ext_vector_type(4))) short;
using f32x16 = __attribute__((ext_vector_type(16))) float;
using u32x4  = __attribute__((ext_vector_type(4))) unsigned;
constexpr int DA = 128, NW = 8, QBLK = 32, KVBLK = 64;
constexpr float SCALE = 0.088388347648318440f;
constexpr float THR = 8.f;
constexpr size_t SHM_V = KVBLK * DA * 2, SHM_K = KVBLK * DA * 2, SHM_ATTN = 2 * SHM_V + 2 * SHM_K + NW * 64 * 4;
#define KSWZ(row, colB) ((row) * 256 + ((colB) ^ (((row) & 15) << 4)))
#define SBAR() __builtin_amdgcn_sched_barrier(0)
__device__ __forceinline__ int crow(int r, int hi) { return (r & 3) + 8 * (r >> 2) + 4 * hi; }
__device__ __forceinline__ unsigned cvtpk(float lo, float hi) { unsigned r; asm volatile("v_cvt_pk_bf16_f32 %0, %1, %2" : "=v"(r) : "v"(lo), "v"(hi)); return r; }
__device__ __forceinline__ bf16x8 ld8(const bf16* p) { return *reinterpret_cast<const bf16x8*>(p); }
__device__ __forceinline__ void partialSM(f32x16& p0, f32x16& p1, float& m_reg, float& mn, float& alpha) {
  constexpr float C = SCALE * 1.4426950408889634f;
  float pmax = p0[0]; for (int r = 1; r < 16; ++r) pmax = fmaxf(pmax, p0[r]); for (int r = 0; r < 16; ++r) pmax = fmaxf(pmax, p1[r]);
  { auto rr = __builtin_amdgcn_permlane32_swap(__float_as_uint(pmax), __float_as_uint(pmax), false, false);
    pmax = fmaxf(__uint_as_float(rr[0]), __uint_as_float(rr[1])); }
  if (__builtin_expect(__all(pmax - m_reg <= THR / SCALE), 1)) { mn = m_reg; alpha = 1.f; }
  else { mn = fmaxf(m_reg, pmax); alpha = __builtin_amdgcn_exp2f((m_reg - mn) * C); m_reg = mn; }
  float mnC = -mn * C;
  for (int r = 0; r < 16; ++r) p0[r] = fmaf(p0[r], C, mnC); for (int r = 0; r < 16; ++r) p1[r] = fmaf(p1[r], C, mnC);
  for (int r = 0; r < 16; ++r) p0[r] = __builtin_amdgcn_exp2f(p0[r]);
}
__device__ __forceinline__ void finishSM(f32x16& p0, f32x16& p1, float alpha, float& l_reg, bf16x8& pa0, bf16x8& pa1, bf16x8& pa2, bf16x8& pa3) {
  for (int r = 0; r < 16; ++r) p1[r] = __builtin_amdgcn_exp2f(p1[r]);
  float ps = 0; for (int r = 0; r < 16; ++r) ps += p0[r]; for (int r = 0; r < 16; ++r) ps += p1[r];
  { auto rr = __builtin_amdgcn_permlane32_swap(__float_as_uint(ps), __float_as_uint(ps), false, false);
    ps = __uint_as_float(rr[0]) + __uint_as_float(rr[1]); }
  l_reg = l_reg * alpha + ps;
#define PK4(P, BASE, OUT) do { unsigned a0 = cvtpk(P[BASE + 0], P[BASE + 1]), a1 = cvtpk(P[BASE + 2], P[BASE + 3]);   \
    unsigned b0 = cvtpk(P[BASE + 4], P[BASE + 5]), b1 = cvtpk(P[BASE + 6], P[BASE + 7]);                              \
    auto r0 = __builtin_amdgcn_permlane32_swap(a0, b0, false, false); auto r1 = __builtin_amdgcn_permlane32_swap(a1, b1, false, false); \
    u32x4 w = {r0[0], r1[0], r0[1], r1[1]}; OUT = *reinterpret_cast<bf16x8*>(&w); } while (0)
  PK4(p0, 0, pa0); PK4(p0, 8, pa1); PK4(p1, 0, pa2); PK4(p1, 8, pa3);
#undef PK4
}
__device__ __forceinline__ void qkt(f32x16& p0, f32x16& p1, const bf16* Ks, const bf16x8* qr, int r32, int hi) {
  p0 = f32x16{}; p1 = f32x16{};
  for (int d0 = 0; d0 < 8; ++d0) { int cb = (d0 * 16 + hi * 8) * 2;
    bf16x8 b0 = *reinterpret_cast<const bf16x8*>((const char*)Ks + KSWZ(r32, cb));
    bf16x8 b1 = *reinterpret_cast<const bf16x8*>((const char*)Ks + KSWZ(32 + r32, cb));
    p0 = __builtin_amdgcn_mfma_f32_32x32x16_bf16(b0, qr[d0], p0, 0, 0, 0);
    p1 = __builtin_amdgcn_mfma_f32_32x32x16_bf16(b1, qr[d0], p1, 0, 0, 0); }
}
__device__ __forceinline__ int v_st(int k, int c) { const int kk = (k & ~0xC) | ((k & 4) << 1) | ((k & 8) >> 1); return ((kk >> 3) * 4 + (c >> 5)) * 512 + ((kk & 7) * 32 + (c & 31)) * 2; }
__device__ __forceinline__ int v_rd_base(int lane) { return ((lane & 3) << 3) | (((lane >> 2) & 3) << 6) | (((lane >> 4) & 1) << 5) | (((lane >> 5) & 1) << 8); }
constexpr int v_rd_off(int d0, int ks, int half) { return d0 * 512 + ks * 4096 + half * 2048; }
template <int OFF> __device__ __forceinline__ s16x4 tr_read(int vb) {
  s16x4 r; asm volatile("ds_read_b64_tr_b16 %0, %1 offset:%2" : "=&v"(r) : "v"(vb), "i"(OFF) : "memory"); return r;
}
template <int D0> __device__ __forceinline__ void pv_one(f32x16& od, int vb, bf16x8 pa0, bf16x8 pa1, bf16x8 pa2, bf16x8 pa3) {
  const s16x4 l0 = tr_read<v_rd_off(D0, 0, 0)>(vb), h0 = tr_read<v_rd_off(D0, 0, 1)>(vb), l1 = tr_read<v_rd_off(D0, 1, 0)>(vb), h1 = tr_read<v_rd_off(D0, 1, 1)>(vb);
  const s16x4 l2 = tr_read<v_rd_off(D0, 2, 0)>(vb), h2 = tr_read<v_rd_off(D0, 2, 1)>(vb), l3 = tr_read<v_rd_off(D0, 3, 0)>(vb), h3 = tr_read<v_rd_off(D0, 3, 1)>(vb);
  asm volatile("s_waitcnt lgkmcnt(0)" ::: "memory"); SBAR();
#define PK(L, H) (bf16x8){L[0], L[1], L[2], L[3], H[0], H[1], H[2], H[3]}
  od = __builtin_amdgcn_mfma_f32_32x32x16_bf16(pa0, PK(l0, h0), od, 0, 0, 0);
  od = __builtin_amdgcn_mfma_f32_32x32x16_bf16(pa1, PK(l1, h1), od, 0, 0, 0);
  od = __builtin_amdgcn_mfma_f32_32x32x16_bf16(pa2, PK(l2, h2), od, 0, 0, 0);
  od = __builtin_amdgcn_mfma_f32_32x32x16_bf16(pa3, PK(l3, h3), od, 0, 0, 0);
#undef PK
}
__device__ __forceinline__ void pv_d0(f32x16* o, int vb, bf16x8 pa0, bf16x8 pa1, bf16x8 pa2, bf16x8 pa3) {
  pv_one<0>(o[0], vb, pa0, pa1, pa2, pa3); pv_one<1>(o[1], vb, pa0, pa1, pa2, pa3); pv_one<2>(o[2], vb, pa0, pa1, pa2, pa3); pv_one<3>(o[3], vb, pa0, pa1, pa2, pa3);
}
struct NaInfo { int rq0, kr0; const float* tab; };
__device__ __forceinline__ void na_mask(f32x16& p0, f32x16& p1, int rk, int rq, int rs, int cq, int cs, int hi, const float* tab) {
  const bool rowok = (rk >= rs) && (rk < rs + NAR);
  int dr = rk - rq + NAR - 1; dr = dr < 0 ? 0 : (dr > 2 * NAR - 2 ? 2 * NAR - 2 : dr);
  const float* trow = tab + dr * (2 * NAC - 1); const float ninf = -__builtin_inff();
#pragma unroll
  for (int r = 0; r < 16; ++r) { const int ck = crow(r, hi); int dc = ck - cq + NAC - 1; dc = dc < 0 ? 0 : (dc > 2 * NAC - 2 ? 2 * NAC - 2 : dc);
    const bool ok = rowok && ck >= cs && ck < cs + NAC; const float b = trow[dc]; p0[r] = ok ? p0[r] + b : ninf; }
#pragma unroll
  for (int r = 0; r < 16; ++r) { const int ck = 32 + crow(r, hi); int dc = ck - cq + NAC - 1; dc = dc < 0 ? 0 : (dc > 2 * NAC - 2 ? 2 * NAC - 2 : dc);
    const bool ok = rowok && ck >= cs && ck < cs + NAC; const float b = trow[dc]; p1[r] = ok ? p1[r] + b : ninf; }
}
template <int LDQ, int LDK, int LDO, int MODE>
__device__ __forceinline__ void attn_dense_body(const bf16* __restrict__ Qb, const bf16* __restrict__ Kh, const bf16* __restrict__ Vh, void* __restrict__ Ob_, int seq, char* lds, NaInfo na, int tid_in) {
  constexpr int SDEPTH = 2;
  int tid_ = tid_in; asm volatile("" : "+v"(tid_));
  const int tid = tid_, wid = tid >> 6, lane = tid & 63, r32 = lane & 31, hi = lane >> 5;
  const int na_rq = na.rq0 + (wid >> 1), na_cq = (wid & 1) * 32 + r32, na_rs = clampi(na_rq - WR / 2, 0, ROWS - WR), na_cs = clampi(na_cq - NAC / 2, 0, GW - NAC);
#define NAMASK(P0, P1, jt) do { if constexpr (MODE == 1) na_mask(P0, P1, na.kr0 + (jt), na_rq, na_rs, na_cq, na_cs, hi, na.tab); } while (0)
  bf16* V_lds = (bf16*)lds; bf16* K_lds = (bf16*)(lds + 2 * SHM_V);
  float* ws = (float*)(lds + 2 * SHM_V + 2 * SHM_K) + wid * 64; float* li_l = ws; float* al_l = ws + 32;
  float m_reg = -1e30f, l_reg = 0; f32x16 o[4] = {}; bf16x8 qr[8];
  const bf16* Qw = Qb + (long)(wid * QBLK + r32) * LDQ + hi * 8;
#pragma unroll
  for (int d0 = 0; d0 < 8; ++d0) qr[d0] = ld8(Qw + d0 * 16);
  const int sr = tid >> 4, sc = (tid & 15) * 8, vst0 = v_st(sr, sc), vst1 = v_st(32 + sr, sc);
  const int vb0 = (int)(uintptr_t)V_lds + v_rd_base(lane);
  struct { bf16x8 vs0, vs1, ks0, ks1; } sr_[SDEPTH];
#define SLOAD(i, k0) do { sr_[i].vs0 = ld8(&Vh[(long)((k0) + sr) * LDK + sc]); sr_[i].vs1 = ld8(&Vh[(long)((k0) + 32 + sr) * LDK + sc]); \
    sr_[i].ks0 = ld8(&Kh[(long)((k0) + sr) * LDK + sc]); sr_[i].ks1 = ld8(&Kh[(long)((k0) + 32 + sr) * LDK + sc]); } while (0)
#define SWRITE(b, i) do { *(bf16x8*)((char*)V_lds + (b) * SHM_V + vst0) = sr_[i].vs0;          \
    *(bf16x8*)((char*)V_lds + (b) * SHM_V + vst1) = sr_[i].vs1; int kc = sc * 2;               \
    *(bf16x8*)((char*)K_lds + (b) * SHM_K + KSWZ(sr, kc)) = sr_[i].ks0;                       \
    *(bf16x8*)((char*)K_lds + (b) * SHM_K + KSWZ(32 + sr, kc)) = sr_[i].ks1; } while (0)
#define SWAIT() asm volatile("s_waitcnt vmcnt(4)" ::: "memory")
#define RESC(a) do { if (__any((a) < 1.f)) { if (hi == 0) al_l[r32] = (a); asm volatile("s_waitcnt lgkmcnt(0)" ::: "memory"); \
    for (int d = 0; d < 4; ++d) for (int r = 0; r < 16; ++r) o[d][r] *= al_l[crow(r, hi)]; } } while (0)
  f32x16 pA0, pA1, pB0, pB1; float mnA, mnB, alA, alB; bf16x8 pa0, pa1, pa2, pa3; const int NT = seq / KVBLK;
  constexpr int SE = 0, SO = SDEPTH - 1;
  SLOAD(SE, 0); asm volatile("s_waitcnt vmcnt(0)" ::: "memory"); SWRITE(0, SE); __syncthreads();
  qkt(pA0, pA1, K_lds, qr, r32, hi); NAMASK(pA0, pA1, 0); partialSM(pA0, pA1, m_reg, mnA, alA);
  SLOAD(SO, KVBLK); if (2 < NT) SLOAD(SE, 2 * KVBLK);
  SWAIT(); SWRITE(1, SO); __syncthreads();
  for (int j = 1; j + 1 < NT; j += 2) {
    SBAR(); qkt(pB0, pB1, (bf16*)((char*)K_lds + SHM_K), qr, r32, hi); NAMASK(pB0, pB1, j);
    finishSM(pA0, pA1, alA, l_reg, pa0, pa1, pa2, pa3); SBAR();
    SLOAD(SO, (j + SDEPTH) * KVBLK); SBAR();
    pv_d0(o, vb0, pa0, pa1, pa2, pa3); partialSM(pB0, pB1, m_reg, mnB, alB);
    __syncthreads(); SWAIT(); SWRITE(0, SE);
    RESC(alB); __syncthreads();
    SBAR(); qkt(pA0, pA1, K_lds, qr, r32, hi); NAMASK(pA0, pA1, j + 1);
    finishSM(pB0, pB1, alB, l_reg, pa0, pa1, pa2, pa3); SBAR();
    if (j + 3 < NT) SLOAD(SE, (j + 1 + SDEPTH) * KVBLK); SBAR();
    pv_d0(o, vb0 + (int)SHM_V, pa0, pa1, pa2, pa3); partialSM(pA0, pA1, m_reg, mnA, alA);
    __syncthreads(); SWAIT(); SWRITE(1, SO);
    RESC(alA); __syncthreads();
  }
  SBAR(); qkt(pB0, pB1, (bf16*)((char*)K_lds + SHM_K), qr, r32, hi); NAMASK(pB0, pB1, NT - 1);
  finishSM(pA0, pA1, alA, l_reg, pa0, pa1, pa2, pa3); SBAR();
  pv_d0(o, vb0, pa0, pa1, pa2, pa3); partialSM(pB0, pB1, m_reg, mnB, alB);
  __syncthreads(); RESC(alB);
  finishSM(pB0, pB1, alB, l_reg, pa0, pa1, pa2, pa3); SBAR();
  pv_d0(o, vb0 + (int)SHM_V, pa0, pa1, pa2, pa3);
  if (hi == 0) li_l[r32] = l_reg; asm volatile("s_waitcnt lgkmcnt(0)" ::: "memory");
  float rli[16];
#pragma unroll
  for (int r = 0; r < 16; ++r) rli[r] = __builtin_amdgcn_rcpf(li_l[crow(r, hi)]);
  if constexpr (MODE == 2) { float* Ow = (float*)Ob_ + (long)(wid * QBLK) * LDO;
#pragma unroll
    for (int r = 0; r < 16; ++r) { int orow = crow(r, hi);
      for (int d0 = 0; d0 < 4; ++d0) Ow[(long)orow * LDO + d0 * 32 + r32] = o[d0][r] * rli[r]; }
  } else { bf16* Ow = (bf16*)Ob_ + (long)(wid * QBLK) * LDO;
#pragma unroll
    for (int r = 0; r < 16; ++r) { int orow = crow(r, hi);
      for (int d0 = 0; d0 < 4; ++d0) Ow[(long)orow * LDO + d0 * 32 + r32] = f2bf(o[d0][r] * rli[r]); } }
#undef NAMASK
#undef SLOAD
#undef SWRITE
#undef SWAIT
#undef RESC
}
template <int LDQ, int LDK, int LDO>
__device__ __forceinline__ void na_body(const bf16* __restrict__ Qb, const bf16* __restrict__ Kh, const bf16* __restrict__ Vh, bf16* __restrict__ Ob, int ntiles, char* lds, NaInfo na, int tid_in) {
  int tid_ = tid_in; asm volatile("" : "+v"(tid_));
  const int tid = tid_, wid = tid >> 6, lane = tid & 63, r32 = lane & 31, hi = lane >> 5;
  const int na_rq = na.rq0 + (wid >> 1), na_cq = (wid & 1) * 32 + r32, na_rs = clampi(na_rq - WR / 2, 0, ROWS - WR), na_cs = clampi(na_cq - NAC / 2, 0, GW - NAC);
  bf16* V_lds = (bf16*)lds; bf16* K_lds = (bf16*)(lds + 2 * SHM_V);
  float* ws = (float*)(lds + 2 * SHM_V + 2 * SHM_K) + wid * 64; float* li_l = ws; float* al_l = ws + 32;
  float m_reg = -1e30f, l_reg = 0; f32x16 o[4] = {}; bf16x8 qr[8];
  const bf16* Qw = Qb + (long)(wid * QBLK + r32) * LDQ + hi * 8;
#pragma unroll
  for (int d0 = 0; d0 < 8; ++d0) qr[d0] = ld8(Qw + d0 * 16);
  const int sr = tid >> 4, sc = (tid & 15) * 8, vst0 = v_st(sr, sc), vst1 = v_st(32 + sr, sc);
  const int vb0 = (int)(uintptr_t)V_lds + v_rd_base(lane);
  bf16x8 vs0 = ld8(&Vh[(long)sr * LDK + sc]), vs1 = ld8(&Vh[(long)(32 + sr) * LDK + sc]), ks0 = ld8(&Kh[(long)sr * LDK + sc]), ks1 = ld8(&Kh[(long)(32 + sr) * LDK + sc]);
  for (int jt = 0; jt < ntiles; ++jt) {
    __syncthreads();
    *(bf16x8*)((char*)V_lds + vst0) = vs0; *(bf16x8*)((char*)V_lds + vst1) = vs1;
    *(bf16x8*)((char*)K_lds + KSWZ(sr, sc * 2)) = ks0; *(bf16x8*)((char*)K_lds + KSWZ(32 + sr, sc * 2)) = ks1;
    __syncthreads();
    if (jt + 1 < ntiles) { const int k0 = (jt + 1) * KVBLK;
      vs0 = ld8(&Vh[(long)(k0 + sr) * LDK + sc]); vs1 = ld8(&Vh[(long)(k0 + 32 + sr) * LDK + sc]); ks0 = ld8(&Kh[(long)(k0 + sr) * LDK + sc]); ks1 = ld8(&Kh[(long)(k0 + 32 + sr) * LDK + sc]); }
    f32x16 p0, p1; float mn, al; bf16x8 pa0, pa1, pa2, pa3;
    qkt(p0, p1, K_lds, qr, r32, hi);
    na_mask(p0, p1, na.kr0 + jt, na_rq, na_rs, na_cq, na_cs, hi, na.tab);
    partialSM(p0, p1, m_reg, mn, al);
    if (__any(al < 1.f)) { if (hi == 0) al_l[r32] = al; asm volatile("s_waitcnt lgkmcnt(0)" ::: "memory");
      for (int d = 0; d < 4; ++d) for (int r = 0; r < 16; ++r) o[d][r] *= al_l[crow(r, hi)]; }
    finishSM(p0, p1, al, l_reg, pa0, pa1, pa2, pa3); SBAR();
    pv_d0(o, vb0, pa0, pa1, pa2, pa3);
  }
  if (hi == 0) li_l[r32] = l_reg; asm volatile("s_waitcnt lgkmcnt(0)" ::: "memory");
  float rli[16];
#pragma unroll
  for (int r = 0; r < 16; ++r) rli[r] = __builtin_amdgcn_rcpf(li_l[crow(r, hi)]);
  bf16* Ow = Ob + (long)(wid * QBLK) * LDO;
#pragma unroll
  for (int r = 0; r < 16; ++r) { int orow = crow(r, hi);
    for (int d0 = 0; d0 < 4; ++d0) Ow[(long)orow * LDO + d0 * 32 + r32] = f2bf(o[d0][r] * rli[r]); }
}
template <int LDQ, int LDK, int LDO>
__device__ __forceinline__ void dattn256_body(const bf16* __restrict__ Qb, const bf16* __restrict__ Kh, const bf16* __restrict__ Vh, bf16* Ob, int ntiles, char* lds, int tid_in,
                                              int mode = 0, bf16* Mx = nullptr, float lam = 0.f, float scale = 0.f, const float* sw = nullptr) {
  typedef __attribute__((address_space(3))) unsigned lds_u32;
  int tid_ = tid_in; asm volatile("" : "+v"(tid_));
  const int tid = tid_, wid = __builtin_amdgcn_readfirstlane(tid >> 6), lane = tid & 63, r32 = lane & 31, hi = lane >> 5;
  constexpr int VB = 2 * (int)SHM_V, KB = (int)SHM_K;
  char* V_lds = lds; char* K_lds = lds + 2 * VB;
  float* ws = (float*)(lds + 2 * VB + 2 * KB) + wid * 64; float* li_l = ws; float* al_l = ws + 32;
  float m_reg = -1e30f, l_reg = 0; f32x16 o[8] = {}; bf16x8 qr[8];
  const bf16* Qw = Qb + (long)(wid * QBLK + r32) * LDQ + hi * 8;
#pragma unroll
  for (int d0 = 0; d0 < 8; ++d0) qr[d0] = ld8(Qw + d0 * 16);
  unsigned koff[2], voff[2];
#pragma unroll
  for (int i = 0; i < 2; ++i) { const int kp = 2 * wid + i; const int row = 4 * kp + (lane >> 4), c = (lane & 15) ^ (row & 15); koff[i] = (unsigned)(row * LDK + c * 8);
    const int st = 2 * kp + (lane >> 5), within = lane & 31, kk = (st >> 2) * 8 + (within >> 2), k = (kk & ~0xC) | ((kk & 4) << 1) | ((kk & 8) >> 1); voff[i] = (unsigned)(k * LDK + (st & 3) * 32 + (within & 3) * 8); }
  const int vbase = (int)(uintptr_t)V_lds + v_rd_base(lane);
#define DA_DMA(t, b) do { const bf16* kt_ = Kh + (long)(t) * KVBLK * LDK; const bf16* vt_ = Vh + (long)(t) * KVBLK * LDK; \
      _Pragma("unroll") for (int i = 0; i < 2; ++i) { \
        __builtin_amdgcn_global_load_lds((const unsigned*)(kt_ + koff[i]), (lds_u32*)(K_lds + (b) * KB + (2 * wid + i) * 1024), 16, 0, 0); \
        __builtin_amdgcn_global_load_lds((const unsigned*)(vt_ + voff[i]), (lds_u32*)(V_lds + (b) * VB + (2 * wid + i) * 1024), 16, 0, 0); \
        __builtin_amdgcn_global_load_lds((const unsigned*)(vt_ + voff[i] + 128), (lds_u32*)(V_lds + (b) * VB + (int)SHM_V + (2 * wid + i) * 1024), 16, 0, 0); } } while (0)
  __syncthreads();
  DA_DMA(0, 0);
  for (int jt = 0; jt < ntiles; ++jt) {
    const int b = jt & 1;
    asm volatile("s_waitcnt vmcnt(0)" ::: "memory");
    __syncthreads();
    if (jt + 1 < ntiles) DA_DMA(jt + 1, b ^ 1);
    const char* Kb = K_lds + b * KB;
    f32x16 p0, p1; float mn, al; bf16x8 pa0, pa1, pa2, pa3;
    p0 = f32x16{}; p1 = f32x16{};
#pragma unroll
    for (int d0 = 0; d0 < 8; ++d0) { const int cb = (d0 * 16 + hi * 8) * 2;
      const bf16x8 b0 = *reinterpret_cast<const bf16x8*>(Kb + KSWZ(r32, cb)), b1 = *reinterpret_cast<const bf16x8*>(Kb + KSWZ(32 + r32, cb));
      p0 = __builtin_amdgcn_mfma_f32_32x32x16_bf16(b0, qr[d0], p0, 0, 0, 0); p1 = __builtin_amdgcn_mfma_f32_32x32x16_bf16(b1, qr[d0], p1, 0, 0, 0); }
    partialSM(p0, p1, m_reg, mn, al);
    if (__any(al < 1.f)) { if (hi == 0) al_l[r32] = al; asm volatile("s_waitcnt lgkmcnt(0)" ::: "memory");
      for (int d = 0; d < 8; ++d) for (int r = 0; r < 16; ++r) o[d][r] *= al_l[crow(r, hi)]; }
    finishSM(p0, p1, al, l_reg, pa0, pa1, pa2, pa3); SBAR();
    pv_d0(o, vbase + b * VB, pa0, pa1, pa2, pa3);
    pv_d0(o + 4, vbase + b * VB + (int)SHM_V, pa0, pa1, pa2, pa3);
  }
#undef DA_DMA
  if (hi == 0) li_l[r32] = l_reg; asm volatile("s_waitcnt lgkmcnt(0)" ::: "memory");
  float rli[16];
#pragma unroll
  for (int r = 0; r < 16; ++r) rli[r] = __builtin_amdgcn_rcpf(li_l[crow(r, hi)]);
  bf16* Ow = Ob + (long)(wid * QBLK) * LDO;
  if (mode == 0) {
#pragma unroll
    for (int r = 0; r < 16; ++r) { int orow = crow(r, hi);
      for (int d0 = 0; d0 < 8; ++d0) Ow[(long)orow * LDO + d0 * 32 + r32] = f2bf(o[d0][r] * rli[r]); }
  } else {
    bf16* Mw = Mx + (long)(wid * QBLK) * LDO;
    float swv[8];
#pragma unroll
    for (int d0 = 0; d0 < 8; ++d0) swv[d0] = sw[d0 * 32 + r32] * scale;
#pragma unroll
    for (int r = 0; r < 16; ++r) { const int orow = crow(r, hi); float ss = 0.f; const float nl = -lam * rli[r];
#pragma unroll
      for (int d0 = 0; d0 < 8; ++d0) { const float x = bf2f(Ow[(long)orow * LDO + d0 * 32 + r32]) + nl * o[d0][r]; o[d0][r] = x; ss += x * x; }
      ss += __shfl_xor(ss, 1); ss += __shfl_xor(ss, 2); ss += __shfl_xor(ss, 4); ss += __shfl_xor(ss, 8); ss += __shfl_xor(ss, 16);
      const float rs = 1.0f / sqrtf(ss * (1.0f / 256.0f) + RMS_EPS);
#pragma unroll
      for (int d0 = 0; d0 < 8; ++d0) Mw[(long)orow * LDO + d0 * 32 + r32] = f2bf(o[d0][r] * rs * swv[d0]); }
  }
}
}
namespace dn {
using bf16x8 = __attribute__((ext_vector_type(8))) short;
using f32x4v = __attribute__((ext_vector_type(4))) float;
using f32x2v = __attribute__((ext_vector_type(2))) float;
using bf16x2v = __attribute__((ext_vector_type(2))) __bf16;
using u32x4 = __attribute__((ext_vector_type(4))) unsigned;
constexpr int KP = 136;
constexpr int L_K = 0, L_Q = 17408, L_V = 34816, L_AKK = 67584, L_AQK = 84224, L_L0 = 100864, L_L1 = 117248, L_SM = 133632, L_DB = 135680, L_END = 143872;
__device__ __forceinline__ unsigned pk(float lo, float hi) { const f32x2v v = {lo, hi}; return __builtin_bit_cast(unsigned, __builtin_convertvector(v, bf16x2v)); }
__device__ __forceinline__ bf16x8 pack8(f32x4v a, f32x4v b) { u32x4 w = {pk(a[0], a[1]), pk(a[2], a[3]), pk(b[0], b[1]), pk(b[2], b[3])}; return __builtin_bit_cast(bf16x8, w); }
__device__ __forceinline__ int kperm(int s, int q, int j) { return 32 * s + 16 * (j >> 2) + 4 * q + (j & 3); }
#define MFMA16(a, b, c) __builtin_amdgcn_mfma_f32_16x16x32_bf16((a), (b), (c), 0, 0, 0)

__device__ __forceinline__ float fexp(float x) { return __builtin_amdgcn_exp2f(x * 1.4426950408889634f); }
__device__ __forceinline__ float fsilu(float x) { return x * __builtin_amdgcn_rcpf(1.0f + fexp(-x)); }
template <int C> __device__ __forceinline__ float dpp_bc(int v) { return __int_as_float(__builtin_amdgcn_update_dpp(0, v, C, 0xf, 0xf, false)); }
template <int I, int J> __device__ __forceinline__ void inv16_terms(float& r, int lk, const float (&x)[16]) {
    if constexpr (J < I) { r -= dpp_bc<0x150 + J>(lk) * x[J]; inv16_terms<I, J + 1>(r, lk, x); }
}
template <int I> __device__ __forceinline__ void inv16_rows(float (&x)[16], const float* Lbb, int c) {
    if constexpr (I < 16) { float r = (I == c) ? 1.f : 0.f; const int lk = __float_as_int(Lbb[I * 64 + c]); inv16_terms<I, 0>(r, lk, x); x[I] = r; inv16_rows<I + 1>(x, Lbb, c); }
}
__device__ __forceinline__ void dn1_unit(const P& p, int jl, int seq, int hh, int chunk, char* lds, int tid_in) {
    int tid_ = tid_in; asm volatile("" : "+v"(tid_));
    const int tid = tid_, lane = tid & 63, wave = tid >> 6;
    bf16* Kl = (bf16*)(lds + L_K); bf16* Ql = (bf16*)(lds + L_Q); float* Vl = (float*)(lds + L_V); float* AKK = (float*)(lds + L_AKK); float* AQK = (float*)(lds + L_AQK);
    float* L0 = (float*)(lds + L_L0); float* L1 = (float*)(lds + L_L1); float* g_l = (float*)(lds + L_SM); float* beta_l = g_l + 128; float* gc_l = g_l + 256; float* bk_l = g_l + 384;
    const int tt0 = chunk * 64; const long tb = (long)seq * S; const bf16* PROJ = WSP(bf16, WS_PROJ);
    const size_t unit = ((size_t)(seq * NH + hh) * (S / 64) + chunk);
    if (tid < 384) {
        const int cgi = tid & 15, part = (tid >> 4) % 3, oct = tid / 48, i0 = 8 * oct; const int coff = part * 1024 + hh * DH + 8 * cgi;
        bf16x8 x[12]; float w[5][8];
#pragma unroll
        for (int k = 0; k < 12; ++k) { const int ts = tt0 + i0 + k - 2; x[k] = (ts >= 0 && ts < S) ? *(const bf16x8*)(PROJ + (size_t)(tb + ts) * ABINP + coff) : (bf16x8){0, 0, 0, 0, 0, 0, 0, 0}; }
#pragma unroll
        for (int tap = 0; tap < 5; ++tap) { const float* cw = PRM(PR_ABCONV) + (size_t)(jl * 5 + tap) * AQKV + coff; const f32x4v a = *(const f32x4v*)cw, b = *(const f32x4v*)(cw + 4);
#pragma unroll
            for (int e = 0; e < 4; ++e) { w[tap][e] = a[e]; w[tap][4 + e] = b[e]; } }
#pragma unroll
        for (int kk = 0; kk < 8; ++kk) { float y[8]; float ss = 0.f;
#pragma unroll
            for (int c = 0; c < 8; ++c) { float acc = 0.f;
#pragma unroll
                for (int tap = 0; tap < 5; ++tap) acc += bf2f((bf16)x[kk + tap][c]) * w[tap][c];
                y[c] = fsilu(acc); ss += y[c] * y[c]; }
            ss += __shfl_xor(ss, 1); ss += __shfl_xor(ss, 2); ss += __shfl_xor(ss, 4); ss += __shfl_xor(ss, 8);
            const float rn = 1.0f / sqrtf(ss + 1e-6f); const float sc_ = part == 0 ? rn * 0.08838834764831845f : (part == 1 ? rn : 1.0f); const int i = i0 + kk;
            if (part < 2) { u32x4 wv; wv[0] = pk(y[0] * sc_, y[1] * sc_); wv[1] = pk(y[2] * sc_, y[3] * sc_); wv[2] = pk(y[4] * sc_, y[5] * sc_); wv[3] = pk(y[6] * sc_, y[7] * sc_);
                *(u32x4*)((part ? Kl : Ql) + i * KP + 8 * cgi) = wv; }
            else { *(f32x4v*)(Vl + i * 128 + 8 * cgi) = (f32x4v){y[0], y[1], y[2], y[3]}; *(f32x4v*)(Vl + i * 128 + 8 * cgi + 4) = (f32x4v){y[4], y[5], y[6], y[7]}; } }
    } else { const int gt = tid - 384; const int dir = gt >> 6, il = gt & 63, ti = dir ? 63 - il : il; const bf16* gr = PROJ + (size_t)(tb + tt0 + ti) * ABINP + COL_G;
        const float graw = bf2f(gr[dir * NH + hh]), braw = bf2f(gr[16 + dir * NH + hh]);
        const float a = expf(PRM(PR_ALOG)[(jl * 2 + dir) * NH + hh]), dtb = PRM(PR_DTB)[(jl * 2 + dir) * NH + hh];
        g_l[dir * 64 + il] = -a * softplusf(graw + dtb); beta_l[dir * 64 + il] = sigmoidf(braw); }
    __syncthreads();
    if (wave < 2) { const int dir = wave; float c = g_l[dir * 64 + lane];
#pragma unroll
        for (int o = 1; o < 64; o <<= 1) { const float t = __shfl_up(c, o); if (lane >= o) c += t; }
        gc_l[dir * 64 + lane] = c; bk_l[dir * 64 + lane] = beta_l[dir * 64 + lane] * fexp(c); }
    {
        const int r = lane & 15, q = lane >> 4;
#pragma unroll
        for (int tt = 0; tt < 2; ++tt) { const int tile = 2 * wave + tt, ti_ = tile >> 2, tj_ = tile & 3; f32x4v ck = {0.f, 0.f, 0.f, 0.f}, cq = {0.f, 0.f, 0.f, 0.f};
#pragma unroll
            for (int s = 0; s < 4; ++s) { const bf16x8 ak = *(const bf16x8*)(Kl + (16 * ti_ + r) * KP + 32 * s + 8 * q), aq = *(const bf16x8*)(Ql + (16 * ti_ + r) * KP + 32 * s + 8 * q), b = *(const bf16x8*)(Kl + (16 * tj_ + r) * KP + 32 * s + 8 * q);
                ck = MFMA16(ak, b, ck); cq = MFMA16(aq, b, cq); }
#pragma unroll
            for (int rr = 0; rr < 4; ++rr) { AKK[(16 * ti_ + 4 * q + rr) * 65 + 16 * tj_ + r] = ck[rr]; AQK[(16 * ti_ + 4 * q + rr) * 65 + 16 * tj_ + r] = cq[rr]; } }
    }
    __syncthreads();
    for (int e = tid; e < 8192; e += 512) { const int dir = e >> 12, i = (e >> 6) & 63, jx = e & 63; float v = 0.f;
        if (jx < i) { const int ti = dir ? 63 - i : i, tj = dir ? 63 - jx : jx; v = beta_l[dir * 64 + i] * AKK[ti * 65 + tj] * fexp(gc_l[dir * 64 + i] - gc_l[dir * 64 + jx]); }
        (dir ? L1 : L0)[i * 64 + jx] = v; }
#pragma unroll
    for (int dir = 0; dir < 2; ++dir) {
        const size_t ud = unit * 2 + dir; const float* gc = gc_l + dir * 64; const float glast = gc[63];
        {
            const int frag = tid >> 6, mt = frag >> 1, s = frag & 1, i = 16 * mt + (lane & 15), q = lane >> 4, ti = dir ? 63 - i : i; const float gi = gc[i]; float v[8];
#pragma unroll
            for (int jv = 0; jv < 8; ++jv) { const int jx = kperm(s, q, jv); v[jv] = (jx <= i) ? AQK[ti * 65 + (dir ? 63 - jx : jx)] * fexp(gi - gc[jx]) : 0.f; }
            u32x4 w = {pk(v[0], v[1]), pk(v[2], v[3]), pk(v[4], v[5]), pk(v[6], v[7])};
            *(u32x4*)(WSP(bf16, WS_DN_IN) + ((ud * 8 + frag) * 64 + lane) * 8) = w;
        }
#pragma unroll
        for (int rep = 0; rep < 2; ++rep) {
            const int fl = tid + 512 * rep, frag = fl >> 6, q = lane >> 4;
            { const int mt = frag >> 2, s = frag & 3, i = 16 * mt + (lane & 15), ti = dir ? 63 - i : i; const float eg = fexp(gc[i]); float v[8];
#pragma unroll
              for (int jv = 0; jv < 8; ++jv) v[jv] = bf2f(Ql[ti * KP + kperm(s, q, jv)]) * eg;
              u32x4 w = {pk(v[0], v[1]), pk(v[2], v[3]), pk(v[4], v[5]), pk(v[6], v[7])};
              *(u32x4*)(WSP(bf16, WS_DN_QE) + ((ud * 16 + frag) * 64 + lane) * 8) = w; }
            { const int mt = frag >> 1, s = frag & 1, d = 16 * mt + (lane & 15); float v[8];
#pragma unroll
              for (int jv = 0; jv < 8; ++jv) { const int jx = kperm(s, q, jv), tj = dir ? 63 - jx : jx; v[jv] = bf2f(Kl[tj * KP + d]) * fexp(glast - gc[jx]); }
              u32x4 w = {pk(v[0], v[1]), pk(v[2], v[3]), pk(v[4], v[5]), pk(v[6], v[7])};
              *(u32x4*)(WSP(bf16, WS_DN_KD) + ((ud * 16 + frag) * 64 + lane) * 8) = w; }
        }
        if (tid == 0) WSP(float, WS_DN_EG)[ud] = fexp(glast);
    }
    __syncthreads();
    {
        float* DB = (float*)(lds + L_DB);
        if (wave < 2) { const int b = lane >> 4, c = lane & 15; const float* Lbb = (wave ? L1 : L0) + (16 * b) * 64 + 16 * b; float x[16];
            inv16_rows<0>(x, Lbb, c);
#pragma unroll
            for (int i = 0; i < 16; ++i) DB[((wave * 4 + b) * 16 + i) * 16 + c] = x[i]; }
        __syncthreads();
        const int dir = __builtin_amdgcn_readfirstlane(tid >> 8), wq = __builtin_amdgcn_readfirstlane((tid >> 6) & 3); const float* L = dir ? L1 : L0; const size_t ud = unit * 2 + dir;
        const float* bv = beta_l + dir * 64; const float* bk = bk_l + dir * 64; const int m = lane & 15, q = lane >> 4;
        const f32x4v zero4 = {0.f, 0.f, 0.f, 0.f};
        bf16x8 A01[3], A23, Ad[4];
#pragma unroll
        for (int b = 1; b < 4; ++b) { const float* lr = L + (16 * b + m) * 64 + 4 * q; const f32x4v l0 = *(const f32x4v*)lr, l1 = (b >= 2) ? *(const f32x4v*)(lr + 16) : zero4; A01[b - 1] = pack8(-l0, -l1); }
        { const float* lr = L + (48 + m) * 64 + 32 + 4 * q; A23 = pack8(-*(const f32x4v*)lr, zero4); }
#pragma unroll
        for (int b = 0; b < 4; ++b) Ad[b] = pack8(*(const f32x4v*)(DB + ((dir * 4 + b) * 16 + m) * 16 + 4 * q), zero4);
#pragma unroll
        for (int nt4 = 0; nt4 < 4; ++nt4) { const int col = 64 * wq + 16 * nt4 + m; f32x4v X[4];
#pragma unroll
            for (int b = 0; b < 4; ++b) { f32x4v acc;
#pragma unroll
                for (int r = 0; r < 4; ++r) { const int i = 16 * b + 4 * q + r, ti = dir ? 63 - i : i; acc[r] = (wq < 2) ? bv[i] * Vl[ti * 128 + col] : bk[i] * bf2f(Kl[ti * KP + (col - 128)]); }
                if (b >= 1) acc = MFMA16(A01[b - 1], pack8(X[0], b >= 2 ? X[1] : zero4), acc);
                if (b == 3) acc = MFMA16(A23, pack8(X[2], zero4), acc);
                X[b] = MFMA16(Ad[b], pack8(acc, zero4), zero4); }
            if (wq < 2) { float* o = WSP(float, WS_DN_UT) + (ud * 128 + col) * 64 + 4 * q;
#pragma unroll
                for (int b = 0; b < 4; ++b) *(f32x4v*)(o + 16 * b) = X[b];
            } else { const int d = col - 128, s = d >> 5, qd = (d >> 2) & 3, jv = 4 * ((d >> 4) & 1) + (d & 3); bf16* o = (bf16*)(lds + L_AKK) + dir * 16 * 512;
#pragma unroll
                for (int b = 0; b < 4; ++b)
#pragma unroll
                    for (int r = 0; r < 4; ++r) o[((b * 4 + s) * 64 + (4 * q + r) + 16 * qd) * 8 + jv] = f2bf(-X[b][r]); }
        }
    }
    __syncthreads();
    {
        u32x4* dst = (u32x4*)(WSP(bf16, WS_DN_WN) + unit * 2 * 16 * 512); const u32x4* src = (const u32x4*)(lds + L_AKK);
#pragma unroll
        for (int e = 0; e < 4; ++e) dst[tid + 512 * e] = src[tid + 512 * e];
    }
}
constexpr int SC_WN = 0, SC_QE = 16384, SC_IN = 32768, SC_KD = 40960, SC_BUF = 57344;
__device__ __forceinline__ void dn_scan_chain(const P& p, int chain, char* lds, int tid_in) {
    int tid_ = tid_in; asm volatile("" : "+v"(tid_));
    const int tid = tid_, lane = tid & 63, wave = tid >> 6, n = lane & 15, q = lane >> 4, n0 = wave * 16;
    const int dir = chain & 1, sh = chain >> 1, hh = sh % NH, seq = sh / NH;
    f32x4v Sacc[8];
#pragma unroll
    for (int mt = 0; mt < 8; ++mt) Sacc[mt] = (f32x4v){0.f, 0.f, 0.f, 0.f};
    bf16* O = WSP(bf16, dir ? WS_OB : WS_OF);
    u32x4 st0[7], st1[7];
#define SC_UD(step) (((size_t)sh * (S / 64) + (dir ? S / 64 - 1 - (step) : (step))) * 2 + dir)
#define SC_LOAD(st, ud) do { const u32x4* a = (const u32x4*)WSP(bf16, WS_DN_WN) + (ud) * 1024 + tid; const u32x4* b = (const u32x4*)WSP(bf16, WS_DN_QE) + (ud) * 1024 + tid; \
        const u32x4* c = (const u32x4*)WSP(bf16, WS_DN_IN) + (ud) * 512 + tid; const u32x4* d = (const u32x4*)WSP(bf16, WS_DN_KD) + (ud) * 1024 + tid; \
        st[0] = a[0]; st[1] = a[512]; st[2] = b[0]; st[3] = b[512]; st[4] = c[0]; st[5] = d[0]; st[6] = d[512]; } while (0)
#define SC_WRITE(st, buf) do { char* b_ = lds + (buf) * SC_BUF + tid * 16; *(u32x4*)(b_ + SC_WN) = st[0]; *(u32x4*)(b_ + SC_WN + 8192) = st[1]; *(u32x4*)(b_ + SC_QE) = st[2]; *(u32x4*)(b_ + SC_QE + 8192) = st[3]; \
        *(u32x4*)(b_ + SC_IN) = st[4]; *(u32x4*)(b_ + SC_KD) = st[5]; *(u32x4*)(b_ + SC_KD + 8192) = st[6]; } while (0)
    f32x4v ut0[4], ut1[4]; float eg0, eg1;
#define SC_LOADU(ut, egv, ud) do { const float* u_ = WSP(float, WS_DN_UT) + ((ud) * 128 + n0 + n) * 64 + 4 * q; _Pragma("unroll") for (int mt = 0; mt < 4; ++mt) ut[mt] = *(const f32x4v*)(u_ + 16 * mt); egv = WSP(float, WS_DN_EG)[ud]; } while (0)
    { const size_t ud0 = SC_UD(0), ud1 = SC_UD(1), ud2 = SC_UD(2); SC_LOAD(st0, ud0); SC_LOADU(ut0, eg0, ud0); SC_LOAD(st1, ud1); SC_LOADU(ut1, eg1, ud1); SC_WRITE(st0, 0); SC_LOAD(st0, ud2); }
    __syncthreads();
#define SC_STEP(step, stY, utX, egX) do { \
        const int c = dir ? S / 64 - 1 - (step) : (step); \
        if ((step) + 1 < S / 64) SC_WRITE(stY, ((step) + 1) & 1);                                       \
        if ((step) + 3 < S / 64) { const size_t udn = SC_UD((step) + 3); SC_LOAD(stY, udn); } \
        f32x4v vn[4], o[4]; const float eg = egX; \
        _Pragma("unroll") for (int mt = 0; mt < 4; ++mt) { vn[mt] = utX[mt]; o[mt] = (f32x4v){0.f, 0.f, 0.f, 0.f}; } \
        if ((step) + 2 < S / 64) { const size_t udu = SC_UD((step) + 2); SC_LOADU(utX, egX, udu); } \
        const char* fb = lds + ((step) & 1) * SC_BUF + lane * 16; \
        bf16x8 Sb[4]; \
        _Pragma("unroll") for (int s = 0; s < 4; ++s) Sb[s] = pack8(Sacc[2 * s], Sacc[2 * s + 1]); \
        _Pragma("unroll") for (int mt = 0; mt < 4; ++mt) \
            _Pragma("unroll") for (int s = 0; s < 4; ++s) { vn[mt] = MFMA16(*(const bf16x8*)(fb + SC_WN + (mt * 4 + s) * 1024), Sb[s], vn[mt]); o[mt] = MFMA16(*(const bf16x8*)(fb + SC_QE + (mt * 4 + s) * 1024), Sb[s], o[mt]); } \
        bf16x8 Vb[2]; \
        _Pragma("unroll") for (int s = 0; s < 2; ++s) Vb[s] = pack8(vn[2 * s], vn[2 * s + 1]); \
        _Pragma("unroll") for (int mt = 0; mt < 4; ++mt) \
            _Pragma("unroll") for (int s = 0; s < 2; ++s) o[mt] = MFMA16(*(const bf16x8*)(fb + SC_IN + (mt * 2 + s) * 1024), Vb[s], o[mt]); \
        const long tbase = (long)seq * S + (long)c * 64; \
        _Pragma("unroll") for (int mt = 0; mt < 4; ++mt) \
            _Pragma("unroll") for (int r = 0; r < 4; ++r) { const int i = 16 * mt + 4 * q + r, ti = dir ? 63 - i : i; O[((size_t)(tbase + ti) * NH + hh) * DH + n0 + n] = f2bf(o[mt][r]); } \
        _Pragma("unroll") for (int mt = 0; mt < 8; ++mt) { f32x4v a = Sacc[mt] * eg; \
            _Pragma("unroll") for (int s = 0; s < 2; ++s) a = MFMA16(*(const bf16x8*)(fb + SC_KD + (mt * 2 + s) * 1024), Vb[s], a); \
            Sacc[mt] = a; } \
        __syncthreads(); } while (0)
#pragma unroll 1
    SC_STEP(0, st1, ut0, eg0); SC_STEP(1, st0, ut1, eg1);
#pragma unroll 1
    for (int step = 2; step < S / 64; step += 2) { SC_STEP(step, st1, ut0, eg0); SC_STEP(step + 1, st0, ut1, eg1); }
#undef SC_STEP
#undef SC_UD
#undef SC_LOAD
#undef SC_LOADU
#undef SC_WRITE
}
#undef MFMA16
}
constexpr int NWAVES = 8, NTHR = 512;
constexpr int RING_BYTES = 131072, LDSCTL_OFF = 158720, MISC_OFF = LDSCTL_OFF + 320, LDS_BYTES = 159744;
#define LAS __attribute__((address_space(3)))
#define GAS __attribute__((address_space(1)))
typedef unsigned v4u __attribute__((ext_vector_type(4)));
typedef float f32x4 __attribute__((ext_vector_type(4)));
#define LDS_WAIT() asm volatile("s_waitcnt lgkmcnt(0)" ::: "memory")
#define XB_TMO      128
#define XB_XCNT(j)  (256  + 64 * (j))
#define XB_XSUB(j)  (1280 + 64 * (j))
#define XB_XGEN(j)  (2304 + 64 * (j))
#define XB_TOP      3328
#define XB_TOPGEN   3392
#define XCD_BAR_WORDS 3456
#define XB_SPIN_CAP (1u << 22)
__device__ __forceinline__ unsigned xb_ld(unsigned* p)              { return __hip_atomic_load(p, __ATOMIC_RELAXED, __HIP_MEMORY_SCOPE_AGENT); }
__device__ __forceinline__ unsigned xb_add(unsigned* p, unsigned v) { return __hip_atomic_fetch_add(p, v, __ATOMIC_RELAXED, __HIP_MEMORY_SCOPE_AGENT); }
__device__ __forceinline__ unsigned xb_xcc_id() { return (unsigned)__builtin_amdgcn_s_getreg((3 << 11) | 20) & 0xFu; }
#define XB_SPIN(cond, bar) do { unsigned _sp = 0; while (cond) { __builtin_amdgcn_s_sleep(1); \
    if ((++_sp & 255u) == 0u) { if (xb_ld(&(bar)[XB_TMO])) break; if (_sp > XB_SPIN_CAP) { atomicAdd(&(bar)[XB_TMO], 1u); break; } } } } while (0)
struct XcdBarrier { unsigned* bar; unsigned x; volatile LAS unsigned* st; };
__device__ __forceinline__ XcdBarrier xcd_barrier_post(unsigned* bar, volatile LAS unsigned* st) {
    XcdBarrier b; b.bar = bar; b.x = xb_xcc_id(); b.st = st;
    if (threadIdx.x == 0) (void)xb_add(&bar[XB_XCNT(b.x)], 1u);
    return b;
}
__device__ __forceinline__ void xcd_barrier_complete(unsigned* bar, unsigned x, unsigned& nloc, unsigned& nx) {
    const unsigned G = gridDim.x * gridDim.y * gridDim.z;
    unsigned sum, cnt, mine, sp = 0u;
    for (;;) {
        sum = 0u; cnt = 0u; mine = 0u;
#pragma unroll
        for (unsigned j = 0; j < 16; ++j) { const unsigned c = xb_ld(&bar[XB_XCNT(j)]); sum += c; cnt += (c > 0u) ? 1u : 0u; mine = (j == x) ? c : mine; }
        if (sum == G) break;
        __builtin_amdgcn_s_sleep(1);
        if ((++sp & 255u) == 0u) { if (xb_ld(&bar[XB_TMO])) break; if (sp > XB_SPIN_CAP) { atomicAdd(&bar[XB_TMO], 1u); break; } }
    }
    nloc = mine > 0u ? mine : 1u; nx = cnt > 0u ? cnt : 1u;
}
__device__ __forceinline__ void xcd_barrier(const XcdBarrier& b, int tid_in) {
    asm volatile("s_waitcnt vmcnt(0)" ::: "memory");
    __syncthreads();
    if (tid_in == 0) {
        unsigned* bar = b.bar; const unsigned bx = xb_xcc_id();
        __builtin_amdgcn_s_waitcnt(0);
        unsigned nloc = b.st[0], nx = b.st[1];
        if (nloc == 0u) { xcd_barrier_complete(bar, bx, nloc, nx); b.st[0] = nloc; b.st[1] = nx; }
        const unsigned old = xb_add(&bar[XB_XSUB(bx)], 1u);
        const unsigned gen = old / nloc;
        if (old + 1u == (gen + 1u) * nloc) {
            __builtin_amdgcn_fence(__ATOMIC_RELEASE, "agent");
            asm volatile("s_waitcnt vmcnt(0)" ::: "memory");
            const unsigned og = xb_add(&bar[XB_TOP], 1u);
            const unsigned tg = og / nx;
            if (og + 1u == (tg + 1u) * nx) xb_add(&bar[XB_TOPGEN], 1u);
            else XB_SPIN(xb_ld(&bar[XB_TOPGEN]) == tg, bar);
            __builtin_amdgcn_fence(__ATOMIC_ACQUIRE, "agent");
            xb_add(&bar[XB_XGEN(bx)], 1u);
            asm volatile("s_waitcnt vmcnt(0)" ::: "memory");
        } else {
            XB_SPIN(xb_ld(&bar[XB_XGEN(bx)]) == gen, bar);
            __builtin_amdgcn_fence(__ATOMIC_ACQUIRE, "agent");
            asm volatile("s_waitcnt vmcnt(0)" ::: "memory");
        }
    }
    __syncthreads();
}
constexpr size_t CTL_ZERO_BYTES = 65536; constexpr int CW_BAR = 1024;

__device__ __forceinline__ float wave_sum(float v) {
#pragma unroll
    for (int o = 1; o < 64; o <<= 1) v += __shfl_xor(v, o);
    return v;
}
constexpr long N_SCAN4 = N_SCAN * 4;
__device__ __forceinline__ void st_dn_scan4(const P& p, long g) {
    const int part = (int)(g & 3); const long g1 = g >> 2;
    const int vc = (int)(g1 % DH); const int dir = (int)((g1 / DH) % 2); const int hh = (int)((g1 / (2 * DH)) % NH); const int seq = (int)(g1 / (2 * DH * NH));
    const float *QN = WSP(float, WS_QN), *KN = WSP(float, WS_KN), *VV = WSP(float, WS_VV), *G = WSP(float, WS_G), *BT = WSP(float, WS_BETA);
    float* O = WSP(float, dir ? WS_OB : WS_OF);
    float Sx[32];
#pragma unroll
    for (int d = 0; d < 32; ++d) Sx[d] = 0.f;
    for (int step = 0; step < S; ++step) {
        const int tt = dir ? S - 1 - step : step; const long t = (long)seq * S + tt;
        const float eg = expf(G[(t * 2 + dir) * NH + hh]), b = BT[(t * 2 + dir) * NH + hh];
        const float* kp = KN + ((size_t)t * NH + hh) * DH + part * 32; const float* qp = QN + ((size_t)t * NH + hh) * DH + part * 32; const float vv = VV[((size_t)t * NH + hh) * DH + vc];
        float dot = 0.f;
#pragma unroll
        for (int d = 0; d < 32; ++d) { Sx[d] *= eg; dot += Sx[d] * kp[d]; }
        dot += __shfl_xor(dot, 1); dot += __shfl_xor(dot, 2);
        const float delta = b * (vv - dot); float o = 0.f;
#pragma unroll
        for (int d = 0; d < 32; ++d) { Sx[d] += kp[d] * delta; o += Sx[d] * qp[d]; }
        o += __shfl_xor(o, 1); o += __shfl_xor(o, 2);
        if (part == 0) O[((size_t)t * NH + hh) * DH + vc] = o;
    }
}
__device__ __forceinline__ unsigned pk2(float lo, float hi) { return (unsigned)f2bf(lo) | ((unsigned)f2bf(hi) << 16); }
template <int ST> __device__ __forceinline__ void grid_items(const Job& j, long n, int tid_in) {
    int t_ = tid_in; asm volatile("" : "+v"(t_));
    for (long g = (long)blockIdx.x * NTHR + t_; g < n; g += (long)gridDim.x * NTHR) run_item<ST>(j, g);
}
__device__ __forceinline__ void transpose_item(const float* W, int K, int N, bf16* WT, LAS float* scr, int item, int lane, int GU = 0) {
    const int nblk_src = (N + 63) / 64; const int kblks = K / 64; const int KBL = kblks < 16 ? kblks : 16, NBL = 64 / KBL, kbb = kblks / KBL;
    const int blk = item >> 6, within = item & 63; const int kb = (blk % kbb) * KBL + (within % KBL), nb = (blk / kbb) * NBL + (within / KBL), k0 = 64 * kb, n0 = 64 * nb;
    const int n0s = GU ? (((n0 >> 7) & 1) * DFF + (n0 >> 8) * 128 + (n0 & 127)) : n0;
    const int c = lane & 7;
    if (nb >= nblk_src) {
#pragma unroll
        for (int jj = 0; jj < 8; ++jj) { const int n = (lane >> 3) + 8 * jj; *(GAS v4u*)(WT + (size_t)(n0 + n) * K + k0 + 8 * c) = (v4u){0u, 0u, 0u, 0u}; }
        return;
    }
    {
        f32x4 v[16]; const int kq = lane >> 4, nn = (lane & 15) * 4;
#pragma unroll
        for (int i = 0; i < 16; ++i) v[i] = (n0s + nn < N) ? *(const f32x4*)(W + (size_t)(k0 + 4 * i + kq) * N + n0s + nn) : (f32x4){0.f, 0.f, 0.f, 0.f};
#pragma unroll
        for (int i = 0; i < 16; ++i) { LAS float* d = scr + (4 * i + kq) * 65 + nn; d[0] = v[i].x; d[1] = v[i].y; d[2] = v[i].z; d[3] = v[i].w; }
    }
    LDS_WAIT(); asm volatile("" ::: "memory");
#pragma unroll
    for (int jj = 0; jj < 8; ++jj) { const int n = (lane >> 3) + 8 * jj; const LAS float* s_ = scr + (8 * c) * 65 + n;
        v4u o; o.x = pk2(s_[0 * 65], s_[1 * 65]); o.y = pk2(s_[2 * 65], s_[3 * 65]); o.z = pk2(s_[4 * 65], s_[5 * 65]); o.w = pk2(s_[6 * 65], s_[7 * 65]);
        *(GAS v4u*)(WT + (size_t)(n0 + n) * K + k0 + 8 * c) = o; }
    LDS_WAIT(); asm volatile("" ::: "memory");
}
__device__ __forceinline__ void pb_phase(const P& p, int tid_in) {
    int t_ = tid_in; asm volatile("" : "+v"(t_));
    constexpr long np8 = (long)NPROMPT * S * PLE / 8, ns8 = (long)(NSEQ - NPROMPT) * S * PLE / 8, n8 = np8 + ns8;
    for (int layer = 0; layer < DEPTH; ++layer) {
        const float* pp = p.p_prompt + (size_t)layer * np8 * 8; const float* ps = p.p_sample + (size_t)layer * ns8 * 8; bf16* o = WSP(bf16, WS_PB + (size_t)layer * SZ_PB);
#pragma unroll 2
        for (long g = (long)blockIdx.x * NTHR + t_; g < n8; g += (long)gridDim.x * NTHR) { const float* src = g < np8 ? pp + g * 8 : ps + (g - np8) * 8;
            const f32x4 a = *(const f32x4*)src, b = *(const f32x4*)(src + 4); v4u w; w.x = pk2(a.x, a.y); w.y = pk2(a.z, a.w); w.z = pk2(b.x, b.y); w.w = pk2(b.z, b.w); *(v4u*)(o + g * 8) = w; }
    }
}
__device__ __forceinline__ float fast_sigmoid(float x) { return __builtin_amdgcn_rcpf(1.0f + __builtin_amdgcn_exp2f(-1.4426950408889634f * x)); }
template <int MODE> __device__ __forceinline__ void row_phase(const P& p, const float* wa, const float* wn, int gw, int ngw, int lane) {
    constexpr int NV = D / 256;
    asm volatile("" : "+v"(lane));
    f32x4 hN[NV]; unsigned long long hB[NV], yN[NV], pN[NV];
#define ROW_LOAD(t_) do { const long tt_ = (t_); \
        if (MODE == 0) { const long np = (long)NPROMPT * S * D; const float* src = (tt_ * D < np) ? p.x_prompt + (size_t)tt_ * D : p.x_sample + ((size_t)tt_ * D - np); \
            _Pragma("unroll") for (int i = 0; i < NV; ++i) hN[i] = *(const f32x4*)(src + (i * 64 + lane) * 4); } \
        else { const bf16* hr_ = WSP(bf16, WS_H16) + (size_t)tt_ * D; const bf16* yr_ = WSP(bf16, WS_GOUT) + (size_t)tt_ * D; \
            _Pragma("unroll") for (int i = 0; i < NV; ++i) { hB[i] = *(const unsigned long long*)(hr_ + (i * 64 + lane) * 4); yN[i] = *(const unsigned long long*)(yr_ + (i * 64 + lane) * 4); } \
            if (MODE == 3) { const bf16* pr_ = WSP(bf16, WS_PP2) + (size_t)tt_ * D; _Pragma("unroll") for (int i = 0; i < NV; ++i) pN[i] = *(const unsigned long long*)(pr_ + (i * 64 + lane) * 4); } } } while (0)
#define UNPK(q_) (f32x4){bf2f((bf16)((q_) & 0xffff)), bf2f((bf16)(((q_) >> 16) & 0xffff)), bf2f((bf16)(((q_) >> 32) & 0xffff)), bf2f((bf16)((q_) >> 48))}
    if (gw < T) ROW_LOAD(gw);
    for (int t = gw; t < T; t += ngw) {
        f32x4 h[NV], y[NV], pp[NV];
#pragma unroll
        for (int i = 0; i < NV; ++i) { if (MODE == 0) h[i] = hN[i]; else { h[i] = UNPK(hB[i]); y[i] = UNPK(yN[i]); } if (MODE == 3) pp[i] = UNPK(pN[i]); }
        if (t + ngw < T) ROW_LOAD(t + ngw);
        if (MODE == 1 || MODE == 2) {
            float ss = 0.f;
#pragma unroll
            for (int i = 0; i < NV; ++i) ss += (y[i].x * y[i].x + y[i].y * y[i].y) + (y[i].z * y[i].z + y[i].w * y[i].w);
            const float r = 1.0f / sqrtf(wave_sum(ss) * (1.0f / D) + RMS_EPS);
#pragma unroll
            for (int i = 0; i < NV; ++i) { const f32x4 w = *(const f32x4*)(wa + (i * 64 + lane) * 4); h[i] = h[i] + y[i] * r * w; }
        } else if (MODE == 3) {
#pragma unroll
            for (int i = 0; i < NV; ++i) { h[i].x += fast_sigmoid(y[i].x) * pp[i].x; h[i].y += fast_sigmoid(y[i].y) * pp[i].y; h[i].z += fast_sigmoid(y[i].z) * pp[i].z; h[i].w += fast_sigmoid(y[i].w) * pp[i].w; }
        }
        if (MODE == 3 && wn == nullptr) { float* hr = p.h + (size_t)t * D;
#pragma unroll
            for (int i = 0; i < NV; ++i) *(f32x4*)(hr + (i * 64 + lane) * 4) = h[i];
            continue; }
        { bf16* hw = WSP(bf16, WS_H16) + (size_t)t * D;
#pragma unroll
            for (int i = 0; i < NV; ++i) *(unsigned long long*)(hw + (i * 64 + lane) * 4) = (unsigned long long)pk2(h[i].x, h[i].y) | ((unsigned long long)pk2(h[i].z, h[i].w) << 32); }
        if (MODE == 2) continue;
        float r2 = 1.f;
        if (MODE != 2) { float ss = 0.f;
#pragma unroll
            for (int i = 0; i < NV; ++i) ss += (h[i].x * h[i].x + h[i].y * h[i].y) + (h[i].z * h[i].z + h[i].w * h[i].w);
            r2 = 1.0f / sqrtf(wave_sum(ss) * (1.0f / D) + RMS_EPS); }
        bf16* o = WSP(bf16, WS_HN) + (size_t)t * D;
#pragma unroll
        for (int i = 0; i < NV; ++i) { f32x4 v = h[i] * r2; if (MODE != 2) { const f32x4 w = *(const f32x4*)(wn + (i * 64 + lane) * 4); v = v * w; }
            *(unsigned long long*)(o + (i * 64 + lane) * 4) = (unsigned long long)pk2(v.x, v.y) | ((unsigned long long)pk2(v.z, v.w) << 32); }
    }
#undef ROW_LOAD
#undef UNPK
}

typedef short bf16x8_t __attribute__((ext_vector_type(8)));
__device__ __forceinline__ float gelu_fast(float x) { const float u = 0.7978845608028654f * (x + 0.044715f * x * x * x); return x * __builtin_amdgcn_rcpf(1.0f + __builtin_amdgcn_exp2f(-2.885390081777927f * u)); }
__device__ __forceinline__ void ffn_act_phase(const P& p, int layer, int gw, int ngw, int lane) {
    asm volatile("" : "+v"(lane));
    constexpr int TT = 32, NCB = DFF / 512, NIT = (T / TT) * NCB;
    const bf16* hid = WSP(bf16, WS_HID); bf16* act = WSP(bf16, WS_ACT);
    const float* cw = PRM(PR_FCW) + (size_t)layer * 3 * 2 * DFF; const float* cb = PRM(PR_FCB) + (size_t)layer * 2 * DFF;
    for (int it = gw; it < NIT; it += ngw) {
        const int cblk = it % NCB, tile = it / NCB; const int c0 = cblk * 512 + lane * 8; const long t0 = (long)tile * TT; const int tt0 = (int)(t0 % S);
        float wg[3][8], wu[3][8], bg[8], bu[8];
#pragma unroll
        for (int i = 0; i < 3; ++i)
#pragma unroll
            for (int e = 0; e < 8; ++e) { wg[i][e] = cw[i * 2 * DFF + c0 + e]; wu[i][e] = cw[i * 2 * DFF + DFF + c0 + e]; }
#pragma unroll
        for (int e = 0; e < 8; ++e) { bg[e] = cb[c0 + e]; bu[e] = cb[DFF + c0 + e]; }
        const bf16x8_t zero8 = {0, 0, 0, 0, 0, 0, 0, 0};
        bf16x8_t g0 = zero8, u0 = zero8, g1, u1, g2, u2;
        if (tt0 > 0) { g0 = *(const bf16x8_t*)(hid + (size_t)(t0 - 1) * (2 * DFF) + c0); u0 = *(const bf16x8_t*)(hid + (size_t)(t0 - 1) * (2 * DFF) + DFF + c0); }
        g1 = *(const bf16x8_t*)(hid + (size_t)t0 * (2 * DFF) + c0); u1 = *(const bf16x8_t*)(hid + (size_t)t0 * (2 * DFF) + DFF + c0);
        for (int k = 0; k < TT; ++k) {
            const long t = t0 + k;
            if (tt0 + k + 1 < S) { g2 = *(const bf16x8_t*)(hid + (size_t)(t + 1) * (2 * DFF) + c0); u2 = *(const bf16x8_t*)(hid + (size_t)(t + 1) * (2 * DFF) + DFF + c0); } else { g2 = zero8; u2 = zero8; }
            float o[8];
#pragma unroll
            for (int e = 0; e < 8; ++e) {
                const float ga = bg[e] + bf2f((bf16)g0[e]) * wg[0][e] + bf2f((bf16)g1[e]) * wg[1][e] + bf2f((bf16)g2[e]) * wg[2][e];
                const float up = bu[e] + bf2f((bf16)u0[e]) * wu[0][e] + bf2f((bf16)u1[e]) * wu[1][e] + bf2f((bf16)u2[e]) * wu[2][e];
                o[e] = gelu_fast(ga) * up; }
            v4u w; w.x = pk2(o[0], o[1]); w.y = pk2(o[2], o[3]); w.z = pk2(o[4], o[5]); w.w = pk2(o[6], o[7]);
            *(v4u*)(act + (size_t)t * DFF + c0) = w;
            g0 = g1; u0 = u1; g1 = g2; u1 = u2;
        }
    }
}
__device__ __forceinline__ void dn_out_phase(const P& p, int jl, int gw, int ngw, int lane) {
    asm volatile("" : "+v"(lane));
    const int hh = lane >> 3, d0 = (lane & 7) * 16; const float* on = PRM(PR_ONORM) + jl * DH + d0;
    bf16x8_t aN[2], bN[2], zN0, zN1;
#define DNO_LOAD(t_) do { const bf16* of_ = WSP(bf16, WS_OF) + ((size_t)(t_) * NH + hh) * DH + d0; const bf16* ob_ = WSP(bf16, WS_OB) + ((size_t)(t_) * NH + hh) * DH + d0; \
        const bf16* z_ = WSP(bf16, WS_PROJ) + (size_t)(t_) * ABINP + COL_Z + hh * DH + d0; \
        aN[0] = *(const bf16x8_t*)of_; aN[1] = *(const bf16x8_t*)(of_ + 8); bN[0] = *(const bf16x8_t*)ob_; bN[1] = *(const bf16x8_t*)(ob_ + 8); zN0 = *(const bf16x8_t*)z_; zN1 = *(const bf16x8_t*)(z_ + 8); } while (0)
    if (gw < T) DNO_LOAD(gw);
    for (int t = gw; t < T; t += ngw) {
        float o[16]; float ss = 0.f; const bf16x8_t z0 = zN0, z1 = zN1;
#pragma unroll
        for (int c8 = 0; c8 < 2; ++c8)
#pragma unroll
            for (int e = 0; e < 8; ++e) { o[8 * c8 + e] = bf2f((bf16)aN[c8][e]) + bf2f((bf16)bN[c8][e]); ss += o[8 * c8 + e] * o[8 * c8 + e]; }
        if (t + ngw < T) DNO_LOAD(t + ngw);
        ss += __shfl_xor(ss, 1); ss += __shfl_xor(ss, 2); ss += __shfl_xor(ss, 4);
        const float r = 1.0f / sqrtf(ss * (1.0f / DH) + RMS_EPS); float v[16];
#pragma unroll
        for (int e = 0; e < 16; ++e) { const float zz = bf2f((bf16)(e < 8 ? z0[e] : z1[e - 8])); v[e] = o[e] * r * on[e] * zz * fast_sigmoid(zz); }
        bf16* out = WSP(bf16, WS_MIXIN) + (size_t)t * ABMIX + hh * DH + d0;
        v4u w0, w1; w0.x = pk2(v[0], v[1]); w0.y = pk2(v[2], v[3]); w0.z = pk2(v[4], v[5]); w0.w = pk2(v[6], v[7]); w1.x = pk2(v[8], v[9]); w1.y = pk2(v[10], v[11]); w1.z = pk2(v[12], v[13]); w1.w = pk2(v[14], v[15]);
        *(v4u*)out = w0; *(v4u*)(out + 8) = w1;
    }
#undef DNO_LOAD
}
__device__ __forceinline__ void c_out_phase(const P& p, int jl, int gw, int ngw, int lane) {
    asm volatile("" : "+v"(lane));
    const int hh = lane >> 3, e0 = (lane & 7) * 32; const float lam = WSP(float, WS_LAM)[0], li = WSP(float, WS_LAM)[1]; const float* sw = PRM(PR_SUBLN) + jl * 256 + e0;
    bf16x8_t aN[4], bN[4];
#define CO_LOAD(t_) do { const bf16* o0_ = WSP(bf16, WS_O0) + (size_t)(t_) * 2048 + hh * 256 + e0; const bf16* o1_ = WSP(bf16, WS_O1) + (size_t)(t_) * 2048 + hh * 256 + e0; \
        _Pragma("unroll") for (int c8 = 0; c8 < 4; ++c8) { aN[c8] = *(const bf16x8_t*)(o0_ + 8 * c8); bN[c8] = *(const bf16x8_t*)(o1_ + 8 * c8); } } while (0)
    if (gw < T) CO_LOAD(gw);
    for (int t = gw; t < T; t += ngw) {
        float o[32]; float ss = 0.f;
#pragma unroll
        for (int c8 = 0; c8 < 4; ++c8)
#pragma unroll
            for (int e = 0; e < 8; ++e) { o[8 * c8 + e] = bf2f((bf16)aN[c8][e]) - lam * bf2f((bf16)bN[c8][e]); ss += o[8 * c8 + e] * o[8 * c8 + e]; }
        if (t + ngw < T) CO_LOAD(t + ngw);
        ss += __shfl_xor(ss, 1); ss += __shfl_xor(ss, 2); ss += __shfl_xor(ss, 4);
        const float r = (1.0f / sqrtf(ss * (1.0f / 256.0f) + RMS_EPS)) * (1.0f - li);
        bf16* out = WSP(bf16, WS_MIXIN) + (size_t)t * 2048 + hh * 256 + e0;
#pragma unroll
        for (int c8 = 0; c8 < 4; ++c8) { v4u w; w.x = pk2(o[8 * c8] * r * sw[8 * c8], o[8 * c8 + 1] * r * sw[8 * c8 + 1]); w.y = pk2(o[8 * c8 + 2] * r * sw[8 * c8 + 2], o[8 * c8 + 3] * r * sw[8 * c8 + 3]);
            w.z = pk2(o[8 * c8 + 4] * r * sw[8 * c8 + 4], o[8 * c8 + 5] * r * sw[8 * c8 + 5]); w.w = pk2(o[8 * c8 + 6] * r * sw[8 * c8 + 6], o[8 * c8 + 7] * r * sw[8 * c8 + 7]); *(v4u*)(out + 8 * c8) = w; }
    }
#undef CO_LOAD
}
__device__ __forceinline__ void rope_table_phase(const P& p, int tid_in) {
    int t_ = tid_in; asm volatile("" : "+v"(t_));
    float* tab = WSP(float, WS_LAM) + 16;
    for (int g = (int)blockIdx.x * NTHR + t_; g < S * 16; g += (int)gridDim.x * NTHR) { const int i = g & 15, pos = g >> 4;
        const float inv = powf(500000.0f, -(float)(2 * i) / 32.0f); const float ang = (float)pos * inv; tab[2 * g] = cosf(ang); tab[2 * g + 1] = sinf(ang); }
}
__device__ __forceinline__ void rope_phase(const P& p, int tid_in) {
    int t_ = tid_in; asm volatile("" : "+v"(t_));
    const float* tab = WSP(const float, WS_LAM) + 16;
    for (long g = (long)blockIdx.x * NTHR + t_; g < (long)T * 32; g += (long)gridDim.x * NTHR) {
        const int hj = (int)(g & 15), which = (int)((g >> 4) & 1); const long t = g >> 5; const float* cs_ = tab + (size_t)(t % S) * 32;
        bf16* x = WSP(bf16, WS_PROJ) + (size_t)t * CIN + which * 2048 + hj * DH;
        bf16x8_t a0 = *(const bf16x8_t*)x, a1 = *(const bf16x8_t*)(x + 8), b0 = *(const bf16x8_t*)(x + 16), b1 = *(const bf16x8_t*)(x + 24); float r1[16], r2[16];
#pragma unroll
        for (int i = 0; i < 16; ++i) { const float cs = cs_[2 * i], sn = cs_[2 * i + 1];
            const float x1 = bf2f((bf16)(i < 8 ? a0[i] : a1[i - 8])), x2 = bf2f((bf16)(i < 8 ? b0[i] : b1[i - 8])); r1[i] = x1 * cs - x2 * sn; r2[i] = x2 * cs + x1 * sn; }
        v4u w;
        w.x = pk2(r1[0], r1[1]); w.y = pk2(r1[2], r1[3]); w.z = pk2(r1[4], r1[5]); w.w = pk2(r1[6], r1[7]); *(v4u*)x = w;
        w.x = pk2(r1[8], r1[9]); w.y = pk2(r1[10], r1[11]); w.z = pk2(r1[12], r1[13]); w.w = pk2(r1[14], r1[15]); *(v4u*)(x + 8) = w;
        w.x = pk2(r2[0], r2[1]); w.y = pk2(r2[2], r2[3]); w.z = pk2(r2[4], r2[5]); w.w = pk2(r2[6], r2[7]); *(v4u*)(x + 16) = w;
        w.x = pk2(r2[8], r2[9]); w.y = pk2(r2[10], r2[11]); w.z = pk2(r2[12], r2[13]); w.w = pk2(r2[14], r2[15]); *(v4u*)(x + 24) = w;
    }
}
__device__ __forceinline__ void ffn_fix_phase(const P& p, int layer, int tid_in) {
    int t_ = tid_in; asm volatile("" : "+v"(t_));
    const int ln = t_ & 63, gwv = (int)blockIdx.x * NWAVES + __builtin_amdgcn_readfirstlane(t_ >> 6), ngwv = (int)gridDim.x * NWAVES;
    const float* cw = PRM(PR_FCW) + (size_t)layer * 3 * 2 * DFF; const float* cb = PRM(PR_FCB) + (size_t)layer * 2 * DFF; const float* HALO = WSP(float, WS_HALO);
    constexpr int NP = T / 256, PPS = S / 256, NCB = DFF / 256;
    for (int g = gwv; g < NP * 2 * NCB; g += ngwv) {
        const int c0 = (g % NCB) * 256 + ln * 4; const int edge = (g / NCB) & 1; const int pm = g / (2 * NCB);
        const bool has_prev = edge ? true : (pm % PPS != 0), has_next = edge ? (pm % PPS != PPS - 1) : true;
        const float* rp = HALO + (((size_t)(edge ? pm : pm - 1) * 4 + (edge ? 2 : 3)) * 2) * DFF + c0;
        const float* rc = HALO + (((size_t)pm * 4 + (edge ? 3 : 0)) * 2) * DFF + c0;
        const float* rn = HALO + (((size_t)(edge ? pm + 1 : pm) * 4 + (edge ? 0 : 1)) * 2) * DFF + c0;
        const f32x4 z4 = {0.f, 0.f, 0.f, 0.f};
        f32x4 gp = z4, up = z4, gn = z4, un = z4;
        if (has_prev) { gp = *(const f32x4*)rp; up = *(const f32x4*)(rp + DFF); }
        if (has_next) { gn = *(const f32x4*)rn; un = *(const f32x4*)(rn + DFF); }
        const f32x4 gc = *(const f32x4*)rc, uc = *(const f32x4*)(rc + DFF);
        const f32x4 bg = *(const f32x4*)(cb + c0), bu = *(const f32x4*)(cb + DFF + c0);
        const f32x4 wg0 = *(const f32x4*)(cw + c0), wu0 = *(const f32x4*)(cw + DFF + c0), wg1 = *(const f32x4*)(cw + 2 * DFF + c0), wu1 = *(const f32x4*)(cw + 3 * DFF + c0),
                    wg2 = *(const f32x4*)(cw + 4 * DFF + c0), wu2 = *(const f32x4*)(cw + 5 * DFF + c0);
        float o[4];
#pragma unroll
        for (int e = 0; e < 4; ++e) {
            const float cg = bg[e] + wg0[e] * gp[e] + wg1[e] * gc[e] + wg2[e] * gn[e];
            const float cu = bu[e] + wu0[e] * up[e] + wu1[e] * uc[e] + wu2[e] * un[e];
            o[e] = pg8::gelu_t(cg) * cu; }
        *(unsigned long long*)(WSP(bf16, WS_ACT) + ((size_t)pm * 256 + (edge ? 255 : 0)) * DFF + c0) = (unsigned long long)pk2(o[0], o[1]) | ((unsigned long long)pk2(o[2], o[3]) << 32);
    }
}
__device__ __forceinline__ int hw_lane() { int l; asm volatile("v_mbcnt_lo_u32_b32 %0, -1, 0\n\tv_mbcnt_hi_u32_b32 %0, -1, %0" : "=v"(l)); return l; }
struct Args { P p; };
__global__ void __launch_bounds__(NTHR, 2) mega_fwd(Args args) {
    extern __shared__ __attribute__((aligned(16))) unsigned char lds_raw[];
    LAS unsigned char* lds = (LAS unsigned char*)lds_raw;
    const P& p = args.p;
    const int tid = threadIdx.x, wave = __builtin_amdgcn_readfirstlane(tid >> 6);
#define HWLANE hw_lane()
#define HWTID ((wave << 6) | HWLANE)
#define lane HWLANE
    const int G = gridDim.x; const int gw = blockIdx.x * NWAVES + wave, ngw = G * NWAVES;
    volatile LAS unsigned* MISC = (volatile LAS unsigned*)(lds + MISC_OFF);
    for (int u = tid; u < (LDS_BYTES - LDSCTL_OFF) / 4; u += NTHR) ((LAS unsigned*)(lds + LDSCTL_OFF))[u] = 0u;
    __syncthreads();
    XcdBarrier bar = xcd_barrier_post(WSP(unsigned, WS_CTL) + CW_BAR, MISC + 8);
    Job j; j.p = p; j.w.W = nullptr; j.w.O = nullptr; j.w.K = 0; j.w.N = 0; j.w.Npad = 0; j.a = nullptr; j.b = nullptr; j.n = 0; j.layer = 0; j.flag = 0;

    {
        LAS float* scr = (LAS float*)(lds + wave * 16640);
        for (int m = 0; m < 24; ++m) {
            const float* W; bf16* O; int K, N, Npad; const int i = m & 1, l = m & 3;
            if (m < 2)       { W = p.ab_w_in + (size_t)i * D * ABIN;  O = WSP(bf16, WS_WABIN + (size_t)i * ABINP * D * 2); K = D; N = ABIN; Npad = ABINP; }
            else if (m < 4)  { W = p.ab_w_out + (size_t)i * ABMIX * D; O = WSP(bf16, WS_WABOUT + (size_t)i * D * ABMIX * 2); K = ABMIX; N = D; Npad = D; }
            else if (m < 6)  { W = p.c_w_in + (size_t)i * D * CIN;    O = WSP(bf16, WS_WCIN + (size_t)i * CIN * D * 2); K = D; N = CIN; Npad = CIN; }
            else if (m < 8)  { W = p.c_w_out + (size_t)i * CV * D;    O = WSP(bf16, WS_WCOUT + (size_t)i * D * CV * 2); K = CV; N = D; Npad = D; }
            else if (m < 12) { W = p.ffn_w_in + (size_t)l * D * 2 * DFF; O = WSP(bf16, WS_WFIN + (size_t)l * 2 * DFF * D * 2); K = D; N = 2 * DFF; Npad = 2 * DFF; }
            else if (m < 16) { W = p.ffn_w_out + (size_t)l * DFF * D;  O = WSP(bf16, WS_WFOUT + (size_t)l * D * DFF * 2); K = DFF; N = D; Npad = D; }
            else if (m < 20) { W = p.ple_w_proj + (size_t)l * PLE * D; O = WSP(bf16, WS_WPP + (size_t)l * D * PLE * 2); K = PLE; N = D; Npad = D; }
            else             { W = p.ple_w_gate + (size_t)l * D * D;   O = WSP(bf16, WS_WPG + (size_t)l * D * D * 2); K = D; N = D; Npad = D; }
            const int nitems = (K / 64) * (Npad / 64);
            for (int it = gw; it < nitems; it += ngw) transpose_item(W, K, N, O, scr, it, lane, (m >= 8 && m < 12) ? 1 : 0);
        }
        rope_table_phase(p, HWTID);
        {
            int t_ = HWTID; asm volatile("" : "+v"(t_));
            if (blockIdx.x == 0 && t_ < 2) { const float* lp = p.c_lambda + (size_t)t_ * 4 * DH; float a = 0.f, b = 0.f;
                for (int d = 0; d < DH; ++d) { a += lp[d] * lp[DH + d]; b += lp[2 * DH + d] * lp[3 * DH + d]; }
                const float li = lambda_init_of(2 * t_ + 1); WSP(float, WS_LAM)[2 * t_] = expf(a) - expf(b) + li; WSP(float, WS_LAM)[2 * t_ + 1] = li; }
        }
        grid_items<ST_PRM>(j, N_PRM, HWTID);
        pb_phase(p, HWTID);
        row_phase<0>(p, nullptr, p.norms, gw, ngw, lane);
    }
    xcd_barrier(bar, HWTID);

    for (int layer = 0; layer < DEPTH; ++layer) {
        j.layer = layer; const int jj = layer >> 1; const float* nw = PRM(PR_NORMS) + (size_t)layer * 4 * D;
        {
            const bool ab = (layer & 1) == 0; const int N = ab ? ABINP : CIN;
            const bf16* Bt = ab ? WSP(bf16, WS_WABIN + (size_t)jj * ABINP * D * 2) : WSP(bf16, WS_WCIN + (size_t)jj * CIN * D * 2);
            pg8::Gemm g{WSP(bf16, WS_HN), Bt, T, N, D}; pg8::StaticOrder S_; S_.init(T, N, G, (int)blockIdx.x);
            pg8::EpiBf16Ro E{WSP(bf16, WS_PROJ), N, ab ? nullptr : WSP(const float, WS_LAM) + 16, S};
            pg8::gemm_phase<pg8::EpiBf16Ro, pg8::StaticOrder, true, true>(lds, g, S_, E, HWTID);
        }
        xcd_barrier(bar, HWTID);
        int pp_first = (int)blockIdx.x, pp_stride = G; bool pp_run = true;
        if ((layer & 1) == 0) {
            {
                constexpr int NU = NSEQ * NH * (S / 64);
                for (int u = (int)blockIdx.x; u < NU; u += G) dn::dn1_unit(p, jj, u / (NH * (S / 64)), (u / (S / 64)) % NH, u % (S / 64), (char*)lds_raw, HWTID);
            }
            xcd_barrier(bar, HWTID);
            constexpr int NSC = NSEQ * NH * 2; const bool split = G >= 2 * NSC; const int na_first = split ? (int)blockIdx.x - NSC : (int)blockIdx.x, na_stride = split ? G - NSC : G;
            if (!split || (int)blockIdx.x < NSC) { for (int ch = (int)blockIdx.x; ch < NSC; ch += G) dn::dn_scan_chain(p, ch, (char*)lds_raw, HWTID); }
            if (!split || (int)blockIdx.x >= NSC)
            {
                constexpr int NU = NSEQ * NH * (ROWS / 4);
                float* tab = (float*)((char*)lds_raw + att::SHM_ATTN);
                for (int u = na_first; u < NU; u += na_stride) {
                    const int rg = u % (ROWS / 4); const int hh = (u / (ROWS / 4)) % NH, seq = u / ((ROWS / 4) * NH); const int r0 = rg * 4;
                    const int kr0 = clampi(r0 - WR / 2, 0, ROWS - WR), krl = clampi(r0 + 3 - WR / 2, 0, ROWS - WR) + WR - 1; const int nt = krl - kr0 + 1;
                    { int t_ = HWTID; asm volatile("" : "+v"(t_)); if (t_ < 15 * 31) tab[t_] = PRM(PR_RPB)[((size_t)jj * NH + hh) * 15 * 31 + t_] * 11.313708498984761f; }
                    const bf16* base = WSP(bf16, WS_PROJ) + (size_t)seq * S * ABINP;
                    att::na_body<ABINP, ABINP, ABMIX>(base + (size_t)r0 * GW * ABINP + COL_QB + hh * DH, base + (size_t)kr0 * GW * ABINP + COL_KB + hh * DH, base + (size_t)kr0 * GW * ABINP + COL_VB + hh * DH,
                        WSP(bf16, WS_MIXIN) + ((size_t)seq * S + (size_t)r0 * GW) * ABMIX + 1024 + hh * DH, nt, (char*)lds_raw, att::NaInfo{r0, kr0, tab}, HWTID);
                    __syncthreads();
                }
            }
            pp_first = na_first; pp_stride = na_stride; pp_run = !split || (int)blockIdx.x >= NSC;
        } else {
            {
                constexpr int NU = NSEQ * NH * (S / 256);
                const int vcu = (G % 8 == 0) ? ((int)blockIdx.x % 8) * (G / 8) + (int)blockIdx.x / 8 : (int)blockIdx.x;
                const float lam = WSP(float, WS_LAM)[2 * jj], li = WSP(float, WS_LAM)[2 * jj + 1];
                for (int u = vcu; u < NU; u += G) {
                    const int qb = u % (S / 256); const int r_ = u / (S / 256); const int hh = r_ % NH, seq = r_ / NH;
                    const bf16* base = WSP(bf16, WS_PROJ) + (size_t)seq * S * CIN; const size_t oo = ((size_t)seq * S + (size_t)qb * 256) * 2048 + hh * 256;
#pragma unroll 1
                    for (int jj2 = 0; jj2 < 2; ++jj2) {
                        att::dattn256_body<CIN, CIN, 2048>(base + (size_t)qb * 256 * CIN + hh * 256 + jj2 * DH, base + 2048 + hh * 256 + jj2 * DH, base + 4096 + hh * 256,
                            WSP(bf16, WS_O0) + oo, S / 64, (char*)lds_raw, HWTID, jj2, WSP(bf16, WS_MIXIN) + oo, lam, 1.0f - li, PRM(PR_SUBLN) + jj * 256);
                        __syncthreads();
                    }
                }
            }
        }
        if (pp_run) {
            pg8::Gemm g{WSP(bf16, WS_PB + (size_t)layer * SZ_PB), WSP(bf16, WS_WPP + (size_t)layer * D * PLE * 2), T, D, PLE}; pg8::StaticOrder S_; S_.init(T, D, pp_stride, pp_first);
            pg8::EpiBf16 E{WSP(bf16, WS_PP2), D};
            pg8::gemm_phase<pg8::EpiBf16, pg8::StaticOrder, true, true>(lds, g, S_, E, HWTID);
        }
        xcd_barrier(bar, HWTID);
        if ((layer & 1) == 0) { dn_out_phase(p, jj, gw, ngw, lane); xcd_barrier(bar, HWTID); }
        {
            const bf16* Bt = (layer & 1) == 0 ? WSP(bf16, WS_WABOUT + (size_t)jj * D * ABMIX * 2) : WSP(bf16, WS_WCOUT + (size_t)jj * D * CV * 2);
            pg8::Gemm g{WSP(bf16, WS_MIXIN), Bt, T, D, 2048}; pg8::StaticOrder S_; S_.init(T, D, G, (int)blockIdx.x);
            pg8::EpiBf16 E{WSP(bf16, WS_GOUT), D};
            pg8::gemm_phase<pg8::EpiBf16, pg8::StaticOrder, true, true>(lds, g, S_, E, HWTID);
        }
        xcd_barrier(bar, HWTID);
        row_phase<1>(p, nw + D, nw + 2 * D, gw, ngw, lane);
        xcd_barrier(bar, HWTID);
        {
            pg8::Gemm g{WSP(bf16, WS_HN), WSP(bf16, WS_WFIN + (size_t)layer * 2 * DFF * D * 2), T, 2 * DFF, D}; pg8::StaticOrder S_; S_.init(T, 2 * DFF, G, (int)blockIdx.x);
            pg8::EpiConvAct E{WSP(bf16, WS_ACT), WSP(float, WS_HALO), WSP(float, WS_HALO) + (size_t)(T / 256) * 4 * 2 * DFF + 4096 * (int)blockIdx.x, PRM(PR_FCW) + (size_t)layer * 3 * 2 * DFF, PRM(PR_FCB) + (size_t)layer * 2 * DFF, (PG8_LAS float*)(lds + RING_BYTES)};
            pg8::gemm_phase<pg8::EpiConvAct, pg8::StaticOrder, true, true>(lds, g, S_, E, HWTID);
        }
        xcd_barrier(bar, HWTID);
        ffn_fix_phase(p, layer, HWTID);
        xcd_barrier(bar, HWTID);
        {
            pg8::Gemm g{WSP(bf16, WS_ACT), WSP(bf16, WS_WFOUT + (size_t)layer * D * DFF * 2), T, D, DFF}; pg8::StaticOrder S_; S_.init(T, D, G, (int)blockIdx.x);
            pg8::EpiBf16 E{WSP(bf16, WS_GOUT), D};
            pg8::gemm_phase<pg8::EpiBf16, pg8::StaticOrder, true, true>(lds, g, S_, E, HWTID);
        }
        xcd_barrier(bar, HWTID);
        row_phase<2>(p, nw + 3 * D, nullptr, gw, ngw, lane);
        xcd_barrier(bar, HWTID);
        {
            pg8::Gemm g{WSP(bf16, WS_H16), WSP(bf16, WS_WPG + (size_t)layer * D * D * 2), T, D, D}; pg8::StaticOrder S_; S_.init(T, D, G, (int)blockIdx.x);
            pg8::EpiBf16 E{WSP(bf16, WS_GOUT), D};
            pg8::gemm_phase<pg8::EpiBf16, pg8::StaticOrder, true, true>(lds, g, S_, E, HWTID);
        }
        xcd_barrier(bar, HWTID);
        row_phase<3>(p, nullptr, layer + 1 < DEPTH ? PRM(PR_NORMS) + (size_t)(layer + 1) * 4 * D : nullptr, gw, ngw, lane);
        if (layer + 1 < DEPTH) xcd_barrier(bar, HWTID);
    }
}

#undef lane
#undef HWTID
#undef HWLANE
extern "C" void kernel_launch(void* const* d_in, const int* in_sizes, int n_in, void* d_out, int out_size, void* d_ws, size_t ws_size, hipStream_t stream) {
    static int grid = 0;
    if (grid == 0) {
        if (n_in != 22 || out_size != T * D || ws_size < WS_END) { fprintf(stderr, "kernel_launch: unexpected shapes n_in %d out %d ws %zu (need %zu)\n", n_in, out_size, ws_size, (size_t)WS_END); grid = -1; return; }
        int dev = 0, cus = 0, per_cu = 0;
        if (hipGetDevice(&dev) != hipSuccess || hipDeviceGetAttribute(&cus, hipDeviceAttributeMultiprocessorCount, dev) != hipSuccess) { grid = -1; return; }
        if (hipFuncSetAttribute((const void*)mega_fwd, hipFuncAttributeMaxDynamicSharedMemorySize, LDS_BYTES) != hipSuccess) { fprintf(stderr, "kernel_launch: hipFuncSetAttribute failed\n"); grid = -1; return; }
        if (hipOccupancyMaxActiveBlocksPerMultiprocessor(&per_cu, (const void*)mega_fwd, NTHR, LDS_BYTES) != hipSuccess || per_cu < 1) fprintf(stderr, "kernel_launch: occupancy query reports %d blocks per CU\n", per_cu);
        (void)hipGetLastError();
        grid = cus;
    }
    if (grid < 0) return;
    if (hipMemsetAsync((char*)d_ws + WS_CTL, 0, CTL_ZERO_BYTES, stream) != hipSuccess) { fprintf(stderr, "kernel_launch: memset failed\n"); return; }
    Args a; memset(&a, 0, sizeof(a));
    const float** f = (const float**)&a.p;
    for (int i = 0; i < 22; ++i) f[i] = (const float*)d_in[i];
    a.p.h = (float*)d_out; a.p.ws = (unsigned char*)d_ws;
    hipLaunchKernelGGL(mega_fwd, dim3(grid), dim3(NTHR), LDS_BYTES, stream, a);
    const hipError_t le = hipPeekAtLastError();
    if (le != hipSuccess) fprintf(stderr, "kernel_launch: launch failed: %s\n", hipGetErrorName(le));
}
#else
int main(int argc, char** argv) {
    FILE* fs = fopen("sizes.txt", "r"); std::vector<long> sizes(22); for (int i = 0; i < 22; ++i) if (fscanf(fs, "%ld", &sizes[i]) != 1) return 1; fclose(fs);
    FILE* fi = fopen("inputs.bin", "rb"); std::vector<std::vector<float>> in(22);
    for (int i = 0; i < 22; ++i) { in[i].resize(sizes[i]); if (fread(in[i].data(), 4, sizes[i], fi) != (size_t)sizes[i]) return 2; } fclose(fi);
    std::vector<float> out((size_t)T * D); std::vector<unsigned char> ws(WS_END, 0xAA);
    printf("T %d D %d WS_END %zu MiB\n", T, D, (size_t)(WS_END / MiB));
    P p; memset(&p, 0, sizeof(p)); const float** f = (const float**)&p; for (int i = 0; i < 22; ++i) f[i] = in[i].data();
    p.h = out.data(); p.ws = ws.data();
    forward(p);
    FILE* fo = fopen("emu_out.bin", "wb"); fwrite(out.data(), 4, out.size(), fo); fclose(fo);
    return 0;
}
#endif
```

```cpp
#ifndef EMU
#include <hip/hip_runtime.h>
#include <cstdio>
#include <cstdint>
#include <cstring>
#define DEVFN __device__ __forceinline__
#define MEMFENCE() asm volatile("" ::: "memory")
#else
#include <cstdio>
#include <cstdint>
#include <cstdlib>
#include <cstring>
#include <cmath>
#include <vector>
#define DEVFN static inline
#define MEMFENCE() do {} while (0)
#endif
#include <cmath>

#ifndef EMU
constexpr int D = 2048, NSEQ = 6, NPROMPT = 2, S = 4096, PLE = 256, DFF = 8192;
#else
constexpr int D = 256, NSEQ = 2, NPROMPT = 1, S = 1024, PLE = 64, DFF = 512;
#endif
constexpr int T = NSEQ * S, DEPTH = 4, NH = 8, DH = 128;
constexpr int AQKV = 3072, ABIN = 7200, ABINP = 7424, ABMIX = 2048, CIN = 6144, CV = 2048;
constexpr int COL_Z = 3072, COL_G = 4096, COL_QB = 4128, COL_KB = 4128 + 1024, COL_VB = 4128 + 2048;
constexpr int GW = 64, ROWS = S / GW, NAR = 8, NAC = 16, WR = (NAR < ROWS ? NAR : ROWS);
constexpr float RMS_EPS = 1e-6f;

typedef unsigned short bf16;
DEVFN float bf2f(bf16 b) { unsigned u = ((unsigned)b) << 16; float f; memcpy(&f, &u, 4); return f; }
DEVFN bf16 f2bf(float f) { unsigned u; memcpy(&u, &f, 4); u += 0x7fffu + ((u >> 16) & 1u); return (bf16)(u >> 16); }
DEVFN float siluf(float x) { return x / (1.f + expf(-x)); }
DEVFN float sigmoidf(float x) { return 1.f / (1.f + expf(-x)); }
DEVFN float softplusf(float x) { if (x > 20.f) return x; const float y = expf(x); return y < 0.01f ? y * (1.f - y * (0.5f - y * 0.33333333f)) : logf(1.f + y); }
DEVFN int clampi(int v, int lo, int hi) { return v < lo ? lo : (v > hi ? hi : v); }

constexpr size_t MiB = 1u << 20;
constexpr size_t SZ_TD2 = (size_t)T * D * 2, SZ_TD4 = (size_t)T * D * 4;
constexpr size_t al(size_t x) { return (x + MiB - 1) / MiB * MiB; }
constexpr size_t WS_CTL = 0;
constexpr size_t WS_PRM = 1 * MiB;
constexpr int PR_ABCONV = 0, PR_ALOG = PR_ABCONV + 2 * 5 * AQKV, PR_DTB = PR_ALOG + 32, PR_ONORM = PR_DTB + 32, PR_RPB = PR_ONORM + 2 * DH, PR_LAMBDA = PR_RPB + 2 * NH * 15 * 31,
    PR_SUBLN = PR_LAMBDA + 2 * 4 * DH, PR_NORMS = PR_SUBLN + 2 * 256, PR_FCW = PR_NORMS + DEPTH * 4 * D, PR_FCB = PR_FCW + DEPTH * 3 * 2 * DFF, PR_END = PR_FCB + DEPTH * 2 * DFF;
static_assert((size_t)PR_END * 4 <= 2 * MiB, "param region");
constexpr size_t WS_WABIN = 3 * MiB;
constexpr size_t WS_WABOUT = WS_WABIN + al((size_t)2 * ABINP * D * 2);
constexpr size_t WS_WCIN = WS_WABOUT + al((size_t)2 * D * ABMIX * 2);
constexpr size_t WS_WCOUT = WS_WCIN + al((size_t)2 * CIN * D * 2);
constexpr size_t WS_WFIN = WS_WCOUT + al((size_t)2 * D * CV * 2);
constexpr size_t WS_WFOUT = WS_WFIN + al((size_t)4 * 2 * DFF * D * 2);
constexpr size_t WS_WPP = WS_WFOUT + al((size_t)4 * D * DFF * 2);
constexpr size_t WS_WPG = WS_WPP + al((size_t)4 * D * PLE * 2);
constexpr size_t WS_HN = WS_WPG + al((size_t)4 * D * D * 2);
#ifdef EMU
constexpr size_t WS_MIXIN = WS_HN + al(SZ_TD2);
#else
constexpr size_t WS_MIXIN = WS_HN;
constexpr size_t WS_H16 = WS_HN + al(SZ_TD2);
#endif
constexpr size_t WS_PB = WS_HN + 2 * al(SZ_TD2);
constexpr size_t SZ_PB = al((size_t)T * PLE * 2);
constexpr size_t WS_SMALL = WS_PB + DEPTH * SZ_PB;
constexpr size_t WS_RSTD = WS_SMALL, WS_G = WS_SMALL + al((size_t)T * 4), WS_BETA = WS_G + al((size_t)T * 16 * 4), WS_LAM = WS_BETA + al((size_t)T * 16 * 4);
constexpr size_t WS_R = WS_LAM + MiB;
constexpr size_t WS_GOUT = WS_R;
constexpr size_t WS_GOUT2 = WS_GOUT + al(SZ_TD4);
constexpr size_t WS_HID = WS_R;
#ifdef EMU
constexpr size_t WS_ACT = WS_HID + al((size_t)T * 2 * DFF * 2);
#else
constexpr size_t WS_ACT = WS_GOUT + al(SZ_TD4);
constexpr size_t WS_PP2 = (size_t)1952 * MiB;
#endif
constexpr size_t WS_HALO = WS_ACT + al((size_t)T * DFF * 2);
constexpr size_t WS_PROJ = WS_GOUT + al(SZ_TD4);
constexpr size_t WS_X1 = WS_PROJ + al((size_t)T * ABINP * 2);
constexpr size_t SZ_HD4 = al((size_t)T * NH * DH * 4);
#ifdef EMU
constexpr size_t WS_QN = WS_X1, WS_KN = WS_QN + SZ_HD4, WS_VV = WS_KN + SZ_HD4, WS_OF = WS_VV + SZ_HD4, WS_OB = WS_OF + SZ_HD4, WS_NASC = WS_OB + SZ_HD4;
constexpr size_t WS_END_AB = WS_NASC + SZ_HD4;
#else
constexpr size_t WS_OF = WS_GOUT, WS_OB = WS_OF + SZ_HD4;
constexpr size_t WS_QN = WS_X1, WS_KN = WS_X1, WS_VV = WS_X1, WS_NASC = WS_X1;
constexpr int NUD_ = NSEQ * NH * (S / 64) * 2;
constexpr size_t WS_DN_UT = WS_X1, WS_DN_WN = WS_DN_UT + al((size_t)NUD_ * 128 * 64 * 4), WS_DN_QE = WS_DN_WN + al((size_t)NUD_ * 16 * 512 * 2), WS_DN_IN = WS_DN_QE + al((size_t)NUD_ * 16 * 512 * 2),
    WS_DN_KD = WS_DN_IN + al((size_t)NUD_ * 8 * 512 * 2), WS_DN_EG = WS_DN_KD + al((size_t)NUD_ * 16 * 512 * 2);
constexpr size_t WS_END_AB = WS_DN_EG + MiB;
#endif
constexpr size_t WS_O0 = WS_X1, WS_O1 = WS_O0 + al((size_t)T * 2048 * 4);
constexpr size_t WS_END_C = WS_O1 + al((size_t)T * 2048 * 4);
constexpr size_t WS_END_F = WS_HALO + 32 * MiB;
constexpr size_t WS_END = (WS_END_AB > WS_END_C ? (WS_END_AB > WS_END_F ? WS_END_AB : WS_END_F) : (WS_END_C > WS_END_F ? WS_END_C : WS_END_F));
#ifndef EMU
static_assert(WS_END <= WS_PP2 && WS_PP2 + SZ_TD2 <= (size_t)2048 * MiB, "workspace map exceeds 2 GiB");
#endif

struct P {
    const float *x_prompt, *x_sample, *p_prompt, *p_sample, *ab_w_in, *ab_conv_w, *ab_a_log, *ab_dt_bias, *ab_out_norm, *ab_rpb, *ab_w_out,
        *c_w_in, *c_lambda, *c_subln, *c_w_out, *norms, *ffn_w_in, *ffn_conv_w, *ffn_conv_b, *ffn_w_out, *ple_w_proj, *ple_w_gate;
    float* h;
    unsigned char* ws;
};
#define WSP(type, off) ((type*)(p.ws + (off)))
#define PRM(off) (WSP(const float, WS_PRM) + (off))
constexpr long N_PRM = PR_END;
DEVFN void st_prm(const P& p, int, long g) {
    const int i = (int)g; float v;
    if (i < PR_ALOG) v = p.ab_conv_w[i - PR_ABCONV]; else if (i < PR_DTB) v = p.ab_a_log[i - PR_ALOG]; else if (i < PR_ONORM) v = p.ab_dt_bias[i - PR_DTB];
    else if (i < PR_RPB) v = p.ab_out_norm[i - PR_ONORM]; else if (i < PR_LAMBDA) v = p.ab_rpb[i - PR_RPB]; else if (i < PR_SUBLN) v = p.c_lambda[i - PR_LAMBDA];
    else if (i < PR_NORMS) v = p.c_subln[i - PR_SUBLN]; else if (i < PR_FCW) v = p.norms[i - PR_NORMS]; else if (i < PR_FCB) v = p.ffn_conv_w[i - PR_FCW]; else v = p.ffn_conv_b[i - PR_FCB];
    WSP(float, WS_PRM)[i] = v;
}
constexpr long N_INIT = (long)T * D / 4;
DEVFN void st_init(const P& p, int, long g) {
    const long i = g * 4, np = (long)NPROMPT * S * D;
    const float* src = i < np ? p.x_prompt + i : p.x_sample + (i - np);
    for (int k = 0; k < 4; ++k) p.h[i + k] = src[k];
}
constexpr long N_PB = (long)T * PLE;
DEVFN void st_pb(const P& p, int layer, long g) {
    const long np = (long)NPROMPT * S * PLE, ns = (long)(NSEQ - NPROMPT) * S * PLE;
    const float v = g < np ? p.p_prompt[(long)layer * np + g] : p.p_sample[(long)layer * ns + (g - np)];
    WSP(bf16, WS_PB + (size_t)layer * SZ_PB)[g] = f2bf(v);
}
struct WT { const float* W; bf16* O; int K, N, Npad; };
DEVFN void st_wt(const WT& w, long g) {
    const int n = (int)(g / w.K), k = (int)(g % w.K);
    w.O[g] = n < w.N ? f2bf(w.W[(size_t)k * w.N + n]) : (bf16)0;
}
constexpr long N_ROWS = T;
DEVFN void st_rowss(const P& p, const float* x, long g) {
    const float* r = x + (size_t)g * D; float s = 0.f;
    for (int c = 0; c < D; ++c) s += r[c] * r[c];
    WSP(float, WS_RSTD)[g] = 1.0f / sqrtf(s / (float)D + RMS_EPS);
}
constexpr long N_TD = (long)T * D;
DEVFN void st_norm_bf16(const P& p, const float* w, long g) {
    const long t = g / D; const int c = (int)(g % D);
    WSP(bf16, WS_HN)[g] = f2bf(p.h[g] * WSP(float, WS_RSTD)[t] * w[c]);
}
DEVFN void st_resid(const P& p, const float* y, const float* w, int write_hb, long g) {
    const long t = g / D; const int c = (int)(g % D);
    const float v = p.h[g] + y[g] * WSP(float, WS_RSTD)[t] * w[c];
    p.h[g] = v; if (write_hb) WSP(bf16, WS_HN)[g] = f2bf(v);
}
constexpr long N_TH = (long)T * NH;
DEVFN void st_dn_prep(const P& p, int layer, long g) {
    const int j = layer / 2; const long t = g / NH; const int hh = (int)(g % NH); const int tt = (int)(t % S); const long t0 = t - tt;
    const bf16* proj = WSP(bf16, WS_PROJ); const float* cw = PRM(PR_ABCONV) + (size_t)j * 5 * AQKV;
    for (int part = 0; part < 3; ++part) {
        float* o = (part == 0 ? WSP(float, WS_QN) : (part == 1 ? WSP(float, WS_KN) : WSP(float, WS_VV))) + (size_t)g * DH; float ss = 0.f;
        for (int d = 0; d < DH; ++d) {
            const int col = part * 1024 + hh * DH + d; float acc = 0.f;
            for (int i = 0; i < 5; ++i) { const int ts = tt + i - 2; if (ts >= 0 && ts < S) acc += bf2f(proj[(size_t)(t0 + ts) * ABINP + col]) * cw[i * AQKV + col]; }
            const float y = siluf(acc); ss += y * y; o[d] = y;
        }
        if (part < 2) { const float r = (1.0f / sqrtf(ss + 1e-6f)) * (part == 0 ? 0.08838834764831845f : 1.f); for (int d = 0; d < DH; ++d) o[d] *= r; }
    }
    for (int dir = 0; dir < 2; ++dir) {
        const float graw = bf2f(proj[(size_t)t * ABINP + COL_G + dir * NH + hh]), braw = bf2f(proj[(size_t)t * ABINP + COL_G + 16 + dir * NH + hh]);
        const float a = expf(PRM(PR_ALOG)[(j * 2 + dir) * NH + hh]), dtb = PRM(PR_DTB)[(j * 2 + dir) * NH + hh];
        WSP(float, WS_G)[(t * 2 + dir) * NH + hh] = -a * softplusf(graw + dtb);
        WSP(float, WS_BETA)[(t * 2 + dir) * NH + hh] = sigmoidf(braw);
    }
}
constexpr long N_SCAN = (long)NSEQ * NH * 2 * DH;
DEVFN void st_dn_scan(const P& p, int, long g) {
    const int vc = (int)(g % DH); const int dir = (int)((g / DH) % 2); const int hh = (int)((g / (2 * DH)) % NH); const int seq = (int)(g / (2 * DH * NH));
    const float *QN = WSP(float, WS_QN), *KN = WSP(float, WS_KN), *VV = WSP(float, WS_VV), *G = WSP(float, WS_G), *BT = WSP(float, WS_BETA);
    float* O = WSP(float, dir ? WS_OB : WS_OF);
    float Sx[DH];
#pragma unroll
    for (int d = 0; d < DH; ++d) Sx[d] = 0.f;
    for (int step = 0; step < S; ++step) {
        const int tt = dir ? S - 1 - step : step; const long t = (long)seq * S + tt;
        const float eg = expf(G[(t * 2 + dir) * NH + hh]), b = BT[(t * 2 + dir) * NH + hh];
        const float* kp = KN + ((size_t)t * NH + hh) * DH; const float* qp = QN + ((size_t)t * NH + hh) * DH; const float vv = VV[((size_t)t * NH + hh) * DH + vc];
        float dot = 0.f;
#pragma unroll
        for (int d0 = 0; d0 < DH; d0 += 16) { MEMFENCE();
#pragma unroll
            for (int d = d0; d < d0 + 16; ++d) { Sx[d] *= eg; dot += Sx[d] * kp[d]; } }
        const float delta = b * (vv - dot); float o = 0.f;
#pragma unroll
        for (int d0 = 0; d0 < DH; d0 += 16) { MEMFENCE();
#pragma unroll
            for (int d = d0; d < d0 + 16; ++d) { Sx[d] += kp[d] * delta; o += Sx[d] * qp[d]; } }
        MEMFENCE();
        O[((size_t)t * NH + hh) * DH + vc] = o;
    }
}
DEVFN void st_dn_out(const P& p, int layer, long g) {
    const int j = layer / 2; const long t = g / NH; const int hh = (int)(g % NH);
    const float *OF = WSP(float, WS_OF) + (size_t)g * DH, *OB = WSP(float, WS_OB) + (size_t)g * DH; const float* on = PRM(PR_ONORM) + j * DH;
    float ss = 0.f; for (int d = 0; d < DH; ++d) { const float o = OF[d] + OB[d]; ss += o * o; }
    const float r = 1.0f / sqrtf(ss / (float)DH + RMS_EPS);
    const bf16* z = WSP(bf16, WS_PROJ) + (size_t)t * ABINP + COL_Z + hh * DH; bf16* out = WSP(bf16, WS_MIXIN) + (size_t)t * ABMIX + hh * DH;
    for (int d = 0; d < DH; ++d) out[d] = f2bf((OF[d] + OB[d]) * r * on[d] * siluf(bf2f(z[d])));
}
constexpr long N_THD = (long)T * NH * DH;
DEVFN long na_key_token(long t, int jw, int& dr, int& dc) {
    const int tt = (int)(t % S); const long t0 = t - tt; const int r = tt / GW, c = tt % GW;
    const int rs = clampi(r - WR / 2, 0, ROWS - WR), cs = clampi(c - NAC / 2, 0, GW - NAC);
    const int rk = rs + jw / NAC, ck = cs + jw % NAC;
    dr = rk - r + NAR - 1; dc = clampi(ck - c + NAC - 1, 0, 2 * NAC - 2);
    return t0 + (long)rk * GW + ck;
}
DEVFN void st_na_scores(const P& p, int layer, long g) {
    const int j = layer / 2; const int jw = (int)(g % DH); const int hh = (int)((g / DH) % NH); const long t = g / (DH * NH);
    int dr, dc; const long tk = na_key_token(t, jw, dr, dc);
    const bf16* q = WSP(bf16, WS_PROJ) + (size_t)t * ABINP + COL_QB + hh * DH; const bf16* k = WSP(bf16, WS_PROJ) + (size_t)tk * ABINP + COL_KB + hh * DH;
    float dot = 0.f; for (int d = 0; d < DH; ++d) dot += bf2f(q[d]) * bf2f(k[d]);
    WSP(float, WS_NASC)[g] = dot * 0.08838834764831845f + PRM(PR_RPB)[(((size_t)j * NH + hh) * (2 * NAR - 1) + dr) * (2 * NAC - 1) + dc];
}
DEVFN void st_na_out(const P& p, int, long g) {
    const int d = (int)(g % DH); const int hh = (int)((g / DH) % NH); const long t = g / (DH * NH);
    const float* sc = WSP(float, WS_NASC) + ((size_t)t * NH + hh) * DH;
    float m = sc[0]; for (int jw = 1; jw < WR * NAC; ++jw) m = fmaxf(m, sc[jw]);
    float l = 0.f, o = 0.f;
    for (int jw = 0; jw < WR * NAC; ++jw) { int dr, dc; const long tk = na_key_token(t, jw, dr, dc); const float e = expf(sc[jw] - m); l += e;
        o += e * bf2f(WSP(bf16, WS_PROJ)[(size_t)tk * ABINP + COL_VB + hh * DH + d]); }
    WSP(bf16, WS_MIXIN)[(size_t)t * ABMIX + 1024 + hh * DH + d] = f2bf(o / l);
}
DEVFN float lambda_init_of(int layer) { return 0.8f - 0.6f * expf(-0.3f * (float)layer); }
DEVFN void st_lam(const P& p, int layer, long) {
    const float* lp = PRM(PR_LAMBDA) + (size_t)(layer / 2) * 4 * DH; float a = 0.f, b = 0.f;
    for (int d = 0; d < DH; ++d) { a += lp[d] * lp[DH + d]; b += lp[2 * DH + d] * lp[3 * DH + d]; }
    const float li = lambda_init_of(layer); WSP(float, WS_LAM)[0] = expf(a) - expf(b) + li; WSP(float, WS_LAM)[1] = li;
}
constexpr long N_ROPE = (long)T * 2 * 16 * 16;
DEVFN void st_rope(const P& p, int, long g) {
    const int i = (int)(g % 16); const int hj = (int)((g / 16) % 16); const int which = (int)((g / 256) % 2); const long t = g / 512;
    bf16* x = WSP(bf16, WS_PROJ) + (size_t)t * CIN + which * 2048 + hj * DH;
    const float inv = powf(500000.0f, -(float)(2 * i) / 32.0f); const float ang = (float)(t % S) * inv; const float cs = cosf(ang), sn = sinf(ang);
    const float x1 = bf2f(x[i]), x2 = bf2f(x[16 + i]);
    x[i] = f2bf(x1 * cs - x2 * sn); x[16 + i] = f2bf(x2 * cs + x1 * sn);
}
constexpr int DA_E = 64;
constexpr long N_DATT = (long)NSEQ * NH * 2 * (256 / DA_E) * S;
DEVFN void st_dattn(const P& p, int, long g) {
    const int qi = (int)(g % S); long r = g / S; const int es = (int)(r % (256 / DA_E)); r /= (256 / DA_E); const int jj = (int)(r % 2); r /= 2; const int hh = (int)(r % NH); const int seq = (int)(r / NH);
    const bf16* proj = WSP(bf16, WS_PROJ); const long t = (long)seq * S + qi;
    float q[DH];
#pragma unroll
    for (int d = 0; d < DH; ++d) q[d] = bf2f(proj[(size_t)t * CIN + hh * 256 + jj * DH + d]) * 0.08838834764831845f;
    float o[DA_E];
#pragma unroll
    for (int e = 0; e < DA_E; ++e) o[e] = 0.f;
    float m = -1e30f, l = 0.f;
    for (int kk = 0; kk < S; ++kk) {
        const bf16* kr = proj + (size_t)((long)seq * S + kk) * CIN + 2048 + hh * 256 + jj * DH; const bf16* vr = proj + (size_t)((long)seq * S + kk) * CIN + 4096 + hh * 256 + es * DA_E;
        float s = 0.f;
#pragma unroll
        for (int d0 = 0; d0 < DH; d0 += 32) { MEMFENCE();
#pragma unroll
            for (int d = d0; d < d0 + 32; ++d) s += q[d] * bf2f(kr[d]); }
        MEMFENCE();
        const float mn = fmaxf(m, s), al = expf(m - mn), pe = expf(s - mn); m = mn; l = l * al + pe;
#pragma unroll
        for (int e = 0; e < DA_E; ++e) o[e] = o[e] * al + pe * bf2f(vr[e]);
    }
    float* O = WSP(float, jj ? WS_O1 : WS_O0) + (size_t)t * 2048 + hh * 256 + es * DA_E; const float il = 1.0f / l;
#pragma unroll
    for (int e = 0; e < DA_E; ++e) O[e] = o[e] * il;
}
DEVFN void st_c_out(const P& p, int layer, long g) {
    const int j = layer / 2; const long t = g / NH; const int hh = (int)(g % NH); const float lam = WSP(float, WS_LAM)[0], li = WSP(float, WS_LAM)[1];
    const float *O0 = WSP(float, WS_O0) + (size_t)t * 2048 + hh * 256, *O1 = WSP(float, WS_O1) + (size_t)t * 2048 + hh * 256; const float* sw = PRM(PR_SUBLN) + j * 256;
    float ss = 0.f; for (int e = 0; e < 256; ++e) { const float o = O0[e] - lam * O1[e]; ss += o * o; }
    const float r = (1.0f / sqrtf(ss / 256.0f + RMS_EPS)) * (1.0f - li);
    bf16* out = WSP(bf16, WS_MIXIN) + (size_t)t * 2048 + hh * 256;
    for (int e = 0; e < 256; ++e) out[e] = f2bf((O0[e] - lam * O1[e]) * r * sw[e]);
}
constexpr long N_ACT = (long)T * DFF;
DEVFN float gelu_tanh(float x) { return 0.5f * x * (1.0f + tanhf(0.7978845608028654f * (x + 0.044715f * x * x * x))); }
DEVFN void st_ffn_act(const P& p, int layer, long g) {
    const long t = g / DFF; const int c = (int)(g % DFF); const int tt = (int)(t % S);
    const bf16* hid = WSP(bf16, WS_HID); const float* cw = PRM(PR_FCW) + (size_t)layer * 3 * 2 * DFF; const float* cb = PRM(PR_FCB) + (size_t)layer * 2 * DFF;
    float ga = cb[c], up = cb[DFF + c];
    for (int i = 0; i < 3; ++i) { const int ts = tt + i - 1; if (ts >= 0 && ts < S) { const bf16* r = hid + (size_t)(t - tt + ts) * (2 * DFF);
        ga += bf2f(r[c]) * cw[i * 2 * DFF + c]; up += bf2f(r[DFF + c]) * cw[i * 2 * DFF + DFF + c]; } }
    WSP(bf16, WS_ACT)[g] = f2bf(gelu_tanh(ga) * up);
}
DEVFN void st_ple(const P& p, int, long g) { p.h[g] += sigmoidf(WSP(float, WS_GOUT)[g]) * WSP(float, WS_GOUT2)[g]; }
#ifndef EMU
namespace pg8 {
#define PG8_LAS __attribute__((address_space(3)))
typedef unsigned short bf16_t;
typedef short bf16x8 __attribute__((ext_vector_type(8)));
typedef float f32x4 __attribute__((ext_vector_type(4)));
typedef unsigned u32x4 __attribute__((ext_vector_type(4)));
constexpr int BM = 256, BK = 64, HALF = 128, HTB = HALF * BK * 2  , STAGE_BYTES = 8 * HTB, NXCD = 8, WGM = 4;

__host__ __device__ __forceinline__ int lds_byte(int r, int c) { const int st = (r >> 4) * 2 + (c >> 5), rr = r & 15, cc = c & 31, ob = rr * 64 + cc * 2; return st * 1024 + (ob ^ (((ob >> 9) & 1) << 5)); }
__host__ __device__ __forceinline__ void stage_rc(int b, int& R, int& C) { const int st = b / 1024, sb = b % 1024, swz = sb ^ (((sb >> 9) & 1) << 5); R = (st >> 1) * 16 + swz / 64; C = (st & 1) * 32 + (swz % 64) / 2; }
__host__ __device__ __forceinline__ int perm32(int rho) { const int n = rho >> 4, i = rho & 15; return 8 * (i >> 2) + 4 * n + (i & 3); }

struct Unit { int pm, pn; };
struct Gemm { const bf16_t* A; const bf16_t* Bt; int M, N, K; };

struct StaticOrder {
    int nM, nN, nwg, G, c;
    __host__ __device__ void init(int M, int N, int G_, int c_) { nM = M / BM; nN = N / BM; nwg = nM * nN; G = G_; c = c_; }
    __host__ __device__ bool next(int i, Unit& u) const {
        const long L = (long)i * G + c; if (L >= nwg) return false;
        int wgid = (int)L; { const int q = nwg / NXCD, r = nwg % NXCD, xcd = wgid % NXCD, off = wgid / NXCD; wgid = (xcd < r ? xcd * (q + 1) : r * (q + 1) + (xcd - r) * q) + off; }
        const int nig = WGM * nN, gid = wgid / nig, fm = gid * WGM, gsz = (nM - fm) < WGM ? (nM - fm) : WGM;
        u.pm = fm + ((wgid % nig) % gsz); u.pn = (wgid % nig) / gsz; return true;
    }
    __device__ __forceinline__ void a_ready(const Unit&) const {}
    __device__ __forceinline__ void done(const Unit&) const {}
};

__device__ __forceinline__ unsigned cvt_pk_bf16(float lo, float hi) { unsigned r; asm volatile("v_cvt_pk_bf16_f32 %0, %1, %2" : "=v"(r) : "v"(lo), "v"(hi)); return r; }
struct EpiBf16 {
    static constexpr bool PERM = true, AFTER_DRAIN = false;
    bf16_t* O; int ldc;
    __device__ __forceinline__ void operator()(const f32x4 (&acc)[2][2][4][2], const Unit& u, int wr, int wc, int fr, int fq) const {
        const int row0 = u.pm * BM + wr * 64 + fr; const int col0 = u.pn * BM + wc * 32 + 8 * fq;
#pragma unroll
        for (int ai = 0; ai < 2; ++ai)
#pragma unroll
            for (int m = 0; m < 4; ++m) { bf16_t* rowp = O + (size_t)(row0 + ai * HALF + m * 16) * ldc + col0;
#pragma unroll
                for (int bj = 0; bj < 2; ++bj) { const f32x4 v0 = acc[ai][bj][m][0], v1 = acc[ai][bj][m][1];
                    u32x4 w; w.x = cvt_pk_bf16(v0[0], v0[1]); w.y = cvt_pk_bf16(v0[2], v0[3]); w.z = cvt_pk_bf16(v1[0], v1[1]); w.w = cvt_pk_bf16(v1[2], v1[3]);
                    *(u32x4*)(rowp + bj * HALF) = w; } }
    }
};
struct EpiBf16Ro {
    static constexpr bool PERM = true, AFTER_DRAIN = false;
    bf16_t* O; int ldc; const float* tab; int seqlen;
    __device__ __forceinline__ void operator()(const f32x4 (&acc)[2][2][4][2], const Unit& u, int wr, int wc, int fr, int fq) const {
        const int row0 = u.pm * BM + wr * 64 + fr; const int col0 = u.pn * BM + wc * 32 + 8 * fq;
        const bool rope = tab != nullptr && u.pn < 16 && wc == 0;
        f32x4 cN[4] = {};
#define RO_LOAD(r_) do { const float* cs_ = tab + ((size_t)((r_) % seqlen) * 16 + 8 * (fq & 1)) * 2; cN[0] = *(const f32x4*)cs_; cN[1] = *(const f32x4*)(cs_ + 4); cN[2] = *(const f32x4*)(cs_ + 8); cN[3] = *(const f32x4*)(cs_ + 12); } while (0)
        if (rope) RO_LOAD(row0);
#pragma unroll
        for (int ai = 0; ai < 2; ++ai)
#pragma unroll
            for (int m = 0; m < 4; ++m) { const int row = row0 + ai * HALF + m * 16; bf16_t* rowp = O + (size_t)row * ldc + col0;
                const f32x4 c0 = cN[0], c1 = cN[1], c2 = cN[2], c3 = cN[3];
                if (rope && (ai * 4 + m) < 7) RO_LOAD(row0 + (m == 3 ? HALF : ai * HALF + (m + 1) * 16));
#pragma unroll
                for (int bj = 0; bj < 2; ++bj) { f32x4 v0 = acc[ai][bj][m][0], v1 = acc[ai][bj][m][1];
                    if (rope) { const float sgn = fq < 2 ? -1.f : 1.f;
#pragma unroll
                        for (int e = 0; e < 4; ++e) { const float o0 = __shfl_xor(v0[e], 32), o1 = __shfl_xor(v1[e], 32);
                            const float cs0 = (e < 2 ? c0 : c1)[2 * (e & 1)], sn0 = (e < 2 ? c0 : c1)[2 * (e & 1) + 1], cs1 = (e < 2 ? c2 : c3)[2 * (e & 1)], sn1 = (e < 2 ? c2 : c3)[2 * (e & 1) + 1];
                            v0[e] = v0[e] * cs0 + sgn * o0 * sn0; v1[e] = v1[e] * cs1 + sgn * o1 * sn1; } }
                    u32x4 w; w.x = cvt_pk_bf16(v0[0], v0[1]); w.y = cvt_pk_bf16(v0[2], v0[3]); w.z = cvt_pk_bf16(v1[0], v1[1]); w.w = cvt_pk_bf16(v1[2], v1[3]);
                    *(u32x4*)(rowp + bj * HALF) = w; } }
    }
};
#undef RO_LOAD
__device__ __forceinline__ float dpp_prev(float oldv, float x) { return __int_as_float(__builtin_amdgcn_update_dpp(__float_as_int(oldv), __float_as_int(x), 0x111, 0xf, 0xf, false)); }
__device__ __forceinline__ float dpp_next(float oldv, float x) { return __int_as_float(__builtin_amdgcn_update_dpp(__float_as_int(oldv), __float_as_int(x), 0x101, 0xf, 0xf, false)); }
__device__ __forceinline__ float dpp_ror1(float x) { return __int_as_float(__builtin_amdgcn_update_dpp(__float_as_int(x), __float_as_int(x), 0x121, 0xf, 0xf, false)); }
__device__ __forceinline__ float dpp_rol1(float x) { return __int_as_float(__builtin_amdgcn_update_dpp(__float_as_int(x), __float_as_int(x), 0x12F, 0xf, 0xf, false)); }
__device__ __forceinline__ void conv3_pair(float& cg, float& cu, float xg, float xu, float egp, float egn, float eup, float eun,
                                           float wg0, float wg1, float wg2, float wu0, float wu1, float wu2, float bg, float bu, unsigned long long m15, unsigned long long m0) {
    float t0, t1, t2, t3;
    asm("v_cndmask_b32_e64 %[t0], %[xg], %[egp], %[m15]\n\t"
        "v_cndmask_b32_e64 %[t1], %[xg], %[egn], %[m0]\n\t"
        "v_cndmask_b32_e64 %[t2], %[xu], %[eup], %[m15]\n\t"
        "v_cndmask_b32_e64 %[t3], %[xu], %[eun], %[m0]\n\t"
        "v_fma_f32 %[cg], %[wg1], %[xg], %[bg]\n\t"
        "v_fma_f32 %[cu], %[wu1], %[xu], %[bu]\n\t"
        "v_fmac_f32_dpp %[cg], %[t0], %[wg0] row_ror:1 row_mask:0xf bank_mask:0xf\n\t"
        "v_fmac_f32_dpp %[cg], %[t1], %[wg2] row_ror:15 row_mask:0xf bank_mask:0xf\n\t"
        "v_fmac_f32_dpp %[cu], %[t2], %[wu0] row_ror:1 row_mask:0xf bank_mask:0xf\n\t"
        "v_fmac_f32_dpp %[cu], %[t3], %[wu2] row_ror:15 row_mask:0xf bank_mask:0xf"
        : [cg] "=&v"(cg), [cu] "=&v"(cu), [t0] "=&v"(t0), [t1] "=&v"(t1), [t2] "=&v"(t2), [t3] "=&v"(t3)
        : [xg] "v"(xg), [xu] "v"(xu), [egp] "v"(egp), [egn] "v"(egn), [eup] "v"(eup), [eun] "v"(eun), [wg0] "v"(wg0), [wg1] "v"(wg1), [wg2] "v"(wg2), [wu0] "v"(wu0), [wu1] "v"(wu1), [wu2] "v"(wu2),
          [bg] "v"(bg), [bu] "v"(bu), [m15] "s"(m15), [m0] "s"(m0));
}
__device__ __forceinline__ float gelu_t(float x) { const float u = 0.7978845608028654f * (x + 0.044715f * x * x * x); return x * __builtin_amdgcn_rcpf(1.0f + __builtin_amdgcn_exp2f(-2.885390081777927f * u)); }
struct EpiConvAct {
    static constexpr bool PERM = true, AFTER_DRAIN = false;
    bf16_t* ACT; float* HALO; float* HDUMP; const float* cw; const float* cb; PG8_LAS float* EX;
    __device__ __forceinline__ void operator()(const f32x4 (&acc)[2][2][4][2], const Unit& u, int wr, int wc, int fr, int fq) const {
        const int ch0 = u.pn * 128 + wc * 32 + 8 * fq;
        PG8_LAS float* WL = EX + 2560; const int t_ = ((wr * 4 + wc) << 6) | (fq * 16 + fr); float wv[2];
#pragma unroll
        for (int j = 0; j < 2; ++j) { const int idx = t_ + 512 * j, r = idx >> 7, c = idx & 127; const float* src = r < 6 ? cw + (size_t)(r >> 1) * 2 * DFF + (r & 1) * DFF : cb + (r & 1) * DFF; wv[j] = src[u.pn * 128 + c]; }
#pragma unroll
        for (int ai = 0; ai < 2; ++ai) { const int sg = 2 * ai + wr;
            PG8_LAS float* d0 = EX + ((fr == 0) ? ((((sg * 2 + 0) * 4 + wc) * 4 + fq) * 16) : (2048 + wc * 64 + fq * 16));
            PG8_LAS float* d1 = EX + ((fr == 15) ? ((((sg * 2 + 1) * 4 + wc) * 4 + fq) * 16) : (2048 + wc * 64 + fq * 16));
#pragma unroll
            for (int bj = 0; bj < 2; ++bj)
#pragma unroll
                for (int n = 0; n < 2; ++n) { *(PG8_LAS f32x4*)(d0 + (bj * 2 + n) * 4) = acc[ai][bj][0][n]; *(PG8_LAS f32x4*)(d1 + (bj * 2 + n) * 4) = acc[ai][bj][3][n]; } }
        if (wr == 0) { float* hp = (fr < 2) ? HALO + (((size_t)u.pm * 4 + fr) * 2) * DFF + ch0 : HDUMP + (size_t)(wc * 4 + fq) * 16;
            const size_t bs = (fr < 2) ? (size_t)DFF : (size_t)8;
#pragma unroll
            for (int bj = 0; bj < 2; ++bj)
#pragma unroll
                for (int n = 0; n < 2; ++n) *(f32x4*)(hp + bj * bs + 4 * n) = acc[0][bj][0][n]; }
        else { float* hp = (fr >= 14) ? HALO + (((size_t)u.pm * 4 + 2 + (fr - 14)) * 2) * DFF + ch0 : HDUMP + (size_t)(wc * 4 + fq) * 16;
            const size_t bs = (fr >= 14) ? (size_t)DFF : (size_t)8;
#pragma unroll
            for (int bj = 0; bj < 2; ++bj)
#pragma unroll
                for (int n = 0; n < 2; ++n) *(f32x4*)(hp + bj * bs + 4 * n) = acc[1][bj][3][n]; }
        WL[t_] = wv[0]; WL[t_ + 512] = wv[1];
        asm volatile("s_waitcnt lgkmcnt(0)" ::: "memory"); __builtin_amdgcn_s_barrier(); asm volatile("" ::: "memory");
        const unsigned long long m15 = __ballot(fr == 15), m0 = __ballot(fr == 0);
        unsigned W[2][4][4];
#pragma unroll
        for (int n = 0; n < 2; ++n)
#pragma unroll
            for (int e2 = 0; e2 < 4; e2 += 2) {
                float wg[3][2], wu[3][2], bg[2], bu[2];
#pragma unroll
                for (int k = 0; k < 2; ++k) { const int cl = wc * 32 + 8 * fq + 4 * n + e2 + k;
#pragma unroll
                    for (int t = 0; t < 3; ++t) { wg[t][k] = WL[(2 * t) * 128 + cl]; wu[t][k] = WL[(2 * t + 1) * 128 + cl]; }
                    bg[k] = WL[6 * 128 + cl]; bu[k] = WL[7 * 128 + cl]; }
#pragma unroll
                for (int ai = 0; ai < 2; ++ai) { const int sg = 2 * ai + wr;
                    float pg[2] = {0.f, 0.f}, pu[2] = {0.f, 0.f}, ng[2] = {0.f, 0.f}, nu[2] = {0.f, 0.f};
                    if (sg > 0) { const PG8_LAS float* d = EX + ((((sg - 1) * 2 + 1) * 4 + wc) * 4 + fq) * 16 + n * 4 + e2; pg[0] = d[0]; pg[1] = d[1]; pu[0] = d[8]; pu[1] = d[9]; }
                    if (sg < 3) { const PG8_LAS float* d = EX + ((((sg + 1) * 2 + 0) * 4 + wc) * 4 + fq) * 16 + n * 4 + e2; ng[0] = d[0]; ng[1] = d[1]; nu[0] = d[8]; nu[1] = d[9]; }
#pragma unroll
                    for (int m = 0; m < 4; ++m) { float o[2];
#pragma unroll
                        for (int k = 0; k < 2; ++k) { const int e = e2 + k;
                            const float xg = acc[ai][0][m][n][e], xu = acc[ai][1][m][n][e];
                            const float bg_p = m > 0 ? acc[ai][0][m - 1][n][e] : pg[k], bu_p = m > 0 ? acc[ai][1][m - 1][n][e] : pu[k];
                            const float bg_n = m < 3 ? acc[ai][0][m + 1][n][e] : ng[k], bu_n = m < 3 ? acc[ai][1][m + 1][n][e] : nu[k];
                            float cg, cu; conv3_pair(cg, cu, xg, xu, bg_p, bg_n, bu_p, bu_n, wg[0][k], wg[1][k], wg[2][k], wu[0][k], wu[1][k], wu[2][k], bg[k], bu[k], m15, m0);
                            o[k] = gelu_t(cg) * cu; }
                        W[ai][m][n * 2 + (e2 >> 1)] = cvt_pk_bf16(o[0], o[1]); } }
            }
        const int row0 = u.pm * BM + wr * 64 + fr;
#pragma unroll
        for (int ai = 0; ai < 2; ++ai)
#pragma unroll
            for (int m = 0; m < 4; ++m) { u32x4 w; w.x = W[ai][m][0]; w.y = W[ai][m][1]; w.z = W[ai][m][2]; w.w = W[ai][m][3];
                *(u32x4*)(ACT + (size_t)(row0 + ai * HALF + m * 16) * DFF + ch0) = w; }
    }
};
struct EpiF32 {
    static constexpr bool PERM = false, AFTER_DRAIN = false;
    float* C; int ldc;
    __device__ __forceinline__ void operator()(const f32x4 (&acc)[2][2][4][2], const Unit& u, int wr, int wc, int fr, int fq) const {
        const int row0 = u.pm * BM + wr * 64 + fr, col0 = u.pn * BM + wc * 32 + 4 * fq;
#pragma unroll
        for (int ai = 0; ai < 2; ++ai)
#pragma unroll
            for (int m = 0; m < 4; ++m) { float* rowp = C + (size_t)(row0 + ai * HALF + m * 16) * ldc + col0;
#pragma unroll
                for (int bj = 0; bj < 2; ++bj)
#pragma unroll
                    for (int n = 0; n < 2; ++n) *(f32x4*)(rowp + bj * HALF + n * 16) = acc[ai][bj][m][n]; }
    }
};
template <class Epi, class Sched, bool ALIGN_EPI = false, bool SP2 = false>
__device__ __forceinline__ void gemm_phase(PG8_LAS unsigned char* lds, const Gemm g, const Sched& S, const Epi& E, int tid_in) {
    int tid_ = tid_in; asm volatile("" : "+v"(tid_));
    const int tid = tid_, wid = __builtin_amdgcn_readfirstlane(tid >> 6), lane = tid & 63, wr = wid >> 2, wc = wid & 3, fr = lane & 15, fq = lane >> 4;
    const int K = g.K, nt = K / BK;
    unsigned voffA[2], voffB[2];
#pragma unroll
    for (int i = 0; i < 2; ++i) { int R, C; stage_rc(tid * 16 + i * 8192, R, C); const int Rb = Epi::PERM ? ((R & ~31) + perm32(R & 31)) : R;
        voffA[i] = (unsigned)(R * K + C) * 2u; voffB[i] = (unsigned)(Rb * K + C) * 2u; }
    const size_t kstep = (size_t)(BK * 2);
    const size_t hstep = (size_t)HALF * K * 2;
    const size_t tstep = 2 * hstep;
    const unsigned ldsw = (unsigned)wid * 1024u;
    const int aoff = lds_byte(wr * 64 + fr, fq * 8), boff = lds_byte(wc * 32 + fr, fq * 8);
#define PG8_SA(b, h) (((b) * 2 + (h)) * HTB)
#define PG8_SB(b, h) ((4 + (b) * 2 + (h)) * HTB)
#define PG8_STAGE(bufoff, gbase, voff) do { _Pragma("unroll") for (int _i = 0; _i < 2; ++_i) \
        __builtin_amdgcn_global_load_lds((const unsigned*)((const char*)(gbase) + (voff)[_i]), (PG8_LAS unsigned*)(lds + (bufoff) + ldsw + _i * 8192), 16, 0, 0); } while (0)
#define PG8_LDA(dst, b, h) do { _Pragma("unroll") for (int m = 0; m < 4; ++m) _Pragma("unroll") for (int k = 0; k < 2; ++k) dst[m][k] = *(const PG8_LAS bf16x8*)(lds + PG8_SA(b, h) + aoff + m * 2048 + k * 1024); } while (0)
#define PG8_LDB(dst, b, h) do { _Pragma("unroll") for (int n = 0; n < 2; ++n) _Pragma("unroll") for (int k = 0; k < 2; ++k) dst[n][k] = *(const PG8_LAS bf16x8*)(lds + PG8_SB(b, h) + boff + n * 2048 + k * 1024); } while (0)
#define PG8_MMA(ai, bj, At, Bt) do { __builtin_amdgcn_s_setprio(1); _Pragma("unroll") for (int m = 0; m < 4; ++m) _Pragma("unroll") for (int n = 0; n < 2; ++n) _Pragma("unroll") for (int k = 0; k < 2; ++k) \
        acc[ai][bj][m][n] = __builtin_amdgcn_mfma_f32_16x16x32_bf16(Bt[n][k], At[m][k], acc[ai][bj][m][n], 0, 0, 0); __builtin_amdgcn_s_setprio(0); } while (0)
#define PG8_WAIT_V(n) asm volatile("s_waitcnt vmcnt(" #n ")" ::: "memory")
#define PG8_WAIT_L(n) asm volatile("s_waitcnt lgkmcnt(" #n ")" ::: "memory")
#define PG8_BAR __builtin_amdgcn_s_barrier()
#define PG8_SCHED __builtin_amdgcn_sched_barrier(0)
    Unit cur, nxt; int ui = 0;
    if (!S.next(0, cur)) return;
    f32x4 acc[2][2][4][2];
#pragma unroll
    for (int a = 0; a < 2; ++a)
#pragma unroll
        for (int b = 0; b < 2; ++b)
#pragma unroll
            for (int m = 0; m < 4; ++m)
#pragma unroll
                for (int n = 0; n < 2; ++n) acc[a][b][m][n] = (f32x4){0.f, 0.f, 0.f, 0.f};
    bf16x8 At[4][2], B0[2][2], B1[2][2];
    const char* cA = (const char*)g.A + (size_t)cur.pm * tstep; const char* cB = (const char*)g.Bt + (size_t)cur.pn * tstep;
    S.a_ready(cur);
    if constexpr (SP2) {
        PG8_STAGE(PG8_SB(0, 0), cB, voffB); PG8_STAGE(PG8_SB(0, 1), cB + hstep, voffB); PG8_STAGE(PG8_SA(0, 0), cA, voffA); PG8_STAGE(PG8_SA(0, 1), cA + hstep, voffA);
        if (wr == 1) PG8_BAR;
        PG8_WAIT_V(2); PG8_BAR;
        PG8_STAGE(PG8_SB(1, 0), cB + kstep, voffB); PG8_STAGE(PG8_SA(1, 0), cA + kstep, voffA); PG8_STAGE(PG8_SB(1, 1), cB + hstep + kstep, voffB);
        PG8_WAIT_V(6); PG8_BAR;
    } else {
        PG8_STAGE(PG8_SB(0, 0), cB, voffB); PG8_STAGE(PG8_SA(0, 0), cA, voffA); PG8_STAGE(PG8_SB(0, 1), cB + hstep, voffB); PG8_STAGE(PG8_SA(0, 1), cA + hstep, voffA);
        if (wr == 1) PG8_BAR;
        PG8_WAIT_V(4); PG8_BAR;
        PG8_STAGE(PG8_SB(1, 0), cB + kstep, voffB); PG8_STAGE(PG8_SA(1, 0), cA + kstep, voffA); PG8_STAGE(PG8_SB(1, 1), cB + hstep + kstep, voffB);
        PG8_WAIT_V(6); PG8_BAR;
    }
    for (;;) {
        const bool has_next = S.next(ui + 1, nxt);
        const char* nA = has_next ? (const char*)g.A + (size_t)nxt.pm * tstep : cA; const char* nB = has_next ? (const char*)g.Bt + (size_t)nxt.pn * tstep : cB;
        for (int t = 0; t < nt; t += 2) {
            const bool last = (t == nt - 2);
            const char* a1 = cA + (size_t)(t + 1) * kstep;
            const char* a2 = last ? nA : cA + (size_t)(t + 2) * kstep; const char* b2 = last ? nB : cB + (size_t)(t + 2) * kstep;
            const char* a3 = a2 + kstep; const char* b3 = b2 + kstep;
            if (last && has_next) S.a_ready(nxt);
            if constexpr (SP2) {
            PG8_LDB(B0, 0, 0); PG8_LDB(B1, 0, 1); PG8_SCHED; PG8_LDA(At, 0, 0); PG8_STAGE(PG8_SA(1, 1), a1 + hstep, voffA);
            PG8_WAIT_V(8); PG8_WAIT_L(0); PG8_BAR; PG8_MMA(0, 0, At, B0); PG8_MMA(0, 1, At, B1); PG8_BAR; PG8_SCHED;
            PG8_LDA(At, 0, 1); PG8_STAGE(PG8_SB(0, 0), b2, voffB); PG8_STAGE(PG8_SB(0, 1), b2 + hstep, voffB); PG8_STAGE(PG8_SA(0, 0), a2, voffA);
            PG8_WAIT_V(8); PG8_WAIT_L(0); PG8_BAR; PG8_MMA(1, 0, At, B0); PG8_MMA(1, 1, At, B1); PG8_BAR; PG8_SCHED;
            PG8_LDB(B0, 1, 0); PG8_LDB(B1, 1, 1); PG8_SCHED; PG8_LDA(At, 1, 0); PG8_STAGE(PG8_SA(0, 1), a2 + hstep, voffA);
            PG8_WAIT_V(8); PG8_WAIT_L(0); PG8_BAR; PG8_MMA(0, 0, At, B0); PG8_MMA(0, 1, At, B1); PG8_BAR; PG8_SCHED;
            PG8_LDA(At, 1, 1); PG8_STAGE(PG8_SB(1, 0), b3, voffB); PG8_STAGE(PG8_SB(1, 1), b3 + hstep, voffB); PG8_STAGE(PG8_SA(1, 0), a3, voffA);
            PG8_WAIT_V(8); PG8_WAIT_L(0); PG8_BAR; PG8_MMA(1, 0, At, B0); PG8_MMA(1, 1, At, B1); PG8_BAR; PG8_SCHED;
            } else {
            PG8_LDB(B0, 0, 0); PG8_SCHED; PG8_LDA(At, 0, 0); PG8_STAGE(PG8_SA(1, 1), a1 + hstep, voffA);
            PG8_WAIT_L(8); PG8_BAR; PG8_WAIT_L(0); PG8_MMA(0, 0, At, B0); PG8_BAR; PG8_SCHED;
            PG8_LDB(B1, 0, 1); PG8_STAGE(PG8_SB(0, 0), b2, voffB);
            PG8_BAR; PG8_WAIT_L(0); PG8_MMA(0, 1, At, B1); PG8_BAR;
            PG8_LDA(At, 0, 1); PG8_STAGE(PG8_SA(0, 0), a2, voffA);
            PG8_BAR; PG8_WAIT_L(0); PG8_MMA(1, 0, At, B0); PG8_BAR; PG8_SCHED;
            PG8_STAGE(PG8_SB(0, 1), b2 + hstep, voffB);
            PG8_WAIT_V(6); PG8_BAR; PG8_MMA(1, 1, At, B1); PG8_BAR;
            PG8_LDB(B0, 1, 0); PG8_SCHED; PG8_LDA(At, 1, 0); PG8_STAGE(PG8_SA(0, 1), a2 + hstep, voffA);
            PG8_WAIT_L(8); PG8_BAR; PG8_WAIT_L(0); PG8_MMA(0, 0, At, B0); PG8_BAR; PG8_SCHED;
            PG8_LDB(B1, 1, 1); PG8_STAGE(PG8_SB(1, 0), b3, voffB);
            PG8_BAR; PG8_WAIT_L(0); PG8_MMA(0, 1, At, B1); PG8_BAR;
            PG8_LDA(At, 1, 1); PG8_STAGE(PG8_SA(1, 0), a3, voffA);
            PG8_BAR; PG8_WAIT_L(0); PG8_MMA(1, 0, At, B0); PG8_BAR; PG8_SCHED;
            PG8_STAGE(PG8_SB(1, 1), b3 + hstep, voffB);
            PG8_WAIT_V(6); PG8_BAR; PG8_MMA(1, 1, At, B1); PG8_BAR;
            }
        }
        if constexpr (ALIGN_EPI) { if (wr == 0) PG8_BAR; }
        if constexpr (!Epi::AFTER_DRAIN) { E(acc, cur, wr, wc, fr, fq); S.done(cur); }
        if (!has_next) break;
#pragma unroll
        for (int a = 0; a < 2; ++a)
#pragma unroll
            for (int b = 0; b < 2; ++b)
#pragma unroll
                for (int m = 0; m < 4; ++m)
#pragma unroll
                    for (int n = 0; n < 2; ++n) acc[a][b][m][n] = (f32x4){0.f, 0.f, 0.f, 0.f};
        cur = nxt; cA = nA; cB = nB; ++ui;
        if constexpr (ALIGN_EPI) { if (wr == 1) PG8_BAR; }
    }
    PG8_WAIT_V(0);
    if constexpr (!ALIGN_EPI) { if (wr == 0) PG8_BAR; }
    PG8_BAR;
    if constexpr (Epi::AFTER_DRAIN) { E.fused(acc, cur, wr, wc, fr, fq, lds, wid, lane); S.done(cur); }
#undef PG8_SA
#undef PG8_SB
#undef PG8_STAGE
#undef PG8_LDA
#undef PG8_LDB
#undef PG8_MMA
#undef PG8_WAIT_V
#undef PG8_WAIT_L
#undef PG8_BAR
#undef PG8_SCHED
}
}
#endif
enum { ST_PRM = 100, ST_INIT = 0, ST_PB, ST_WT, ST_ROWSS, ST_NORM, ST_RESID, ST_DNPREP, ST_DNSCAN, ST_DNOUT, ST_NASC, ST_NAOUT, ST_LAM, ST_ROPE, ST_DATTN, ST_COUT, ST_FFNACT, ST_PLE };
struct Job { P p; WT w; const float* a; const float* b; long n; int layer; int flag; };
template <int ST> DEVFN void run_item(const Job& j, long g) {
    if constexpr (ST == ST_PRM) st_prm(j.p, j.layer, g);
    else if constexpr (ST == ST_INIT) st_init(j.p, j.layer, g);
    else if constexpr (ST == ST_PB) st_pb(j.p, j.layer, g);
    else if constexpr (ST == ST_WT) st_wt(j.w, g);
    else if constexpr (ST == ST_ROWSS) st_rowss(j.p, j.a, g);
    else if constexpr (ST == ST_NORM) st_norm_bf16(j.p, j.a, g);
    else if constexpr (ST == ST_RESID) st_resid(j.p, j.a, j.b, j.flag, g);
    else if constexpr (ST == ST_DNPREP) st_dn_prep(j.p, j.layer, g);
    else if constexpr (ST == ST_DNSCAN) st_dn_scan(j.p, j.layer, g);
    else if constexpr (ST == ST_DNOUT) st_dn_out(j.p, j.layer, g);
    else if constexpr (ST == ST_NASC) st_na_scores(j.p, j.layer, g);
    else if constexpr (ST == ST_NAOUT) st_na_out(j.p, j.layer, g);
    else if constexpr (ST == ST_LAM) st_lam(j.p, j.layer, g);
    else if constexpr (ST == ST_ROPE) st_rope(j.p, j.layer, g);
    else if constexpr (ST == ST_DATTN) st_dattn(j.p, j.layer, g);
    else if constexpr (ST == ST_COUT) st_c_out(j.p, j.layer, g);
    else if constexpr (ST == ST_FFNACT) st_ffn_act(j.p, j.layer, g);
    else if constexpr (ST == ST_PLE) st_ple(j.p, j.layer, g);
}
#ifdef EMU
template <int ST> static void run_stage(Job j, long n) {
    j.n = n;
#pragma omp parallel for schedule(dynamic, 64)
    for (long g = 0; g < n; ++g) run_item<ST>(j, g);
}
static void emu_gemm(const bf16* A, const bf16* Bt, int M, int N, int K, bf16* Ob, float* Of, int ldc) {
    std::vector<float> Af((size_t)M * K), Bf((size_t)N * K);
    for (size_t i = 0; i < Af.size(); ++i) Af[i] = bf2f(A[i]);
    for (size_t i = 0; i < Bf.size(); ++i) Bf[i] = bf2f(Bt[i]);
#pragma omp parallel for schedule(dynamic, 8)
    for (int m = 0; m < M; ++m) for (int n = 0; n < N; ++n) { const float* a = &Af[(size_t)m * K]; const float* b = &Bf[(size_t)n * K]; float s = 0.f;
        for (int k = 0; k < K; ++k) s += a[k] * b[k];
        if (Ob) Ob[(size_t)m * ldc + n] = f2bf(s); else Of[(size_t)m * ldc + n] = s; }
}
static void gemm_bf16(const bf16* A, const bf16* Bt, int M, int N, int K, bf16* O, int ldc) { emu_gemm(A, Bt, M, N, K, O, nullptr, ldc); }
static void gemm_f32(const bf16* A, const bf16* Bt, int M, int N, int K, float* O, int ldc) { emu_gemm(A, Bt, M, N, K, nullptr, O, ldc); }

static void forward(const P& p) {
    Job j; memset(&j, 0, sizeof(j)); j.p = p;
    auto wt = [&](const float* W, size_t off, int K, int N, int Npad) { j.w.W = W; j.w.O = WSP(bf16, off); j.w.K = K; j.w.N = N; j.w.Npad = Npad; run_stage<ST_WT>(j, (long)Npad * K); };
    for (int i = 0; i < 2; ++i) {
        wt(p.ab_w_in + (size_t)i * D * ABIN, WS_WABIN + (size_t)i * ABINP * D * 2, D, ABIN, ABINP);
        wt(p.ab_w_out + (size_t)i * ABMIX * D, WS_WABOUT + (size_t)i * D * ABMIX * 2, ABMIX, D, D);
        wt(p.c_w_in + (size_t)i * D * CIN, WS_WCIN + (size_t)i * CIN * D * 2, D, CIN, CIN);
        wt(p.c_w_out + (size_t)i * CV * D, WS_WCOUT + (size_t)i * D * CV * 2, CV, D, D);
    }
    for (int l = 0; l < DEPTH; ++l) {
        wt(p.ffn_w_in + (size_t)l * D * 2 * DFF, WS_WFIN + (size_t)l * 2 * DFF * D * 2, D, 2 * DFF, 2 * DFF);
        wt(p.ffn_w_out + (size_t)l * DFF * D, WS_WFOUT + (size_t)l * D * DFF * 2, DFF, D, D);
        wt(p.ple_w_proj + (size_t)l * PLE * D, WS_WPP + (size_t)l * D * PLE * 2, PLE, D, D);
        wt(p.ple_w_gate + (size_t)l * D * D, WS_WPG + (size_t)l * D * D * 2, D, D, D);
    }
    run_stage<ST_PRM>(j, N_PRM);
    for (int l = 0; l < DEPTH; ++l) { j.layer = l; run_stage<ST_PB>(j, N_PB); }
    run_stage<ST_INIT>(j, N_INIT);
    for (int layer = 0; layer < DEPTH; ++layer) {
        j.layer = layer; const int jj = layer / 2; const float* nw = PRM(PR_NORMS) + (size_t)layer * 4 * D;
        j.a = p.h; run_stage<ST_ROWSS>(j, N_ROWS);
        j.a = nw; run_stage<ST_NORM>(j, N_TD);
        if (layer % 2 == 0) {
            gemm_bf16(WSP(bf16, WS_HN), WSP(bf16, WS_WABIN + (size_t)jj * ABINP * D * 2), T, ABINP, D, WSP(bf16, WS_PROJ), ABINP);
            run_stage<ST_DNPREP>(j, N_TH);
            run_stage<ST_DNSCAN>(j, N_SCAN);
            run_stage<ST_DNOUT>(j, N_TH);
            run_stage<ST_NASC>(j, N_THD);
            run_stage<ST_NAOUT>(j, N_THD);
            gemm_f32(WSP(bf16, WS_MIXIN), WSP(bf16, WS_WABOUT + (size_t)jj * D * ABMIX * 2), T, D, ABMIX, WSP(float, WS_GOUT), D);
        } else {
            gemm_bf16(WSP(bf16, WS_HN), WSP(bf16, WS_WCIN + (size_t)jj * CIN * D * 2), T, CIN, D, WSP(bf16, WS_PROJ), CIN);
            run_stage<ST_LAM>(j, 1);
            run_stage<ST_ROPE>(j, N_ROPE);
            run_stage<ST_DATTN>(j, N_DATT);
            run_stage<ST_COUT>(j, N_TH);
            gemm_f32(WSP(bf16, WS_MIXIN), WSP(bf16, WS_WCOUT + (size_t)jj * D * CV * 2), T, D, CV, WSP(float, WS_GOUT), D);
        }
        j.a = WSP(float, WS_GOUT); run_stage<ST_ROWSS>(j, N_ROWS);
        j.a = WSP(float, WS_GOUT); j.b = nw + D; j.flag = 0; run_stage<ST_RESID>(j, N_TD);
        j.a = p.h; run_stage<ST_ROWSS>(j, N_ROWS);
        j.a = nw + 2 * D; run_stage<ST_NORM>(j, N_TD);
        gemm_bf16(WSP(bf16, WS_HN), WSP(bf16, WS_WFIN + (size_t)layer * 2 * DFF * D * 2), T, 2 * DFF, D, WSP(bf16, WS_HID), 2 * DFF);
        run_stage<ST_FFNACT>(j, N_ACT);
        gemm_f32(WSP(bf16, WS_ACT), WSP(bf16, WS_WFOUT + (size_t)layer * D * DFF * 2), T, D, DFF, WSP(float, WS_GOUT), D);
        j.a = WSP(float, WS_GOUT); run_stage<ST_ROWSS>(j, N_ROWS);
        j.a = WSP(float, WS_GOUT); j.b = nw + 3 * D; j.flag = 1; run_stage<ST_RESID>(j, N_TD);
        gemm_f32(WSP(bf16, WS_HN), WSP(bf16, WS_WPG + (size_t)layer * D * D * 2), T, D, D, WSP(float, WS_GOUT), D);
        gemm_f32(WSP(bf16, WS_PB + (size_t)layer * SZ_PB), WSP(bf16, WS_WPP + (size_t)layer * D * PLE * 2), T, D, PLE, WSP(float, WS_GOUT2), D);
        run_stage<ST_PLE>(j, N_TD);
    }
}
#endif

#ifndef EMU
namespace att {
using bf16x8 = __attribute__((ext_vector_type(8))) short;
using s16x4  = __attribute__((ext_vector_type(4))) short;
using f32x16 = __attribute__((ext_vector_type(16))) float;
using u32x4  = __attribute__((ext_vector_type(4))) unsigned;
constexpr int DA = 128, NW = 8, QBLK = 32, KVBLK = 64;
constexpr float SCALE = 0.088388347648318440f;
constexpr float THR = 8.f;
constexpr size_t SHM_V = KVBLK * DA * 2, SHM_K = KVBLK * DA * 2, SHM_ATTN = 2 * SHM_V + 2 * SHM_K + NW * 64 * 4;
#define KSWZ(row, colB) ((row) * 256 + ((colB) ^ (((row) & 15) << 4)))
#define SBAR() __builtin_amdgcn_sched_barrier(0)
__device__ __forceinline__ int crow(int r, int hi) { return (r & 3) + 8 * (r >> 2) + 4 * hi; }
__device__ __forceinline__ unsigned cvtpk(float lo, float hi) { unsigned r; asm volatile("v_cvt_pk_bf16_f32 %0, %1, %2" : "=v"(r) : "v"(lo), "v"(hi)); return r; }
__device__ __forceinline__ bf16x8 ld8(const bf16* p) { return *reinterpret_cast<const bf16x8*>(p); }
__device__ __forceinline__ void partialSM(f32x16& p0, f32x16& p1, float& m_reg, float& mn, float& alpha) {
  constexpr float C = SCALE * 1.4426950408889634f;
  float pmax = p0[0]; for (int r = 1; r < 16; ++r) pmax = fmaxf(pmax, p0[r]); for (int r = 0; r < 16; ++r) pmax = fmaxf(pmax, p1[r]);
  { auto rr = __builtin_amdgcn_permlane32_swap(__float_as_uint(pmax), __float_as_uint(pmax), false, false);
    pmax = fmaxf(__uint_as_float(rr[0]), __uint_as_float(rr[1])); }
  if (__builtin_expect(__all(pmax - m_reg <= THR / SCALE), 1)) { mn = m_reg; alpha = 1.f; }
  else { mn = fmaxf(m_reg, pmax); alpha = __builtin_amdgcn_exp2f((m_reg - mn) * C); m_reg = mn; }
  float mnC = -mn * C;
  for (int r = 0; r < 16; ++r) p0[r] = fmaf(p0[r], C, mnC); for (int r = 0; r < 16; ++r) p1[r] = fmaf(p1[r], C, mnC);
  for (int r = 0; r < 16; ++r) p0[r] = __builtin_amdgcn_exp2f(p0[r]);
}
__device__ __forceinline__ void finishSM(f32x16& p0, f32x16& p1, float alpha, float& l_reg, bf16x8& pa0, bf16x8& pa1, bf16x8& pa2, bf16x8& pa3) {
  for (int r = 0; r < 16; ++r) p1[r] = __builtin_amdgcn_exp2f(p1[r]);
  float ps = 0; for (int r = 0; r < 16; ++r) ps += p0[r]; for (int r = 0; r < 16; ++r) ps += p1[r];
  { auto rr = __builtin_amdgcn_permlane32_swap(__float_as_uint(ps), __float_as_uint(ps), false, false);
    ps = __uint_as_float(rr[0]) + __uint_as_float(rr[1]); }
  l_reg = l_reg * alpha + ps;
#define PK4(P, BASE, OUT) do { unsigned a0 = cvtpk(P[BASE + 0], P[BASE + 1]), a1 = cvtpk(P[BASE + 2], P[BASE + 3]);   \
    unsigned b0 = cvtpk(P[BASE + 4], P[BASE + 5]), b1 = cvtpk(P[BASE + 6], P[BASE + 7]);                              \
    auto r0 = __builtin_amdgcn_permlane32_swap(a0, b0, false, false); auto r1 = __builtin_amdgcn_permlane32_swap(a1, b1, false, false); \
    u32x4 w = {r0[0], r1[0], r0[1], r1[1]}; OUT = *reinterpret_cast<bf16x8*>(&w); } while (0)
  PK4(p0, 0, pa0); PK4(p0, 8, pa1); PK4(p1, 0, pa2); PK4(p1, 8, pa3);
#undef PK4
}
__device__ __forceinline__ void qkt(f32x16& p0, f32x16& p1, const bf16* Ks, const bf16x8* qr, int r32, int hi) {
  p0 = f32x16{}; p1 = f32x16{};
  for (int d0 = 0; d0 < 8; ++d0) { int cb = (d0 * 16 + hi * 8) * 2;
    bf16x8 b0 = *reinterpret_cast<const bf16x8*>((const char*)Ks + KSWZ(r32, cb));
    bf16x8 b1 = *reinterpret_cast<const bf16x8*>((const char*)Ks + KSWZ(32 + r32, cb));
    p0 = __builtin_amdgcn_mfma_f32_32x32x16_bf16(b0, qr[d0], p0, 0, 0, 0);
    p1 = __builtin_amdgcn_mfma_f32_32x32x16_bf16(b1, qr[d0], p1, 0, 0, 0); }
}
__device__ __forceinline__ int v_st(int k, int c) { const int kk = (k & ~0xC) | ((k & 4) << 1) | ((k & 8) >> 1); return ((kk >> 3) * 4 + (c >> 5)) * 512 + ((kk & 7) * 32 + (c & 31)) * 2; }
__device__ __forceinline__ int v_rd_base(int lane) { return ((lane & 3) << 3) | (((lane >> 2) & 3) << 6) | (((lane >> 4) & 1) << 5) | (((lane >> 5) & 1) << 8); }
constexpr int v_rd_off(int d0, int ks, int half) { return d0 * 512 + ks * 4096 + half * 2048; }
template <int OFF> __device__ __forceinline__ s16x4 tr_read(int vb) {
  s16x4 r; asm volatile("ds_read_b64_tr_b16 %0, %1 offset:%2" : "=&v"(r) : "v"(vb), "i"(OFF) : "memory"); return r;
}
template <int D0> __device__ __forceinline__ void pv_one(f32x16& od, int vb, bf16x8 pa0, bf16x8 pa1, bf16x8 pa2, bf16x8 pa3) {
  const s16x4 l0 = tr_read<v_rd_off(D0, 0, 0)>(vb), h0 = tr_read<v_rd_off(D0, 0, 1)>(vb), l1 = tr_read<v_rd_off(D0, 1, 0)>(vb), h1 = tr_read<v_rd_off(D0, 1, 1)>(vb);
  const s16x4 l2 = tr_read<v_rd_off(D0, 2, 0)>(vb), h2 = tr_read<v_rd_off(D0, 2, 1)>(vb), l3 = tr_read<v_rd_off(D0, 3, 0)>(vb), h3 = tr_read<v_rd_off(D0, 3, 1)>(vb);
  asm volatile("s_waitcnt lgkmcnt(0)" ::: "memory"); SBAR();
#define PK(L, H) (bf16x8){L[0], L[1], L[2], L[3], H[0], H[1], H[2], H[3]}
  od = __builtin_amdgcn_mfma_f32_32x32x16_bf16(pa0, PK(l0, h0), od, 0, 0, 0);
  od = __builtin_amdgcn_mfma_f32_32x32x16_bf16(pa1, PK(l1, h1), od, 0, 0, 0);
  od = __builtin_amdgcn_mfma_f32_32x32x16_bf16(pa2, PK(l2, h2), od, 0, 0, 0);
  od = __builtin_amdgcn_mfma_f32_32x32x16_bf16(pa3, PK(l3, h3), od, 0, 0, 0);
#undef PK
}
__device__ __forceinline__ void pv_d0(f32x16* o, int vb, bf16x8 pa0, bf16x8 pa1, bf16x8 pa2, bf16x8 pa3) {
  pv_one<0>(o[0], vb, pa0, pa1, pa2, pa3); pv_one<1>(o[1], vb, pa0, pa1, pa2, pa3); pv_one<2>(o[2], vb, pa0, pa1, pa2, pa3); pv_one<3>(o[3], vb, pa0, pa1, pa2, pa3);
}
struct NaInfo { int rq0, kr0; const float* tab; };
__device__ __forceinline__ void na_mask(f32x16& p0, f32x16& p1, int rk, int rq, int rs, int cq, int cs, int hi, const float* tab) {
  const bool rowok = (rk >= rs) && (rk < rs + NAR);
  int dr = rk - rq + NAR - 1; dr = dr < 0 ? 0 : (dr > 2 * NAR - 2 ? 2 * NAR - 2 : dr);
  const float* trow = tab + dr * (2 * NAC - 1); const float ninf = -__builtin_inff();
#pragma unroll
  for (int r = 0; r < 16; ++r) { const int ck = crow(r, hi); int dc = ck - cq + NAC - 1; dc = dc < 0 ? 0 : (dc > 2 * NAC - 2 ? 2 * NAC - 2 : dc);
    const bool ok = rowok && ck >= cs && ck < cs + NAC; const float b = trow[dc]; p0[r] = ok ? p0[r] + b : ninf; }
#pragma unroll
  for (int r = 0; r < 16; ++r) { const int ck = 32 + crow(r, hi); int dc = ck - cq + NAC - 1; dc = dc < 0 ? 0 : (dc > 2 * NAC - 2 ? 2 * NAC - 2 : dc);
    const bool ok = rowok && ck >= cs && ck < cs + NAC; const float b = trow[dc]; p1[r] = ok ? p1[r] + b : ninf; }
}
template <int LDQ, int LDK, int LDO, int MODE>
__device__ __forceinline__ void attn_dense_body(const bf16* __restrict__ Qb, const bf16* __restrict__ Kh, const bf16* __restrict__ Vh, void* __restrict__ Ob_, int seq, char* lds, NaInfo na, int tid_in) {
  constexpr int SDEPTH = 2;
  int tid_ = tid_in; asm volatile("" : "+v"(tid_));
  const int tid = tid_, wid = tid >> 6, lane = tid & 63, r32 = lane & 31, hi = lane >> 5;
  const int na_rq = na.rq0 + (wid >> 1), na_cq = (wid & 1) * 32 + r32, na_rs = clampi(na_rq - WR / 2, 0, ROWS - WR), na_cs = clampi(na_cq - NAC / 2, 0, GW - NAC);
#define NAMASK(P0, P1, jt) do { if constexpr (MODE == 1) na_mask(P0, P1, na.kr0 + (jt), na_rq, na_rs, na_cq, na_cs, hi, na.tab); } while (0)
  bf16* V_lds = (bf16*)lds; bf16* K_lds = (bf16*)(lds + 2 * SHM_V);
  float* ws = (float*)(lds + 2 * SHM_V + 2 * SHM_K) + wid * 64; float* li_l = ws; float* al_l = ws + 32;
  float m_reg = -1e30f, l_reg = 0; f32x16 o[4] = {}; bf16x8 qr[8];
  const bf16* Qw = Qb + (long)(wid * QBLK + r32) * LDQ + hi * 8;
#pragma unroll
  for (int d0 = 0; d0 < 8; ++d0) qr[d0] = ld8(Qw + d0 * 16);
  const int sr = tid >> 4, sc = (tid & 15) * 8, vst0 = v_st(sr, sc), vst1 = v_st(32 + sr, sc);
  const int vb0 = (int)(uintptr_t)V_lds + v_rd_base(lane);
  struct { bf16x8 vs0, vs1, ks0, ks1; } sr_[SDEPTH];
#define SLOAD(i, k0) do { sr_[i].vs0 = ld8(&Vh[(long)((k0) + sr) * LDK + sc]); sr_[i].vs1 = ld8(&Vh[(long)((k0) + 32 + sr) * LDK + sc]); \
    sr_[i].ks0 = ld8(&Kh[(long)((k0) + sr) * LDK + sc]); sr_[i].ks1 = ld8(&Kh[(long)((k0) + 32 + sr) * LDK + sc]); } while (0)
#define SWRITE(b, i) do { *(bf16x8*)((char*)V_lds + (b) * SHM_V + vst0) = sr_[i].vs0;          \
    *(bf16x8*)((char*)V_lds + (b) * SHM_V + vst1) = sr_[i].vs1; int kc = sc * 2;               \
    *(bf16x8*)((char*)K_lds + (b) * SHM_K + KSWZ(sr, kc)) = sr_[i].ks0;                       \
    *(bf16x8*)((char*)K_lds + (b) * SHM_K + KSWZ(32 + sr, kc)) = sr_[i].ks1; } while (0)
#define SWAIT() asm volatile("s_waitcnt vmcnt(4)" ::: "memory")
#define RESC(a) do { if (__any((a) < 1.f)) { if (hi == 0) al_l[r32] = (a); asm volatile("s_waitcnt lgkmcnt(0)" ::: "memory"); \
    for (int d = 0; d < 4; ++d) for (int r = 0; r < 16; ++r) o[d][r] *= al_l[crow(r, hi)]; } } while (0)
  f32x16 pA0, pA1, pB0, pB1; float mnA, mnB, alA, alB; bf16x8 pa0, pa1, pa2, pa3; const int NT = seq / KVBLK;
  constexpr int SE = 0, SO = SDEPTH - 1;
  SLOAD(SE, 0); asm volatile("s_waitcnt vmcnt(0)" ::: "memory"); SWRITE(0, SE); __syncthreads();
  qkt(pA0, pA1, K_lds, qr, r32, hi); NAMASK(pA0, pA1, 0); partialSM(pA0, pA1, m_reg, mnA, alA);
  SLOAD(SO, KVBLK); if (2 < NT) SLOAD(SE, 2 * KVBLK);
  SWAIT(); SWRITE(1, SO); __syncthreads();
  for (int j = 1; j + 1 < NT; j += 2) {
    SBAR(); qkt(pB0, pB1, (bf16*)((char*)K_lds + SHM_K), qr, r32, hi); NAMASK(pB0, pB1, j);
    finishSM(pA0, pA1, alA, l_reg, pa0, pa1, pa2, pa3); SBAR();
    SLOAD(SO, (j + SDEPTH) * KVBLK); SBAR();
    pv_d0(o, vb0, pa0, pa1, pa2, pa3); partialSM(pB0, pB1, m_reg, mnB, alB);
    __syncthreads(); SWAIT(); SWRITE(0, SE);
    RESC(alB); __syncthreads();
    SBAR(); qkt(pA0, pA1, K_lds, qr, r32, hi); NAMASK(pA0, pA1, j + 1);
    finishSM(pB0, pB1, alB, l_reg, pa0, pa1, pa2, pa3); SBAR();
    if (j + 3 < NT) SLOAD(SE, (j + 1 + SDEPTH) * KVBLK); SBAR();
    pv_d0(o, vb0 + (int)SHM_V, pa0, pa1, pa2, pa3); partialSM(pA0, pA1, m_reg, mnA, alA);
    __syncthreads(); SWAIT(); SWRITE(1, SO);
    RESC(alA); __syncthreads();
  }
  SBAR(); qkt(pB0, pB1, (bf16*)((char*)K_lds + SHM_K), qr, r32, hi); NAMASK(pB0, pB1, NT - 1);
  finishSM(pA0, pA1, alA, l_reg, pa0, pa1, pa2, pa3); SBAR();
  pv_d0(o, vb0, pa0, pa1, pa2, pa3); partialSM(pB0, pB1, m_reg, mnB, alB);
  __syncthreads(); RESC(alB);
  finishSM(pB0, pB1, alB, l_reg, pa0, pa1, pa2, pa3); SBAR();
  pv_d0(o, vb0 + (int)SHM_V, pa0, pa1, pa2, pa3);
  if (hi == 0) li_l[r32] = l_reg; asm volatile("s_waitcnt lgkmcnt(0)" ::: "memory");
  float rli[16];
#pragma unroll
  for (int r = 0; r < 16; ++r) rli[r] = __builtin_amdgcn_rcpf(li_l[crow(r, hi)]);
  if constexpr (MODE == 2) { float* Ow = (float*)Ob_ + (long)(wid * QBLK) * LDO;
#pragma unroll
    for (int r = 0; r < 16; ++r) { int orow = crow(r, hi);
      for (int d0 = 0; d0 < 4; ++d0) Ow[(long)orow * LDO + d0 * 32 + r32] = o[d0][r] * rli[r]; }
  } else { bf16* Ow = (bf16*)Ob_ + (long)(wid * QBLK) * LDO;
#pragma unroll
    for (int r = 0; r < 16; ++r) { int orow = crow(r, hi);
      for (int d0 = 0; d0 < 4; ++d0) Ow[(long)orow * LDO + d0 * 32 + r32] = f2bf(o[d0][r] * rli[r]); } }
#undef NAMASK
#undef SLOAD
#undef SWRITE
#undef SWAIT
#undef RESC
}
template <int LDQ, int LDK, int LDO>
__device__ __forceinline__ void na_body(const bf16* __restrict__ Qb, const bf16* __restrict__ Kh, const bf16* __restrict__ Vh, bf16* __restrict__ Ob, int ntiles, char* lds, NaInfo na, int tid_in) {
  int tid_ = tid_in; asm volatile("" : "+v"(tid_));
  const int tid = tid_, wid = tid >> 6, lane = tid & 63, r32 = lane & 31, hi = lane >> 5;
  const int na_rq = na.rq0 + (wid >> 1), na_cq = (wid & 1) * 32 + r32, na_rs = clampi(na_rq - WR / 2, 0, ROWS - WR), na_cs = clampi(na_cq - NAC / 2, 0, GW - NAC);
  bf16* V_lds = (bf16*)lds; bf16* K_lds = (bf16*)(lds + 2 * SHM_V);
  float* ws = (float*)(lds + 2 * SHM_V + 2 * SHM_K) + wid * 64; float* li_l = ws; float* al_l = ws + 32;
  float m_reg = -1e30f, l_reg = 0; f32x16 o[4] = {}; bf16x8 qr[8];
  const bf16* Qw = Qb + (long)(wid * QBLK + r32) * LDQ + hi * 8;
#pragma unroll
  for (int d0 = 0; d0 < 8; ++d0) qr[d0] = ld8(Qw + d0 * 16);
  const int sr = tid >> 4, sc = (tid & 15) * 8, vst0 = v_st(sr, sc), vst1 = v_st(32 + sr, sc);
  const int vb0 = (int)(uintptr_t)V_lds + v_rd_base(lane);
  bf16x8 vs0 = ld8(&Vh[(long)sr * LDK + sc]), vs1 = ld8(&Vh[(long)(32 + sr) * LDK + sc]), ks0 = ld8(&Kh[(long)sr * LDK + sc]), ks1 = ld8(&Kh[(long)(32 + sr) * LDK + sc]);
  for (int jt = 0; jt < ntiles; ++jt) {
    __syncthreads();
    *(bf16x8*)((char*)V_lds + vst0) = vs0; *(bf16x8*)((char*)V_lds + vst1) = vs1;
    *(bf16x8*)((char*)K_lds + KSWZ(sr, sc * 2)) = ks0; *(bf16x8*)((char*)K_lds + KSWZ(32 + sr, sc * 2)) = ks1;
    __syncthreads();
    if (jt + 1 < ntiles) { const int k0 = (jt + 1) * KVBLK;
      vs0 = ld8(&Vh[(long)(k0 + sr) * LDK + sc]); vs1 = ld8(&Vh[(long)(k0 + 32 + sr) * LDK + sc]); ks0 = ld8(&Kh[(long)(k0 + sr) * LDK + sc]); ks1 = ld8(&Kh[(long)(k0 + 32 + sr) * LDK + sc]); }
    f32x16 p0, p1; float mn, al; bf16x8 pa0, pa1, pa2, pa3;
    qkt(p0, p1, K_lds, qr, r32, hi);
    na_mask(p0, p1, na.kr0 + jt, na_rq, na_rs, na_cq, na_cs, hi, na.tab);
    partialSM(p0, p1, m_reg, mn, al);
    if (__any(al < 1.f)) { if (hi == 0) al_l[r32] = al; asm volatile("s_waitcnt lgkmcnt(0)" ::: "memory");
      for (int d = 0; d < 4; ++d) for (int r = 0; r < 16; ++r) o[d][r] *= al_l[crow(r, hi)]; }
    finishSM(p0, p1, al, l_reg, pa0, pa1, pa2, pa3); SBAR();
    pv_d0(o, vb0, pa0, pa1, pa2, pa3);
  }
  if (hi == 0) li_l[r32] = l_reg; asm volatile("s_waitcnt lgkmcnt(0)" ::: "memory");
  float rli[16];
#pragma unroll
  for (int r = 0; r < 16; ++r) rli[r] = __builtin_amdgcn_rcpf(li_l[crow(r, hi)]);
  bf16* Ow = Ob + (long)(wid * QBLK) * LDO;
#pragma unroll
  for (int r = 0; r < 16; ++r) { int orow = crow(r, hi);
    for (int d0 = 0; d0 < 4; ++d0) Ow[(long)orow * LDO + d0 * 32 + r32] = f2bf(o[d0][r] * rli[r]); }
}
template <int LDQ, int LDK, int LDO>
__device__ __forceinline__ void dattn256_body(const bf16* __restrict__ Qb, const bf16* __restrict__ Kh, const bf16* __restrict__ Vh, bf16* Ob, int ntiles, char* lds, int tid_in,
                                              int mode = 0, bf16* Mx = nullptr, float lam = 0.f, float scale = 0.f, const float* sw = nullptr) {
  typedef __attribute__((address_space(3))) unsigned lds_u32;
  int tid_ = tid_in; asm volatile("" : "+v"(tid_));
  const int tid = tid_, wid = __builtin_amdgcn_readfirstlane(tid >> 6), lane = tid & 63, r32 = lane & 31, hi = lane >> 5;
  constexpr int VB = 2 * (int)SHM_V, KB = (int)SHM_K;
  char* V_lds = lds; char* K_lds = lds + 2 * VB;
  float* ws = (float*)(lds + 2 * VB + 2 * KB) + wid * 64; float* li_l = ws; float* al_l = ws + 32;
  float m_reg = -1e30f, l_reg = 0; f32x16 o[8] = {}; bf16x8 qr[8];
  const bf16* Qw = Qb + (long)(wid * QBLK + r32) * LDQ + hi * 8;
#pragma unroll
  for (int d0 = 0; d0 < 8; ++d0) qr[d0] = ld8(Qw + d0 * 16);
  unsigned koff[2], voff[2];
#pragma unroll
  for (int i = 0; i < 2; ++i) { const int kp = 2 * wid + i; const int row = 4 * kp + (lane >> 4), c = (lane & 15) ^ (row & 15); koff[i] = (unsigned)(row * LDK + c * 8);
    const int st = 2 * kp + (lane >> 5), within = lane & 31, kk = (st >> 2) * 8 + (within >> 2), k = (kk & ~0xC) | ((kk & 4) << 1) | ((kk & 8) >> 1); voff[i] = (unsigned)(k * LDK + (st & 3) * 32 + (within & 3) * 8); }
  const int vbase = (int)(uintptr_t)V_lds + v_rd_base(lane);
#define DA_DMA(t, b) do { const bf16* kt_ = Kh + (long)(t) * KVBLK * LDK; const bf16* vt_ = Vh + (long)(t) * KVBLK * LDK; \
      _Pragma("unroll") for (int i = 0; i < 2; ++i) { \
        __builtin_amdgcn_global_load_lds((const unsigned*)(kt_ + koff[i]), (lds_u32*)(K_lds + (b) * KB + (2 * wid + i) * 1024), 16, 0, 0); \
        __builtin_amdgcn_global_load_lds((const unsigned*)(vt_ + voff[i]), (lds_u32*)(V_lds + (b) * VB + (2 * wid + i) * 1024), 16, 0, 0); \
        __builtin_amdgcn_global_load_lds((const unsigned*)(vt_ + voff[i] + 128), (lds_u32*)(V_lds + (b) * VB + (int)SHM_V + (2 * wid + i) * 1024), 16, 0, 0); } } while (0)
  __syncthreads();
  DA_DMA(0, 0);
  for (int jt = 0; jt < ntiles; ++jt) {
    const int b = jt & 1;
    asm volatile("s_waitcnt vmcnt(0)" ::: "memory");
    __syncthreads();
    if (jt + 1 < ntiles) DA_DMA(jt + 1, b ^ 1);
    const char* Kb = K_lds + b * KB;
    f32x16 p0, p1; float mn, al; bf16x8 pa0, pa1, pa2, pa3;
    p0 = f32x16{}; p1 = f32x16{};
#pragma unroll
    for (int d0 = 0; d0 < 8; ++d0) { const int cb = (d0 * 16 + hi * 8) * 2;
      const bf16x8 b0 = *reinterpret_cast<const bf16x8*>(Kb + KSWZ(r32, cb)), b1 = *reinterpret_cast<const bf16x8*>(Kb + KSWZ(32 + r32, cb));
      p0 = __builtin_amdgcn_mfma_f32_32x32x16_bf16(b0, qr[d0], p0, 0, 0, 0); p1 = __builtin_amdgcn_mfma_f32_32x32x16_bf16(b1, qr[d0], p1, 0, 0, 0); }
    partialSM(p0, p1, m_reg, mn, al);
    if (__any(al < 1.f)) { if (hi == 0) al_l[r32] = al; asm volatile("s_waitcnt lgkmcnt(0)" ::: "memory");
      for (int d = 0; d < 8; ++d) for (int r = 0; r < 16; ++r) o[d][r] *= al_l[crow(r, hi)]; }
    finishSM(p0, p1, al, l_reg, pa0, pa1, pa2, pa3); SBAR();
    pv_d0(o, vbase + b * VB, pa0, pa1, pa2, pa3);
    pv_d0(o + 4, vbase + b * VB + (int)SHM_V, pa0, pa1, pa2, pa3);
  }
#undef DA_DMA
  if (hi == 0) li_l[r32] = l_reg; asm volatile("s_waitcnt lgkmcnt(0)" ::: "memory");
  float rli[16];
#pragma unroll
  for (int r = 0; r < 16; ++r) rli[r] = __builtin_amdgcn_rcpf(li_l[crow(r, hi)]);
  bf16* Ow = Ob + (long)(wid * QBLK) * LDO;
  if (mode == 0) {
#pragma unroll
    for (int r = 0; r < 16; ++r) { int orow = crow(r, hi);
      for (int d0 = 0; d0 < 8; ++d0) Ow[(long)orow * LDO + d0 * 32 + r32] = f2bf(o[d0][r] * rli[r]); }
  } else {
    bf16* Mw = Mx + (long)(wid * QBLK) * LDO;
    float swv[8];
#pragma unroll
    for (int d0 = 0; d0 < 8; ++d0) swv[d0] = sw[d0 * 32 + r32] * scale;
#pragma unroll
    for (int r = 0; r < 16; ++r) { const int orow = crow(r, hi); float ss = 0.f; const float nl = -lam * rli[r];
#pragma unroll
      for (int d0 = 0; d0 < 8; ++d0) { const float x = bf2f(Ow[(long)orow * LDO + d0 * 32 + r32]) + nl * o[d0][r]; o[d0][r] = x; ss += x * x; }
      ss += __shfl_xor(ss, 1); ss += __shfl_xor(ss, 2); ss += __shfl_xor(ss, 4); ss += __shfl_xor(ss, 8); ss += __shfl_xor(ss, 16);
      const float rs = 1.0f / sqrtf(ss * (1.0f / 256.0f) + RMS_EPS);
#pragma unroll
      for (int d0 = 0; d0 < 8; ++d0) Mw[(long)orow * LDO + d0 * 32 + r32] = f2bf(o[d0][r] * rs * swv[d0]); }
  }
}
}
namespace dn {
using bf16x8 = __attribute__((ext_vector_type(8))) short;
using f32x4v = __attribute__((ext_vector_type(4))) float;
using f32x2v = __attribute__((ext_vector_type(2))) float;
using bf16x2v = __attribute__((ext_vector_type(2))) __bf16;
using u32x4 = __attribute__((ext_vector_type(4))) unsigned;
constexpr int KP = 136;
constexpr int L_K = 0, L_Q = 17408, L_V = 34816, L_AKK = 67584, L_AQK = 84224, L_L0 = 100864, L_L1 = 117248, L_SM = 133632, L_DB = 135680, L_END = 143872;
__device__ __forceinline__ unsigned pk(float lo, float hi) { const f32x2v v = {lo, hi}; return __builtin_bit_cast(unsigned, __builtin_convertvector(v, bf16x2v)); }
__device__ __forceinline__ bf16x8 pack8(f32x4v a, f32x4v b) { u32x4 w = {pk(a[0], a[1]), pk(a[2], a[3]), pk(b[0], b[1]), pk(b[2], b[3])}; return __builtin_bit_cast(bf16x8, w); }
__device__ __forceinline__ int kperm(int s, int q, int j) { return 32 * s + 16 * (j >> 2) + 4 * q + (j & 3); }
#define MFMA16(a, b, c) __builtin_amdgcn_mfma_f32_16x16x32_bf16((a), (b), (c), 0, 0, 0)

__device__ __forceinline__ float fexp(float x) { return __builtin_amdgcn_exp2f(x * 1.4426950408889634f); }
__device__ __forceinline__ float fsilu(float x) { return x * __builtin_amdgcn_rcpf(1.0f + fexp(-x)); }
template <int C> __device__ __forceinline__ float dpp_bc(int v) { return __int_as_float(__builtin_amdgcn_update_dpp(0, v, C, 0xf, 0xf, false)); }
template <int I, int J> __device__ __forceinline__ void inv16_terms(float& r, int lk, const float (&x)[16]) {
    if constexpr (J < I) { r -= dpp_bc<0x150 + J>(lk) * x[J]; inv16_terms<I, J + 1>(r, lk, x); }
}
template <int I> __device__ __forceinline__ void inv16_rows(float (&x)[16], const float* Lbb, int c) {
    if constexpr (I < 16) { float r = (I == c) ? 1.f : 0.f; const int lk = __float_as_int(Lbb[I * 64 + c]); inv16_terms<I, 0>(r, lk, x); x[I] = r; inv16_rows<I + 1>(x, Lbb, c); }
}
__device__ __forceinline__ void dn1_unit(const P& p, int jl, int seq, int hh, int chunk, char* lds, int tid_in) {
    int tid_ = tid_in; asm volatile("" : "+v"(tid_));
    const int tid = tid_, lane = tid & 63, wave = tid >> 6;
    bf16* Kl = (bf16*)(lds + L_K); bf16* Ql = (bf16*)(lds + L_Q); float* Vl = (float*)(lds + L_V); float* AKK = (float*)(lds + L_AKK); float* AQK = (float*)(lds + L_AQK);
    float* L0 = (float*)(lds + L_L0); float* L1 = (float*)(lds + L_L1); float* g_l = (float*)(lds + L_SM); float* beta_l = g_l + 128; float* gc_l = g_l + 256; float* bk_l = g_l + 384;
    const int tt0 = chunk * 64; const long tb = (long)seq * S; const bf16* PROJ = WSP(bf16, WS_PROJ);
    const size_t unit = ((size_t)(seq * NH + hh) * (S / 64) + chunk);
    if (tid < 384) {
        const int cgi = tid & 15, part = (tid >> 4) % 3, oct = tid / 48, i0 = 8 * oct; const int coff = part * 1024 + hh * DH + 8 * cgi;
        bf16x8 x[12]; float w[5][8];
#pragma unroll
        for (int k = 0; k < 12; ++k) { const int ts = tt0 + i0 + k - 2; x[k] = (ts >= 0 && ts < S) ? *(const bf16x8*)(PROJ + (size_t)(tb + ts) * ABINP + coff) : (bf16x8){0, 0, 0, 0, 0, 0, 0, 0}; }
#pragma unroll
        for (int tap = 0; tap < 5; ++tap) { const float* cw = PRM(PR_ABCONV) + (size_t)(jl * 5 + tap) * AQKV + coff; const f32x4v a = *(const f32x4v*)cw, b = *(const f32x4v*)(cw + 4);
#pragma unroll
            for (int e = 0; e < 4; ++e) { w[tap][e] = a[e]; w[tap][4 + e] = b[e]; } }
#pragma unroll
        for (int kk = 0; kk < 8; ++kk) { float y[8]; float ss = 0.f;
#pragma unroll
            for (int c = 0; c < 8; ++c) { float acc = 0.f;
#pragma unroll
                for (int tap = 0; tap < 5; ++tap) acc += bf2f((bf16)x[kk + tap][c]) * w[tap][c];
                y[c] = fsilu(acc); ss += y[c] * y[c]; }
            ss += __shfl_xor(ss, 1); ss += __shfl_xor(ss, 2); ss += __shfl_xor(ss, 4); ss += __shfl_xor(ss, 8);
            const float rn = 1.0f / sqrtf(ss + 1e-6f); const float sc_ = part == 0 ? rn * 0.08838834764831845f : (part == 1 ? rn : 1.0f); const int i = i0 + kk;
            if (part < 2) { u32x4 wv; wv[0] = pk(y[0] * sc_, y[1] * sc_); wv[1] = pk(y[2] * sc_, y[3] * sc_); wv[2] = pk(y[4] * sc_, y[5] * sc_); wv[3] = pk(y[6] * sc_, y[7] * sc_);
                *(u32x4*)((part ? Kl : Ql) + i * KP + 8 * cgi) = wv; }
            else { *(f32x4v*)(Vl + i * 128 + 8 * cgi) = (f32x4v){y[0], y[1], y[2], y[3]}; *(f32x4v*)(Vl + i * 128 + 8 * cgi + 4) = (f32x4v){y[4], y[5], y[6], y[7]}; } }
    } else { const int gt = tid - 384; const int dir = gt >> 6, il = gt & 63, ti = dir ? 63 - il : il; const bf16* gr = PROJ + (size_t)(tb + tt0 + ti) * ABINP + COL_G;
        const float graw = bf2f(gr[dir * NH + hh]), braw = bf2f(gr[16 + dir * NH + hh]);
        const float a = expf(PRM(PR_ALOG)[(jl * 2 + dir) * NH + hh]), dtb = PRM(PR_DTB)[(jl * 2 + dir) * NH + hh];
        g_l[dir * 64 + il] = -a * softplusf(graw + dtb); beta_l[dir * 64 + il] = sigmoidf(braw); }
    __syncthreads();
    if (wave < 2) { const int dir = wave; float c = g_l[dir * 64 + lane];
#pragma unroll
        for (int o = 1; o < 64; o <<= 1) { const float t = __shfl_up(c, o); if (lane >= o) c += t; }
        gc_l[dir * 64 + lane] = c; bk_l[dir * 64 + lane] = beta_l[dir * 64 + lane] * fexp(c); }
    {
        const int r = lane & 15, q = lane >> 4;
#pragma unroll
        for (int tt = 0; tt < 2; ++tt) { const int tile = 2 * wave + tt, ti_ = tile >> 2, tj_ = tile & 3; f32x4v ck = {0.f, 0.f, 0.f, 0.f}, cq = {0.f, 0.f, 0.f, 0.f};
#pragma unroll
            for (int s = 0; s < 4; ++s) { const bf16x8 ak = *(const bf16x8*)(Kl + (16 * ti_ + r) * KP + 32 * s + 8 * q), aq = *(const bf16x8*)(Ql + (16 * ti_ + r) * KP + 32 * s + 8 * q), b = *(const bf16x8*)(Kl + (16 * tj_ + r) * KP + 32 * s + 8 * q);
                ck = MFMA16(ak, b, ck); cq = MFMA16(aq, b, cq); }
#pragma unroll
            for (int rr = 0; rr < 4; ++rr) { AKK[(16 * ti_ + 4 * q + rr) * 65 + 16 * tj_ + r] = ck[rr]; AQK[(16 * ti_ + 4 * q + rr) * 65 + 16 * tj_ + r] = cq[rr]; } }
    }
    __syncthreads();
    for (int e = tid; e < 8192; e += 512) { const int dir = e >> 12, i = (e >> 6) & 63, jx = e & 63; float v = 0.f;
        if (jx < i) { const int ti = dir ? 63 - i : i, tj = dir ? 63 - jx : jx; v = beta_l[dir * 64 + i] * AKK[ti * 65 + tj] * fexp(gc_l[dir * 64 + i] - gc_l[dir * 64 + jx]); }
        (dir ? L1 : L0)[i * 64 + jx] = v; }
#pragma unroll
    for (int dir = 0; dir < 2; ++dir) {
        const size_t ud = unit * 2 + dir; const float* gc = gc_l + dir * 64; const float glast = gc[63];
        {
            const int frag = tid >> 6, mt = frag >> 1, s = frag & 1, i = 16 * mt + (lane & 15), q = lane >> 4, ti = dir ? 63 - i : i; const float gi = gc[i]; float v[8];
#pragma unroll
            for (int jv = 0; jv < 8; ++jv) { const int jx = kperm(s, q, jv); v[jv] = (jx <= i) ? AQK[ti * 65 + (dir ? 63 - jx : jx)] * fexp(gi - gc[jx]) : 0.f; }
            u32x4 w = {pk(v[0], v[1]), pk(v[2], v[3]), pk(v[4], v[5]), pk(v[6], v[7])};
            *(u32x4*)(WSP(bf16, WS_DN_IN) + ((ud * 8 + frag) * 64 + lane) * 8) = w;
        }
#pragma unroll
        for (int rep = 0; rep < 2; ++rep) {
            const int fl = tid + 512 * rep, frag = fl >> 6, q = lane >> 4;
            { const int mt = frag >> 2, s = frag & 3, i = 16 * mt + (lane & 15), ti = dir ? 63 - i : i; const float eg = fexp(gc[i]); float v[8];
#pragma unroll
              for (int jv = 0; jv < 8; ++jv) v[jv] = bf2f(Ql[ti * KP + kperm(s, q, jv)]) * eg;
              u32x4 w = {pk(v[0], v[1]), pk(v[2], v[3]), pk(v[4], v[5]), pk(v[6], v[7])};
              *(u32x4*)(WSP(bf16, WS_DN_QE) + ((ud * 16 + frag) * 64 + lane) * 8) = w; }
            { const int mt = frag >> 1, s = frag & 1, d = 16 * mt + (lane & 15); float v[8];
#pragma unroll
              for (int jv = 0; jv < 8; ++jv) { const int jx = kperm(s, q, jv), tj = dir ? 63 - jx : jx; v[jv] = bf2f(Kl[tj * KP + d]) * fexp(glast - gc[jx]); }
              u32x4 w = {pk(v[0], v[1]), pk(v[2], v[3]), pk(v[4], v[5]), pk(v[6], v[7])};
              *(u32x4*)(WSP(bf16, WS_DN_KD) + ((ud * 16 + frag) * 64 + lane) * 8) = w; }
        }
        if (tid == 0) WSP(float, WS_DN_EG)[ud] = fexp(glast);
    }
    __syncthreads();
    {
        float* DB = (float*)(lds + L_DB);
        if (wave < 2) { const int b = lane >> 4, c = lane & 15; const float* Lbb = (wave ? L1 : L0) + (16 * b) * 64 + 16 * b; float x[16];
            inv16_rows<0>(x, Lbb, c);
#pragma unroll
            for (int i = 0; i < 16; ++i) DB[((wave * 4 + b) * 16 + i) * 16 + c] = x[i]; }
        __syncthreads();
        const int dir = __builtin_amdgcn_readfirstlane(tid >> 8), wq = __builtin_amdgcn_readfirstlane((tid >> 6) & 3); const float* L = dir ? L1 : L0; const size_t ud = unit * 2 + dir;
        const float* bv = beta_l + dir * 64; const float* bk = bk_l + dir * 64; const int m = lane & 15, q = lane >> 4;
        const f32x4v zero4 = {0.f, 0.f, 0.f, 0.f};
        bf16x8 A01[3], A23, Ad[4];
#pragma unroll
        for (int b = 1; b < 4; ++b) { const float* lr = L + (16 * b + m) * 64 + 4 * q; const f32x4v l0 = *(const f32x4v*)lr, l1 = (b >= 2) ? *(const f32x4v*)(lr + 16) : zero4; A01[b - 1] = pack8(-l0, -l1); }
        { const float* lr = L + (48 + m) * 64 + 32 + 4 * q; A23 = pack8(-*(const f32x4v*)lr, zero4); }
#pragma unroll
        for (int b = 0; b < 4; ++b) Ad[b] = pack8(*(const f32x4v*)(DB + ((dir * 4 + b) * 16 + m) * 16 + 4 * q), zero4);
#pragma unroll
        for (int nt4 = 0; nt4 < 4; ++nt4) { const int col = 64 * wq + 16 * nt4 + m; f32x4v X[4];
#pragma unroll
            for (int b = 0; b < 4; ++b) { f32x4v acc;
#pragma unroll
                for (int r = 0; r < 4; ++r) { const int i = 16 * b + 4 * q + r, ti = dir ? 63 - i : i; acc[r] = (wq < 2) ? bv[i] * Vl[ti * 128 + col] : bk[i] * bf2f(Kl[ti * KP + (col - 128)]); }
                if (b >= 1) acc = MFMA16(A01[b - 1], pack8(X[0], b >= 2 ? X[1] : zero4), acc);
                if (b == 3) acc = MFMA16(A23, pack8(X[2], zero4), acc);
                X[b] = MFMA16(Ad[b], pack8(acc, zero4), zero4); }
            if (wq < 2) { float* o = WSP(float, WS_DN_UT) + (ud * 128 + col) * 64 + 4 * q;
#pragma unroll
                for (int b = 0; b < 4; ++b) *(f32x4v*)(o + 16 * b) = X[b];
            } else { const int d = col - 128, s = d >> 5, qd = (d >> 2) & 3, jv = 4 * ((d >> 4) & 1) + (d & 3); bf16* o = (bf16*)(lds + L_AKK) + dir * 16 * 512;
#pragma unroll
                for (int b = 0; b < 4; ++b)
#pragma unroll
                    for (int r = 0; r < 4; ++r) o[((b * 4 + s) * 64 + (4 * q + r) + 16 * qd) * 8 + jv] = f2bf(-X[b][r]); }
        }
    }
    __syncthreads();
    {
        u32x4* dst = (u32x4*)(WSP(bf16, WS_DN_WN) + unit * 2 * 16 * 512); const u32x4* src = (const u32x4*)(lds + L_AKK);
#pragma unroll
        for (int e = 0; e < 4; ++e) dst[tid + 512 * e] = src[tid + 512 * e];
    }
}
constexpr int SC_WN = 0, SC_QE = 16384, SC_IN = 32768, SC_KD = 40960, SC_BUF = 57344;
__device__ __forceinline__ void dn_scan_chain(const P& p, int chain, char* lds, int tid_in) {
    int tid_ = tid_in; asm volatile("" : "+v"(tid_));
    const int tid = tid_, lane = tid & 63, wave = tid >> 6, n = lane & 15, q = lane >> 4, n0 = wave * 16;
    const int dir = chain & 1, sh = chain >> 1, hh = sh % NH, seq = sh / NH;
    f32x4v Sacc[8];
#pragma unroll
    for (int mt = 0; mt < 8; ++mt) Sacc[mt] = (f32x4v){0.f, 0.f, 0.f, 0.f};
    bf16* O = WSP(bf16, dir ? WS_OB : WS_OF);
    u32x4 st0[7], st1[7];
#define SC_UD(step) (((size_t)sh * (S / 64) + (dir ? S / 64 - 1 - (step) : (step))) * 2 + dir)
#define SC_LOAD(st, ud) do { const u32x4* a = (const u32x4*)WSP(bf16, WS_DN_WN) + (ud) * 1024 + tid; const u32x4* b = (const u32x4*)WSP(bf16, WS_DN_QE) + (ud) * 1024 + tid; \
        const u32x4* c = (const u32x4*)WSP(bf16, WS_DN_IN) + (ud) * 512 + tid; const u32x4* d = (const u32x4*)WSP(bf16, WS_DN_KD) + (ud) * 1024 + tid; \
        st[0] = a[0]; st[1] = a[512]; st[2] = b[0]; st[3] = b[512]; st[4] = c[0]; st[5] = d[0]; st[6] = d[512]; } while (0)
#define SC_WRITE(st, buf) do { char* b_ = lds + (buf) * SC_BUF + tid * 16; *(u32x4*)(b_ + SC_WN) = st[0]; *(u32x4*)(b_ + SC_WN + 8192) = st[1]; *(u32x4*)(b_ + SC_QE) = st[2]; *(u32x4*)(b_ + SC_QE + 8192) = st[3]; \
        *(u32x4*)(b_ + SC_IN) = st[4]; *(u32x4*)(b_ + SC_KD) = st[5]; *(u32x4*)(b_ + SC_KD + 8192) = st[6]; } while (0)
    f32x4v ut0[4], ut1[4]; float eg0, eg1;
#define SC_LOADU(ut, egv, ud) do { const float* u_ = WSP(float, WS_DN_UT) + ((ud) * 128 + n0 + n) * 64 + 4 * q; _Pragma("unroll") for (int mt = 0; mt < 4; ++mt) ut[mt] = *(const f32x4v*)(u_ + 16 * mt); egv = WSP(float, WS_DN_EG)[ud]; } while (0)
    { const size_t ud0 = SC_UD(0), ud1 = SC_UD(1), ud2 = SC_UD(2); SC_LOAD(st0, ud0); SC_LOADU(ut0, eg0, ud0); SC_LOAD(st1, ud1); SC_LOADU(ut1, eg1, ud1); SC_WRITE(st0, 0); SC_LOAD(st0, ud2); }
    __syncthreads();
#define SC_STEP(step, stY, utX, egX) do { \
        const int c = dir ? S / 64 - 1 - (step) : (step); \
        if ((step) + 1 < S / 64) SC_WRITE(stY, ((step) + 1) & 1);                                       \
        if ((step) + 3 < S / 64) { const size_t udn = SC_UD((step) + 3); SC_LOAD(stY, udn); } \
        f32x4v vn[4], o[4]; const float eg = egX; \
        _Pragma("unroll") for (int mt = 0; mt < 4; ++mt) { vn[mt] = utX[mt]; o[mt] = (f32x4v){0.f, 0.f, 0.f, 0.f}; } \
        if ((step) + 2 < S / 64) { const size_t udu = SC_UD((step) + 2); SC_LOADU(utX, egX, udu); } \
        const char* fb = lds + ((step) & 1) * SC_BUF + lane * 16; \
        bf16x8 Sb[4]; \
        _Pragma("unroll") for (int s = 0; s < 4; ++s) Sb[s] = pack8(Sacc[2 * s], Sacc[2 * s + 1]); \
        _Pragma("unroll") for (int mt = 0; mt < 4; ++mt) \
            _Pragma("unroll") for (int s = 0; s < 4; ++s) { vn[mt] = MFMA16(*(const bf16x8*)(fb + SC_WN + (mt * 4 + s) * 1024), Sb[s], vn[mt]); o[mt] = MFMA16(*(const bf16x8*)(fb + SC_QE + (mt * 4 + s) * 1024), Sb[s], o[mt]); } \
        bf16x8 Vb[2]; \
        _Pragma("unroll") for (int s = 0; s < 2; ++s) Vb[s] = pack8(vn[2 * s], vn[2 * s + 1]); \
        _Pragma("unroll") for (int mt = 0; mt < 4; ++mt) \
            _Pragma("unroll") for (int s = 0; s < 2; ++s) o[mt] = MFMA16(*(const bf16x8*)(fb + SC_IN + (mt * 2 + s) * 1024), Vb[s], o[mt]); \
        const long tbase = (long)seq * S + (long)c * 64; \
        _Pragma("unroll") for (int mt = 0; mt < 4; ++mt) \
            _Pragma("unroll") for (int r = 0; r < 4; ++r) { const int i = 16 * mt + 4 * q + r, ti = dir ? 63 - i : i; O[((size_t)(tbase + ti) * NH + hh) * DH + n0 + n] = f2bf(o[mt][r]); } \
        _Pragma("unroll") for (int mt = 0; mt < 8; ++mt) { f32x4v a = Sacc[mt] * eg; \
            _Pragma("unroll") for (int s = 0; s < 2; ++s) a = MFMA16(*(const bf16x8*)(fb + SC_KD + (mt * 2 + s) * 1024), Vb[s], a); \
            Sacc[mt] = a; } \
        __syncthreads(); } while (0)
#pragma unroll 1
    SC_STEP(0, st1, ut0, eg0); SC_STEP(1, st0, ut1, eg1);
#pragma unroll 1
    for (int step = 2; step < S / 64; step += 2) { SC_STEP(step, st1, ut0, eg0); SC_STEP(step + 1, st0, ut1, eg1); }
#undef SC_STEP
#undef SC_UD
#undef SC_LOAD
#undef SC_LOADU
#undef SC_WRITE
}
#undef MFMA16
}
constexpr int NWAVES = 8, NTHR = 512;
constexpr int RING_BYTES = 131072, LDSCTL_OFF = 158720, MISC_OFF = LDSCTL_OFF + 320, LDS_BYTES = 159744;
#define LAS __attribute__((address_space(3)))
#define GAS __attribute__((address_space(1)))
typedef unsigned v4u __attribute__((ext_vector_type(4)));
typedef float f32x4 __attribute__((ext_vector_type(4)));
#define LDS_WAIT() asm volatile("s_waitcnt lgkmcnt(0)" ::: "memory")
#define XB_TMO      128
#define XB_XCNT(j)  (256  + 64 * (j))
#define XB_XSUB(j)  (1280 + 64 * (j))
#define XB_XGEN(j)  (2304 + 64 * (j))
#define XB_TOP      3328
#define XB_TOPGEN   3392
#define XCD_BAR_WORDS 3456
#define XB_SPIN_CAP (1u << 22)
__device__ __forceinline__ unsigned xb_ld(unsigned* p)              { return __hip_atomic_load(p, __ATOMIC_RELAXED, __HIP_MEMORY_SCOPE_AGENT); }
__device__ __forceinline__ unsigned xb_add(unsigned* p, unsigned v) { return __hip_atomic_fetch_add(p, v, __ATOMIC_RELAXED, __HIP_MEMORY_SCOPE_AGENT); }
__device__ __forceinline__ unsigned xb_xcc_id() { return (unsigned)__builtin_amdgcn_s_getreg((3 << 11) | 20) & 0xFu; }
#define XB_SPIN(cond, bar) do { unsigned _sp = 0; while (cond) { __builtin_amdgcn_s_sleep(1); \
    if ((++_sp & 255u) == 0u) { if (xb_ld(&(bar)[XB_TMO])) break; if (_sp > XB_SPIN_CAP) { atomicAdd(&(bar)[XB_TMO], 1u); break; } } } } while (0)
struct XcdBarrier { unsigned* bar; unsigned x; volatile LAS unsigned* st; };
__device__ __forceinline__ XcdBarrier xcd_barrier_post(unsigned* bar, volatile LAS unsigned* st) {
    XcdBarrier b; b.bar = bar; b.x = xb_xcc_id(); b.st = st;
    if (threadIdx.x == 0) (void)xb_add(&bar[XB_XCNT(b.x)], 1u);
    return b;
}
__device__ __forceinline__ void xcd_barrier_complete(unsigned* bar, unsigned x, unsigned& nloc, unsigned& nx) {
    const unsigned G = gridDim.x * gridDim.y * gridDim.z;
    unsigned sum, cnt, mine, sp = 0u;
    for (;;) {
        sum = 0u; cnt = 0u; mine = 0u;
#pragma unroll
        for (unsigned j = 0; j < 16; ++j) { const unsigned c = xb_ld(&bar[XB_XCNT(j)]); sum += c; cnt += (c > 0u) ? 1u : 0u; mine = (j == x) ? c : mine; }
        if (sum == G) break;
        __builtin_amdgcn_s_sleep(1);
        if ((++sp & 255u) == 0u) { if (xb_ld(&bar[XB_TMO])) break; if (sp > XB_SPIN_CAP) { atomicAdd(&bar[XB_TMO], 1u); break; } }
    }
    nloc = mine > 0u ? mine : 1u; nx = cnt > 0u ? cnt : 1u;
}
__device__ __forceinline__ void xcd_barrier(const XcdBarrier& b, int tid_in) {
    asm volatile("s_waitcnt vmcnt(0)" ::: "memory");
    __syncthreads();
    if (tid_in == 0) {
        unsigned* bar = b.bar; const unsigned bx = xb_xcc_id();
        __builtin_amdgcn_s_waitcnt(0);
        unsigned nloc = b.st[0], nx = b.st[1];
        if (nloc == 0u) { xcd_barrier_complete(bar, bx, nloc, nx); b.st[0] = nloc; b.st[1] = nx; }
        const unsigned old = xb_add(&bar[XB_XSUB(bx)], 1u);
        const unsigned gen = old / nloc;
        if (old + 1u == (gen + 1u) * nloc) {
            __builtin_amdgcn_fence(__ATOMIC_RELEASE, "agent");
            asm volatile("s_waitcnt vmcnt(0)" ::: "memory");
            const unsigned og = xb_add(&bar[XB_TOP], 1u);
            const unsigned tg = og / nx;
            if (og + 1u == (tg + 1u) * nx) xb_add(&bar[XB_TOPGEN], 1u);
            else XB_SPIN(xb_ld(&bar[XB_TOPGEN]) == tg, bar);
            __builtin_amdgcn_fence(__ATOMIC_ACQUIRE, "agent");
            xb_add(&bar[XB_XGEN(bx)], 1u);
            asm volatile("s_waitcnt vmcnt(0)" ::: "memory");
        } else {
            XB_SPIN(xb_ld(&bar[XB_XGEN(bx)]) == gen, bar);
            __builtin_amdgcn_fence(__ATOMIC_ACQUIRE, "agent");
            asm volatile("s_waitcnt vmcnt(0)" ::: "memory");
        }
    }
    __syncthreads();
}
constexpr size_t CTL_ZERO_BYTES = 65536; constexpr int CW_BAR = 1024;

__device__ __forceinline__ float wave_sum(float v) {
#pragma unroll
    for (int o = 1; o < 64; o <<= 1) v += __shfl_xor(v, o);
    return v;
}
constexpr long N_SCAN4 = N_SCAN * 4;
__device__ __forceinline__ void st_dn_scan4(const P& p, long g) {
    const int part = (int)(g & 3); const long g1 = g >> 2;
    const int vc = (int)(g1 % DH); const int dir = (int)((g1 / DH) % 2); const int hh = (int)((g1 / (2 * DH)) % NH); const int seq = (int)(g1 / (2 * DH * NH));
    const float *QN = WSP(float, WS_QN), *KN = WSP(float, WS_KN), *VV = WSP(float, WS_VV), *G = WSP(float, WS_G), *BT = WSP(float, WS_BETA);
    float* O = WSP(float, dir ? WS_OB : WS_OF);
    float Sx[32];
#pragma unroll
    for (int d = 0; d < 32; ++d) Sx[d] = 0.f;
    for (int step = 0; step < S; ++step) {
        const int tt = dir ? S - 1 - step : step; const long t = (long)seq * S + tt;
        const float eg = expf(G[(t * 2 + dir) * NH + hh]), b = BT[(t * 2 + dir) * NH + hh];
        const float* kp = KN + ((size_t)t * NH + hh) * DH + part * 32; const float* qp = QN + ((size_t)t * NH + hh) * DH + part * 32; const float vv = VV[((size_t)t * NH + hh) * DH + vc];
        float dot = 0.f;
#pragma unroll
        for (int d = 0; d < 32; ++d) { Sx[d] *= eg; dot += Sx[d] * kp[d]; }
        dot += __shfl_xor(dot, 1); dot += __shfl_xor(dot, 2);
        const float delta = b * (vv - dot); float o = 0.f;
#pragma unroll
        for (int d = 0; d < 32; ++d) { Sx[d] += kp[d] * delta; o += Sx[d] * qp[d]; }
        o += __shfl_xor(o, 1); o += __shfl_xor(o, 2);
        if (part == 0) O[((size_t)t * NH + hh) * DH + vc] = o;
    }
}
__device__ __forceinline__ unsigned pk2(float lo, float hi) { return (unsigned)f2bf(lo) | ((unsigned)f2bf(hi) << 16); }
template <int ST> __device__ __forceinline__ void grid_items(const Job& j, long n, int tid_in) {
    int t_ = tid_in; asm volatile("" : "+v"(t_));
    for (long g = (long)blockIdx.x * NTHR + t_; g < n; g += (long)gridDim.x * NTHR) run_item<ST>(j, g);
}
__device__ __forceinline__ void transpose_item(const float* W, int K, int N, bf16* WT, LAS float* scr, int item, int lane, int GU = 0) {
    const int nblk_src = (N + 63) / 64; const int kblks = K / 64; const int KBL = kblks < 16 ? kblks : 16, NBL = 64 / KBL, kbb = kblks / KBL;
    const int blk = item >> 6, within = item & 63; const int kb = (blk % kbb) * KBL + (within % KBL), nb = (blk / kbb) * NBL + (within / KBL), k0 = 64 * kb, n0 = 64 * nb;
    const int n0s = GU ? (((n0 >> 7) & 1) * DFF + (n0 >> 8) * 128 + (n0 & 127)) : n0;
    const int c = lane & 7;
    if (nb >= nblk_src) {
#pragma unroll
        for (int jj = 0; jj < 8; ++jj) { const int n = (lane >> 3) + 8 * jj; *(GAS v4u*)(WT + (size_t)(n0 + n) * K + k0 + 8 * c) = (v4u){0u, 0u, 0u, 0u}; }
        return;
    }
    {
        f32x4 v[16]; const int kq = lane >> 4, nn = (lane & 15) * 4;
#pragma unroll
        for (int i = 0; i < 16; ++i) v[i] = (n0s + nn < N) ? *(const f32x4*)(W + (size_t)(k0 + 4 * i + kq) * N + n0s + nn) : (f32x4){0.f, 0.f, 0.f, 0.f};
#pragma unroll
        for (int i = 0; i < 16; ++i) { LAS float* d = scr + (4 * i + kq) * 65 + nn; d[0] = v[i].x; d[1] = v[i].y; d[2] = v[i].z; d[3] = v[i].w; }
    }
    LDS_WAIT(); asm volatile("" ::: "memory");
#pragma unroll
    for (int jj = 0; jj < 8; ++jj) { const int n = (lane >> 3) + 8 * jj; const LAS float* s_ = scr + (8 * c) * 65 + n;
        v4u o; o.x = pk2(s_[0 * 65], s_[1 * 65]); o.y = pk2(s_[2 * 65], s_[3 * 65]); o.z = pk2(s_[4 * 65], s_[5 * 65]); o.w = pk2(s_[6 * 65], s_[7 * 65]);
        *(GAS v4u*)(WT + (size_t)(n0 + n) * K + k0 + 8 * c) = o; }
    LDS_WAIT(); asm volatile("" ::: "memory");
}
__device__ __forceinline__ void pb_phase(const P& p, int tid_in) {
    int t_ = tid_in; asm volatile("" : "+v"(t_));
    constexpr long np8 = (long)NPROMPT * S * PLE / 8, ns8 = (long)(NSEQ - NPROMPT) * S * PLE / 8, n8 = np8 + ns8;
    for (int layer = 0; layer < DEPTH; ++layer) {
        const float* pp = p.p_prompt + (size_t)layer * np8 * 8; const float* ps = p.p_sample + (size_t)layer * ns8 * 8; bf16* o = WSP(bf16, WS_PB + (size_t)layer * SZ_PB);
#pragma unroll 2
        for (long g = (long)blockIdx.x * NTHR + t_; g < n8; g += (long)gridDim.x * NTHR) { const float* src = g < np8 ? pp + g * 8 : ps + (g - np8) * 8;
            const f32x4 a = *(const f32x4*)src, b = *(const f32x4*)(src + 4); v4u w; w.x = pk2(a.x, a.y); w.y = pk2(a.z, a.w); w.z = pk2(b.x, b.y); w.w = pk2(b.z, b.w); *(v4u*)(o + g * 8) = w; }
    }
}
__device__ __forceinline__ float fast_sigmoid(float x) { return __builtin_amdgcn_rcpf(1.0f + __builtin_amdgcn_exp2f(-1.4426950408889634f * x)); }
template <int MODE> __device__ __forceinline__ void row_phase(const P& p, const float* wa, const float* wn, int gw, int ngw, int lane) {
    constexpr int NV = D / 256;
    asm volatile("" : "+v"(lane));
    f32x4 hN[NV]; unsigned long long hB[NV], yN[NV], pN[NV];
#define ROW_LOAD(t_) do { const long tt_ = (t_); \
        if (MODE == 0) { const long np = (long)NPROMPT * S * D; const float* src = (tt_ * D < np) ? p.x_prompt + (size_t)tt_ * D : p.x_sample + ((size_t)tt_ * D - np); \
            _Pragma("unroll") for (int i = 0; i < NV; ++i) hN[i] = *(const f32x4*)(src + (i * 64 + lane) * 4); } \
        else { const bf16* hr_ = WSP(bf16, WS_H16) + (size_t)tt_ * D; const bf16* yr_ = WSP(bf16, WS_GOUT) + (size_t)tt_ * D; \
            _Pragma("unroll") for (int i = 0; i < NV; ++i) { hB[i] = *(const unsigned long long*)(hr_ + (i * 64 + lane) * 4); yN[i] = *(const unsigned long long*)(yr_ + (i * 64 + lane) * 4); } \
            if (MODE == 3) { const bf16* pr_ = WSP(bf16, WS_PP2) + (size_t)tt_ * D; _Pragma("unroll") for (int i = 0; i < NV; ++i) pN[i] = *(const unsigned long long*)(pr_ + (i * 64 + lane) * 4); } } } while (0)
#define UNPK(q_) (f32x4){bf2f((bf16)((q_) & 0xffff)), bf2f((bf16)(((q_) >> 16) & 0xffff)), bf2f((bf16)(((q_) >> 32) & 0xffff)), bf2f((bf16)((q_) >> 48))}
    f32x4 wA[NV], wN[NV];
#pragma unroll
    for (int i = 0; i < NV; ++i) { wA[i] = (MODE == 1 || MODE == 2) ? *(const f32x4*)(wa + (i * 64 + lane) * 4) : (f32x4){0.f, 0.f, 0.f, 0.f}; wN[i] = (MODE != 2 && wn != nullptr) ? *(const f32x4*)(wn + (i * 64 + lane) * 4) : (f32x4){0.f, 0.f, 0.f, 0.f}; }
    if (gw < T) ROW_LOAD(gw);
    for (int t = gw; t < T; t += ngw) {
        f32x4 h[NV], y[NV], pp[NV];
#pragma unroll
        for (int i = 0; i < NV; ++i) { if (MODE == 0) h[i] = hN[i]; else { h[i] = UNPK(hB[i]); y[i] = UNPK(yN[i]); } if (MODE == 3) pp[i] = UNPK(pN[i]); }
        if (t + ngw < T) ROW_LOAD(t + ngw);
        if (MODE == 1 || MODE == 2) {
            float ss = 0.f;
#pragma unroll
            for (int i = 0; i < NV; ++i) ss += (y[i].x * y[i].x + y[i].y * y[i].y) + (y[i].z * y[i].z + y[i].w * y[i].w);
            const float r = 1.0f / sqrtf(wave_sum(ss) * (1.0f / D) + RMS_EPS);
#pragma unroll
            for (int i = 0; i < NV; ++i) h[i] = h[i] + y[i] * r * wA[i];
        } else if (MODE == 3) {
#pragma unroll
            for (int i = 0; i < NV; ++i) { h[i].x += fast_sigmoid(y[i].x) * pp[i].x; h[i].y += fast_sigmoid(y[i].y) * pp[i].y; h[i].z += fast_sigmoid(y[i].z) * pp[i].z; h[i].w += fast_sigmoid(y[i].w) * pp[i].w; }
        }
        if (MODE == 3 && wn == nullptr) { float* hr = p.h + (size_t)t * D;
#pragma unroll
            for (int i = 0; i < NV; ++i) *(f32x4*)(hr + (i * 64 + lane) * 4) = h[i];
            continue; }
        { bf16* hw = WSP(bf16, WS_H16) + (size_t)t * D;
#pragma unroll
            for (int i = 0; i < NV; ++i) *(unsigned long long*)(hw + (i * 64 + lane) * 4) = (unsigned long long)pk2(h[i].x, h[i].y) | ((unsigned long long)pk2(h[i].z, h[i].w) << 32); }
        if (MODE == 2) continue;
        float r2 = 1.f;
        if (MODE != 2) { float ss = 0.f;
#pragma unroll
            for (int i = 0; i < NV; ++i) ss += (h[i].x * h[i].x + h[i].y * h[i].y) + (h[i].z * h[i].z + h[i].w * h[i].w);
            r2 = 1.0f / sqrtf(wave_sum(ss) * (1.0f / D) + RMS_EPS); }
        bf16* o = WSP(bf16, WS_HN) + (size_t)t * D;
#pragma unroll
        for (int i = 0; i < NV; ++i) { f32x4 v = h[i] * r2; if (MODE != 2) v = v * wN[i];
            *(unsigned long long*)(o + (i * 64 + lane) * 4) = (unsigned long long)pk2(v.x, v.y) | ((unsigned long long)pk2(v.z, v.w) << 32); }
    }
#undef ROW_LOAD
#undef UNPK
}

typedef short bf16x8_t __attribute__((ext_vector_type(8)));
__device__ __forceinline__ float gelu_fast(float x) { const float u = 0.7978845608028654f * (x + 0.044715f * x * x * x); return x * __builtin_amdgcn_rcpf(1.0f + __builtin_amdgcn_exp2f(-2.885390081777927f * u)); }
__device__ __forceinline__ void ffn_act_phase(const P& p, int layer, int gw, int ngw, int lane) {
    asm volatile("" : "+v"(lane));
    constexpr int TT = 32, NCB = DFF / 512, NIT = (T / TT) * NCB;
    const bf16* hid = WSP(bf16, WS_HID); bf16* act = WSP(bf16, WS_ACT);
    const float* cw = PRM(PR_FCW) + (size_t)layer * 3 * 2 * DFF; const float* cb = PRM(PR_FCB) + (size_t)layer * 2 * DFF;
    for (int it = gw; it < NIT; it += ngw) {
        const int cblk = it % NCB, tile = it / NCB; const int c0 = cblk * 512 + lane * 8; const long t0 = (long)tile * TT; const int tt0 = (int)(t0 % S);
        float wg[3][8], wu[3][8], bg[8], bu[8];
#pragma unroll
        for (int i = 0; i < 3; ++i)
#pragma unroll
            for (int e = 0; e < 8; ++e) { wg[i][e] = cw[i * 2 * DFF + c0 + e]; wu[i][e] = cw[i * 2 * DFF + DFF + c0 + e]; }
#pragma unroll
        for (int e = 0; e < 8; ++e) { bg[e] = cb[c0 + e]; bu[e] = cb[DFF + c0 + e]; }
        const bf16x8_t zero8 = {0, 0, 0, 0, 0, 0, 0, 0};
        bf16x8_t g0 = zero8, u0 = zero8, g1, u1, g2, u2;
        if (tt0 > 0) { g0 = *(const bf16x8_t*)(hid + (size_t)(t0 - 1) * (2 * DFF) + c0); u0 = *(const bf16x8_t*)(hid + (size_t)(t0 - 1) * (2 * DFF) + DFF + c0); }
        g1 = *(const bf16x8_t*)(hid + (size_t)t0 * (2 * DFF) + c0); u1 = *(const bf16x8_t*)(hid + (size_t)t0 * (2 * DFF) + DFF + c0);
        for (int k = 0; k < TT; ++k) {
            const long t = t0 + k;
            if (tt0 + k + 1 < S) { g2 = *(const bf16x8_t*)(hid + (size_t)(t + 1) * (2 * DFF) + c0); u2 = *(const bf16x8_t*)(hid + (size_t)(t + 1) * (2 * DFF) + DFF + c0); } else { g2 = zero8; u2 = zero8; }
            float o[8];
#pragma unroll
            for (int e = 0; e < 8; ++e) {
                const float ga = bg[e] + bf2f((bf16)g0[e]) * wg[0][e] + bf2f((bf16)g1[e]) * wg[1][e] + bf2f((bf16)g2[e]) * wg[2][e];
                const float up = bu[e] + bf2f((bf16)u0[e]) * wu[0][e] + bf2f((bf16)u1[e]) * wu[1][e] + bf2f((bf16)u2[e]) * wu[2][e];
                o[e] = gelu_fast(ga) * up; }
            v4u w; w.x = pk2(o[0], o[1]); w.y = pk2(o[2], o[3]); w.z = pk2(o[4], o[5]); w.w = pk2(o[6], o[7]);
            *(v4u*)(act + (size_t)t * DFF + c0) = w;
            g0 = g1; u0 = u1; g1 = g2; u1 = u2;
        }
    }
}
__device__ __forceinline__ void dn_out_phase(const P& p, int jl, int gw, int ngw, int lane) {
    asm volatile("" : "+v"(lane));
    const int hh = lane >> 3, d0 = (lane & 7) * 16; const float* on = PRM(PR_ONORM) + jl * DH + d0;
    bf16x8_t aN[2], bN[2], zN0, zN1;
#define DNO_LOAD(t_) do { const bf16* of_ = WSP(bf16, WS_OF) + ((size_t)(t_) * NH + hh) * DH + d0; const bf16* ob_ = WSP(bf16, WS_OB) + ((size_t)(t_) * NH + hh) * DH + d0; \
        const bf16* z_ = WSP(bf16, WS_PROJ) + (size_t)(t_) * ABINP + COL_Z + hh * DH + d0; \
        aN[0] = *(const bf16x8_t*)of_; aN[1] = *(const bf16x8_t*)(of_ + 8); bN[0] = *(const bf16x8_t*)ob_; bN[1] = *(const bf16x8_t*)(ob_ + 8); zN0 = *(const bf16x8_t*)z_; zN1 = *(const bf16x8_t*)(z_ + 8); } while (0)
    if (gw < T) DNO_LOAD(gw);
    for (int t = gw; t < T; t += ngw) {
        float o[16]; float ss = 0.f; const bf16x8_t z0 = zN0, z1 = zN1;
#pragma unroll
        for (int c8 = 0; c8 < 2; ++c8)
#pragma unroll
            for (int e = 0; e < 8; ++e) { o[8 * c8 + e] = bf2f((bf16)aN[c8][e]) + bf2f((bf16)bN[c8][e]); ss += o[8 * c8 + e] * o[8 * c8 + e]; }
        if (t + ngw < T) DNO_LOAD(t + ngw);
        ss += __shfl_xor(ss, 1); ss += __shfl_xor(ss, 2); ss += __shfl_xor(ss, 4);
        const float r = 1.0f / sqrtf(ss * (1.0f / DH) + RMS_EPS); float v[16];
#pragma unroll
        for (int e = 0; e < 16; ++e) { const float zz = bf2f((bf16)(e < 8 ? z0[e] : z1[e - 8])); v[e] = o[e] * r * on[e] * zz * fast_sigmoid(zz); }
        bf16* out = WSP(bf16, WS_MIXIN) + (size_t)t * ABMIX + hh * DH + d0;
        v4u w0, w1; w0.x = pk2(v[0], v[1]); w0.y = pk2(v[2], v[3]); w0.z = pk2(v[4], v[5]); w0.w = pk2(v[6], v[7]); w1.x = pk2(v[8], v[9]); w1.y = pk2(v[10], v[11]); w1.z = pk2(v[12], v[13]); w1.w = pk2(v[14], v[15]);
        *(v4u*)out = w0; *(v4u*)(out + 8) = w1;
    }
#undef DNO_LOAD
}
__device__ __forceinline__ void c_out_phase(const P& p, int jl, int gw, int ngw, int lane) {
    asm volatile("" : "+v"(lane));
    const int hh = lane >> 3, e0 = (lane & 7) * 32; const float lam = WSP(float, WS_LAM)[0], li = WSP(float, WS_LAM)[1]; const float* sw = PRM(PR_SUBLN) + jl * 256 + e0;
    bf16x8_t aN[4], bN[4];
#define CO_LOAD(t_) do { const bf16* o0_ = WSP(bf16, WS_O0) + (size_t)(t_) * 2048 + hh * 256 + e0; const bf16* o1_ = WSP(bf16, WS_O1) + (size_t)(t_) * 2048 + hh * 256 + e0; \
        _Pragma("unroll") for (int c8 = 0; c8 < 4; ++c8) { aN[c8] = *(const bf16x8_t*)(o0_ + 8 * c8); bN[c8] = *(const bf16x8_t*)(o1_ + 8 * c8); } } while (0)
    if (gw < T) CO_LOAD(gw);
    for (int t = gw; t < T; t += ngw) {
        float o[32]; float ss = 0.f;
#pragma unroll
        for (int c8 = 0; c8 < 4; ++c8)
#pragma unroll
            for (int e = 0; e < 8; ++e) { o[8 * c8 + e] = bf2f((bf16)aN[c8][e]) - lam * bf2f((bf16)bN[c8][e]); ss += o[8 * c8 + e] * o[8 * c8 + e]; }
        if (t + ngw < T) CO_LOAD(t + ngw);
        ss += __shfl_xor(ss, 1); ss += __shfl_xor(ss, 2); ss += __shfl_xor(ss, 4);
        const float r = (1.0f / sqrtf(ss * (1.0f / 256.0f) + RMS_EPS)) * (1.0f - li);
        bf16* out = WSP(bf16, WS_MIXIN) + (size_t)t * 2048 + hh * 256 + e0;
#pragma unroll
        for (int c8 = 0; c8 < 4; ++c8) { v4u w; w.x = pk2(o[8 * c8] * r * sw[8 * c8], o[8 * c8 + 1] * r * sw[8 * c8 + 1]); w.y = pk2(o[8 * c8 + 2] * r * sw[8 * c8 + 2], o[8 * c8 + 3] * r * sw[8 * c8 + 3]);
            w.z = pk2(o[8 * c8 + 4] * r * sw[8 * c8 + 4], o[8 * c8 + 5] * r * sw[8 * c8 + 5]); w.w = pk2(o[8 * c8 + 6] * r * sw[8 * c8 + 6], o[8 * c8 + 7] * r * sw[8 * c8 + 7]); *(v4u*)(out + 8 * c8) = w; }
    }
#undef CO_LOAD
}
__device__ __forceinline__ void rope_table_phase(const P& p, int tid_in) {
    int t_ = tid_in; asm volatile("" : "+v"(t_));
    float* tab = WSP(float, WS_LAM) + 16;
    for (int g = (int)blockIdx.x * NTHR + t_; g < S * 16; g += (int)gridDim.x * NTHR) { const int i = g & 15, pos = g >> 4;
        const float inv = powf(500000.0f, -(float)(2 * i) / 32.0f); const float ang = (float)pos * inv; tab[2 * g] = cosf(ang); tab[2 * g + 1] = sinf(ang); }
}
__device__ __forceinline__ void rope_phase(const P& p, int tid_in) {
    int t_ = tid_in; asm volatile("" : "+v"(t_));
    const float* tab = WSP(const float, WS_LAM) + 16;
    for (long g = (long)blockIdx.x * NTHR + t_; g < (long)T * 32; g += (long)gridDim.x * NTHR) {
        const int hj = (int)(g & 15), which = (int)((g >> 4) & 1); const long t = g >> 5; const float* cs_ = tab + (size_t)(t % S) * 32;
        bf16* x = WSP(bf16, WS_PROJ) + (size_t)t * CIN + which * 2048 + hj * DH;
        bf16x8_t a0 = *(const bf16x8_t*)x, a1 = *(const bf16x8_t*)(x + 8), b0 = *(const bf16x8_t*)(x + 16), b1 = *(const bf16x8_t*)(x + 24); float r1[16], r2[16];
#pragma unroll
        for (int i = 0; i < 16; ++i) { const float cs = cs_[2 * i], sn = cs_[2 * i + 1];
            const float x1 = bf2f((bf16)(i < 8 ? a0[i] : a1[i - 8])), x2 = bf2f((bf16)(i < 8 ? b0[i] : b1[i - 8])); r1[i] = x1 * cs - x2 * sn; r2[i] = x2 * cs + x1 * sn; }
        v4u w;
        w.x = pk2(r1[0], r1[1]); w.y = pk2(r1[2], r1[3]); w.z = pk2(r1[4], r1[5]); w.w = pk2(r1[6], r1[7]); *(v4u*)x = w;
        w.x = pk2(r1[8], r1[9]); w.y = pk2(r1[10], r1[11]); w.z = pk2(r1[12], r1[13]); w.w = pk2(r1[14], r1[15]); *(v4u*)(x + 8) = w;
        w.x = pk2(r2[0], r2[1]); w.y = pk2(r2[2], r2[3]); w.z = pk2(r2[4], r2[5]); w.w = pk2(r2[6], r2[7]); *(v4u*)(x + 16) = w;
        w.x = pk2(r2[8], r2[9]); w.y = pk2(r2[10], r2[11]); w.z = pk2(r2[12], r2[13]); w.w = pk2(r2[14], r2[15]); *(v4u*)(x + 24) = w;
    }
}
__device__ __forceinline__ void ffn_fix_phase(const P& p, int layer, int tid_in) {
    int t_ = tid_in; asm volatile("" : "+v"(t_));
    const int ln = t_ & 63, gwv = (int)blockIdx.x * NWAVES + __builtin_amdgcn_readfirstlane(t_ >> 6), ngwv = (int)gridDim.x * NWAVES;
    const float* cw = PRM(PR_FCW) + (size_t)layer * 3 * 2 * DFF; const float* cb = PRM(PR_FCB) + (size_t)layer * 2 * DFF; const float* HALO = WSP(float, WS_HALO);
    constexpr int NP = T / 256, PPS = S / 256, NCB = DFF / 256;
    for (int g = gwv; g < NP * 2 * NCB; g += ngwv) {
        const int c0 = (g % NCB) * 256 + ln * 4; const int edge = (g / NCB) & 1; const int pm = g / (2 * NCB);
        const bool has_prev = edge ? true : (pm % PPS != 0), has_next = edge ? (pm % PPS != PPS - 1) : true;
        const float* rp = HALO + (((size_t)(edge ? pm : pm - 1) * 4 + (edge ? 2 : 3)) * 2) * DFF + c0;
        const float* rc = HALO + (((size_t)pm * 4 + (edge ? 3 : 0)) * 2) * DFF + c0;
        const float* rn = HALO + (((size_t)(edge ? pm + 1 : pm) * 4 + (edge ? 0 : 1)) * 2) * DFF + c0;
        const f32x4 z4 = {0.f, 0.f, 0.f, 0.f};
        f32x4 gp = z4, up = z4, gn = z4, un = z4;
        if (has_prev) { gp = *(const f32x4*)rp; up = *(const f32x4*)(rp + DFF); }
        if (has_next) { gn = *(const f32x4*)rn; un = *(const f32x4*)(rn + DFF); }
        const f32x4 gc = *(const f32x4*)rc, uc = *(const f32x4*)(rc + DFF);
        const f32x4 bg = *(const f32x4*)(cb + c0), bu = *(const f32x4*)(cb + DFF + c0);
        const f32x4 wg0 = *(const f32x4*)(cw + c0), wu0 = *(const f32x4*)(cw + DFF + c0), wg1 = *(const f32x4*)(cw + 2 * DFF + c0), wu1 = *(const f32x4*)(cw + 3 * DFF + c0),
                    wg2 = *(const f32x4*)(cw + 4 * DFF + c0), wu2 = *(const f32x4*)(cw + 5 * DFF + c0);
        float o[4];
#pragma unroll
        for (int e = 0; e < 4; ++e) {
            const float cg = bg[e] + wg0[e] * gp[e] + wg1[e] * gc[e] + wg2[e] * gn[e];
            const float cu = bu[e] + wu0[e] * up[e] + wu1[e] * uc[e] + wu2[e] * un[e];
            o[e] = pg8::gelu_t(cg) * cu; }
        *(unsigned long long*)(WSP(bf16, WS_ACT) + ((size_t)pm * 256 + (edge ? 255 : 0)) * DFF + c0) = (unsigned long long)pk2(o[0], o[1]) | ((unsigned long long)pk2(o[2], o[3]) << 32);
    }
}
__device__ __forceinline__ int hw_lane() { int l; asm volatile("v_mbcnt_lo_u32_b32 %0, -1, 0\n\tv_mbcnt_hi_u32_b32 %0, -1, %0" : "=v"(l)); return l; }
struct Args { P p; };
__global__ void __launch_bounds__(NTHR, 2) mega_fwd(Args args) {
    extern __shared__ __attribute__((aligned(16))) unsigned char lds_raw[];
    LAS unsigned char* lds = (LAS unsigned char*)lds_raw;
    const P& p = args.p;
    const int tid = threadIdx.x, wave = __builtin_amdgcn_readfirstlane(tid >> 6);
#define HWLANE hw_lane()
#define HWTID ((wave << 6) | HWLANE)
#define lane HWLANE
    const int G = gridDim.x; const int gw = blockIdx.x * NWAVES + wave, ngw = G * NWAVES;
    volatile LAS unsigned* MISC = (volatile LAS unsigned*)(lds + MISC_OFF);
    for (int u = tid; u < (LDS_BYTES - LDSCTL_OFF) / 4; u += NTHR) ((LAS unsigned*)(lds + LDSCTL_OFF))[u] = 0u;
    __syncthreads();
    XcdBarrier bar = xcd_barrier_post(WSP(unsigned, WS_CTL) + CW_BAR, MISC + 8);
    Job j; j.p = p; j.w.W = nullptr; j.w.O = nullptr; j.w.K = 0; j.w.N = 0; j.w.Npad = 0; j.a = nullptr; j.b = nullptr; j.n = 0; j.layer = 0; j.flag = 0;

    {
        LAS float* scr = (LAS float*)(lds + wave * 16640);
        for (int m = 0; m < 24; ++m) {
            const float* W; bf16* O; int K, N, Npad; const int i = m & 1, l = m & 3;
            if (m < 2)       { W = p.ab_w_in + (size_t)i * D * ABIN;  O = WSP(bf16, WS_WABIN + (size_t)i * ABINP * D * 2); K = D; N = ABIN; Npad = ABINP; }
            else if (m < 4)  { W = p.ab_w_out + (size_t)i * ABMIX * D; O = WSP(bf16, WS_WABOUT + (size_t)i * D * ABMIX * 2); K = ABMIX; N = D; Npad = D; }
            else if (m < 6)  { W = p.c_w_in + (size_t)i * D * CIN;    O = WSP(bf16, WS_WCIN + (size_t)i * CIN * D * 2); K = D; N = CIN; Npad = CIN; }
            else if (m < 8)  { W = p.c_w_out + (size_t)i * CV * D;    O = WSP(bf16, WS_WCOUT + (size_t)i * D * CV * 2); K = CV; N = D; Npad = D; }
            else if (m < 12) { W = p.ffn_w_in + (size_t)l * D * 2 * DFF; O = WSP(bf16, WS_WFIN + (size_t)l * 2 * DFF * D * 2); K = D; N = 2 * DFF; Npad = 2 * DFF; }
            else if (m < 16) { W = p.ffn_w_out + (size_t)l * DFF * D;  O = WSP(bf16, WS_WFOUT + (size_t)l * D * DFF * 2); K = DFF; N = D; Npad = D; }
            else if (m < 20) { W = p.ple_w_proj + (size_t)l * PLE * D; O = WSP(bf16, WS_WPP + (size_t)l * D * PLE * 2); K = PLE; N = D; Npad = D; }
            else             { W = p.ple_w_gate + (size_t)l * D * D;   O = WSP(bf16, WS_WPG + (size_t)l * D * D * 2); K = D; N = D; Npad = D; }
            const int nitems = (K / 64) * (Npad / 64);
            for (int it = gw; it < nitems; it += ngw) transpose_item(W, K, N, O, scr, it, lane, (m >= 8 && m < 12) ? 1 : 0);
        }
        rope_table_phase(p, HWTID);
        {
            int t_ = HWTID; asm volatile("" : "+v"(t_));
            if (blockIdx.x == 0 && t_ < 2) { const float* lp = p.c_lambda + (size_t)t_ * 4 * DH; float a = 0.f, b = 0.f;
                for (int d = 0; d < DH; ++d) { a += lp[d] * lp[DH + d]; b += lp[2 * DH + d] * lp[3 * DH + d]; }
                const float li = lambda_init_of(2 * t_ + 1); WSP(float, WS_LAM)[2 * t_] = expf(a) - expf(b) + li; WSP(float, WS_LAM)[2 * t_ + 1] = li; }
        }
        grid_items<ST_PRM>(j, N_PRM, HWTID);
        pb_phase(p, HWTID);
        row_phase<0>(p, nullptr, p.norms, gw, ngw, lane);
    }
    xcd_barrier(bar, HWTID);

    for (int layer = 0; layer < DEPTH; ++layer) {
        j.layer = layer; const int jj = layer >> 1; const float* nw = PRM(PR_NORMS) + (size_t)layer * 4 * D;
        {
            const bool ab = (layer & 1) == 0; const int N = ab ? ABINP : CIN;
            const bf16* Bt = ab ? WSP(bf16, WS_WABIN + (size_t)jj * ABINP * D * 2) : WSP(bf16, WS_WCIN + (size_t)jj * CIN * D * 2);
            pg8::Gemm g{WSP(bf16, WS_HN), Bt, T, N, D}; pg8::StaticOrder S_; S_.init(T, N, G, (int)blockIdx.x);
            pg8::EpiBf16Ro E{WSP(bf16, WS_PROJ), N, ab ? nullptr : WSP(const float, WS_LAM) + 16, S};
            pg8::gemm_phase<pg8::EpiBf16Ro, pg8::StaticOrder, true, true>(lds, g, S_, E, HWTID);
        }
        xcd_barrier(bar, HWTID);
        int pp_first = (int)blockIdx.x, pp_stride = G; bool pp_run = true;
        if ((layer & 1) == 0) {
            {
                constexpr int NU = NSEQ * NH * (S / 64);
                for (int u = (int)blockIdx.x; u < NU; u += G) dn::dn1_unit(p, jj, u / (NH * (S / 64)), (u / (S / 64)) % NH, u % (S / 64), (char*)lds_raw, HWTID);
            }
            xcd_barrier(bar, HWTID);
            constexpr int NSC = NSEQ * NH * 2; const bool split = G >= 2 * NSC; const int na_first = split ? (int)blockIdx.x - NSC : (int)blockIdx.x, na_stride = split ? G - NSC : G;
            if (!split || (int)blockIdx.x < NSC) { for (int ch = (int)blockIdx.x; ch < NSC; ch += G) dn::dn_scan_chain(p, ch, (char*)lds_raw, HWTID); }
            if (!split || (int)blockIdx.x >= NSC)
            {
                constexpr int NU = NSEQ * NH * (ROWS / 4);
                float* tab = (float*)((char*)lds_raw + att::SHM_ATTN);
                for (int u = na_first; u < NU; u += na_stride) {
                    const int rg = u % (ROWS / 4); const int hh = (u / (ROWS / 4)) % NH, seq = u / ((ROWS / 4) * NH); const int r0 = rg * 4;
                    const int kr0 = clampi(r0 - WR / 2, 0, ROWS - WR), krl = clampi(r0 + 3 - WR / 2, 0, ROWS - WR) + WR - 1; const int nt = krl - kr0 + 1;
                    { int t_ = HWTID; asm volatile("" : "+v"(t_)); if (t_ < 15 * 31) tab[t_] = PRM(PR_RPB)[((size_t)jj * NH + hh) * 15 * 31 + t_] * 11.313708498984761f; }
                    const bf16* base = WSP(bf16, WS_PROJ) + (size_t)seq * S * ABINP;
                    att::na_body<ABINP, ABINP, ABMIX>(base + (size_t)r0 * GW * ABINP + COL_QB + hh * DH, base + (size_t)kr0 * GW * ABINP + COL_KB + hh * DH, base + (size_t)kr0 * GW * ABINP + COL_VB + hh * DH,
                        WSP(bf16, WS_MIXIN) + ((size_t)seq * S + (size_t)r0 * GW) * ABMIX + 1024 + hh * DH, nt, (char*)lds_raw, att::NaInfo{r0, kr0, tab}, HWTID);
                    __syncthreads();
                }
            }
            pp_first = na_first; pp_stride = na_stride; pp_run = !split || (int)blockIdx.x >= NSC;
        } else {
            {
                constexpr int NU = NSEQ * NH * (S / 256);
                const int vcu = (G % 8 == 0) ? ((int)blockIdx.x % 8) * (G / 8) + (int)blockIdx.x / 8 : (int)blockIdx.x;
                const float lam = WSP(float, WS_LAM)[2 * jj], li = WSP(float, WS_LAM)[2 * jj + 1];
                for (int u = vcu; u < NU; u += G) {
                    const int qb = u % (S / 256); const int r_ = u / (S / 256); const int hh = r_ % NH, seq = r_ / NH;
                    const bf16* base = WSP(bf16, WS_PROJ) + (size_t)seq * S * CIN; const size_t oo = ((size_t)seq * S + (size_t)qb * 256) * 2048 + hh * 256;
#pragma unroll 1
                    for (int jj2 = 0; jj2 < 2; ++jj2) {
                        att::dattn256_body<CIN, CIN, 2048>(base + (size_t)qb * 256 * CIN + hh * 256 + jj2 * DH, base + 2048 + hh * 256 + jj2 * DH, base + 4096 + hh * 256,
                            WSP(bf16, WS_O0) + oo, S / 64, (char*)lds_raw, HWTID, jj2, WSP(bf16, WS_MIXIN) + oo, lam, 1.0f - li, PRM(PR_SUBLN) + jj * 256);
                        __syncthreads();
                    }
                }
            }
        }
        if (pp_run) {
            pg8::Gemm g{WSP(bf16, WS_PB + (size_t)layer * SZ_PB), WSP(bf16, WS_WPP + (size_t)layer * D * PLE * 2), T, D, PLE}; pg8::StaticOrder S_; S_.init(T, D, pp_stride, pp_first);
            pg8::EpiBf16 E{WSP(bf16, WS_PP2), D};
            pg8::gemm_phase<pg8::EpiBf16, pg8::StaticOrder, true, true>(lds, g, S_, E, HWTID);
        }
        xcd_barrier(bar, HWTID);
        if ((layer & 1) == 0) { dn_out_phase(p, jj, gw, ngw, lane); xcd_barrier(bar, HWTID); }
        {
            const bf16* Bt = (layer & 1) == 0 ? WSP(bf16, WS_WABOUT + (size_t)jj * D * ABMIX * 2) : WSP(bf16, WS_WCOUT + (size_t)jj * D * CV * 2);
            pg8::Gemm g{WSP(bf16, WS_MIXIN), Bt, T, D, 2048}; pg8::StaticOrder S_; S_.init(T, D, G, (int)blockIdx.x);
            pg8::EpiBf16 E{WSP(bf16, WS_GOUT), D};
            pg8::gemm_phase<pg8::EpiBf16, pg8::StaticOrder, true, true>(lds, g, S_, E, HWTID);
        }
        xcd_barrier(bar, HWTID);
        row_phase<1>(p, nw + D, nw + 2 * D, gw, ngw, lane);
        xcd_barrier(bar, HWTID);
        {
            pg8::Gemm g{WSP(bf16, WS_HN), WSP(bf16, WS_WFIN + (size_t)layer * 2 * DFF * D * 2), T, 2 * DFF, D}; pg8::StaticOrder S_; S_.init(T, 2 * DFF, G, (int)blockIdx.x);
            pg8::EpiConvAct E{WSP(bf16, WS_ACT), WSP(float, WS_HALO), WSP(float, WS_HALO) + (size_t)(T / 256) * 4 * 2 * DFF + 4096 * (int)blockIdx.x, PRM(PR_FCW) + (size_t)layer * 3 * 2 * DFF, PRM(PR_FCB) + (size_t)layer * 2 * DFF, (PG8_LAS float*)(lds + RING_BYTES)};
            pg8::gemm_phase<pg8::EpiConvAct, pg8::StaticOrder, true, true>(lds, g, S_, E, HWTID);
        }
        xcd_barrier(bar, HWTID);
        ffn_fix_phase(p, layer, HWTID);
        xcd_barrier(bar, HWTID);
        {
            pg8::Gemm g{WSP(bf16, WS_ACT), WSP(bf16, WS_WFOUT + (size_t)layer * D * DFF * 2), T, D, DFF}; pg8::StaticOrder S_; S_.init(T, D, G, (int)blockIdx.x);
            pg8::EpiBf16 E{WSP(bf16, WS_GOUT), D};
            pg8::gemm_phase<pg8::EpiBf16, pg8::StaticOrder, true, true>(lds, g, S_, E, HWTID);
        }
        xcd_barrier(bar, HWTID);
        row_phase<2>(p, nw + 3 * D, nullptr, gw, ngw, lane);
        xcd_barrier(bar, HWTID);
        {
            pg8::Gemm g{WSP(bf16, WS_H16), WSP(bf16, WS_WPG + (size_t)layer * D * D * 2), T, D, D}; pg8::StaticOrder S_; S_.init(T, D, G, (int)blockIdx.x);
            pg8::EpiBf16 E{WSP(bf16, WS_GOUT), D};
            pg8::gemm_phase<pg8::EpiBf16, pg8::StaticOrder, true, true>(lds, g, S_, E, HWTID);
        }
        xcd_barrier(bar, HWTID);
        row_phase<3>(p, nullptr, layer + 1 < DEPTH ? PRM(PR_NORMS) + (size_t)(layer + 1) * 4 * D : nullptr, gw, ngw, lane);
        if (layer + 1 < DEPTH) xcd_barrier(bar, HWTID);
    }
}

#undef lane
#undef HWTID
#undef HWLANE
extern "C" void kernel_launch(void* const* d_in, const int* in_sizes, int n_in, void* d_out, int out_size, void* d_ws, size_t ws_size, hipStream_t stream) {
    static int grid = 0;
    if (grid == 0) {
        if (n_in != 22 || out_size != T * D || ws_size < WS_END) { fprintf(stderr, "kernel_launch: unexpected shapes n_in %d out %d ws %zu (need %zu)\n", n_in, out_size, ws_size, (size_t)WS_END); grid = -1; return; }
        int dev = 0, cus = 0, per_cu = 0;
        if (hipGetDevice(&dev) != hipSuccess || hipDeviceGetAttribute(&cus, hipDeviceAttributeMultiprocessorCount, dev) != hipSuccess) { grid = -1; return; }
        if (hipFuncSetAttribute((const void*)mega_fwd, hipFuncAttributeMaxDynamicSharedMemorySize, LDS_BYTES) != hipSuccess) { fprintf(stderr, "kernel_launch: hipFuncSetAttribute failed\n"); grid = -1; return; }
        if (hipOccupancyMaxActiveBlocksPerMultiprocessor(&per_cu, (const void*)mega_fwd, NTHR, LDS_BYTES) != hipSuccess || per_cu < 1) fprintf(stderr, "kernel_launch: occupancy query reports %d blocks per CU\n", per_cu);
        (void)hipGetLastError();
        grid = cus;
    }
    if (grid < 0) return;
    if (hipMemsetAsync((char*)d_ws + WS_CTL, 0, CTL_ZERO_BYTES, stream) != hipSuccess) { fprintf(stderr, "kernel_launch: memset failed\n"); return; }
    Args a; memset(&a, 0, sizeof(a));
    const float** f = (const float**)&a.p;
    for (int i = 0; i < 22; ++i) f[i] = (const float*)d_in[i];
    a.p.h = (float*)d_out; a.p.ws = (unsigned char*)d_ws;
    hipLaunchKernelGGL(mega_fwd, dim3(grid), dim3(NTHR), LDS_BYTES, stream, a);
    const hipError_t le = hipPeekAtLastError();
    if (le != hipSuccess) fprintf(stderr, "kernel_launch: launch failed: %s\n", hipGetErrorName(le));
}
#else
int main(int argc, char** argv) {
    FILE* fs = fopen("sizes.txt", "r"); std::vector<long> sizes(22); for (int i = 0; i < 22; ++i) if (fscanf(fs, "%ld", &sizes[i]) != 1) return 1; fclose(fs);
    FILE* fi = fopen("inputs.bin", "rb"); std::vector<std::vector<float>> in(22);
    for (int i = 0; i < 22; ++i) { in[i].resize(sizes[i]); if (fread(in[i].data(), 4, sizes[i], fi) != (size_t)sizes[i]) return 2; } fclose(fi);
    std::vector<float> out((size_t)T * D); std::vector<unsigned char> ws(WS_END, 0xAA);
    printf("T %d D %d WS_END %zu MiB\n", T, D, (size_t)(WS_END / MiB));
    P p; memset(&p, 0, sizeof(p)); const float** f = (const float**)&p; for (int i = 0; i < 22; ++i) f[i] = in[i].data();
    p.h = out.data(); p.ws = ws.data();
    forward(p);
    FILE* fo = fopen("emu_out.bin", "wb"); fwrite(out.data(), 4, out.size(), fo); fclose(fo);
    return 0;
}
#endif
```

```cpp
#ifndef EMU
#include <hip/hip_runtime.h>
#include <cstdio>
#include <cstdint>
#include <cstring>
#define DEVFN __device__ __forceinline__
#define MEMFENCE() asm volatile("" ::: "memory")
#else
#include <cstdio>
#include <cstdint>
#include <cstdlib>
#include <cstring>
#include <cmath>
#include <vector>
#define DEVFN static inline
#define MEMFENCE() do {} while (0)
#endif
#include <cmath>

#ifndef EMU
constexpr int D = 2048, NSEQ = 6, NPROMPT = 2, S = 4096, PLE = 256, DFF = 8192;
#else
constexpr int D = 256, NSEQ = 2, NPROMPT = 1, S = 1024, PLE = 64, DFF = 512;
#endif
constexpr int T = NSEQ * S, DEPTH = 4, NH = 8, DH = 128;
constexpr int AQKV = 3072, ABIN = 7200, ABINP = 7424, ABMIX = 2048, CIN = 6144, CV = 2048;
constexpr int COL_Z = 3072, COL_G = 4096, COL_QB = 4128, COL_KB = 4128 + 1024, COL_VB = 4128 + 2048;
constexpr int GW = 64, ROWS = S / GW, NAR = 8, NAC = 16, WR = (NAR < ROWS ? NAR : ROWS);
constexpr float RMS_EPS = 1e-6f;

typedef unsigned short bf16;
DEVFN float bf2f(bf16 b) { unsigned u = ((unsigned)b) << 16; float f; memcpy(&f, &u, 4); return f; }
DEVFN bf16 f2bf(float f) { unsigned u; memcpy(&u, &f, 4); u += 0x7fffu + ((u >> 16) & 1u); return (bf16)(u >> 16); }
DEVFN float siluf(float x) { return x / (1.f + expf(-x)); }
DEVFN float sigmoidf(float x) { return 1.f / (1.f + expf(-x)); }
DEVFN float softplusf(float x) { if (x > 20.f) return x; const float y = expf(x); return y < 0.01f ? y * (1.f - y * (0.5f - y * 0.33333333f)) : logf(1.f + y); }
DEVFN int clampi(int v, int lo, int hi) { return v < lo ? lo : (v > hi ? hi : v); }

constexpr size_t MiB = 1u << 20;
constexpr size_t SZ_TD2 = (size_t)T * D * 2, SZ_TD4 = (size_t)T * D * 4;
constexpr size_t al(size_t x) { return (x + MiB - 1) / MiB * MiB; }
constexpr size_t WS_CTL = 0;
constexpr size_t WS_PRM = 1 * MiB;
constexpr int PR_ABCONV = 0, PR_ALOG = PR_ABCONV + 2 * 5 * AQKV, PR_DTB = PR_ALOG + 32, PR_ONORM = PR_DTB + 32, PR_RPB = PR_ONORM + 2 * DH, PR_LAMBDA = PR_RPB + 2 * NH * 15 * 31,
    PR_SUBLN = PR_LAMBDA + 2 * 4 * DH, PR_NORMS = PR_SUBLN + 2 * 256, PR_FCW = PR_NORMS + DEPTH * 4 * D, PR_FCB = PR_FCW + DEPTH * 3 * 2 * DFF, PR_END = PR_FCB + DEPTH * 2 * DFF;
static_assert((size_t)PR_END * 4 <= 2 * MiB, "param region");
constexpr size_t WS_WABIN = 3 * MiB;
constexpr size_t WS_WABOUT = WS_WABIN + al((size_t)2 * ABINP * D * 2);
constexpr size_t WS_WCIN = WS_WABOUT + al((size_t)2 * D * ABMIX * 2);
constexpr size_t WS_WCOUT = WS_WCIN + al((size_t)2 * CIN * D * 2);
constexpr size_t WS_WFIN = WS_WCOUT + al((size_t)2 * D * CV * 2);
constexpr size_t WS_WFOUT = WS_WFIN + al((size_t)4 * 2 * DFF * D * 2);
constexpr size_t WS_WPP = WS_WFOUT + al((size_t)4 * D * DFF * 2);
constexpr size_t WS_WPG = WS_WPP + al((size_t)4 * D * PLE * 2);
constexpr size_t WS_HN = WS_WPG + al((size_t)4 * D * D * 2);
#ifdef EMU
constexpr size_t WS_MIXIN = WS_HN + al(SZ_TD2);
#else
constexpr size_t WS_MIXIN = WS_HN;
constexpr size_t WS_H16 = WS_HN + al(SZ_TD2);
#endif
constexpr size_t WS_PB = WS_HN + 2 * al(SZ_TD2);
constexpr size_t SZ_PB = al((size_t)T * PLE * 2);
constexpr size_t WS_SMALL = WS_PB + DEPTH * SZ_PB;
constexpr size_t WS_RSTD = WS_SMALL, WS_G = WS_SMALL + al((size_t)T * 4), WS_BETA = WS_G + al((size_t)T * 16 * 4), WS_LAM = WS_BETA + al((size_t)T * 16 * 4);
constexpr size_t WS_R = WS_LAM + MiB;
constexpr size_t WS_GOUT = WS_R;
constexpr size_t WS_GOUT2 = WS_GOUT + al(SZ_TD4);
constexpr size_t WS_HID = WS_R;
#ifdef EMU
constexpr size_t WS_ACT = WS_HID + al((size_t)T * 2 * DFF * 2);
#else
constexpr size_t WS_ACT = WS_GOUT + al(SZ_TD4);
constexpr size_t WS_PP2 = (size_t)1952 * MiB;
#endif
constexpr size_t WS_HALO = WS_ACT + al((size_t)T * DFF * 2);
constexpr size_t WS_PROJ = WS_GOUT + al(SZ_TD4);
constexpr size_t WS_X1 = WS_PROJ + al((size_t)T * ABINP * 2);
constexpr size_t SZ_HD4 = al((size_t)T * NH * DH * 4);
#ifdef EMU
constexpr size_t WS_QN = WS_X1, WS_KN = WS_QN + SZ_HD4, WS_VV = WS_KN + SZ_HD4, WS_OF = WS_VV + SZ_HD4, WS_OB = WS_OF + SZ_HD4, WS_NASC = WS_OB + SZ_HD4;
constexpr size_t WS_END_AB = WS_NASC + SZ_HD4;
#else
constexpr size_t WS_OF = WS_GOUT, WS_OB = WS_OF + SZ_HD4;
constexpr size_t WS_QN = WS_X1, WS_KN = WS_X1, WS_VV = WS_X1, WS_NASC = WS_X1;
constexpr int NUD_ = NSEQ * NH * (S / 64) * 2;
constexpr size_t WS_DN_UT = WS_X1, WS_DN_WN = WS_DN_UT + al((size_t)NUD_ * 128 * 64 * 4), WS_DN_QE = WS_DN_WN + al((size_t)NUD_ * 16 * 512 * 2), WS_DN_IN = WS_DN_QE + al((size_t)NUD_ * 16 * 512 * 2),
    WS_DN_KD = WS_DN_IN + al((size_t)NUD_ * 8 * 512 * 2), WS_DN_EG = WS_DN_KD + al((size_t)NUD_ * 16 * 512 * 2);
constexpr size_t WS_END_AB = WS_DN_EG + MiB;
#endif
constexpr size_t WS_O0 = WS_X1, WS_O1 = WS_O0 + al((size_t)T * 2048 * 4);
constexpr size_t WS_END_C = WS_O1 + al((size_t)T * 2048 * 4);
constexpr size_t WS_END_F = WS_HALO + 32 * MiB;
constexpr size_t WS_END = (WS_END_AB > WS_END_C ? (WS_END_AB > WS_END_F ? WS_END_AB : WS_END_F) : (WS_END_C > WS_END_F ? WS_END_C : WS_END_F));
#ifndef EMU
static_assert(WS_END <= WS_PP2 && WS_PP2 + SZ_TD2 <= (size_t)2048 * MiB, "workspace map exceeds 2 GiB");
#endif

struct P {
    const float *x_prompt, *x_sample, *p_prompt, *p_sample, *ab_w_in, *ab_conv_w, *ab_a_log, *ab_dt_bias, *ab_out_norm, *ab_rpb, *ab_w_out,
        *c_w_in, *c_lambda, *c_subln, *c_w_out, *norms, *ffn_w_in, *ffn_conv_w, *ffn_conv_b, *ffn_w_out, *ple_w_proj, *ple_w_gate;
    float* h;
    unsigned char* ws;
};
#define WSP(type, off) ((type*)(p.ws + (off)))
#define PRM(off) (WSP(const float, WS_PRM) + (off))
constexpr long N_PRM = PR_END;
DEVFN void st_prm(const P& p, int, long g) {
    const int i = (int)g; float v;
    if (i < PR_ALOG) v = p.ab_conv_w[i - PR_ABCONV]; else if (i < PR_DTB) v = p.ab_a_log[i - PR_ALOG]; else if (i < PR_ONORM) v = p.ab_dt_bias[i - PR_DTB];
    else if (i < PR_RPB) v = p.ab_out_norm[i - PR_ONORM]; else if (i < PR_LAMBDA) v = p.ab_rpb[i - PR_RPB]; else if (i < PR_SUBLN) v = p.c_lambda[i - PR_LAMBDA];
    else if (i < PR_NORMS) v = p.c_subln[i - PR_SUBLN]; else if (i < PR_FCW) v = p.norms[i - PR_NORMS]; else if (i < PR_FCB) v = p.ffn_conv_w[i - PR_FCW]; else v = p.ffn_conv_b[i - PR_FCB];
    WSP(float, WS_PRM)[i] = v;
}
constexpr long N_INIT = (long)T * D / 4;
DEVFN void st_init(const P& p, int, long g) {
    const long i = g * 4, np = (long)NPROMPT * S * D;
    const float* src = i < np ? p.x_prompt + i : p.x_sample + (i - np);
    for (int k = 0; k < 4; ++k) p.h[i + k] = src[k];
}
constexpr long N_PB = (long)T * PLE;
DEVFN void st_pb(const P& p, int layer, long g) {
    const long np = (long)NPROMPT * S * PLE, ns = (long)(NSEQ - NPROMPT) * S * PLE;
    const float v = g < np ? p.p_prompt[(long)layer * np + g] : p.p_sample[(long)layer * ns + (g - np)];
    WSP(bf16, WS_PB + (size_t)layer * SZ_PB)[g] = f2bf(v);
}
struct WT { const float* W; bf16* O; int K, N, Npad; };
DEVFN void st_wt(const WT& w, long g) {
    const int n = (int)(g / w.K), k = (int)(g % w.K);
    w.O[g] = n < w.N ? f2bf(w.W[(size_t)k * w.N + n]) : (bf16)0;
}
constexpr long N_ROWS = T;
DEVFN void st_rowss(const P& p, const float* x, long g) {
    const float* r = x + (size_t)g * D; float s = 0.f;
    for (int c = 0; c < D; ++c) s += r[c] * r[c];
    WSP(float, WS_RSTD)[g] = 1.0f / sqrtf(s / (float)D + RMS_EPS);
}
constexpr long N_TD = (long)T * D;
DEVFN void st_norm_bf16(const P& p, const float* w, long g) {
    const long t = g / D; const int c = (int)(g % D);
    WSP(bf16, WS_HN)[g] = f2bf(p.h[g] * WSP(float, WS_RSTD)[t] * w[c]);
}
DEVFN void st_resid(const P& p, const float* y, const float* w, int write_hb, long g) {
    const long t = g / D; const int c = (int)(g % D);
    const float v = p.h[g] + y[g] * WSP(float, WS_RSTD)[t] * w[c];
    p.h[g] = v; if (write_hb) WSP(bf16, WS_HN)[g] = f2bf(v);
}
constexpr long N_TH = (long)T * NH;
DEVFN void st_dn_prep(const P& p, int layer, long g) {
    const int j = layer / 2; const long t = g / NH; const int hh = (int)(g % NH); const int tt = (int)(t % S); const long t0 = t - tt;
    const bf16* proj = WSP(bf16, WS_PROJ); const float* cw = PRM(PR_ABCONV) + (size_t)j * 5 * AQKV;
    for (int part = 0; part < 3; ++part) {
        float* o = (part == 0 ? WSP(float, WS_QN) : (part == 1 ? WSP(float, WS_KN) : WSP(float, WS_VV))) + (size_t)g * DH; float ss = 0.f;
        for (int d = 0; d < DH; ++d) {
            const int col = part * 1024 + hh * DH + d; float acc = 0.f;
            for (int i = 0; i < 5; ++i) { const int ts = tt + i - 2; if (ts >= 0 && ts < S) acc += bf2f(proj[(size_t)(t0 + ts) * ABINP + col]) * cw[i * AQKV + col]; }
            const float y = siluf(acc); ss += y * y; o[d] = y;
        }
        if (part < 2) { const float r = (1.0f / sqrtf(ss + 1e-6f)) * (part == 0 ? 0.08838834764831845f : 1.f); for (int d = 0; d < DH; ++d) o[d] *= r; }
    }
    for (int dir = 0; dir < 2; ++dir) {
        const float graw = bf2f(proj[(size_t)t * ABINP + COL_G + dir * NH + hh]), braw = bf2f(proj[(size_t)t * ABINP + COL_G + 16 + dir * NH + hh]);
        const float a = expf(PRM(PR_ALOG)[(j * 2 + dir) * NH + hh]), dtb = PRM(PR_DTB)[(j * 2 + dir) * NH + hh];
        WSP(float, WS_G)[(t * 2 + dir) * NH + hh] = -a * softplusf(graw + dtb);
        WSP(float, WS_BETA)[(t * 2 + dir) * NH + hh] = sigmoidf(braw);
    }
}
constexpr long N_SCAN = (long)NSEQ * NH * 2 * DH;
DEVFN void st_dn_scan(const P& p, int, long g) {
    const int vc = (int)(g % DH); const int dir = (int)((g / DH) % 2); const int hh = (int)((g / (2 * DH)) % NH); const int seq = (int)(g / (2 * DH * NH));
    const float *QN = WSP(float, WS_QN), *KN = WSP(float, WS_KN), *VV = WSP(float, WS_VV), *G = WSP(float, WS_G), *BT = WSP(float, WS_BETA);
    float* O = WSP(float, dir ? WS_OB : WS_OF);
    float Sx[DH];
#pragma unroll
    for (int d = 0; d < DH; ++d) Sx[d] = 0.f;
    for (int step = 0; step < S; ++step) {
        const int tt = dir ? S - 1 - step : step; const long t = (long)seq * S + tt;
        const float eg = expf(G[(t * 2 + dir) * NH + hh]), b = BT[(t * 2 + dir) * NH + hh];
        const float* kp = KN + ((size_t)t * NH + hh) * DH; const float* qp = QN + ((size_t)t * NH + hh) * DH; const float vv = VV[((size_t)t * NH + hh) * DH + vc];
        float dot = 0.f;
#pragma unroll
        for (int d0 = 0; d0 < DH; d0 += 16) { MEMFENCE();
#pragma unroll
            for (int d = d0; d < d0 + 16; ++d) { Sx[d] *= eg; dot += Sx[d] * kp[d]; } }
        const float delta = b * (vv - dot); float o = 0.f;
#pragma unroll
        for (int d0 = 0; d0 < DH; d0 += 16) { MEMFENCE();
#pragma unroll
            for (int d = d0; d < d0 + 16; ++d) { Sx[d] += kp[d] * delta; o += Sx[d] * qp[d]; } }
        MEMFENCE();
        O[((size_t)t * NH + hh) * DH + vc] = o;
    }
}
DEVFN void st_dn_out(const P& p, int layer, long g) {
    const int j = layer / 2; const long t = g / NH; const int hh = (int)(g % NH);
    const float *OF = WSP(float, WS_OF) + (size_t)g * DH, *OB = WSP(float, WS_OB) + (size_t)g * DH; const float* on = PRM(PR_ONORM) + j * DH;
    float ss = 0.f; for (int d = 0; d < DH; ++d) { const float o = OF[d] + OB[d]; ss += o * o; }
    const float r = 1.0f / sqrtf(ss / (float)DH + RMS_EPS);
    const bf16* z = WSP(bf16, WS_PROJ) + (size_t)t * ABINP + COL_Z + hh * DH; bf16* out = WSP(bf16, WS_MIXIN) + (size_t)t * ABMIX + hh * DH;
    for (int d = 0; d < DH; ++d) out[d] = f2bf((OF[d] + OB[d]) * r * on[d] * siluf(bf2f(z[d])));
}
constexpr long N_THD = (long)T * NH * DH;
DEVFN long na_key_token(long t, int jw, int& dr, int& dc) {
    const int tt = (int)(t % S); const long t0 = t - tt; const int r = tt / GW, c = tt % GW;
    const int rs = clampi(r - WR / 2, 0, ROWS - WR), cs = clampi(c - NAC / 2, 0, GW - NAC);
    const int rk = rs + jw / NAC, ck = cs + jw % NAC;
    dr = rk - r + NAR - 1; dc = clampi(ck - c + NAC - 1, 0, 2 * NAC - 2);
    return t0 + (long)rk * GW + ck;
}
DEVFN void st_na_scores(const P& p, int layer, long g) {
    const int j = layer / 2; const int jw = (int)(g % DH); const int hh = (int)((g / DH) % NH); const long t = g / (DH * NH);
    int dr, dc; const long tk = na_key_token(t, jw, dr, dc);
    const bf16* q = WSP(bf16, WS_PROJ) + (size_t)t * ABINP + COL_QB + hh * DH; const bf16* k = WSP(bf16, WS_PROJ) + (size_t)tk * ABINP + COL_KB + hh * DH;
    float dot = 0.f; for (int d = 0; d < DH; ++d) dot += bf2f(q[d]) * bf2f(k[d]);
    WSP(float, WS_NASC)[g] = dot * 0.08838834764831845f + PRM(PR_RPB)[(((size_t)j * NH + hh) * (2 * NAR - 1) + dr) * (2 * NAC - 1) + dc];
}
DEVFN void st_na_out(const P& p, int, long g) {
    const int d = (int)(g % DH); const int hh = (int)((g / DH) % NH); const long t = g / (DH * NH);
    const float* sc = WSP(float, WS_NASC) + ((size_t)t * NH + hh) * DH;
    float m = sc[0]; for (int jw = 1; jw < WR * NAC; ++jw) m = fmaxf(m, sc[jw]);
    float l = 0.f, o = 0.f;
    for (int jw = 0; jw < WR * NAC; ++jw) { int dr, dc; const long tk = na_key_token(t, jw, dr, dc); const float e = expf(sc[jw] - m); l += e;
        o += e * bf2f(WSP(bf16, WS_PROJ)[(size_t)tk * ABINP + COL_VB + hh * DH + d]); }
    WSP(bf16, WS_MIXIN)[(size_t)t * ABMIX + 1024 + hh * DH + d] = f2bf(o / l);
}
DEVFN float lambda_init_of(int layer) { return 0.8f - 0.6f * expf(-0.3f * (float)layer); }
DEVFN void st_lam(const P& p, int layer, long) {
    const float* lp = PRM(PR_LAMBDA) + (size_t)(layer / 2) * 4 * DH; float a = 0.f, b = 0.f;
    for (int d = 0; d < DH; ++d) { a += lp[d] * lp[DH + d]; b += lp[2 * DH + d] * lp[3 * DH + d]; }
    const float li = lambda_init_of(layer); WSP(float, WS_LAM)[0] = expf(a) - expf(b) + li; WSP(float, WS_LAM)[1] = li;
}
constexpr long N_ROPE = (long)T * 2 * 16 * 16;
DEVFN void st_rope(const P& p, int, long g) {
    const int i = (int)(g % 16); const int hj = (int)((g / 16) % 16); const int which = (int)((g / 256) % 2); const long t = g / 512;
    bf16* x = WSP(bf16, WS_PROJ) + (size_t)t * CIN + which * 2048 + hj * DH;
    const float inv = powf(500000.0f, -(float)(2 * i) / 32.0f); const float ang = (float)(t % S) * inv; const float cs = cosf(ang), sn = sinf(ang);
    const float x1 = bf2f(x[i]), x2 = bf2f(x[16 + i]);
    x[i] = f2bf(x1 * cs - x2 * sn); x[16 + i] = f2bf(x2 * cs + x1 * sn);
}
constexpr int DA_E = 64;
constexpr long N_DATT = (long)NSEQ * NH * 2 * (256 / DA_E) * S;
DEVFN void st_dattn(const P& p, int, long g) {
    const int qi = (int)(g % S); long r = g / S; const int es = (int)(r % (256 / DA_E)); r /= (256 / DA_E); const int jj = (int)(r % 2); r /= 2; const int hh = (int)(r % NH); const int seq = (int)(r / NH);
    const bf16* proj = WSP(bf16, WS_PROJ); const long t = (long)seq * S + qi;
    float q[DH];
#pragma unroll
    for (int d = 0; d < DH; ++d) q[d] = bf2f(proj[(size_t)t * CIN + hh * 256 + jj * DH + d]) * 0.08838834764831845f;
    float o[DA_E];
#pragma unroll
    for (int e = 0; e < DA_E; ++e) o[e] = 0.f;
    float m = -1e30f, l = 0.f;
    for (int kk = 0; kk < S; ++kk) {
        const bf16* kr = proj + (size_t)((long)seq * S + kk) * CIN + 2048 + hh * 256 + jj * DH; const bf16* vr = proj + (size_t)((long)seq * S + kk) * CIN + 4096 + hh * 256 + es * DA_E;
        float s = 0.f;
#pragma unroll
        for (int d0 = 0; d0 < DH; d0 += 32) { MEMFENCE();
#pragma unroll
            for (int d = d0; d < d0 + 32; ++d) s += q[d] * bf2f(kr[d]); }
        MEMFENCE();
        const float mn = fmaxf(m, s), al = expf(m - mn), pe = expf(s - mn); m = mn; l = l * al + pe;
#pragma unroll
        for (int e = 0; e < DA_E; ++e) o[e] = o[e] * al + pe * bf2f(vr[e]);
    }
    float* O = WSP(float, jj ? WS_O1 : WS_O0) + (size_t)t * 2048 + hh * 256 + es * DA_E; const float il = 1.0f / l;
#pragma unroll
    for (int e = 0; e < DA_E; ++e) O[e] = o[e] * il;
}
DEVFN void st_c_out(const P& p, int layer, long g) {
    const int j = layer / 2; const long t = g / NH; const int hh = (int)(g % NH); const float lam = WSP(float, WS_LAM)[0], li = WSP(float, WS_LAM)[1];
    const float *O0 = WSP(float, WS_O0) + (size_t)t * 2048 + hh * 256, *O1 = WSP(float, WS_O1) + (size_t)t * 2048 + hh * 256; const float* sw = PRM(PR_SUBLN) + j * 256;
    float ss = 0.f; for (int e = 0; e < 256; ++e) { const float o = O0[e] - lam * O1[e]; ss += o * o; }
    const float r = (1.0f / sqrtf(ss / 256.0f + RMS_EPS)) * (1.0f - li);
    bf16* out = WSP(bf16, WS_MIXIN) + (size_t)t * 2048 + hh * 256;
    for (int e = 0; e < 256; ++e) out[e] = f2bf((O0[e] - lam * O1[e]) * r * sw[e]);
}
constexpr long N_ACT = (long)T * DFF;
DEVFN float gelu_tanh(float x) { return 0.5f * x * (1.0f + tanhf(0.7978845608028654f * (x + 0.044715f * x * x * x))); }
DEVFN void st_ffn_act(const P& p, int layer, long g) {
    const long t = g / DFF; const int c = (int)(g % DFF); const int tt = (int)(t % S);
    const bf16* hid = WSP(bf16, WS_HID); const float* cw = PRM(PR_FCW) + (size_t)layer * 3 * 2 * DFF; const float* cb = PRM(PR_FCB) + (size_t)layer * 2 * DFF;
    float ga = cb[c], up = cb[DFF + c];
    for (int i = 0; i < 3; ++i) { const int ts = tt + i - 1; if (ts >= 0 && ts < S) { const bf16* r = hid + (size_t)(t - tt + ts) * (2 * DFF);
        ga += bf2f(r[c]) * cw[i * 2 * DFF + c]; up += bf2f(r[DFF + c]) * cw[i * 2 * DFF + DFF + c]; } }
    WSP(bf16, WS_ACT)[g] = f2bf(gelu_tanh(ga) * up);
}
DEVFN void st_ple(const P& p, int, long g) { p.h[g] += sigmoidf(WSP(float, WS_GOUT)[g]) * WSP(float, WS_GOUT2)[g]; }
#ifndef EMU
namespace pg8 {
#define PG8_LAS __attribute__((address_space(3)))
typedef unsigned short bf16_t;
typedef short bf16x8 __attribute__((ext_vector_type(8)));
typedef float f32x4 __attribute__((ext_vector_type(4)));
typedef unsigned u32x4 __attribute__((ext_vector_type(4)));
constexpr int BM = 256, BK = 64, HALF = 128, HTB = HALF * BK * 2  , STAGE_BYTES = 8 * HTB, NXCD = 8, WGM = 4;

__host__ __device__ __forceinline__ int lds_byte(int r, int c) { const int st = (r >> 4) * 2 + (c >> 5), rr = r & 15, cc = c & 31, ob = rr * 64 + cc * 2; return st * 1024 + (ob ^ (((ob >> 9) & 1) << 5)); }
__host__ __device__ __forceinline__ void stage_rc(int b, int& R, int& C) { const int st = b / 1024, sb = b % 1024, swz = sb ^ (((sb >> 9) & 1) << 5); R = (st >> 1) * 16 + swz / 64; C = (st & 1) * 32 + (swz % 64) / 2; }
__host__ __device__ __forceinline__ int perm32(int rho) { const int n = rho >> 4, i = rho & 15; return 8 * (i >> 2) + 4 * n + (i & 3); }

struct Unit { int pm, pn; };
struct Gemm { const bf16_t* A; const bf16_t* Bt; int M, N, K; };

struct StaticOrder {
    int nM, nN, nwg, G, c;
    __host__ __device__ void init(int M, int N, int G_, int c_) { nM = M / BM; nN = N / BM; nwg = nM * nN; G = G_; c = c_; }
    __host__ __device__ bool next(int i, Unit& u) const {
        const long L = (long)i * G + c; if (L >= nwg) return false;
        int wgid = (int)L; { const int q = nwg / NXCD, r = nwg % NXCD, xcd = wgid % NXCD, off = wgid / NXCD; wgid = (xcd < r ? xcd * (q + 1) : r * (q + 1) + (xcd - r) * q) + off; }
        const int nig = WGM * nN, gid = wgid / nig, fm = gid * WGM, gsz = (nM - fm) < WGM ? (nM - fm) : WGM;
        u.pm = fm + ((wgid % nig) % gsz); u.pn = (wgid % nig) / gsz; return true;
    }
    __device__ __forceinline__ void a_ready(const Unit&) const {}
    __device__ __forceinline__ void done(const Unit&) const {}
};

__device__ __forceinline__ unsigned cvt_pk_bf16(float lo, float hi) { unsigned r; asm volatile("v_cvt_pk_bf16_f32 %0, %1, %2" : "=v"(r) : "v"(lo), "v"(hi)); return r; }
struct EpiBf16 {
    static constexpr bool PERM = true, AFTER_DRAIN = false;
    bf16_t* O; int ldc;
    __device__ __forceinline__ void operator()(const f32x4 (&acc)[2][2][4][2], const Unit& u, int wr, int wc, int fr, int fq) const {
        const int row0 = u.pm * BM + wr * 64 + fr; const int col0 = u.pn * BM + wc * 32 + 8 * fq;
#pragma unroll
        for (int ai = 0; ai < 2; ++ai)
#pragma unroll
            for (int m = 0; m < 4; ++m) { bf16_t* rowp = O + (size_t)(row0 + ai * HALF + m * 16) * ldc + col0;
#pragma unroll
                for (int bj = 0; bj < 2; ++bj) { const f32x4 v0 = acc[ai][bj][m][0], v1 = acc[ai][bj][m][1];
                    u32x4 w; w.x = cvt_pk_bf16(v0[0], v0[1]); w.y = cvt_pk_bf16(v0[2], v0[3]); w.z = cvt_pk_bf16(v1[0], v1[1]); w.w = cvt_pk_bf16(v1[2], v1[3]);
                    *(u32x4*)(rowp + bj * HALF) = w; } }
    }
};
struct EpiBf16Ro {
    static constexpr bool PERM = true, AFTER_DRAIN = false;
    bf16_t* O; int ldc; const float* tab; int seqlen;
    __device__ __forceinline__ void operator()(const f32x4 (&acc)[2][2][4][2], const Unit& u, int wr, int wc, int fr, int fq) const {
        const int row0 = u.pm * BM + wr * 64 + fr; const int col0 = u.pn * BM + wc * 32 + 8 * fq;
        const bool rope = tab != nullptr && u.pn < 16 && wc == 0;
        f32x4 cN[4] = {};
#define RO_LOAD(r_) do { const float* cs_ = tab + ((size_t)((r_) % seqlen) * 16 + 8 * (fq & 1)) * 2; cN[0] = *(const f32x4*)cs_; cN[1] = *(const f32x4*)(cs_ + 4); cN[2] = *(const f32x4*)(cs_ + 8); cN[3] = *(const f32x4*)(cs_ + 12); } while (0)
        if (rope) RO_LOAD(row0);
#pragma unroll
        for (int ai = 0; ai < 2; ++ai)
#pragma unroll
            for (int m = 0; m < 4; ++m) { const int row = row0 + ai * HALF + m * 16; bf16_t* rowp = O + (size_t)row * ldc + col0;
                const f32x4 c0 = cN[0], c1 = cN[1], c2 = cN[2], c3 = cN[3];
                if (rope && (ai * 4 + m) < 7) RO_LOAD(row0 + (m == 3 ? HALF : ai * HALF + (m + 1) * 16));
#pragma unroll
                for (int bj = 0; bj < 2; ++bj) { f32x4 v0 = acc[ai][bj][m][0], v1 = acc[ai][bj][m][1];
                    if (rope) { const float sgn = fq < 2 ? -1.f : 1.f;
#pragma unroll
                        for (int e = 0; e < 4; ++e) { const float o0 = __shfl_xor(v0[e], 32), o1 = __shfl_xor(v1[e], 32);
                            const float cs0 = (e < 2 ? c0 : c1)[2 * (e & 1)], sn0 = (e < 2 ? c0 : c1)[2 * (e & 1) + 1], cs1 = (e < 2 ? c2 : c3)[2 * (e & 1)], sn1 = (e < 2 ? c2 : c3)[2 * (e & 1) + 1];
                            v0[e] = v0[e] * cs0 + sgn * o0 * sn0; v1[e] = v1[e] * cs1 + sgn * o1 * sn1; } }
                    u32x4 w; w.x = cvt_pk_bf16(v0[0], v0[1]); w.y = cvt_pk_bf16(v0[2], v0[3]); w.z = cvt_pk_bf16(v1[0], v1[1]); w.w = cvt_pk_bf16(v1[2], v1[3]);
                    *(u32x4*)(rowp + bj * HALF) = w; } }
    }
};
#undef RO_LOAD
__device__ __forceinline__ float dpp_prev(float oldv, float x) { return __int_as_float(__builtin_amdgcn_update_dpp(__float_as_int(oldv), __float_as_int(x), 0x111, 0xf, 0xf, false)); }
__device__ __forceinline__ float dpp_next(float oldv, float x) { return __int_as_float(__builtin_amdgcn_update_dpp(__float_as_int(oldv), __float_as_int(x), 0x101, 0xf, 0xf, false)); }
__device__ __forceinline__ float dpp_ror1(float x) { return __int_as_float(__builtin_amdgcn_update_dpp(__float_as_int(x), __float_as_int(x), 0x121, 0xf, 0xf, false)); }
__device__ __forceinline__ float dpp_rol1(float x) { return __int_as_float(__builtin_amdgcn_update_dpp(__float_as_int(x), __float_as_int(x), 0x12F, 0xf, 0xf, false)); }
__device__ __forceinline__ void conv3_pair(float& cg, float& cu, float xg, float xu, float egp, float egn, float eup, float eun,
                                           float wg0, float wg1, float wg2, float wu0, float wu1, float wu2, float bg, float bu, unsigned long long m15, unsigned long long m0) {
    float t0, t1, t2, t3;
    asm("v_cndmask_b32_e64 %[t0], %[xg], %[egp], %[m15]\n\t"
        "v_cndmask_b32_e64 %[t1], %[xg], %[egn], %[m0]\n\t"
        "v_cndmask_b32_e64 %[t2], %[xu], %[eup], %[m15]\n\t"
        "v_cndmask_b32_e64 %[t3], %[xu], %[eun], %[m0]\n\t"
        "v_fma_f32 %[cg], %[wg1], %[xg], %[bg]\n\t"
        "v_fma_f32 %[cu], %[wu1], %[xu], %[bu]\n\t"
        "v_fmac_f32_dpp %[cg], %[t0], %[wg0] row_ror:1 row_mask:0xf bank_mask:0xf\n\t"
        "v_fmac_f32_dpp %[cg], %[t1], %[wg2] row_ror:15 row_mask:0xf bank_mask:0xf\n\t"
        "v_fmac_f32_dpp %[cu], %[t2], %[wu0] row_ror:1 row_mask:0xf bank_mask:0xf\n\t"
        "v_fmac_f32_dpp %[cu], %[t3], %[wu2] row_ror:15 row_mask:0xf bank_mask:0xf"
        : [cg] "=&v"(cg), [cu] "=&v"(cu), [t0] "=&v"(t0), [t1] "=&v"(t1), [t2] "=&v"(t2), [t3] "=&v"(t3)
        : [xg] "v"(xg), [xu] "v"(xu), [egp] "v"(egp), [egn] "v"(egn), [eup] "v"(eup), [eun] "v"(eun), [wg0] "v"(wg0), [wg1] "v"(wg1), [wg2] "v"(wg2), [wu0] "v"(wu0), [wu1] "v"(wu1), [wu2] "v"(wu2),
          [bg] "v"(bg), [bu] "v"(bu), [m15] "s"(m15), [m0] "s"(m0));
}
__device__ __forceinline__ float gelu_t(float x) { const float u = 0.7978845608028654f * (x + 0.044715f * x * x * x); return x * __builtin_amdgcn_rcpf(1.0f + __builtin_amdgcn_exp2f(-2.885390081777927f * u)); }
struct EpiConvAct {
    static constexpr bool PERM = true, AFTER_DRAIN = false;
    bf16_t* ACT; float* HALO; float* HDUMP; const float* cw; const float* cb; PG8_LAS float* EX;
    __device__ __forceinline__ void operator()(const f32x4 (&acc)[2][2][4][2], const Unit& u, int wr, int wc, int fr, int fq) const {
        const int ch0 = u.pn * 128 + wc * 32 + 8 * fq;
        PG8_LAS float* WL = EX + 2560; const int t_ = ((wr * 4 + wc) << 6) | (fq * 16 + fr); float wv[2];
#pragma unroll
        for (int j = 0; j < 2; ++j) { const int idx = t_ + 512 * j, r = idx >> 7, c = idx & 127; const float* src = r < 6 ? cw + (size_t)(r >> 1) * 2 * DFF + (r & 1) * DFF : cb + (r & 1) * DFF; wv[j] = src[u.pn * 128 + c]; }
#pragma unroll
        for (int ai = 0; ai < 2; ++ai) { const int sg = 2 * ai + wr;
            PG8_LAS float* d0 = EX + ((fr == 0) ? ((((sg * 2 + 0) * 4 + wc) * 4 + fq) * 16) : (2048 + wc * 64 + fq * 16));
            PG8_LAS float* d1 = EX + ((fr == 15) ? ((((sg * 2 + 1) * 4 + wc) * 4 + fq) * 16) : (2048 + wc * 64 + fq * 16));
#pragma unroll
            for (int bj = 0; bj < 2; ++bj)
#pragma unroll
                for (int n = 0; n < 2; ++n) { *(PG8_LAS f32x4*)(d0 + (bj * 2 + n) * 4) = acc[ai][bj][0][n]; *(PG8_LAS f32x4*)(d1 + (bj * 2 + n) * 4) = acc[ai][bj][3][n]; } }
        if (wr == 0) { float* hp = (fr < 2) ? HALO + (((size_t)u.pm * 4 + fr) * 2) * DFF + ch0 : HDUMP + (size_t)(wc * 4 + fq) * 16;
            const size_t bs = (fr < 2) ? (size_t)DFF : (size_t)8;
#pragma unroll
            for (int bj = 0; bj < 2; ++bj)
#pragma unroll
                for (int n = 0; n < 2; ++n) *(f32x4*)(hp + bj * bs + 4 * n) = acc[0][bj][0][n]; }
        else { float* hp = (fr >= 14) ? HALO + (((size_t)u.pm * 4 + 2 + (fr - 14)) * 2) * DFF + ch0 : HDUMP + (size_t)(wc * 4 + fq) * 16;
            const size_t bs = (fr >= 14) ? (size_t)DFF : (size_t)8;
#pragma unroll
            for (int bj = 0; bj < 2; ++bj)
#pragma unroll
                for (int n = 0; n < 2; ++n) *(f32x4*)(hp + bj * bs + 4 * n) = acc[1][bj][3][n]; }
        WL[t_] = wv[0]; WL[t_ + 512] = wv[1];
        asm volatile("s_waitcnt lgkmcnt(0)" ::: "memory"); __builtin_amdgcn_s_barrier(); asm volatile("" ::: "memory");
        const unsigned long long m15 = __ballot(fr == 15), m0 = __ballot(fr == 0);
        unsigned W[2][4][4];
#pragma unroll
        for (int n = 0; n < 2; ++n)
#pragma unroll
            for (int e2 = 0; e2 < 4; e2 += 2) {
                float wg[3][2], wu[3][2], bg[2], bu[2];
#pragma unroll
                for (int k = 0; k < 2; ++k) { const int cl = wc * 32 + 8 * fq + 4 * n + e2 + k;
#pragma unroll
                    for (int t = 0; t < 3; ++t) { wg[t][k] = WL[(2 * t) * 128 + cl]; wu[t][k] = WL[(2 * t + 1) * 128 + cl]; }
                    bg[k] = WL[6 * 128 + cl]; bu[k] = WL[7 * 128 + cl]; }
#pragma unroll
                for (int ai = 0; ai < 2; ++ai) { const int sg = 2 * ai + wr;
                    float pg[2] = {0.f, 0.f}, pu[2] = {0.f, 0.f}, ng[2] = {0.f, 0.f}, nu[2] = {0.f, 0.f};
                    if (sg > 0) { const PG8_LAS float* d = EX + ((((sg - 1) * 2 + 1) * 4 + wc) * 4 + fq) * 16 + n * 4 + e2; pg[0] = d[0]; pg[1] = d[1]; pu[0] = d[8]; pu[1] = d[9]; }
                    if (sg < 3) { const PG8_LAS float* d = EX + ((((sg + 1) * 2 + 0) * 4 + wc) * 4 + fq) * 16 + n * 4 + e2; ng[0] = d[0]; ng[1] = d[1]; nu[0] = d[8]; nu[1] = d[9]; }
#pragma unroll
                    for (int m = 0; m < 4; ++m) { float o[2];
#pragma unroll
                        for (int k = 0; k < 2; ++k) { const int e = e2 + k;
                            const float xg = acc[ai][0][m][n][e], xu = acc[ai][1][m][n][e];
                            const float bg_p = m > 0 ? acc[ai][0][m - 1][n][e] : pg[k], bu_p = m > 0 ? acc[ai][1][m - 1][n][e] : pu[k];
                            const float bg_n = m < 3 ? acc[ai][0][m + 1][n][e] : ng[k], bu_n = m < 3 ? acc[ai][1][m + 1][n][e] : nu[k];
                            float cg, cu; conv3_pair(cg, cu, xg, xu, bg_p, bg_n, bu_p, bu_n, wg[0][k], wg[1][k], wg[2][k], wu[0][k], wu[1][k], wu[2][k], bg[k], bu[k], m15, m0);
                            o[k] = gelu_t(cg) * cu; }
                        W[ai][m][n * 2 + (e2 >> 1)] = cvt_pk_bf16(o[0], o[1]); } }
            }
        const int row0 = u.pm * BM + wr * 64 + fr;
#pragma unroll
        for (int ai = 0; ai < 2; ++ai)
#pragma unroll
            for (int m = 0; m < 4; ++m) { u32x4 w; w.x = W[ai][m][0]; w.y = W[ai][m][1]; w.z = W[ai][m][2]; w.w = W[ai][m][3];
                *(u32x4*)(ACT + (size_t)(row0 + ai * HALF + m * 16) * DFF + ch0) = w; }
    }
};
struct EpiF32 {
    static constexpr bool PERM = false, AFTER_DRAIN = false;
    float* C; int ldc;
    __device__ __forceinline__ void operator()(const f32x4 (&acc)[2][2][4][2], const Unit& u, int wr, int wc, int fr, int fq) const {
        const int row0 = u.pm * BM + wr * 64 + fr, col0 = u.pn * BM + wc * 32 + 4 * fq;
#pragma unroll
        for (int ai = 0; ai < 2; ++ai)
#pragma unroll
            for (int m = 0; m < 4; ++m) { float* rowp = C + (size_t)(row0 + ai * HALF + m * 16) * ldc + col0;
#pragma unroll
                for (int bj = 0; bj < 2; ++bj)
#pragma unroll
                    for (int n = 0; n < 2; ++n) *(f32x4*)(rowp + bj * HALF + n * 16) = acc[ai][bj][m][n]; }
    }
};
template <class Epi, class Sched, bool ALIGN_EPI = false, bool SP2 = false>
__device__ __forceinline__ void gemm_phase(PG8_LAS unsigned char* lds, const Gemm g, const Sched& S, const Epi& E, int tid_in) {
    int tid_ = tid_in; asm volatile("" : "+v"(tid_));
    const int tid = tid_, wid = __builtin_amdgcn_readfirstlane(tid >> 6), lane = tid & 63, wr = wid >> 2, wc = wid & 3, fr = lane & 15, fq = lane >> 4;
    const int K = g.K, nt = K / BK;
    unsigned voffA[2], voffB[2];
#pragma unroll
    for (int i = 0; i < 2; ++i) { int R, C; stage_rc(tid * 16 + i * 8192, R, C); const int Rb = Epi::PERM ? ((R & ~31) + perm32(R & 31)) : R;
        voffA[i] = (unsigned)(R * K + C) * 2u; voffB[i] = (unsigned)(Rb * K + C) * 2u; }
    const size_t kstep = (size_t)(BK * 2);
    const size_t hstep = (size_t)HALF * K * 2;
    const size_t tstep = 2 * hstep;
    const unsigned ldsw = (unsigned)wid * 1024u;
    const int aoff = lds_byte(wr * 64 + fr, fq * 8), boff = lds_byte(wc * 32 + fr, fq * 8);
#define PG8_SA(b, h) (((b) * 2 + (h)) * HTB)
#define PG8_SB(b, h) ((4 + (b) * 2 + (h)) * HTB)
#define PG8_STAGE(bufoff, gbase, voff) do { _Pragma("unroll") for (int _i = 0; _i < 2; ++_i) \
        __builtin_amdgcn_global_load_lds((const unsigned*)((const char*)(gbase) + (voff)[_i]), (PG8_LAS unsigned*)(lds + (bufoff) + ldsw + _i * 8192), 16, 0, 0); } while (0)
#define PG8_LDA(dst, b, h) do { _Pragma("unroll") for (int m = 0; m < 4; ++m) _Pragma("unroll") for (int k = 0; k < 2; ++k) dst[m][k] = *(const PG8_LAS bf16x8*)(lds + PG8_SA(b, h) + aoff + m * 2048 + k * 1024); } while (0)
#define PG8_LDB(dst, b, h) do { _Pragma("unroll") for (int n = 0; n < 2; ++n) _Pragma("unroll") for (int k = 0; k < 2; ++k) dst[n][k] = *(const PG8_LAS bf16x8*)(lds + PG8_SB(b, h) + boff + n * 2048 + k * 1024); } while (0)
#define PG8_MMA(ai, bj, At, Bt) do { __builtin_amdgcn_s_setprio(1); _Pragma("unroll") for (int m = 0; m < 4; ++m) _Pragma("unroll") for (int n = 0; n < 2; ++n) _Pragma("unroll") for (int k = 0; k < 2; ++k) \
        acc[ai][bj][m][n] = __builtin_amdgcn_mfma_f32_16x16x32_bf16(Bt[n][k], At[m][k], acc[ai][bj][m][n], 0, 0, 0); __builtin_amdgcn_s_setprio(0); } while (0)
#define PG8_WAIT_V(n) asm volatile("s_waitcnt vmcnt(" #n ")" ::: "memory")
#define PG8_WAIT_L(n) asm volatile("s_waitcnt lgkmcnt(" #n ")" ::: "memory")
#define PG8_BAR __builtin_amdgcn_s_barrier()
#define PG8_SCHED __builtin_amdgcn_sched_barrier(0)
    Unit cur, nxt; int ui = 0;
    if (!S.next(0, cur)) return;
    f32x4 acc[2][2][4][2];
#pragma unroll
    for (int a = 0; a < 2; ++a)
#pragma unroll
        for (int b = 0; b < 2; ++b)
#pragma unroll
            for (int m = 0; m < 4; ++m)
#pragma unroll
                for (int n = 0; n < 2; ++n) acc[a][b][m][n] = (f32x4){0.f, 0.f, 0.f, 0.f};
    bf16x8 At[4][2], B0[2][2], B1[2][2];
    const char* cA = (const char*)g.A + (size_t)cur.pm * tstep; const char* cB = (const char*)g.Bt + (size_t)cur.pn * tstep;
    S.a_ready(cur);
    if constexpr (SP2) {
        PG8_STAGE(PG8_SB(0, 0), cB, voffB); PG8_STAGE(PG8_SB(0, 1), cB + hstep, voffB); PG8_STAGE(PG8_SA(0, 0), cA, voffA); PG8_STAGE(PG8_SA(0, 1), cA + hstep, voffA);
        if (wr == 1) PG8_BAR;
        PG8_WAIT_V(2); PG8_BAR;
        PG8_STAGE(PG8_SB(1, 0), cB + kstep, voffB); PG8_STAGE(PG8_SA(1, 0), cA + kstep, voffA); PG8_STAGE(PG8_SB(1, 1), cB + hstep + kstep, voffB);
        PG8_WAIT_V(6); PG8_BAR;
    } else {
        PG8_STAGE(PG8_SB(0, 0), cB, voffB); PG8_STAGE(PG8_SA(0, 0), cA, voffA); PG8_STAGE(PG8_SB(0, 1), cB + hstep, voffB); PG8_STAGE(PG8_SA(0, 1), cA + hstep, voffA);
        if (wr == 1) PG8_BAR;
        PG8_WAIT_V(4); PG8_BAR;
        PG8_STAGE(PG8_SB(1, 0), cB + kstep, voffB); PG8_STAGE(PG8_SA(1, 0), cA + kstep, voffA); PG8_STAGE(PG8_SB(1, 1), cB + hstep + kstep, voffB);
        PG8_WAIT_V(6); PG8_BAR;
    }
    for (;;) {
        const bool has_next = S.next(ui + 1, nxt);
        const char* nA = has_next ? (const char*)g.A + (size_t)nxt.pm * tstep : cA; const char* nB = has_next ? (const char*)g.Bt + (size_t)nxt.pn * tstep : cB;
        for (int t = 0; t < nt; t += 2) {
            const bool last = (t == nt - 2);
            const char* a1 = cA + (size_t)(t + 1) * kstep;
            const char* a2 = last ? nA : cA + (size_t)(t + 2) * kstep; const char* b2 = last ? nB : cB + (size_t)(t + 2) * kstep;
            const char* a3 = a2 + kstep; const char* b3 = b2 + kstep;
            if (last && has_next) S.a_ready(nxt);
            if constexpr (SP2) {
            PG8_LDB(B0, 0, 0); PG8_LDB(B1, 0, 1); PG8_SCHED; PG8_LDA(At, 0, 0); PG8_STAGE(PG8_SA(1, 1), a1 + hstep, voffA);
            PG8_WAIT_V(8); PG8_WAIT_L(0); PG8_BAR; PG8_MMA(0, 0, At, B0); PG8_MMA(0, 1, At, B1); PG8_BAR; PG8_SCHED;
            PG8_LDA(At, 0, 1); PG8_STAGE(PG8_SB(0, 0), b2, voffB); PG8_STAGE(PG8_SB(0, 1), b2 + hstep, voffB); PG8_STAGE(PG8_SA(0, 0), a2, voffA);
            PG8_WAIT_V(8); PG8_WAIT_L(0); PG8_BAR; PG8_MMA(1, 0, At, B0); PG8_MMA(1, 1, At, B1); PG8_BAR; PG8_SCHED;
            PG8_LDB(B0, 1, 0); PG8_LDB(B1, 1, 1); PG8_SCHED; PG8_LDA(At, 1, 0); PG8_STAGE(PG8_SA(0, 1), a2 + hstep, voffA);
            PG8_WAIT_V(8); PG8_WAIT_L(0); PG8_BAR; PG8_MMA(0, 0, At, B0); PG8_MMA(0, 1, At, B1); PG8_BAR; PG8_SCHED;
            PG8_LDA(At, 1, 1); PG8_STAGE(PG8_SB(1, 0), b3, voffB); PG8_STAGE(PG8_SB(1, 1), b3 + hstep, voffB); PG8_STAGE(PG8_SA(1, 0), a3, voffA);
            PG8_WAIT_V(8); PG8_WAIT_L(0); PG8_BAR; PG8_MMA(1, 0, At, B0); PG8_MMA(1, 1, At, B1); PG8_BAR; PG8_SCHED;
            } else {
            PG8_LDB(B0, 0, 0); PG8_SCHED; PG8_LDA(At, 0, 0); PG8_STAGE(PG8_SA(1, 1), a1 + hstep, voffA);
            PG8_WAIT_L(8); PG8_BAR; PG8_WAIT_L(0); PG8_MMA(0, 0, At, B0); PG8_BAR; PG8_SCHED;
            PG8_LDB(B1, 0, 1); PG8_STAGE(PG8_SB(0, 0), b2, voffB);
            PG8_BAR; PG8_WAIT_L(0); PG8_MMA(0, 1, At, B1); PG8_BAR;
            PG8_LDA(At, 0, 1); PG8_STAGE(PG8_SA(0, 0), a2, voffA);
            PG8_BAR; PG8_WAIT_L(0); PG8_MMA(1, 0, At, B0); PG8_BAR; PG8_SCHED;
            PG8_STAGE(PG8_SB(0, 1), b2 + hstep, voffB);
            PG8_WAIT_V(6); PG8_BAR; PG8_MMA(1, 1, At, B1); PG8_BAR;
            PG8_LDB(B0, 1, 0); PG8_SCHED; PG8_LDA(At, 1, 0); PG8_STAGE(PG8_SA(0, 1), a2 + hstep, voffA);
            PG8_WAIT_L(8); PG8_BAR; PG8_WAIT_L(0); PG8_MMA(0, 0, At, B0); PG8_BAR; PG8_SCHED;
            PG8_LDB(B1, 1, 1); PG8_STAGE(PG8_SB(1, 0), b3, voffB);
            PG8_BAR; PG8_WAIT_L(0); PG8_MMA(0, 1, At, B1); PG8_BAR;
            PG8_LDA(At, 1, 1); PG8_STAGE(PG8_SA(1, 0), a3, voffA);
            PG8_BAR; PG8_WAIT_L(0); PG8_MMA(1, 0, At, B0); PG8_BAR; PG8_SCHED;
            PG8_STAGE(PG8_SB(1, 1), b3 + hstep, voffB);
            PG8_WAIT_V(6); PG8_BAR; PG8_MMA(1, 1, At, B1); PG8_BAR;
            }
        }
        if constexpr (ALIGN_EPI) { if (wr == 0) PG8_BAR; }
        if constexpr (!Epi::AFTER_DRAIN) { E(acc, cur, wr, wc, fr, fq); S.done(cur); }
        if (!has_next) break;
#pragma unroll
        for (int a = 0; a < 2; ++a)
#pragma unroll
            for (int b = 0; b < 2; ++b)
#pragma unroll
                for (int m = 0; m < 4; ++m)
#pragma unroll
                    for (int n = 0; n < 2; ++n) acc[a][b][m][n] = (f32x4){0.f, 0.f, 0.f, 0.f};
        cur = nxt; cA = nA; cB = nB; ++ui;
        if constexpr (ALIGN_EPI) { if (wr == 1) PG8_BAR; }
    }
    PG8_WAIT_V(0);
    if constexpr (!ALIGN_EPI) { if (wr == 0) PG8_BAR; }
    PG8_BAR;
    if constexpr (Epi::AFTER_DRAIN) { E.fused(acc, cur, wr, wc, fr, fq, lds, wid, lane); S.done(cur); }
#undef PG8_SA
#undef PG8_SB
#undef PG8_STAGE
#undef PG8_LDA
#undef PG8_LDB
#undef PG8_MMA
#undef PG8_WAIT_V
#undef PG8_WAIT_L
#undef PG8_BAR
#undef PG8_SCHED
}
}
#endif
enum { ST_PRM = 100, ST_INIT = 0, ST_PB, ST_WT, ST_ROWSS, ST_NORM, ST_RESID, ST_DNPREP, ST_DNSCAN, ST_DNOUT, ST_NASC, ST_NAOUT, ST_LAM, ST_ROPE, ST_DATTN, ST_COUT, ST_FFNACT, ST_PLE };
struct Job { P p; WT w; const float* a; const float* b; long n; int layer; int flag; };
template <int ST> DEVFN void run_item(const Job& j, long g) {
    if constexpr (ST == ST_PRM) st_prm(j.p, j.layer, g);
    else if constexpr (ST == ST_INIT) st_init(j.p, j.layer, g);
    else if constexpr (ST == ST_PB) st_pb(j.p, j.layer, g);
    else if constexpr (ST == ST_WT) st_wt(j.w, g);
    else if constexpr (ST == ST_ROWSS) st_rowss(j.p, j.a, g);
    else if constexpr (ST == ST_NORM) st_norm_bf16(j.p, j.a, g);
    else if constexpr (ST == ST_RESID) st_resid(j.p, j.a, j.b, j.flag, g);
    else if constexpr (ST == ST_DNPREP) st_dn_prep(j.p, j.layer, g);
    else if constexpr (ST == ST_DNSCAN) st_dn_scan(j.p, j.layer, g);
    else if constexpr (ST == ST_DNOUT) st_dn_out(j.p, j.layer, g);
    else if constexpr (ST == ST_NASC) st_na_scores(j.p, j.layer, g);
    else if constexpr (ST == ST_NAOUT) st_na_out(j.p, j.layer, g);
    else if constexpr (ST == ST_LAM) st_lam(j.p, j.layer, g);
    else if constexpr (ST == ST_ROPE) st_rope(j.p, j.layer, g);
    else if constexpr (ST == ST_DATTN) st_dattn(j.p, j.layer, g);
    else if constexpr (ST == ST_COUT) st_c_out(j.p, j.layer, g);
    else if constexpr (ST == ST_FFNACT) st_ffn_act(j.p, j.layer, g);
    else if constexpr (ST == ST_PLE) st_ple(j.p, j.layer, g);
}
#ifdef EMU
template <int ST> static void run_stage(Job j, long n) {
    j.n = n;
#pragma omp parallel for schedule(dynamic, 64)
    for (long g = 0; g < n; ++g) run_item<ST>(j, g);
}
static void emu_gemm(const bf16* A, const bf16* Bt, int M, int N, int K, bf16* Ob, float* Of, int ldc) {
    std::vector<float> Af((size_t)M * K), Bf((size_t)N * K);
    for (size_t i = 0; i < Af.size(); ++i) Af[i] = bf2f(A[i]);
    for (size_t i = 0; i < Bf.size(); ++i) Bf[i] = bf2f(Bt[i]);
#pragma omp parallel for schedule(dynamic, 8)
    for (int m = 0; m < M; ++m) for (int n = 0; n < N; ++n) { const float* a = &Af[(size_t)m * K]; const float* b = &Bf[(size_t)n * K]; float s = 0.f;
        for (int k = 0; k < K; ++k) s += a[k] * b[k];
        if (Ob) Ob[(size_t)m * ldc + n] = f2bf(s); else Of[(size_t)m * ldc + n] = s; }
}
static void gemm_bf16(const bf16* A, const bf16* Bt, int M, int N, int K, bf16* O, int ldc) { emu_gemm(A, Bt, M, N, K, O, nullptr, ldc); }
static void gemm_f32(const bf16* A, const bf16* Bt, int M, int N, int K, float* O, int ldc) { emu_gemm(A, Bt, M, N, K, nullptr, O, ldc); }

static void forward(const P& p) {
    Job j; memset(&j, 0, sizeof(j)); j.p = p;
    auto wt = [&](const float* W, size_t off, int K, int N, int Npad) { j.w.W = W; j.w.O = WSP(bf16, off); j.w.K = K; j.w.N = N; j.w.Npad = Npad; run_stage<ST_WT>(j, (long)Npad * K); };
    for (int i = 0; i < 2; ++i) {
        wt(p.ab_w_in + (size_t)i * D * ABIN, WS_WABIN + (size_t)i * ABINP * D * 2, D, ABIN, ABINP);
        wt(p.ab_w_out + (size_t)i * ABMIX * D, WS_WABOUT + (size_t)i * D * ABMIX * 2, ABMIX, D, D);
        wt(p.c_w_in + (size_t)i * D * CIN, WS_WCIN + (size_t)i * CIN * D * 2, D, CIN, CIN);
        wt(p.c_w_out + (size_t)i * CV * D, WS_WCOUT + (size_t)i * D * CV * 2, CV, D, D);
    }
    for (int l = 0; l < DEPTH; ++l) {
        wt(p.ffn_w_in + (size_t)l * D * 2 * DFF, WS_WFIN + (size_t)l * 2 * DFF * D * 2, D, 2 * DFF, 2 * DFF);
        wt(p.ffn_w_out + (size_t)l * DFF * D, WS_WFOUT + (size_t)l * D * DFF * 2, DFF, D, D);
        wt(p.ple_w_proj + (size_t)l * PLE * D, WS_WPP + (size_t)l * D * PLE * 2, PLE, D, D);
        wt(p.ple_w_gate + (size_t)l * D * D, WS_WPG + (size_t)l * D * D * 2, D, D, D);
    }
    run_stage<ST_PRM>(j, N_PRM);
    for (int l = 0; l < DEPTH; ++l) { j.layer = l; run_stage<ST_PB>(j, N_PB); }
    run_stage<ST_INIT>(j, N_INIT);
    for (int layer = 0; layer < DEPTH; ++layer) {
        j.layer = layer; const int jj = layer / 2; const float* nw = PRM(PR_NORMS) + (size_t)layer * 4 * D;
        j.a = p.h; run_stage<ST_ROWSS>(j, N_ROWS);
        j.a = nw; run_stage<ST_NORM>(j, N_TD);
        if (layer % 2 == 0) {
            gemm_bf16(WSP(bf16, WS_HN), WSP(bf16, WS_WABIN + (size_t)jj * ABINP * D * 2), T, ABINP, D, WSP(bf16, WS_PROJ), ABINP);
            run_stage<ST_DNPREP>(j, N_TH);
            run_stage<ST_DNSCAN>(j, N_SCAN);
            run_stage<ST_DNOUT>(j, N_TH);
            run_stage<ST_NASC>(j, N_THD);
            run_stage<ST_NAOUT>(j, N_THD);
            gemm_f32(WSP(bf16, WS_MIXIN), WSP(bf16, WS_WABOUT + (size_t)jj * D * ABMIX * 2), T, D, ABMIX, WSP(float, WS_GOUT), D);
        } else {
            gemm_bf16(WSP(bf16, WS_HN), WSP(bf16, WS_WCIN + (size_t)jj * CIN * D * 2), T, CIN, D, WSP(bf16, WS_PROJ), CIN);
            run_stage<ST_LAM>(j, 1);
            run_stage<ST_ROPE>(j, N_ROPE);
            run_stage<ST_DATTN>(j, N_DATT);
            run_stage<ST_COUT>(j, N_TH);
            gemm_f32(WSP(bf16, WS_MIXIN), WSP(bf16, WS_WCOUT + (size_t)jj * D * CV * 2), T, D, CV, WSP(float, WS_GOUT), D);
        }
        j.a = WSP(float, WS_GOUT); run_stage<ST_ROWSS>(j, N_ROWS);
        j.a = WSP(float, WS_GOUT); j.b = nw + D; j.flag = 0; run_stage<ST_RESID>(j, N_TD);
        j.a = p.h; run_stage<ST_ROWSS>(j, N_ROWS);
        j.a = nw + 2 * D; run_stage<ST_NORM>(j, N_TD);
        gemm_bf16(WSP(bf16, WS_HN), WSP(bf16, WS_WFIN + (size_t)layer * 2 * DFF * D * 2), T, 2 * DFF, D, WSP(bf16, WS_HID), 2 * DFF);
        run_stage<ST_FFNACT>(j, N_ACT);
        gemm_f32(WSP(bf16, WS_ACT), WSP(bf16, WS_WFOUT + (size_t)layer * D * DFF * 2), T, D, DFF, WSP(float, WS_GOUT), D);
        j.a = WSP(float, WS_GOUT); run_stage<ST_ROWSS>(j, N_ROWS);
        j.a = WSP(float, WS_GOUT); j.b = nw + 3 * D; j.flag = 1; run_stage<ST_RESID>(j, N_TD);
        gemm_f32(WSP(bf16, WS_HN), WSP(bf16, WS_WPG + (size_t)layer * D * D * 2), T, D, D, WSP(float, WS_GOUT), D);
        gemm_f32(WSP(bf16, WS_PB + (size_t)layer * SZ_PB), WSP(bf16, WS_WPP + (size_t)layer * D * PLE * 2), T, D, PLE, WSP(float, WS_GOUT2), D);
        run_stage<ST_PLE>(j, N_TD);
    }
}
#endif

#ifndef EMU
namespace att {
using bf16x8 = __attribute__((ext_vector_type(8))) short;
using s16x4  = __attribute__((ext_vector_type(4))) short;
using f32x16 = __attribute__((ext_vector_type(16))) float;
using u32x4  = __attribute__((ext_vector_type(4))) unsigned;
constexpr int DA = 128, NW = 8, QBLK = 32, KVBLK = 64;
constexpr float SCALE = 0.088388347648318440f;
constexpr float THR = 8.f;
constexpr size_t SHM_V = KVBLK * DA * 2, SHM_K = KVBLK * DA * 2, SHM_ATTN = 2 * SHM_V + 2 * SHM_K + NW * 64 * 4;
#define KSWZ(row, colB) ((row) * 256 + ((colB) ^ (((row) & 15) << 4)))
#define SBAR() __builtin_amdgcn_sched_barrier(0)
__device__ __forceinline__ int crow(int r, int hi) { return (r & 3) + 8 * (r >> 2) + 4 * hi; }
__device__ __forceinline__ unsigned cvtpk(float lo, float hi) { unsigned r; asm volatile("v_cvt_pk_bf16_f32 %0, %1, %2" : "=v"(r) : "v"(lo), "v"(hi)); return r; }
__device__ __forceinline__ bf16x8 ld8(const bf16* p) { return *reinterpret_cast<const bf16x8*>(p); }
__device__ __forceinline__ void partialSM(f32x16& p0, f32x16& p1, float& m_reg, float& mn, float& alpha) {
  constexpr float C = SCALE * 1.4426950408889634f;
  float pmax = p0[0]; for (int r = 1; r < 16; ++r) pmax = fmaxf(pmax, p0[r]); for (int r = 0; r < 16; ++r) pmax = fmaxf(pmax, p1[r]);
  { auto rr = __builtin_amdgcn_permlane32_swap(__float_as_uint(pmax), __float_as_uint(pmax), false, false);
    pmax = fmaxf(__uint_as_float(rr[0]), __uint_as_float(rr[1])); }
  if (__builtin_expect(__all(pmax - m_reg <= THR / SCALE), 1)) { mn = m_reg; alpha = 1.f; }
  else { mn = fmaxf(m_reg, pmax); alpha = __builtin_amdgcn_exp2f((m_reg - mn) * C); m_reg = mn; }
  float mnC = -mn * C;
  for (int r = 0; r < 16; ++r) p0[r] = fmaf(p0[r], C, mnC); for (int r = 0; r < 16; ++r) p1[r] = fmaf(p1[r], C, mnC);
  for (int r = 0; r < 16; ++r) p0[r] = __builtin_amdgcn_exp2f(p0[r]);
}
__device__ __forceinline__ void finishSM(f32x16& p0, f32x16& p1, float alpha, float& l_reg, bf16x8& pa0, bf16x8& pa1, bf16x8& pa2, bf16x8& pa3) {
  for (int r = 0; r < 16; ++r) p1[r] = __builtin_amdgcn_exp2f(p1[r]);
  float ps = 0; for (int r = 0; r < 16; ++r) ps += p0[r]; for (int r = 0; r < 16; ++r) ps += p1[r];
  { auto rr = __builtin_amdgcn_permlane32_swap(__float_as_uint(ps), __float_as_uint(ps), false, false);
    ps = __uint_as_float(rr[0]) + __uint_as_float(rr[1]); }
  l_reg = l_reg * alpha + ps;
#define PK4(P, BASE, OUT) do { unsigned a0 = cvtpk(P[BASE + 0], P[BASE + 1]), a1 = cvtpk(P[BASE + 2], P[BASE + 3]);   \
    unsigned b0 = cvtpk(P[BASE + 4], P[BASE + 5]), b1 = cvtpk(P[BASE + 6], P[BASE + 7]);                              \
    auto r0 = __builtin_amdgcn_permlane32_swap(a0, b0, false, false); auto r1 = __builtin_amdgcn_permlane32_swap(a1, b1, false, false); \
    u32x4 w = {r0[0], r1[0], r0[1], r1[1]}; OUT = *reinterpret_cast<bf16x8*>(&w); } while (0)
  PK4(p0, 0, pa0); PK4(p0, 8, pa1); PK4(p1, 0, pa2); PK4(p1, 8, pa3);
#undef PK4
}
__device__ __forceinline__ void qkt(f32x16& p0, f32x16& p1, const bf16* Ks, const bf16x8* qr, int r32, int hi) {
  p0 = f32x16{}; p1 = f32x16{};
  for (int d0 = 0; d0 < 8; ++d0) { int cb = (d0 * 16 + hi * 8) * 2;
    bf16x8 b0 = *reinterpret_cast<const bf16x8*>((const char*)Ks + KSWZ(r32, cb));
    bf16x8 b1 = *reinterpret_cast<const bf16x8*>((const char*)Ks + KSWZ(32 + r32, cb));
    p0 = __builtin_amdgcn_mfma_f32_32x32x16_bf16(b0, qr[d0], p0, 0, 0, 0);
    p1 = __builtin_amdgcn_mfma_f32_32x32x16_bf16(b1, qr[d0], p1, 0, 0, 0); }
}
__device__ __forceinline__ int v_st(int k, int c) { const int kk = (k & ~0xC) | ((k & 4) << 1) | ((k & 8) >> 1); return ((kk >> 3) * 4 + (c >> 5)) * 512 + ((kk & 7) * 32 + (c & 31)) * 2; }
__device__ __forceinline__ int v_rd_base(int lane) { return ((lane & 3) << 3) | (((lane >> 2) & 3) << 6) | (((lane >> 4) & 1) << 5) | (((lane >> 5) & 1) << 8); }
constexpr int v_rd_off(int d0, int ks, int half) { return d0 * 512 + ks * 4096 + half * 2048; }
template <int OFF> __device__ __forceinline__ s16x4 tr_read(int vb) {
  s16x4 r; asm volatile("ds_read_b64_tr_b16 %0, %1 offset:%2" : "=&v"(r) : "v"(vb), "i"(OFF) : "memory"); return r;
}
template <int D0> __device__ __forceinline__ void pv_one(f32x16& od, int vb, bf16x8 pa0, bf16x8 pa1, bf16x8 pa2, bf16x8 pa3) {
  const s16x4 l0 = tr_read<v_rd_off(D0, 0, 0)>(vb), h0 = tr_read<v_rd_off(D0, 0, 1)>(vb), l1 = tr_read<v_rd_off(D0, 1, 0)>(vb), h1 = tr_read<v_rd_off(D0, 1, 1)>(vb);
  const s16x4 l2 = tr_read<v_rd_off(D0, 2, 0)>(vb), h2 = tr_read<v_rd_off(D0, 2, 1)>(vb), l3 = tr_read<v_rd_off(D0, 3, 0)>(vb), h3 = tr_read<v_rd_off(D0, 3, 1)>(vb);
  asm volatile("s_waitcnt lgkmcnt(0)" ::: "memory"); SBAR();
#define PK(L, H) (bf16x8){L[0], L[1], L[2], L[3], H[0], H[1], H[2], H[3]}
  od = __builtin_amdgcn_mfma_f32_32x32x16_bf16(pa0, PK(l0, h0), od, 0, 0, 0);
  od = __builtin_amdgcn_mfma_f32_32x32x16_bf16(pa1, PK(l1, h1), od, 0, 0, 0);
  od = __builtin_amdgcn_mfma_f32_32x32x16_bf16(pa2, PK(l2, h2), od, 0, 0, 0);
  od = __builtin_amdgcn_mfma_f32_32x32x16_bf16(pa3, PK(l3, h3), od, 0, 0, 0);
#undef PK
}
__device__ __forceinline__ void pv_d0(f32x16* o, int vb, bf16x8 pa0, bf16x8 pa1, bf16x8 pa2, bf16x8 pa3) {
  pv_one<0>(o[0], vb, pa0, pa1, pa2, pa3); pv_one<1>(o[1], vb, pa0, pa1, pa2, pa3); pv_one<2>(o[2], vb, pa0, pa1, pa2, pa3); pv_one<3>(o[3], vb, pa0, pa1, pa2, pa3);
}
struct NaInfo { int rq0, kr0; const float* tab; };
__device__ __forceinline__ void na_mask(f32x16& p0, f32x16& p1, int rk, int rq, int rs, int cq, int cs, int hi, const float* tab) {
  const bool rowok = (rk >= rs) && (rk < rs + NAR);
  int dr = rk - rq + NAR - 1; dr = dr < 0 ? 0 : (dr > 2 * NAR - 2 ? 2 * NAR - 2 : dr);
  const float* trow = tab + dr * (2 * NAC - 1); const float ninf = -__builtin_inff();
#pragma unroll
  for (int r = 0; r < 16; ++r) { const int ck = crow(r, hi); int dc = ck - cq + NAC - 1; dc = dc < 0 ? 0 : (dc > 2 * NAC - 2 ? 2 * NAC - 2 : dc);
    const bool ok = rowok && ck >= cs && ck < cs + NAC; const float b = trow[dc]; p0[r] = ok ? p0[r] + b : ninf; }
#pragma unroll
  for (int r = 0; r < 16; ++r) { const int ck = 32 + crow(r, hi); int dc = ck - cq + NAC - 1; dc = dc < 0 ? 0 : (dc > 2 * NAC - 2 ? 2 * NAC - 2 : dc);
    const bool ok = rowok && ck >= cs && ck < cs + NAC; const float b = trow[dc]; p1[r] = ok ? p1[r] + b : ninf; }
}
template <int LDQ, int LDK, int LDO, int MODE>
__device__ __forceinline__ void attn_dense_body(const bf16* __restrict__ Qb, const bf16* __restrict__ Kh, const bf16* __restrict__ Vh, void* __restrict__ Ob_, int seq, char* lds, NaInfo na, int tid_in) {
  constexpr int SDEPTH = 2;
  int tid_ = tid_in; asm volatile("" : "+v"(tid_));
  const int tid = tid_, wid = tid >> 6, lane = tid & 63, r32 = lane & 31, hi = lane >> 5;
  const int na_rq = na.rq0 + (wid >> 1), na_cq = (wid & 1) * 32 + r32, na_rs = clampi(na_rq - WR / 2, 0, ROWS - WR), na_cs = clampi(na_cq - NAC / 2, 0, GW - NAC);
#define NAMASK(P0, P1, jt) do { if constexpr (MODE == 1) na_mask(P0, P1, na.kr0 + (jt), na_rq, na_rs, na_cq, na_cs, hi, na.tab); } while (0)
  bf16* V_lds = (bf16*)lds; bf16* K_lds = (bf16*)(lds + 2 * SHM_V);
  float* ws = (float*)(lds + 2 * SHM_V + 2 * SHM_K) + wid * 64; float* li_l = ws; float* al_l = ws + 32;
  float m_reg = -1e30f, l_reg = 0; f32x16 o[4] = {}; bf16x8 qr[8];
  const bf16* Qw = Qb + (long)(wid * QBLK + r32) * LDQ + hi * 8;
#pragma unroll
  for (int d0 = 0; d0 < 8; ++d0) qr[d0] = ld8(Qw + d0 * 16);
  const int sr = tid >> 4, sc = (tid & 15) * 8, vst0 = v_st(sr, sc), vst1 = v_st(32 + sr, sc);
  const int vb0 = (int)(uintptr_t)V_lds + v_rd_base(lane);
  struct { bf16x8 vs0, vs1, ks0, ks1; } sr_[SDEPTH];
#define SLOAD(i, k0) do { sr_[i].vs0 = ld8(&Vh[(long)((k0) + sr) * LDK + sc]); sr_[i].vs1 = ld8(&Vh[(long)((k0) + 32 + sr) * LDK + sc]); \
    sr_[i].ks0 = ld8(&Kh[(long)((k0) + sr) * LDK + sc]); sr_[i].ks1 = ld8(&Kh[(long)((k0) + 32 + sr) * LDK + sc]); } while (0)
#define SWRITE(b, i) do { *(bf16x8*)((char*)V_lds + (b) * SHM_V + vst0) = sr_[i].vs0;          \
    *(bf16x8*)((char*)V_lds + (b) * SHM_V + vst1) = sr_[i].vs1; int kc = sc * 2;               \
    *(bf16x8*)((char*)K_lds + (b) * SHM_K + KSWZ(sr, kc)) = sr_[i].ks0;                       \
    *(bf16x8*)((char*)K_lds + (b) * SHM_K + KSWZ(32 + sr, kc)) = sr_[i].ks1; } while (0)
#define SWAIT() asm volatile("s_waitcnt vmcnt(4)" ::: "memory")
#define RESC(a) do { if (__any((a) < 1.f)) { if (hi == 0) al_l[r32] = (a); asm volatile("s_waitcnt lgkmcnt(0)" ::: "memory"); \
    for (int d = 0; d < 4; ++d) for (int r = 0; r < 16; ++r) o[d][r] *= al_l[crow(r, hi)]; } } while (0)
  f32x16 pA0, pA1, pB0, pB1; float mnA, mnB, alA, alB; bf16x8 pa0, pa1, pa2, pa3; const int NT = seq / KVBLK;
  constexpr int SE = 0, SO = SDEPTH - 1;
  SLOAD(SE, 0); asm volatile("s_waitcnt vmcnt(0)" ::: "memory"); SWRITE(0, SE); __syncthreads();
  qkt(pA0, pA1, K_lds, qr, r32, hi); NAMASK(pA0, pA1, 0); partialSM(pA0, pA1, m_reg, mnA, alA);
  SLOAD(SO, KVBLK); if (2 < NT) SLOAD(SE, 2 * KVBLK);
  SWAIT(); SWRITE(1, SO); __syncthreads();
  for (int j = 1; j + 1 < NT; j += 2) {
    SBAR(); qkt(pB0, pB1, (bf16*)((char*)K_lds + SHM_K), qr, r32, hi); NAMASK(pB0, pB1, j);
    finishSM(pA0, pA1, alA, l_reg, pa0, pa1, pa2, pa3); SBAR();
    SLOAD(SO, (j + SDEPTH) * KVBLK); SBAR();
    pv_d0(o, vb0, pa0, pa1, pa2, pa3); partialSM(pB0, pB1, m_reg, mnB, alB);
    __syncthreads(); SWAIT(); SWRITE(0, SE);
    RESC(alB); __syncthreads();
    SBAR(); qkt(pA0, pA1, K_lds, qr, r32, hi); NAMASK(pA0, pA1, j + 1);
    finishSM(pB0, pB1, alB, l_reg, pa0, pa1, pa2, pa3); SBAR();
    if (j + 3 < NT) SLOAD(SE, (j + 1 + SDEPTH) * KVBLK); SBAR();
    pv_d0(o, vb0 + (int)SHM_V, pa0, pa1, pa2, pa3); partialSM(pA0, pA1, m_reg, mnA, alA);
    __syncthreads(); SWAIT(); SWRITE(1, SO);
    RESC(alA); __syncthreads();
  }
  SBAR(); qkt(pB0, pB1, (bf16*)((char*)K_lds + SHM_K), qr, r32, hi); NAMASK(pB0, pB1, NT - 1);
  finishSM(pA0, pA1, alA, l_reg, pa0, pa1, pa2, pa3); SBAR();
  pv_d0(o, vb0, pa0, pa1, pa2, pa3); partialSM(pB0, pB1, m_reg, mnB, alB);
  __syncthreads(); RESC(alB);
  finishSM(pB0, pB1, alB, l_reg, pa0, pa1, pa2, pa3); SBAR();
  pv_d0(o, vb0 + (int)SHM_V, pa0, pa1, pa2, pa3);
  if (hi == 0) li_l[r32] = l_reg; asm volatile("s_waitcnt lgkmcnt(0)" ::: "memory");
  float rli[16];
#pragma unroll
  for (int r = 0; r < 16; ++r) rli[r] = __builtin_amdgcn_rcpf(li_l[crow(r, hi)]);
  if constexpr (MODE == 2) { float* Ow = (float*)Ob_ + (long)(wid * QBLK) * LDO;
#pragma unroll
    for (int r = 0; r < 16; ++r) { int orow = crow(r, hi);
      for (int d0 = 0; d0 < 4; ++d0) Ow[(long)orow * LDO + d0 * 32 + r32] = o[d0][r] * rli[r]; }
  } else { bf16* Ow = (bf16*)Ob_ + (long)(wid * QBLK) * LDO;
#pragma unroll
    for (int r = 0; r < 16; ++r) { int orow = crow(r, hi);
      for (int d0 = 0; d0 < 4; ++d0) Ow[(long)orow * LDO + d0 * 32 + r32] = f2bf(o[d0][r] * rli[r]); } }
#undef NAMASK
#undef SLOAD
#undef SWRITE
#undef SWAIT
#undef RESC
}
template <int LDQ, int LDK, int LDO>
__device__ __forceinline__ void na_body(const bf16* __restrict__ Qb, const bf16* __restrict__ Kh, const bf16* __restrict__ Vh, bf16* __restrict__ Ob, int ntiles, char* lds, NaInfo na, int tid_in) {
  int tid_ = tid_in; asm volatile("" : "+v"(tid_));
  const int tid = tid_, wid = tid >> 6, lane = tid & 63, r32 = lane & 31, hi = lane >> 5;
  const int na_rq = na.rq0 + (wid >> 1), na_cq = (wid & 1) * 32 + r32, na_rs = clampi(na_rq - WR / 2, 0, ROWS - WR), na_cs = clampi(na_cq - NAC / 2, 0, GW - NAC);
  bf16* V_lds = (bf16*)lds; bf16* K_lds = (bf16*)(lds + 2 * SHM_V);
  float* ws = (float*)(lds + 2 * SHM_V + 2 * SHM_K) + wid * 64; float* li_l = ws; float* al_l = ws + 32;
  float m_reg = -1e30f, l_reg = 0; f32x16 o[4] = {}; bf16x8 qr[8];
  const bf16* Qw = Qb + (long)(wid * QBLK + r32) * LDQ + hi * 8;
#pragma unroll
  for (int d0 = 0; d0 < 8; ++d0) qr[d0] = ld8(Qw + d0 * 16);
  const int sr = tid >> 4, sc = (tid & 15) * 8, vst0 = v_st(sr, sc), vst1 = v_st(32 + sr, sc);
  const int vb0 = (int)(uintptr_t)V_lds + v_rd_base(lane);
  bf16x8 vs0 = ld8(&Vh[(long)sr * LDK + sc]), vs1 = ld8(&Vh[(long)(32 + sr) * LDK + sc]), ks0 = ld8(&Kh[(long)sr * LDK + sc]), ks1 = ld8(&Kh[(long)(32 + sr) * LDK + sc]);
  for (int jt = 0; jt < ntiles; ++jt) {
    __syncthreads();
    *(bf16x8*)((char*)V_lds + vst0) = vs0; *(bf16x8*)((char*)V_lds + vst1) = vs1;
    *(bf16x8*)((char*)K_lds + KSWZ(sr, sc * 2)) = ks0; *(bf16x8*)((char*)K_lds + KSWZ(32 + sr, sc * 2)) = ks1;
    __syncthreads();
    if (jt + 1 < ntiles) { const int k0 = (jt + 1) * KVBLK;
      vs0 = ld8(&Vh[(long)(k0 + sr) * LDK + sc]); vs1 = ld8(&Vh[(long)(k0 + 32 + sr) * LDK + sc]); ks0 = ld8(&Kh[(long)(k0 + sr) * LDK + sc]); ks1 = ld8(&Kh[(long)(k0 + 32 + sr) * LDK + sc]); }
    f32x16 p0, p1; float mn, al; bf16x8 pa0, pa1, pa2, pa3;
    qkt(p0, p1, K_lds, qr, r32, hi);
    na_mask(p0, p1, na.kr0 + jt, na_rq, na_rs, na_cq, na_cs, hi, na.tab);
    partialSM(p0, p1, m_reg, mn, al);
    if (__any(al < 1.f)) { if (hi == 0) al_l[r32] = al; asm volatile("s_waitcnt lgkmcnt(0)" ::: "memory");
      for (int d = 0; d < 4; ++d) for (int r = 0; r < 16; ++r) o[d][r] *= al_l[crow(r, hi)]; }
    finishSM(p0, p1, al, l_reg, pa0, pa1, pa2, pa3); SBAR();
    pv_d0(o, vb0, pa0, pa1, pa2, pa3);
  }
  if (hi == 0) li_l[r32] = l_reg; asm volatile("s_waitcnt lgkmcnt(0)" ::: "memory");
  float rli[16];
#pragma unroll
  for (int r = 0; r < 16; ++r) rli[r] = __builtin_amdgcn_rcpf(li_l[crow(r, hi)]);
  bf16* Ow = Ob + (long)(wid * QBLK) * LDO;
#pragma unroll
  for (int r = 0; r < 16; ++r) { int orow = crow(r, hi);
    for (int d0 = 0; d0 < 4; ++d0) Ow[(long)orow * LDO + d0 * 32 + r32] = f2bf(o[d0][r] * rli[r]); }
}
template <int LDQ, int LDK, int LDO>
__device__ __forceinline__ void dattn256_body(const bf16* __restrict__ Qb, const bf16* __restrict__ Kh, const bf16* __restrict__ Vh, bf16* Ob, int ntiles, char* lds, int tid_in,
                                              int mode = 0, bf16* Mx = nullptr, float lam = 0.f, float scale = 0.f, const float* sw = nullptr) {
  typedef __attribute__((address_space(3))) unsigned lds_u32;
  int tid_ = tid_in; asm volatile("" : "+v"(tid_));
  const int tid = tid_, wid = __builtin_amdgcn_readfirstlane(tid >> 6), lane = tid & 63, r32 = lane & 31, hi = lane >> 5;
  constexpr int VB = 2 * (int)SHM_V, KB = (int)SHM_K;
  char* V_lds = lds; char* K_lds = lds + 2 * VB;
  float* ws = (float*)(lds + 2 * VB + 2 * KB) + wid * 64; float* li_l = ws; float* al_l = ws + 32;
  float m_reg = -1e30f, l_reg = 0; f32x16 o[8] = {}; bf16x8 qr[8];
  const bf16* Qw = Qb + (long)(wid * QBLK + r32) * LDQ + hi * 8;
#pragma unroll
  for (int d0 = 0; d0 < 8; ++d0) qr[d0] = ld8(Qw + d0 * 16);
  unsigned koff[2], voff[2];
#pragma unroll
  for (int i = 0; i < 2; ++i) { const int kp = 2 * wid + i; const int row = 4 * kp + (lane >> 4), c = (lane & 15) ^ (row & 15); koff[i] = (unsigned)(row * LDK + c * 8);
    const int st = 2 * kp + (lane >> 5), within = lane & 31, kk = (st >> 2) * 8 + (within >> 2), k = (kk & ~0xC) | ((kk & 4) << 1) | ((kk & 8) >> 1); voff[i] = (unsigned)(k * LDK + (st & 3) * 32 + (within & 3) * 8); }
  const int vbase = (int)(uintptr_t)V_lds + v_rd_base(lane);
#define DA_DMA(t, b) do { const bf16* kt_ = Kh + (long)(t) * KVBLK * LDK; const bf16* vt_ = Vh + (long)(t) * KVBLK * LDK; \
      _Pragma("unroll") for (int i = 0; i < 2; ++i) { \
        __builtin_amdgcn_global_load_lds((const unsigned*)(kt_ + koff[i]), (lds_u32*)(K_lds + (b) * KB + (2 * wid + i) * 1024), 16, 0, 0); \
        __builtin_amdgcn_global_load_lds((const unsigned*)(vt_ + voff[i]), (lds_u32*)(V_lds + (b) * VB + (2 * wid + i) * 1024), 16, 0, 0); \
        __builtin_amdgcn_global_load_lds((const unsigned*)(vt_ + voff[i] + 128), (lds_u32*)(V_lds + (b) * VB + (int)SHM_V + (2 * wid + i) * 1024), 16, 0, 0); } } while (0)
  __syncthreads();
  DA_DMA(0, 0);
  for (int jt = 0; jt < ntiles; ++jt) {
    const int b = jt & 1;
    asm volatile("s_waitcnt vmcnt(0)" ::: "memory");
    __syncthreads();
    if (jt + 1 < ntiles) DA_DMA(jt + 1, b ^ 1);
    const char* Kb = K_lds + b * KB;
    f32x16 p0, p1; float mn, al; bf16x8 pa0, pa1, pa2, pa3;
    p0 = f32x16{}; p1 = f32x16{};
#pragma unroll
    for (int d0 = 0; d0 < 8; ++d0) { const int cb = (d0 * 16 + hi * 8) * 2;
      const bf16x8 b0 = *reinterpret_cast<const bf16x8*>(Kb + KSWZ(r32, cb)), b1 = *reinterpret_cast<const bf16x8*>(Kb + KSWZ(32 + r32, cb));
      p0 = __builtin_amdgcn_mfma_f32_32x32x16_bf16(b0, qr[d0], p0, 0, 0, 0); p1 = __builtin_amdgcn_mfma_f32_32x32x16_bf16(b1, qr[d0], p1, 0, 0, 0); }
    partialSM(p0, p1, m_reg, mn, al);
    if (__any(al < 1.f)) { if (hi == 0) al_l[r32] = al; asm volatile("s_waitcnt lgkmcnt(0)" ::: "memory");
      for (int d = 0; d < 8; ++d) for (int r = 0; r < 16; ++r) o[d][r] *= al_l[crow(r, hi)]; }
    finishSM(p0, p1, al, l_reg, pa0, pa1, pa2, pa3); SBAR();
    pv_d0(o, vbase + b * VB, pa0, pa1, pa2, pa3);
    pv_d0(o + 4, vbase + b * VB + (int)SHM_V, pa0, pa1, pa2, pa3);
  }
#undef DA_DMA
  if (hi == 0) li_l[r32] = l_reg; asm volatile("s_waitcnt lgkmcnt(0)" ::: "memory");
  float rli[16];
#pragma unroll
  for (int r = 0; r < 16; ++r) rli[r] = __builtin_amdgcn_rcpf(li_l[crow(r, hi)]);
  bf16* Ow = Ob + (long)(wid * QBLK) * LDO;
  if (mode == 0) {
#pragma unroll
    for (int r = 0; r < 16; ++r) { int orow = crow(r, hi);
      for (int d0 = 0; d0 < 8; ++d0) Ow[(long)orow * LDO + d0 * 32 + r32] = f2bf(o[d0][r] * rli[r]); }
  } else {
    bf16* Mw = Mx + (long)(wid * QBLK) * LDO;
    float swv[8];
#pragma unroll
    for (int d0 = 0; d0 < 8; ++d0) swv[d0] = sw[d0 * 32 + r32] * scale;
#pragma unroll
    for (int r = 0; r < 16; ++r) { const int orow = crow(r, hi); float ss = 0.f; const float nl = -lam * rli[r];
#pragma unroll
      for (int d0 = 0; d0 < 8; ++d0) { const float x = bf2f(Ow[(long)orow * LDO + d0 * 32 + r32]) + nl * o[d0][r]; o[d0][r] = x; ss += x * x; }
      ss += __shfl_xor(ss, 1); ss += __shfl_xor(ss, 2); ss += __shfl_xor(ss, 4); ss += __shfl_xor(ss, 8); ss += __shfl_xor(ss, 16);
      const float rs = 1.0f / sqrtf(ss * (1.0f / 256.0f) + RMS_EPS);
#pragma unroll
      for (int d0 = 0; d0 < 8; ++d0) Mw[(long)orow * LDO + d0 * 32 + r32] = f2bf(o[d0][r] * rs * swv[d0]); }
  }
}
}
namespace dn {
using bf16x8 = __attribute__((ext_vector_type(8))) short;
using f32x4v = __attribute__((ext_vector_type(4))) float;
using f32x2v = __attribute__((ext_vector_type(2))) float;
using bf16x2v = __attribute__((ext_vector_type(2))) __bf16;
using u32x4 = __attribute__((ext_vector_type(4))) unsigned;
constexpr int KP = 136;
constexpr int L_K = 0, L_Q = 17408, L_V = 34816, L_AKK = 67584, L_AQK = 84224, L_L0 = 100864, L_L1 = 117248, L_SM = 133632, L_DB = 135680, L_END = 143872;
__device__ __forceinline__ unsigned pk(float lo, float hi) { const f32x2v v = {lo, hi}; return __builtin_bit_cast(unsigned, __builtin_convertvector(v, bf16x2v)); }
__device__ __forceinline__ bf16x8 pack8(f32x4v a, f32x4v b) { u32x4 w = {pk(a[0], a[1]), pk(a[2], a[3]), pk(b[0], b[1]), pk(b[2], b[3])}; return __builtin_bit_cast(bf16x8, w); }
__device__ __forceinline__ int kperm(int s, int q, int j) { return 32 * s + 16 * (j >> 2) + 4 * q + (j & 3); }
#define MFMA16(a, b, c) __builtin_amdgcn_mfma_f32_16x16x32_bf16((a), (b), (c), 0, 0, 0)

__device__ __forceinline__ float fexp(float x) { return __builtin_amdgcn_exp2f(x * 1.4426950408889634f); }
__device__ __forceinline__ float fsilu(float x) { return x * __builtin_amdgcn_rcpf(1.0f + fexp(-x)); }
template <int C> __device__ __forceinline__ float dpp_bc(int v) { return __int_as_float(__builtin_amdgcn_update_dpp(0, v, C, 0xf, 0xf, false)); }
template <int I, int J> __device__ __forceinline__ void inv16_terms(float& r, int lk, const float (&x)[16]) {
    if constexpr (J < I) { r -= dpp_bc<0x150 + J>(lk) * x[J]; inv16_terms<I, J + 1>(r, lk, x); }
}
template <int I> __device__ __forceinline__ void inv16_rows(float (&x)[16], const float* Lbb, int c) {
    if constexpr (I < 16) { float r = (I == c) ? 1.f : 0.f; const int lk = __float_as_int(Lbb[I * 64 + c]); inv16_terms<I, 0>(r, lk, x); x[I] = r; inv16_rows<I + 1>(x, Lbb, c); }
}
__device__ __forceinline__ void dn1_unit(const P& p, int jl, int seq, int hh, int chunk, char* lds, int tid_in) {
    int tid_ = tid_in; asm volatile("" : "+v"(tid_));
    const int tid = tid_, lane = tid & 63, wave = tid >> 6;
    bf16* Kl = (bf16*)(lds + L_K); bf16* Ql = (bf16*)(lds + L_Q); float* Vl = (float*)(lds + L_V); float* AKK = (float*)(lds + L_AKK); float* AQK = (float*)(lds + L_AQK);
    float* L0 = (float*)(lds + L_L0); float* L1 = (float*)(lds + L_L1); float* g_l = (float*)(lds + L_SM); float* beta_l = g_l + 128; float* gc_l = g_l + 256; float* bk_l = g_l + 384;
    const int tt0 = chunk * 64; const long tb = (long)seq * S; const bf16* PROJ = WSP(bf16, WS_PROJ);
    const size_t unit = ((size_t)(seq * NH + hh) * (S / 64) + chunk);
    if (tid < 384) {
        const int cgi = tid & 15, part = (tid >> 4) % 3, oct = tid / 48, i0 = 8 * oct; const int coff = part * 1024 + hh * DH + 8 * cgi;
        bf16x8 x[12]; float w[5][8];
#pragma unroll
        for (int k = 0; k < 12; ++k) { const int ts = tt0 + i0 + k - 2; x[k] = (ts >= 0 && ts < S) ? *(const bf16x8*)(PROJ + (size_t)(tb + ts) * ABINP + coff) : (bf16x8){0, 0, 0, 0, 0, 0, 0, 0}; }
#pragma unroll
        for (int tap = 0; tap < 5; ++tap) { const float* cw = PRM(PR_ABCONV) + (size_t)(jl * 5 + tap) * AQKV + coff; const f32x4v a = *(const f32x4v*)cw, b = *(const f32x4v*)(cw + 4);
#pragma unroll
            for (int e = 0; e < 4; ++e) { w[tap][e] = a[e]; w[tap][4 + e] = b[e]; } }
#pragma unroll
        for (int kk = 0; kk < 8; ++kk) { float y[8]; float ss = 0.f;
#pragma unroll
            for (int c = 0; c < 8; ++c) { float acc = 0.f;
#pragma unroll
                for (int tap = 0; tap < 5; ++tap) acc += bf2f((bf16)x[kk + tap][c]) * w[tap][c];
                y[c] = fsilu(acc); ss += y[c] * y[c]; }
            ss += __shfl_xor(ss, 1); ss += __shfl_xor(ss, 2); ss += __shfl_xor(ss, 4); ss += __shfl_xor(ss, 8);
            const float rn = 1.0f / sqrtf(ss + 1e-6f); const float sc_ = part == 0 ? rn * 0.08838834764831845f : (part == 1 ? rn : 1.0f); const int i = i0 + kk;
            if (part < 2) { u32x4 wv; wv[0] = pk(y[0] * sc_, y[1] * sc_); wv[1] = pk(y[2] * sc_, y[3] * sc_); wv[2] = pk(y[4] * sc_, y[5] * sc_); wv[3] = pk(y[6] * sc_, y[7] * sc_);
                *(u32x4*)((part ? Kl : Ql) + i * KP + 8 * cgi) = wv; }
            else { *(f32x4v*)(Vl + i * 128 + 8 * cgi) = (f32x4v){y[0], y[1], y[2], y[3]}; *(f32x4v*)(Vl + i * 128 + 8 * cgi + 4) = (f32x4v){y[4], y[5], y[6], y[7]}; } }
    } else { const int gt = tid - 384; const int dir = gt >> 6, il = gt & 63, ti = dir ? 63 - il : il; const bf16* gr = PROJ + (size_t)(tb + tt0 + ti) * ABINP + COL_G;
        const float graw = bf2f(gr[dir * NH + hh]), braw = bf2f(gr[16 + dir * NH + hh]);
        const float a = expf(PRM(PR_ALOG)[(jl * 2 + dir) * NH + hh]), dtb = PRM(PR_DTB)[(jl * 2 + dir) * NH + hh];
        g_l[dir * 64 + il] = -a * softplusf(graw + dtb); beta_l[dir * 64 + il] = sigmoidf(braw); }
    __syncthreads();
    if (wave < 2) { const int dir = wave; float c = g_l[dir * 64 + lane];
#pragma unroll
        for (int o = 1; o < 64; o <<= 1) { const float t = __shfl_up(c, o); if (lane >= o) c += t; }
        gc_l[dir * 64 + lane] = c; bk_l[dir * 64 + lane] = beta_l[dir * 64 + lane] * fexp(c); }
    {
        const int r = lane & 15, q = lane >> 4;
#pragma unroll
        for (int tt = 0; tt < 2; ++tt) { const int tile = 2 * wave + tt, ti_ = tile >> 2, tj_ = tile & 3; f32x4v ck = {0.f, 0.f, 0.f, 0.f}, cq = {0.f, 0.f, 0.f, 0.f};
#pragma unroll
            for (int s = 0; s < 4; ++s) { const bf16x8 ak = *(const bf16x8*)(Kl + (16 * ti_ + r) * KP + 32 * s + 8 * q), aq = *(const bf16x8*)(Ql + (16 * ti_ + r) * KP + 32 * s + 8 * q), b = *(const bf16x8*)(Kl + (16 * tj_ + r) * KP + 32 * s + 8 * q);
                ck = MFMA16(ak, b, ck); cq = MFMA16(aq, b, cq); }
#pragma unroll
            for (int rr = 0; rr < 4; ++rr) { AKK[(16 * ti_ + 4 * q + rr) * 65 + 16 * tj_ + r] = ck[rr]; AQK[(16 * ti_ + 4 * q + rr) * 65 + 16 * tj_ + r] = cq[rr]; } }
    }
    __syncthreads();
    for (int e = tid; e < 8192; e += 512) { const int dir = e >> 12, i = (e >> 6) & 63, jx = e & 63; float v = 0.f;
        if (jx < i) { const int ti = dir ? 63 - i : i, tj = dir ? 63 - jx : jx; v = beta_l[dir * 64 + i] * AKK[ti * 65 + tj] * fexp(gc_l[dir * 64 + i] - gc_l[dir * 64 + jx]); }
        (dir ? L1 : L0)[i * 64 + jx] = v; }
#pragma unroll
    for (int dir = 0; dir < 2; ++dir) {
        const size_t ud = unit * 2 + dir; const float* gc = gc_l + dir * 64; const float glast = gc[63];
        {
            const int frag = tid >> 6, mt = frag >> 1, s = frag & 1, i = 16 * mt + (lane & 15), q = lane >> 4, ti = dir ? 63 - i : i; const float gi = gc[i]; float v[8];
#pragma unroll
            for (int jv = 0; jv < 8; ++jv) { const int jx = kperm(s, q, jv); v[jv] = (jx <= i) ? AQK[ti * 65 + (dir ? 63 - jx : jx)] * fexp(gi - gc[jx]) : 0.f; }
            u32x4 w = {pk(v[0], v[1]), pk(v[2], v[3]), pk(v[4], v[5]), pk(v[6], v[7])};
            *(u32x4*)(WSP(bf16, WS_DN_IN) + ((ud * 8 + frag) * 64 + lane) * 8) = w;
        }
#pragma unroll
        for (int rep = 0; rep < 2; ++rep) {
            const int fl = tid + 512 * rep, frag = fl >> 6, q = lane >> 4;
            { const int mt = frag >> 2, s = frag & 3, i = 16 * mt + (lane & 15), ti = dir ? 63 - i : i; const float eg = fexp(gc[i]); float v[8];
#pragma unroll
              for (int jv = 0; jv < 8; ++jv) v[jv] = bf2f(Ql[ti * KP + kperm(s, q, jv)]) * eg;
              u32x4 w = {pk(v[0], v[1]), pk(v[2], v[3]), pk(v[4], v[5]), pk(v[6], v[7])};
              *(u32x4*)(WSP(bf16, WS_DN_QE) + ((ud * 16 + frag) * 64 + lane) * 8) = w; }
            { const int mt = frag >> 1, s = frag & 1, d = 16 * mt + (lane & 15); float v[8];
#pragma unroll
              for (int jv = 0; jv < 8; ++jv) { const int jx = kperm(s, q, jv), tj = dir ? 63 - jx : jx; v[jv] = bf2f(Kl[tj * KP + d]) * fexp(glast - gc[jx]); }
              u32x4 w = {pk(v[0], v[1]), pk(v[2], v[3]), pk(v[4], v[5]), pk(v[6], v[7])};
              *(u32x4*)(WSP(bf16, WS_DN_KD) + ((ud * 16 + frag) * 64 + lane) * 8) = w; }
        }
        if (tid == 0) WSP(float, WS_DN_EG)[ud] = fexp(glast);
    }
    __syncthreads();
    {
        float* DB = (float*)(lds + L_DB);
        if (wave < 2) { const int b = lane >> 4, c = lane & 15; const float* Lbb = (wave ? L1 : L0) + (16 * b) * 64 + 16 * b; float x[16];
            inv16_rows<0>(x, Lbb, c);
#pragma unroll
            for (int i = 0; i < 16; ++i) DB[((wave * 4 + b) * 16 + i) * 16 + c] = x[i]; }
        __syncthreads();
        const int dir = __builtin_amdgcn_readfirstlane(tid >> 8), wq = __builtin_amdgcn_readfirstlane((tid >> 6) & 3); const float* L = dir ? L1 : L0; const size_t ud = unit * 2 + dir;
        const float* bv = beta_l + dir * 64; const float* bk = bk_l + dir * 64; const int m = lane & 15, q = lane >> 4;
        const f32x4v zero4 = {0.f, 0.f, 0.f, 0.f};
        bf16x8 A01[3], A23, Ad[4];
#pragma unroll
        for (int b = 1; b < 4; ++b) { const float* lr = L + (16 * b + m) * 64 + 4 * q; const f32x4v l0 = *(const f32x4v*)lr, l1 = (b >= 2) ? *(const f32x4v*)(lr + 16) : zero4; A01[b - 1] = pack8(-l0, -l1); }
        { const float* lr = L + (48 + m) * 64 + 32 + 4 * q; A23 = pack8(-*(const f32x4v*)lr, zero4); }
#pragma unroll
        for (int b = 0; b < 4; ++b) Ad[b] = pack8(*(const f32x4v*)(DB + ((dir * 4 + b) * 16 + m) * 16 + 4 * q), zero4);
#pragma unroll
        for (int nt4 = 0; nt4 < 4; ++nt4) { const int col = 64 * wq + 16 * nt4 + m; f32x4v X[4];
#pragma unroll
            for (int b = 0; b < 4; ++b) { f32x4v acc;
#pragma unroll
                for (int r = 0; r < 4; ++r) { const int i = 16 * b + 4 * q + r, ti = dir ? 63 - i : i; acc[r] = (wq < 2) ? bv[i] * Vl[ti * 128 + col] : bk[i] * bf2f(Kl[ti * KP + (col - 128)]); }
                if (b >= 1) acc = MFMA16(A01[b - 1], pack8(X[0], b >= 2 ? X[1] : zero4), acc);
                if (b == 3) acc = MFMA16(A23, pack8(X[2], zero4), acc);
                X[b] = MFMA16(Ad[b], pack8(acc, zero4), zero4); }
            if (wq < 2) { float* o = WSP(float, WS_DN_UT) + (ud * 128 + col) * 64 + 4 * q;
#pragma unroll
                for (int b = 0; b < 4; ++b) *(f32x4v*)(o + 16 * b) = X[b];
            } else { const int d = col - 128, s = d >> 5, qd = (d >> 2) & 3, jv = 4 * ((d >> 4) & 1) + (d & 3); bf16* o = (bf16*)(lds + L_AKK) + dir * 16 * 512;
#pragma unroll
                for (int b = 0; b < 4; ++b)
#pragma unroll
                    for (int r = 0; r < 4; ++r) o[((b * 4 + s) * 64 + (4 * q + r) + 16 * qd) * 8 + jv] = f2bf(-X[b][r]); }
        }
    }
    __syncthreads();
    {
        u32x4* dst = (u32x4*)(WSP(bf16, WS_DN_WN) + unit * 2 * 16 * 512); const u32x4* src = (const u32x4*)(lds + L_AKK);
#pragma unroll
        for (int e = 0; e < 4; ++e) dst[tid + 512 * e] = src[tid + 512 * e];
    }
}
constexpr int SC_WN = 0, SC_QE = 16384, SC_IN = 32768, SC_KD = 40960, SC_BUF = 57344, SC_OT = 2 * SC_BUF, SC_OTR = 272, SC_OTB = 64 * SC_OTR;
__device__ __forceinline__ void dn_scan_chain(const P& p, int chain, char* lds, int tid_in) {
    int tid_ = tid_in; asm volatile("" : "+v"(tid_));
    const int tid = tid_, lane = tid & 63, wave = tid >> 6, n = lane & 15, q = lane >> 4, n0 = wave * 16;
    const int dir = chain & 1, sh = chain >> 1, hh = sh % NH, seq = sh / NH;
    f32x4v Sacc[8];
#pragma unroll
    for (int mt = 0; mt < 8; ++mt) Sacc[mt] = (f32x4v){0.f, 0.f, 0.f, 0.f};
    bf16* O = WSP(bf16, dir ? WS_OB : WS_OF);
    u32x4 st0[7], st1[7];
#define SC_UD(step) (((size_t)sh * (S / 64) + (dir ? S / 64 - 1 - (step) : (step))) * 2 + dir)
#define SC_LOAD(st, ud) do { const u32x4* a = (const u32x4*)WSP(bf16, WS_DN_WN) + (ud) * 1024 + tid; const u32x4* b = (const u32x4*)WSP(bf16, WS_DN_QE) + (ud) * 1024 + tid; \
        const u32x4* c = (const u32x4*)WSP(bf16, WS_DN_IN) + (ud) * 512 + tid; const u32x4* d = (const u32x4*)WSP(bf16, WS_DN_KD) + (ud) * 1024 + tid; \
        st[0] = a[0]; st[1] = a[512]; st[2] = b[0]; st[3] = b[512]; st[4] = c[0]; st[5] = d[0]; st[6] = d[512]; } while (0)
#define SC_WRITE(st, buf) do { char* b_ = lds + (buf) * SC_BUF + tid * 16; *(u32x4*)(b_ + SC_WN) = st[0]; *(u32x4*)(b_ + SC_WN + 8192) = st[1]; *(u32x4*)(b_ + SC_QE) = st[2]; *(u32x4*)(b_ + SC_QE + 8192) = st[3]; \
        *(u32x4*)(b_ + SC_IN) = st[4]; *(u32x4*)(b_ + SC_KD) = st[5]; *(u32x4*)(b_ + SC_KD + 8192) = st[6]; } while (0)
    f32x4v ut0[4], ut1[4]; float eg0, eg1;
#define SC_LOADU(ut, egv, ud) do { const float* u_ = WSP(float, WS_DN_UT) + ((ud) * 128 + n0 + n) * 64 + 4 * q; _Pragma("unroll") for (int mt = 0; mt < 4; ++mt) ut[mt] = *(const f32x4v*)(u_ + 16 * mt); egv = WSP(float, WS_DN_EG)[ud]; } while (0)
    { const size_t ud0 = SC_UD(0), ud1 = SC_UD(1), ud2 = SC_UD(2); SC_LOAD(st0, ud0); SC_LOADU(ut0, eg0, ud0); SC_LOAD(st1, ud1); SC_LOADU(ut1, eg1, ud1); SC_WRITE(st0, 0); SC_LOAD(st0, ud2); }
    __syncthreads();
#define SC_COPYOUT(ps) do { const int cp_ = dir ? S / 64 - 1 - (ps) : (ps); const long tbp_ = (long)seq * S + (long)cp_ * 64; const char* otp_ = lds + SC_OT + ((ps) & 1) * SC_OTB; \
        _Pragma("unroll") for (int j_ = 0; j_ < 2; ++j_) { const int v_ = tid + 512 * j_, row_ = v_ >> 4, cv_ = v_ & 15, ti_ = dir ? 63 - row_ : row_; \
            *(u32x4*)(O + ((size_t)(tbp_ + ti_) * NH + hh) * DH + cv_ * 8) = *(const u32x4*)(otp_ + row_ * SC_OTR + cv_ * 16); } } while (0)
#define SC_STEP(step, stY, utX, egX) do { \
        const int c = dir ? S / 64 - 1 - (step) : (step); \
        if ((step) + 1 < S / 64) SC_WRITE(stY, ((step) + 1) & 1);                                       \
        if ((step) > 0) SC_COPYOUT((step) - 1); \
        if ((step) + 3 < S / 64) { const size_t udn = SC_UD((step) + 3); SC_LOAD(stY, udn); } \
        f32x4v vn[4], o[4]; const float eg = egX; \
        _Pragma("unroll") for (int mt = 0; mt < 4; ++mt) { vn[mt] = utX[mt]; o[mt] = (f32x4v){0.f, 0.f, 0.f, 0.f}; } \
        if ((step) + 2 < S / 64) { const size_t udu = SC_UD((step) + 2); SC_LOADU(utX, egX, udu); } \
        const char* fb = lds + ((step) & 1) * SC_BUF + lane * 16; \
        bf16x8 Sb[4]; \
        _Pragma("unroll") for (int s = 0; s < 4; ++s) Sb[s] = pack8(Sacc[2 * s], Sacc[2 * s + 1]); \
        _Pragma("unroll") for (int mt = 0; mt < 4; ++mt) \
            _Pragma("unroll") for (int s = 0; s < 4; ++s) { vn[mt] = MFMA16(*(const bf16x8*)(fb + SC_WN + (mt * 4 + s) * 1024), Sb[s], vn[mt]); o[mt] = MFMA16(*(const bf16x8*)(fb + SC_QE + (mt * 4 + s) * 1024), Sb[s], o[mt]); } \
        bf16x8 Vb[2]; \
        _Pragma("unroll") for (int s = 0; s < 2; ++s) Vb[s] = pack8(vn[2 * s], vn[2 * s + 1]); \
        _Pragma("unroll") for (int mt = 0; mt < 4; ++mt) \
            _Pragma("unroll") for (int s = 0; s < 2; ++s) o[mt] = MFMA16(*(const bf16x8*)(fb + SC_IN + (mt * 2 + s) * 1024), Vb[s], o[mt]); \
        { char* ot_ = lds + SC_OT + ((step) & 1) * SC_OTB + (n0 + n) * 2;                                  \
        _Pragma("unroll") for (int mt = 0; mt < 4; ++mt) \
            _Pragma("unroll") for (int r = 0; r < 4; ++r) *(bf16*)(ot_ + (16 * mt + 4 * q + r) * SC_OTR) = f2bf(o[mt][r]); } \
        _Pragma("unroll") for (int mt = 0; mt < 8; ++mt) { f32x4v a = Sacc[mt] * eg; \
            _Pragma("unroll") for (int s = 0; s < 2; ++s) a = MFMA16(*(const bf16x8*)(fb + SC_KD + (mt * 2 + s) * 1024), Vb[s], a); \
            Sacc[mt] = a; } \
        __syncthreads(); } while (0)
#pragma unroll 1
    SC_STEP(0, st1, ut0, eg0); SC_STEP(1, st0, ut1, eg1);
#pragma unroll 1
    for (int step = 2; step < S / 64; step += 2) { SC_STEP(step, st1, ut0, eg0); SC_STEP(step + 1, st0, ut1, eg1); }
    SC_COPYOUT(S / 64 - 1);
#undef SC_STEP
#undef SC_COPYOUT
#undef SC_UD
#undef SC_LOAD
#undef SC_LOADU
#undef SC_WRITE
}
#undef MFMA16
}
constexpr int NWAVES = 8, NTHR = 512;
constexpr int RING_BYTES = 131072, LDSCTL_OFF = 158720, MISC_OFF = LDSCTL_OFF + 320, LDS_BYTES = 159744;
#define LAS __attribute__((address_space(3)))
#define GAS __attribute__((address_space(1)))
typedef unsigned v4u __attribute__((ext_vector_type(4)));
typedef float f32x4 __attribute__((ext_vector_type(4)));
#define LDS_WAIT() asm volatile("s_waitcnt lgkmcnt(0)" ::: "memory")
#define XB_TMO      128
#define XB_XCNT(j)  (256  + 64 * (j))
#define XB_XSUB(j)  (1280 + 64 * (j))
#define XB_XGEN(j)  (2304 + 64 * (j))
#define XB_TOP      3328
#define XB_TOPGEN   3392
#define XCD_BAR_WORDS 3456
#define XB_SPIN_CAP (1u << 22)
__device__ __forceinline__ unsigned xb_ld(unsigned* p)              { return __hip_atomic_load(p, __ATOMIC_RELAXED, __HIP_MEMORY_SCOPE_AGENT); }
__device__ __forceinline__ unsigned xb_add(unsigned* p, unsigned v) { return __hip_atomic_fetch_add(p, v, __ATOMIC_RELAXED, __HIP_MEMORY_SCOPE_AGENT); }
__device__ __forceinline__ unsigned xb_xcc_id() { return (unsigned)__builtin_amdgcn_s_getreg((3 << 11) | 20) & 0xFu; }
#define XB_SPIN(cond, bar) do { unsigned _sp = 0; while (cond) { __builtin_amdgcn_s_sleep(1); \
    if ((++_sp & 255u) == 0u) { if (xb_ld(&(bar)[XB_TMO])) break; if (_sp > XB_SPIN_CAP) { atomicAdd(&(bar)[XB_TMO], 1u); break; } } } } while (0)
struct XcdBarrier { unsigned* bar; unsigned x; volatile LAS unsigned* st; };
__device__ __forceinline__ XcdBarrier xcd_barrier_post(unsigned* bar, volatile LAS unsigned* st) {
    XcdBarrier b; b.bar = bar; b.x = xb_xcc_id(); b.st = st;
    if (threadIdx.x == 0) (void)xb_add(&bar[XB_XCNT(b.x)], 1u);
    return b;
}
__device__ __forceinline__ void xcd_barrier_complete(unsigned* bar, unsigned x, unsigned& nloc, unsigned& nx) {
    const unsigned G = gridDim.x * gridDim.y * gridDim.z;
    unsigned sum, cnt, mine, sp = 0u;
    for (;;) {
        sum = 0u; cnt = 0u; mine = 0u;
#pragma unroll
        for (unsigned j = 0; j < 16; ++j) { const unsigned c = xb_ld(&bar[XB_XCNT(j)]); sum += c; cnt += (c > 0u) ? 1u : 0u; mine = (j == x) ? c : mine; }
        if (sum == G) break;
        __builtin_amdgcn_s_sleep(1);
        if ((++sp & 255u) == 0u) { if (xb_ld(&bar[XB_TMO])) break; if (sp > XB_SPIN_CAP) { atomicAdd(&bar[XB_TMO], 1u); break; } }
    }
    nloc = mine > 0u ? mine : 1u; nx = cnt > 0u ? cnt : 1u;
}
__device__ __forceinline__ void xcd_barrier(const XcdBarrier& b, int tid_in) {
    asm volatile("s_waitcnt vmcnt(0)" ::: "memory");
    __syncthreads();
    if (tid_in == 0) {
        unsigned* bar = b.bar; const unsigned bx = xb_xcc_id();
        __builtin_amdgcn_s_waitcnt(0);
        unsigned nloc = b.st[0], nx = b.st[1];
        if (nloc == 0u) { xcd_barrier_complete(bar, bx, nloc, nx); b.st[0] = nloc; b.st[1] = nx; }
        const unsigned old = xb_add(&bar[XB_XSUB(bx)], 1u);
        const unsigned gen = old / nloc;
        if (old + 1u == (gen + 1u) * nloc) {
            __builtin_amdgcn_fence(__ATOMIC_RELEASE, "agent");
            asm volatile("s_waitcnt vmcnt(0)" ::: "memory");
            const unsigned og = xb_add(&bar[XB_TOP], 1u);
            const unsigned tg = og / nx;
            if (og + 1u == (tg + 1u) * nx) xb_add(&bar[XB_TOPGEN], 1u);
            else XB_SPIN(xb_ld(&bar[XB_TOPGEN]) == tg, bar);
            __builtin_amdgcn_fence(__ATOMIC_ACQUIRE, "agent");
            xb_add(&bar[XB_XGEN(bx)], 1u);
            asm volatile("s_waitcnt vmcnt(0)" ::: "memory");
        } else {
            XB_SPIN(xb_ld(&bar[XB_XGEN(bx)]) == gen, bar);
            __builtin_amdgcn_fence(__ATOMIC_ACQUIRE, "agent");
            asm volatile("s_waitcnt vmcnt(0)" ::: "memory");
        }
    }
    __syncthreads();
}
constexpr size_t CTL_ZERO_BYTES = 65536; constexpr int CW_BAR = 1024;

__device__ __forceinline__ float wave_sum(float v) {
#pragma unroll
    for (int o = 1; o < 64; o <<= 1) v += __shfl_xor(v, o);
    return v;
}
constexpr long N_SCAN4 = N_SCAN * 4;
__device__ __forceinline__ void st_dn_scan4(const P& p, long g) {
    const int part = (int)(g & 3); const long g1 = g >> 2;
    const int vc = (int)(g1 % DH); const int dir = (int)((g1 / DH) % 2); const int hh = (int)((g1 / (2 * DH)) % NH); const int seq = (int)(g1 / (2 * DH * NH));
    const float *QN = WSP(float, WS_QN), *KN = WSP(float, WS_KN), *VV = WSP(float, WS_VV), *G = WSP(float, WS_G), *BT = WSP(float, WS_BETA);
    float* O = WSP(float, dir ? WS_OB : WS_OF);
    float Sx[32];
#pragma unroll
    for (int d = 0; d < 32; ++d) Sx[d] = 0.f;
    for (int step = 0; step < S; ++step) {
        const int tt = dir ? S - 1 - step : step; const long t = (long)seq * S + tt;
        const float eg = expf(G[(t * 2 + dir) * NH + hh]), b = BT[(t * 2 + dir) * NH + hh];
        const float* kp = KN + ((size_t)t * NH + hh) * DH + part * 32; const float* qp = QN + ((size_t)t * NH + hh) * DH + part * 32; const float vv = VV[((size_t)t * NH + hh) * DH + vc];
        float dot = 0.f;
#pragma unroll
        for (int d = 0; d < 32; ++d) { Sx[d] *= eg; dot += Sx[d] * kp[d]; }
        dot += __shfl_xor(dot, 1); dot += __shfl_xor(dot, 2);
        const float delta = b * (vv - dot); float o = 0.f;
#pragma unroll
        for (int d = 0; d < 32; ++d) { Sx[d] += kp[d] * delta; o += Sx[d] * qp[d]; }
        o += __shfl_xor(o, 1); o += __shfl_xor(o, 2);
        if (part == 0) O[((size_t)t * NH + hh) * DH + vc] = o;
    }
}
__device__ __forceinline__ unsigned pk2(float lo, float hi) { return (unsigned)f2bf(lo) | ((unsigned)f2bf(hi) << 16); }
template <int ST> __device__ __forceinline__ void grid_items(const Job& j, long n, int tid_in) {
    int t_ = tid_in; asm volatile("" : "+v"(t_));
    for (long g = (long)blockIdx.x * NTHR + t_; g < n; g += (long)gridDim.x * NTHR) run_item<ST>(j, g);
}
__device__ __forceinline__ void transpose_item(const float* W, int K, int N, bf16* WT, LAS float* scr, int item, int lane, int GU = 0) {
    const int nblk_src = (N + 63) / 64; const int kblks = K / 64; const int KBL = kblks < 16 ? kblks : 16, NBL = 64 / KBL, kbb = kblks / KBL;
    const int blk = item >> 6, within = item & 63; const int kb = (blk % kbb) * KBL + (within % KBL), nb = (blk / kbb) * NBL + (within / KBL), k0 = 64 * kb, n0 = 64 * nb;
    const int n0s = GU ? (((n0 >> 7) & 1) * DFF + (n0 >> 8) * 128 + (n0 & 127)) : n0;
    const int c = lane & 7;
    if (nb >= nblk_src) {
#pragma unroll
        for (int jj = 0; jj < 8; ++jj) { const int n = (lane >> 3) + 8 * jj; *(GAS v4u*)(WT + (size_t)(n0 + n) * K + k0 + 8 * c) = (v4u){0u, 0u, 0u, 0u}; }
        return;
    }
    {
        f32x4 v[16]; const int kq = lane >> 4, nn = (lane & 15) * 4;
#pragma unroll
        for (int i = 0; i < 16; ++i) v[i] = (n0s + nn < N) ? *(const f32x4*)(W + (size_t)(k0 + 4 * i + kq) * N + n0s + nn) : (f32x4){0.f, 0.f, 0.f, 0.f};
#pragma unroll
        for (int i = 0; i < 16; ++i) { LAS float* d = scr + (4 * i + kq) * 65 + nn; d[0] = v[i].x; d[1] = v[i].y; d[2] = v[i].z; d[3] = v[i].w; }
    }
    LDS_WAIT(); asm volatile("" ::: "memory");
#pragma unroll
    for (int jj = 0; jj < 8; ++jj) { const int n = (lane >> 3) + 8 * jj; const LAS float* s_ = scr + (8 * c) * 65 + n;
        v4u o; o.x = pk2(s_[0 * 65], s_[1 * 65]); o.y = pk2(s_[2 * 65], s_[3 * 65]); o.z = pk2(s_[4 * 65], s_[5 * 65]); o.w = pk2(s_[6 * 65], s_[7 * 65]);
        *(GAS v4u*)(WT + (size_t)(n0 + n) * K + k0 + 8 * c) = o; }
    LDS_WAIT(); asm volatile("" ::: "memory");
}
__device__ __forceinline__ void pb_phase(const P& p, int tid_in) {
    int t_ = tid_in; asm volatile("" : "+v"(t_));
    constexpr long np8 = (long)NPROMPT * S * PLE / 8, ns8 = (long)(NSEQ - NPROMPT) * S * PLE / 8, n8 = np8 + ns8;
    for (int layer = 0; layer < DEPTH; ++layer) {
        const float* pp = p.p_prompt + (size_t)layer * np8 * 8; const float* ps = p.p_sample + (size_t)layer * ns8 * 8; bf16* o = WSP(bf16, WS_PB + (size_t)layer * SZ_PB);
#pragma unroll 2
        for (long g = (long)blockIdx.x * NTHR + t_; g < n8; g += (long)gridDim.x * NTHR) { const float* src = g < np8 ? pp + g * 8 : ps + (g - np8) * 8;
            const f32x4 a = *(const f32x4*)src, b = *(const f32x4*)(src + 4); v4u w; w.x = pk2(a.x, a.y); w.y = pk2(a.z, a.w); w.z = pk2(b.x, b.y); w.w = pk2(b.z, b.w); *(v4u*)(o + g * 8) = w; }
    }
}
__device__ __forceinline__ float fast_sigmoid(float x) { return __builtin_amdgcn_rcpf(1.0f + __builtin_amdgcn_exp2f(-1.4426950408889634f * x)); }
template <int MODE> __device__ __forceinline__ void row_phase(const P& p, const float* wa, const float* wn, int gw, int ngw, int lane) {
    constexpr int NV = D / 256;
    asm volatile("" : "+v"(lane));
    f32x4 hN[NV]; unsigned long long hB[NV], yN[NV], pN[NV];
#define ROW_LOAD(t_) do { const long tt_ = (t_); \
        if (MODE == 0) { const long np = (long)NPROMPT * S * D; const float* src = (tt_ * D < np) ? p.x_prompt + (size_t)tt_ * D : p.x_sample + ((size_t)tt_ * D - np); \
            _Pragma("unroll") for (int i = 0; i < NV; ++i) hN[i] = *(const f32x4*)(src + (i * 64 + lane) * 4); } \
        else { const bf16* hr_ = WSP(bf16, WS_H16) + (size_t)tt_ * D; const bf16* yr_ = WSP(bf16, WS_GOUT) + (size_t)tt_ * D; \
            _Pragma("unroll") for (int i = 0; i < NV; ++i) { hB[i] = *(const unsigned long long*)(hr_ + (i * 64 + lane) * 4); yN[i] = *(const unsigned long long*)(yr_ + (i * 64 + lane) * 4); } \
            if (MODE == 3) { const bf16* pr_ = WSP(bf16, WS_PP2) + (size_t)tt_ * D; _Pragma("unroll") for (int i = 0; i < NV; ++i) pN[i] = *(const unsigned long long*)(pr_ + (i * 64 + lane) * 4); } } } while (0)
#define UNPK(q_) (f32x4){bf2f((bf16)((q_) & 0xffff)), bf2f((bf16)(((q_) >> 16) & 0xffff)), bf2f((bf16)(((q_) >> 32) & 0xffff)), bf2f((bf16)((q_) >> 48))}
    f32x4 wA[NV], wN[NV];
#pragma unroll
    for (int i = 0; i < NV; ++i) { wA[i] = (MODE == 1 || MODE == 2) ? *(const f32x4*)(wa + (i * 64 + lane) * 4) : (f32x4){0.f, 0.f, 0.f, 0.f}; wN[i] = (MODE != 2 && wn != nullptr) ? *(const f32x4*)(wn + (i * 64 + lane) * 4) : (f32x4){0.f, 0.f, 0.f, 0.f}; }
    if (gw < T) ROW_LOAD(gw);
    for (int t = gw; t < T; t += ngw) {
        f32x4 h[NV], y[NV], pp[NV];
#pragma unroll
        for (int i = 0; i < NV; ++i) { if (MODE == 0) h[i] = hN[i]; else { h[i] = UNPK(hB[i]); y[i] = UNPK(yN[i]); } if (MODE == 3) pp[i] = UNPK(pN[i]); }
        if (t + ngw < T) ROW_LOAD(t + ngw);
        if (MODE == 1 || MODE == 2) {
            float ss = 0.f;
#pragma unroll
            for (int i = 0; i < NV; ++i) ss += (y[i].x * y[i].x + y[i].y * y[i].y) + (y[i].z * y[i].z + y[i].w * y[i].w);
            const float r = 1.0f / sqrtf(wave_sum(ss) * (1.0f / D) + RMS_EPS);
#pragma unroll
            for (int i = 0; i < NV; ++i) h[i] = h[i] + y[i] * r * wA[i];
        } else if (MODE == 3) {
#pragma unroll
            for (int i = 0; i < NV; ++i) { h[i].x += fast_sigmoid(y[i].x) * pp[i].x; h[i].y += fast_sigmoid(y[i].y) * pp[i].y; h[i].z += fast_sigmoid(y[i].z) * pp[i].z; h[i].w += fast_sigmoid(y[i].w) * pp[i].w; }
        }
        if (MODE == 3 && wn == nullptr) { float* hr = p.h + (size_t)t * D;
#pragma unroll
            for (int i = 0; i < NV; ++i) *(f32x4*)(hr + (i * 64 + lane) * 4) = h[i];
            continue; }
        { bf16* hw = WSP(bf16, WS_H16) + (size_t)t * D;
#pragma unroll
            for (int i = 0; i < NV; ++i) *(unsigned long long*)(hw + (i * 64 + lane) * 4) = (unsigned long long)pk2(h[i].x, h[i].y) | ((unsigned long long)pk2(h[i].z, h[i].w) << 32); }
        if (MODE == 2) continue;
        float r2 = 1.f;
        if (MODE != 2) { float ss = 0.f;
#pragma unroll
            for (int i = 0; i < NV; ++i) ss += (h[i].x * h[i].x + h[i].y * h[i].y) + (h[i].z * h[i].z + h[i].w * h[i].w);
            r2 = 1.0f / sqrtf(wave_sum(ss) * (1.0f / D) + RMS_EPS); }
        bf16* o = WSP(bf16, WS_HN) + (size_t)t * D;
#pragma unroll
        for (int i = 0; i < NV; ++i) { f32x4 v = h[i] * r2; if (MODE != 2) v = v * wN[i];
            *(unsigned long long*)(o + (i * 64 + lane) * 4) = (unsigned long long)pk2(v.x, v.y) | ((unsigned long long)pk2(v.z, v.w) << 32); }
    }
#undef ROW_LOAD
#undef UNPK
}

typedef short bf16x8_t __attribute__((ext_vector_type(8)));
__device__ __forceinline__ float gelu_fast(float x) { const float u = 0.7978845608028654f * (x + 0.044715f * x * x * x); return x * __builtin_amdgcn_rcpf(1.0f + __builtin_amdgcn_exp2f(-2.885390081777927f * u)); }
__device__ __forceinline__ void ffn_act_phase(const P& p, int layer, int gw, int ngw, int lane) {
    asm volatile("" : "+v"(lane));
    constexpr int TT = 32, NCB = DFF / 512, NIT = (T / TT) * NCB;
    const bf16* hid = WSP(bf16, WS_HID); bf16* act = WSP(bf16, WS_ACT);
    const float* cw = PRM(PR_FCW) + (size_t)layer * 3 * 2 * DFF; const float* cb = PRM(PR_FCB) + (size_t)layer * 2 * DFF;
    for (int it = gw; it < NIT; it += ngw) {
        const int cblk = it % NCB, tile = it / NCB; const int c0 = cblk * 512 + lane * 8; const long t0 = (long)tile * TT; const int tt0 = (int)(t0 % S);
        float wg[3][8], wu[3][8], bg[8], bu[8];
#pragma unroll
        for (int i = 0; i < 3; ++i)
#pragma unroll
            for (int e = 0; e < 8; ++e) { wg[i][e] = cw[i * 2 * DFF + c0 + e]; wu[i][e] = cw[i * 2 * DFF + DFF + c0 + e]; }
#pragma unroll
        for (int e = 0; e < 8; ++e) { bg[e] = cb[c0 + e]; bu[e] = cb[DFF + c0 + e]; }
        const bf16x8_t zero8 = {0, 0, 0, 0, 0, 0, 0, 0};
        bf16x8_t g0 = zero8, u0 = zero8, g1, u1, g2, u2;
        if (tt0 > 0) { g0 = *(const bf16x8_t*)(hid + (size_t)(t0 - 1) * (2 * DFF) + c0); u0 = *(const bf16x8_t*)(hid + (size_t)(t0 - 1) * (2 * DFF) + DFF + c0); }
        g1 = *(const bf16x8_t*)(hid + (size_t)t0 * (2 * DFF) + c0); u1 = *(const bf16x8_t*)(hid + (size_t)t0 * (2 * DFF) + DFF + c0);
        for (int k = 0; k < TT; ++k) {
            const long t = t0 + k;
            if (tt0 + k + 1 < S) { g2 = *(const bf16x8_t*)(hid + (size_t)(t + 1) * (2 * DFF) + c0); u2 = *(const bf16x8_t*)(hid + (size_t)(t + 1) * (2 * DFF) + DFF + c0); } else { g2 = zero8; u2 = zero8; }
            float o[8];
#pragma unroll
            for (int e = 0; e < 8; ++e) {
                const float ga = bg[e] + bf2f((bf16)g0[e]) * wg[0][e] + bf2f((bf16)g1[e]) * wg[1][e] + bf2f((bf16)g2[e]) * wg[2][e];
                const float up = bu[e] + bf2f((bf16)u0[e]) * wu[0][e] + bf2f((bf16)u1[e]) * wu[1][e] + bf2f((bf16)u2[e]) * wu[2][e];
                o[e] = gelu_fast(ga) * up; }
            v4u w; w.x = pk2(o[0], o[1]); w.y = pk2(o[2], o[3]); w.z = pk2(o[4], o[5]); w.w = pk2(o[6], o[7]);
            *(v4u*)(act + (size_t)t * DFF + c0) = w;
            g0 = g1; u0 = u1; g1 = g2; u1 = u2;
        }
    }
}
__device__ __forceinline__ void dn_out_phase(const P& p, int jl, int gw, int ngw, int lane) {
    asm volatile("" : "+v"(lane));
    const int hh = lane >> 3, d0 = (lane & 7) * 16; const float* on = PRM(PR_ONORM) + jl * DH + d0;
    bf16x8_t aN[2], bN[2], zN0, zN1;
#define DNO_LOAD(t_) do { const bf16* of_ = WSP(bf16, WS_OF) + ((size_t)(t_) * NH + hh) * DH + d0; const bf16* ob_ = WSP(bf16, WS_OB) + ((size_t)(t_) * NH + hh) * DH + d0; \
        const bf16* z_ = WSP(bf16, WS_PROJ) + (size_t)(t_) * ABINP + COL_Z + hh * DH + d0; \
        aN[0] = *(const bf16x8_t*)of_; aN[1] = *(const bf16x8_t*)(of_ + 8); bN[0] = *(const bf16x8_t*)ob_; bN[1] = *(const bf16x8_t*)(ob_ + 8); zN0 = *(const bf16x8_t*)z_; zN1 = *(const bf16x8_t*)(z_ + 8); } while (0)
    if (gw < T) DNO_LOAD(gw);
    for (int t = gw; t < T; t += ngw) {
        float o[16]; float ss = 0.f; const bf16x8_t z0 = zN0, z1 = zN1;
#pragma unroll
        for (int c8 = 0; c8 < 2; ++c8)
#pragma unroll
            for (int e = 0; e < 8; ++e) { o[8 * c8 + e] = bf2f((bf16)aN[c8][e]) + bf2f((bf16)bN[c8][e]); ss += o[8 * c8 + e] * o[8 * c8 + e]; }
        if (t + ngw < T) DNO_LOAD(t + ngw);
        ss += __shfl_xor(ss, 1); ss += __shfl_xor(ss, 2); ss += __shfl_xor(ss, 4);
        const float r = 1.0f / sqrtf(ss * (1.0f / DH) + RMS_EPS); float v[16];
#pragma unroll
        for (int e = 0; e < 16; ++e) { const float zz = bf2f((bf16)(e < 8 ? z0[e] : z1[e - 8])); v[e] = o[e] * r * on[e] * zz * fast_sigmoid(zz); }
        bf16* out = WSP(bf16, WS_MIXIN) + (size_t)t * ABMIX + hh * DH + d0;
        v4u w0, w1; w0.x = pk2(v[0], v[1]); w0.y = pk2(v[2], v[3]); w0.z = pk2(v[4], v[5]); w0.w = pk2(v[6], v[7]); w1.x = pk2(v[8], v[9]); w1.y = pk2(v[10], v[11]); w1.z = pk2(v[12], v[13]); w1.w = pk2(v[14], v[15]);
        *(v4u*)out = w0; *(v4u*)(out + 8) = w1;
    }
#undef DNO_LOAD
}
__device__ __forceinline__ void c_out_phase(const P& p, int jl, int gw, int ngw, int lane) {
    asm volatile("" : "+v"(lane));
    const int hh = lane >> 3, e0 = (lane & 7) * 32; const float lam = WSP(float, WS_LAM)[0], li = WSP(float, WS_LAM)[1]; const float* sw = PRM(PR_SUBLN) + jl * 256 + e0;
    bf16x8_t aN[4], bN[4];
#define CO_LOAD(t_) do { const bf16* o0_ = WSP(bf16, WS_O0) + (size_t)(t_) * 2048 + hh * 256 + e0; const bf16* o1_ = WSP(bf16, WS_O1) + (size_t)(t_) * 2048 + hh * 256 + e0; \
        _Pragma("unroll") for (int c8 = 0; c8 < 4; ++c8) { aN[c8] = *(const bf16x8_t*)(o0_ + 8 * c8); bN[c8] = *(const bf16x8_t*)(o1_ + 8 * c8); } } while (0)
    if (gw < T) CO_LOAD(gw);
    for (int t = gw; t < T; t += ngw) {
        float o[32]; float ss = 0.f;
#pragma unroll
        for (int c8 = 0; c8 < 4; ++c8)
#pragma unroll
            for (int e = 0; e < 8; ++e) { o[8 * c8 + e] = bf2f((bf16)aN[c8][e]) - lam * bf2f((bf16)bN[c8][e]); ss += o[8 * c8 + e] * o[8 * c8 + e]; }
        if (t + ngw < T) CO_LOAD(t + ngw);
        ss += __shfl_xor(ss, 1); ss += __shfl_xor(ss, 2); ss += __shfl_xor(ss, 4);
        const float r = (1.0f / sqrtf(ss * (1.0f / 256.0f) + RMS_EPS)) * (1.0f - li);
        bf16* out = WSP(bf16, WS_MIXIN) + (size_t)t * 2048 + hh * 256 + e0;
#pragma unroll
        for (int c8 = 0; c8 < 4; ++c8) { v4u w; w.x = pk2(o[8 * c8] * r * sw[8 * c8], o[8 * c8 + 1] * r * sw[8 * c8 + 1]); w.y = pk2(o[8 * c8 + 2] * r * sw[8 * c8 + 2], o[8 * c8 + 3] * r * sw[8 * c8 + 3]);
            w.z = pk2(o[8 * c8 + 4] * r * sw[8 * c8 + 4], o[8 * c8 + 5] * r * sw[8 * c8 + 5]); w.w = pk2(o[8 * c8 + 6] * r * sw[8 * c8 + 6], o[8 * c8 + 7] * r * sw[8 * c8 + 7]); *(v4u*)(out + 8 * c8) = w; }
    }
#undef CO_LOAD
}
__device__ __forceinline__ void rope_table_phase(const P& p, int tid_in) {
    int t_ = tid_in; asm volatile("" : "+v"(t_));
    float* tab = WSP(float, WS_LAM) + 16;
    for (int g = (int)blockIdx.x * NTHR + t_; g < S * 16; g += (int)gridDim.x * NTHR) { const int i = g & 15, pos = g >> 4;
        const float inv = powf(500000.0f, -(float)(2 * i) / 32.0f); const float ang = (float)pos * inv; tab[2 * g] = cosf(ang); tab[2 * g + 1] = sinf(ang); }
}
__device__ __forceinline__ void rope_phase(const P& p, int tid_in) {
    int t_ = tid_in; asm volatile("" : "+v"(t_));
    const float* tab = WSP(const float, WS_LAM) + 16;
    for (long g = (long)blockIdx.x * NTHR + t_; g < (long)T * 32; g += (long)gridDim.x * NTHR) {
        const int hj = (int)(g & 15), which = (int)((g >> 4) & 1); const long t = g >> 5; const float* cs_ = tab + (size_t)(t % S) * 32;
        bf16* x = WSP(bf16, WS_PROJ) + (size_t)t * CIN + which * 2048 + hj * DH;
        bf16x8_t a0 = *(const bf16x8_t*)x, a1 = *(const bf16x8_t*)(x + 8), b0 = *(const bf16x8_t*)(x + 16), b1 = *(const bf16x8_t*)(x + 24); float r1[16], r2[16];
#pragma unroll
        for (int i = 0; i < 16; ++i) { const float cs = cs_[2 * i], sn = cs_[2 * i + 1];
            const float x1 = bf2f((bf16)(i < 8 ? a0[i] : a1[i - 8])), x2 = bf2f((bf16)(i < 8 ? b0[i] : b1[i - 8])); r1[i] = x1 * cs - x2 * sn; r2[i] = x2 * cs + x1 * sn; }
        v4u w;
        w.x = pk2(r1[0], r1[1]); w.y = pk2(r1[2], r1[3]); w.z = pk2(r1[4], r1[5]); w.w = pk2(r1[6], r1[7]); *(v4u*)x = w;
        w.x = pk2(r1[8], r1[9]); w.y = pk2(r1[10], r1[11]); w.z = pk2(r1[12], r1[13]); w.w = pk2(r1[14], r1[15]); *(v4u*)(x + 8) = w;
        w.x = pk2(r2[0], r2[1]); w.y = pk2(r2[2], r2[3]); w.z = pk2(r2[4], r2[5]); w.w = pk2(r2[6], r2[7]); *(v4u*)(x + 16) = w;
        w.x = pk2(r2[8], r2[9]); w.y = pk2(r2[10], r2[11]); w.z = pk2(r2[12], r2[13]); w.w = pk2(r2[14], r2[15]); *(v4u*)(x + 24) = w;
    }
}
__device__ __forceinline__ void ffn_fix_phase(const P& p, int layer, int tid_in) {
    int t_ = tid_in; asm volatile("" : "+v"(t_));
    const int ln = t_ & 63, gwv = (int)blockIdx.x * NWAVES + __builtin_amdgcn_readfirstlane(t_ >> 6), ngwv = (int)gridDim.x * NWAVES;
    const float* cw = PRM(PR_FCW) + (size_t)layer * 3 * 2 * DFF; const float* cb = PRM(PR_FCB) + (size_t)layer * 2 * DFF; const float* HALO = WSP(float, WS_HALO);
    constexpr int NP = T / 256, PPS = S / 256, NCB = DFF / 256;
    for (int g = gwv; g < NP * 2 * NCB; g += ngwv) {
        const int c0 = (g % NCB) * 256 + ln * 4; const int edge = (g / NCB) & 1; const int pm = g / (2 * NCB);
        const bool has_prev = edge ? true : (pm % PPS != 0), has_next = edge ? (pm % PPS != PPS - 1) : true;
        const float* rp = HALO + (((size_t)(edge ? pm : pm - 1) * 4 + (edge ? 2 : 3)) * 2) * DFF + c0;
        const float* rc = HALO + (((size_t)pm * 4 + (edge ? 3 : 0)) * 2) * DFF + c0;
        const float* rn = HALO + (((size_t)(edge ? pm + 1 : pm) * 4 + (edge ? 0 : 1)) * 2) * DFF + c0;
        const f32x4 z4 = {0.f, 0.f, 0.f, 0.f};
        f32x4 gp = z4, up = z4, gn = z4, un = z4;
        if (has_prev) { gp = *(const f32x4*)rp; up = *(const f32x4*)(rp + DFF); }
        if (has_next) { gn = *(const f32x4*)rn; un = *(const f32x4*)(rn + DFF); }
        const f32x4 gc = *(const f32x4*)rc, uc = *(const f32x4*)(rc + DFF);
        const f32x4 bg = *(const f32x4*)(cb + c0), bu = *(const f32x4*)(cb + DFF + c0);
        const f32x4 wg0 = *(const f32x4*)(cw + c0), wu0 = *(const f32x4*)(cw + DFF + c0), wg1 = *(const f32x4*)(cw + 2 * DFF + c0), wu1 = *(const f32x4*)(cw + 3 * DFF + c0),
                    wg2 = *(const f32x4*)(cw + 4 * DFF + c0), wu2 = *(const f32x4*)(cw + 5 * DFF + c0);
        float o[4];
#pragma unroll
        for (int e = 0; e < 4; ++e) {
            const float cg = bg[e] + wg0[e] * gp[e] + wg1[e] * gc[e] + wg2[e] * gn[e];
            const float cu = bu[e] + wu0[e] * up[e] + wu1[e] * uc[e] + wu2[e] * un[e];
            o[e] = pg8::gelu_t(cg) * cu; }
        *(unsigned long long*)(WSP(bf16, WS_ACT) + ((size_t)pm * 256 + (edge ? 255 : 0)) * DFF + c0) = (unsigned long long)pk2(o[0], o[1]) | ((unsigned long long)pk2(o[2], o[3]) << 32);
    }
}
__device__ __forceinline__ int hw_lane() { int l; asm volatile("v_mbcnt_lo_u32_b32 %0, -1, 0\n\tv_mbcnt_hi_u32_b32 %0, -1, %0" : "=v"(l)); return l; }
struct Args { P p; };
__global__ void __launch_bounds__(NTHR, 2) mega_fwd(Args args) {
    extern __shared__ __attribute__((aligned(16))) unsigned char lds_raw[];
    LAS unsigned char* lds = (LAS unsigned char*)lds_raw;
    const P& p = args.p;
    const int tid = threadIdx.x, wave = __builtin_amdgcn_readfirstlane(tid >> 6);
#define HWLANE hw_lane()
#define HWTID ((wave << 6) | HWLANE)
#define lane HWLANE
    const int G = gridDim.x; const int gw = blockIdx.x * NWAVES + wave, ngw = G * NWAVES;
    volatile LAS unsigned* MISC = (volatile LAS unsigned*)(lds + MISC_OFF);
    for (int u = tid; u < (LDS_BYTES - LDSCTL_OFF) / 4; u += NTHR) ((LAS unsigned*)(lds + LDSCTL_OFF))[u] = 0u;
    __syncthreads();
    XcdBarrier bar = xcd_barrier_post(WSP(unsigned, WS_CTL) + CW_BAR, MISC + 8);
    Job j; j.p = p; j.w.W = nullptr; j.w.O = nullptr; j.w.K = 0; j.w.N = 0; j.w.Npad = 0; j.a = nullptr; j.b = nullptr; j.n = 0; j.layer = 0; j.flag = 0;

    {
        LAS float* scr = (LAS float*)(lds + wave * 16640);
        for (int m = 0; m < 24; ++m) {
            const float* W; bf16* O; int K, N, Npad; const int i = m & 1, l = m & 3;
            if (m < 2)       { W = p.ab_w_in + (size_t)i * D * ABIN;  O = WSP(bf16, WS_WABIN + (size_t)i * ABINP * D * 2); K = D; N = ABIN; Npad = ABINP; }
            else if (m < 4)  { W = p.ab_w_out + (size_t)i * ABMIX * D; O = WSP(bf16, WS_WABOUT + (size_t)i * D * ABMIX * 2); K = ABMIX; N = D; Npad = D; }
            else if (m < 6)  { W = p.c_w_in + (size_t)i * D * CIN;    O = WSP(bf16, WS_WCIN + (size_t)i * CIN * D * 2); K = D; N = CIN; Npad = CIN; }
            else if (m < 8)  { W = p.c_w_out + (size_t)i * CV * D;    O = WSP(bf16, WS_WCOUT + (size_t)i * D * CV * 2); K = CV; N = D; Npad = D; }
            else if (m < 12) { W = p.ffn_w_in + (size_t)l * D * 2 * DFF; O = WSP(bf16, WS_WFIN + (size_t)l * 2 * DFF * D * 2); K = D; N = 2 * DFF; Npad = 2 * DFF; }
            else if (m < 16) { W = p.ffn_w_out + (size_t)l * DFF * D;  O = WSP(bf16, WS_WFOUT + (size_t)l * D * DFF * 2); K = DFF; N = D; Npad = D; }
            else if (m < 20) { W = p.ple_w_proj + (size_t)l * PLE * D; O = WSP(bf16, WS_WPP + (size_t)l * D * PLE * 2); K = PLE; N = D; Npad = D; }
            else             { W = p.ple_w_gate + (size_t)l * D * D;   O = WSP(bf16, WS_WPG + (size_t)l * D * D * 2); K = D; N = D; Npad = D; }
            const int nitems = (K / 64) * (Npad / 64);
            for (int it = gw; it < nitems; it += ngw) transpose_item(W, K, N, O, scr, it, lane, (m >= 8 && m < 12) ? 1 : 0);
        }
        rope_table_phase(p, HWTID);
        {
            int t_ = HWTID; asm volatile("" : "+v"(t_));
            if (blockIdx.x == 0 && t_ < 2) { const float* lp = p.c_lambda + (size_t)t_ * 4 * DH; float a = 0.f, b = 0.f;
                for (int d = 0; d < DH; ++d) { a += lp[d] * lp[DH + d]; b += lp[2 * DH + d] * lp[3 * DH + d]; }
                const float li = lambda_init_of(2 * t_ + 1); WSP(float, WS_LAM)[2 * t_] = expf(a) - expf(b) + li; WSP(float, WS_LAM)[2 * t_ + 1] = li; }
        }
        grid_items<ST_PRM>(j, N_PRM, HWTID);
        pb_phase(p, HWTID);
        row_phase<0>(p, nullptr, p.norms, gw, ngw, lane);
    }
    xcd_barrier(bar, HWTID);

    for (int layer = 0; layer < DEPTH; ++layer) {
        j.layer = layer; const int jj = layer >> 1; const float* nw = PRM(PR_NORMS) + (size_t)layer * 4 * D;
        {
            const bool ab = (layer & 1) == 0; const int N = ab ? ABINP : CIN;
            const bf16* Bt = ab ? WSP(bf16, WS_WABIN + (size_t)jj * ABINP * D * 2) : WSP(bf16, WS_WCIN + (size_t)jj * CIN * D * 2);
            pg8::Gemm g{WSP(bf16, WS_HN), Bt, T, N, D}; pg8::StaticOrder S_; S_.init(T, N, G, (int)blockIdx.x);
            pg8::EpiBf16Ro E{WSP(bf16, WS_PROJ), N, ab ? nullptr : WSP(const float, WS_LAM) + 16, S};
            pg8::gemm_phase<pg8::EpiBf16Ro, pg8::StaticOrder, true, true>(lds, g, S_, E, HWTID);
        }
        xcd_barrier(bar, HWTID);
        int pp_first = (int)blockIdx.x, pp_stride = G; bool pp_run = true;
        if ((layer & 1) == 0) {
            {
                constexpr int NU = NSEQ * NH * (S / 64);
                for (int u = (int)blockIdx.x; u < NU; u += G) dn::dn1_unit(p, jj, u / (NH * (S / 64)), (u / (S / 64)) % NH, u % (S / 64), (char*)lds_raw, HWTID);
            }
            xcd_barrier(bar, HWTID);
            constexpr int NSC = NSEQ * NH * 2; const bool split = G >= 2 * NSC; const int na_first = split ? (int)blockIdx.x - NSC : (int)blockIdx.x, na_stride = split ? G - NSC : G;
            if (!split || (int)blockIdx.x < NSC) { for (int ch = (int)blockIdx.x; ch < NSC; ch += G) dn::dn_scan_chain(p, ch, (char*)lds_raw, HWTID); }
            if (!split || (int)blockIdx.x >= NSC)
            {
                constexpr int NU = NSEQ * NH * (ROWS / 4);
                float* tab = (float*)((char*)lds_raw + att::SHM_ATTN);
                for (int u = na_first; u < NU; u += na_stride) {
                    const int rg = u % (ROWS / 4); const int hh = (u / (ROWS / 4)) % NH, seq = u / ((ROWS / 4) * NH); const int r0 = rg * 4;
                    const int kr0 = clampi(r0 - WR / 2, 0, ROWS - WR), krl = clampi(r0 + 3 - WR / 2, 0, ROWS - WR) + WR - 1; const int nt = krl - kr0 + 1;
                    { int t_ = HWTID; asm volatile("" : "+v"(t_)); if (t_ < 15 * 31) tab[t_] = PRM(PR_RPB)[((size_t)jj * NH + hh) * 15 * 31 + t_] * 11.313708498984761f; }
                    const bf16* base = WSP(bf16, WS_PROJ) + (size_t)seq * S * ABINP;
                    att::na_body<ABINP, ABINP, ABMIX>(base + (size_t)r0 * GW * ABINP + COL_QB + hh * DH, base + (size_t)kr0 * GW * ABINP + COL_KB + hh * DH, base + (size_t)kr0 * GW * ABINP + COL_VB + hh * DH,
                        WSP(bf16, WS_MIXIN) + ((size_t)seq * S + (size_t)r0 * GW) * ABMIX + 1024 + hh * DH, nt, (char*)lds_raw, att::NaInfo{r0, kr0, tab}, HWTID);
                    __syncthreads();
                }
            }
            pp_first = na_first; pp_stride = na_stride; pp_run = !split || (int)blockIdx.x >= NSC;
        } else {
            {
                constexpr int NU = NSEQ * NH * (S / 256);
                const int vcu = (G % 8 == 0) ? ((int)blockIdx.x % 8) * (G / 8) + (int)blockIdx.x / 8 : (int)blockIdx.x;
                const float lam = WSP(float, WS_LAM)[2 * jj], li = WSP(float, WS_LAM)[2 * jj + 1];
                for (int u = vcu; u < NU; u += G) {
                    const int qb = u % (S / 256); const int r_ = u / (S / 256); const int hh = r_ % NH, seq = r_ / NH;
                    const bf16* base = WSP(bf16, WS_PROJ) + (size_t)seq * S * CIN; const size_t oo = ((size_t)seq * S + (size_t)qb * 256) * 2048 + hh * 256;
#pragma unroll 1
                    for (int jj2 = 0; jj2 < 2; ++jj2) {
                        att::dattn256_body<CIN, CIN, 2048>(base + (size_t)qb * 256 * CIN + hh * 256 + jj2 * DH, base + 2048 + hh * 256 + jj2 * DH, base + 4096 + hh * 256,
                            WSP(bf16, WS_O0) + oo, S / 64, (char*)lds_raw, HWTID, jj2, WSP(bf16, WS_MIXIN) + oo, lam, 1.0f - li, PRM(PR_SUBLN) + jj * 256);
                        __syncthreads();
                    }
                }
            }
        }
        if (pp_run) {
            pg8::Gemm g{WSP(bf16, WS_PB + (size_t)layer * SZ_PB), WSP(bf16, WS_WPP + (size_t)layer * D * PLE * 2), T, D, PLE}; pg8::StaticOrder S_; S_.init(T, D, pp_stride, pp_first);
            pg8::EpiBf16 E{WSP(bf16, WS_PP2), D};
            pg8::gemm_phase<pg8::EpiBf16, pg8::StaticOrder, true, true>(lds, g, S_, E, HWTID);
        }
        xcd_barrier(bar, HWTID);
        if ((layer & 1) == 0) { dn_out_phase(p, jj, gw, ngw, lane); xcd_barrier(bar, HWTID); }
        {
            const bf16* Bt = (layer & 1) == 0 ? WSP(bf16, WS_WABOUT + (size_t)jj * D * ABMIX * 2) : WSP(bf16, WS_WCOUT + (size_t)jj * D * CV * 2);
            pg8::Gemm g{WSP(bf16, WS_MIXIN), Bt, T, D, 2048}; pg8::StaticOrder S_; S_.init(T, D, G, (int)blockIdx.x);
            pg8::EpiBf16 E{WSP(bf16, WS_GOUT), D};
            pg8::gemm_phase<pg8::EpiBf16, pg8::StaticOrder, true, true>(lds, g, S_, E, HWTID);
        }
        xcd_barrier(bar, HWTID);
        row_phase<1>(p, nw + D, nw + 2 * D, gw, ngw, lane);
        xcd_barrier(bar, HWTID);
        {
            pg8::Gemm g{WSP(bf16, WS_HN), WSP(bf16, WS_WFIN + (size_t)layer * 2 * DFF * D * 2), T, 2 * DFF, D}; pg8::StaticOrder S_; S_.init(T, 2 * DFF, G, (int)blockIdx.x);
            pg8::EpiConvAct E{WSP(bf16, WS_ACT), WSP(float, WS_HALO), WSP(float, WS_HALO) + (size_t)(T / 256) * 4 * 2 * DFF + 4096 * (int)blockIdx.x, PRM(PR_FCW) + (size_t)layer * 3 * 2 * DFF, PRM(PR_FCB) + (size_t)layer * 2 * DFF, (PG8_LAS float*)(lds + RING_BYTES)};
            pg8::gemm_phase<pg8::EpiConvAct, pg8::StaticOrder, true, true>(lds, g, S_, E, HWTID);
        }
        xcd_barrier(bar, HWTID);
        ffn_fix_phase(p, layer, HWTID);
        xcd_barrier(bar, HWTID);
        {
            pg8::Gemm g{WSP(bf16, WS_ACT), WSP(bf16, WS_WFOUT + (size_t)layer * D * DFF * 2), T, D, DFF}; pg8::StaticOrder S_; S_.init(T, D, G, (int)blockIdx.x);
            pg8::EpiBf16 E{WSP(bf16, WS_GOUT), D};
            pg8::gemm_phase<pg8::EpiBf16, pg8::StaticOrder, true, true>(lds, g, S_, E, HWTID);
        }
        xcd_barrier(bar, HWTID);
        row_phase<2>(p, nw + 3 * D, nullptr, gw, ngw, lane);
        xcd_barrier(bar, HWTID);
        {
            pg8::Gemm g{WSP(bf16, WS_H16), WSP(bf16, WS_WPG + (size_t)layer * D * D * 2), T, D, D}; pg8::StaticOrder S_; S_.init(T, D, G, (int)blockIdx.x);
            pg8::EpiBf16 E{WSP(bf16, WS_GOUT), D};
            pg8::gemm_phase<pg8::EpiBf16, pg8::StaticOrder, true, true>(lds, g, S_, E, HWTID);
        }
        xcd_barrier(bar, HWTID);
        row_phase<3>(p, nullptr, layer + 1 < DEPTH ? PRM(PR_NORMS) + (size_t)(layer + 1) * 4 * D : nullptr, gw, ngw, lane);
        if (layer + 1 < DEPTH) xcd_barrier(bar, HWTID);
    }
}

#undef lane
#undef HWTID
#undef HWLANE
extern "C" void kernel_launch(void* const* d_in, const int* in_sizes, int n_in, void* d_out, int out_size, void* d_ws, size_t ws_size, hipStream_t stream) {
    static int grid = 0;
    if (grid == 0) {
        if (n_in != 22 || out_size != T * D || ws_size < WS_END) { fprintf(stderr, "kernel_launch: unexpected shapes n_in %d out %d ws %zu (need %zu)\n", n_in, out_size, ws_size, (size_t)WS_END); grid = -1; return; }
        int dev = 0, cus = 0, per_cu = 0;
        if (hipGetDevice(&dev) != hipSuccess || hipDeviceGetAttribute(&cus, hipDeviceAttributeMultiprocessorCount, dev) != hipSuccess) { grid = -1; return; }
        if (hipFuncSetAttribute((const void*)mega_fwd, hipFuncAttributeMaxDynamicSharedMemorySize, LDS_BYTES) != hipSuccess) { fprintf(stderr, "kernel_launch: hipFuncSetAttribute failed\n"); grid = -1; return; }
        if (hipOccupancyMaxActiveBlocksPerMultiprocessor(&per_cu, (const void*)mega_fwd, NTHR, LDS_BYTES) != hipSuccess || per_cu < 1) fprintf(stderr, "kernel_launch: occupancy query reports %d blocks per CU\n", per_cu);
        (void)hipGetLastError();
        grid = cus;
    }
    if (grid < 0) return;
    if (hipMemsetAsync((char*)d_ws + WS_CTL, 0, CTL_ZERO_BYTES, stream) != hipSuccess) { fprintf(stderr, "kernel_launch: memset failed\n"); return; }
    Args a; memset(&a, 0, sizeof(a));
    const float** f = (const float**)&a.p;
    for (int i = 0; i < 22; ++i) f[i] = (const float*)d_in[i];
    a.p.h = (float*)d_out; a.p.ws = (unsigned char*)d_ws;
    hipLaunchKernelGGL(mega_fwd, dim3(grid), dim3(NTHR), LDS_BYTES, stream, a);
    const hipError_t le = hipPeekAtLastError();
    if (le != hipSuccess) fprintf(stderr, "kernel_launch: launch failed: %s\n", hipGetErrorName(le));
}
#else
int main(int argc, char** argv) {
    FILE* fs = fopen("sizes.txt", "r"); std::vector<long> sizes(22); for (int i = 0; i < 22; ++i) if (fscanf(fs, "%ld", &sizes[i]) != 1) return 1; fclose(fs);
    FILE* fi = fopen("inputs.bin", "rb"); std::vector<std::vector<float>> in(22);
    for (int i = 0; i < 22; ++i) { in[i].resize(sizes[i]); if (fread(in[i].data(), 4, sizes[i], fi) != (size_t)sizes[i]) return 2; } fclose(fi);
    std::vector<float> out((size_t)T * D); std::vector<unsigned char> ws(WS_END, 0xAA);
    printf("T %d D %d WS_END %zu MiB\n", T, D, (size_t)(WS_END / MiB));
    P p; memset(&p, 0, sizeof(p)); const float** f = (const float**)&p; for (int i = 0; i < 22; ++i) f[i] = in[i].data();
    p.h = out.data(); p.ws = ws.data();
    forward(p);
    FILE* fo = fopen("emu_out.bin", "wb"); fwrite(out.data(), 4, out.size(), fo); fclose(fo);
    return 0;
}
#endif
```
